# Optimizing an MI355X kernel written in HIP

```python
import math
import jax, jax.numpy as jnp
from jax import lax
import numpy as np

D_MODEL = 1024
BATCH = 2
SEQ = 8192
DEPTH = 2
DEC_BATCH = 32
DEC_SEQ = 1
PAST_LEN = 8192
PAGE_SIZE = 128

N_EVEN = (DEPTH + 1) // 2
N_ODD = DEPTH // 2
MOBA_HEADS = 8
MOBA_HEAD_DIM = 64
MOBA_WIDTH = MOBA_HEADS * MOBA_HEAD_DIM
MOBA_BLOCK = 256
MOBA_TOPK = 3
MOBA_QUERY_BLOCK = 64
MOBA_SCALE = MOBA_HEAD_DIM ** -0.5
CONV_CH = D_MODEL // 2
CONV_WIDTH = 31
EVEN_IN = 3 * MOBA_WIDTH + 2 * CONV_CH
EVEN_MIX = MOBA_WIDTH + CONV_CH
HGRN_HEADS = 8
HGRN_DK = D_MODEL // HGRN_HEADS
HGRN_DV = D_MODEL // HGRN_HEADS
HGRN_KW = HGRN_HEADS * HGRN_DK
HGRN_VW = HGRN_HEADS * HGRN_DV
ODD_IN = 2 * HGRN_KW + 2 * HGRN_VW
HGRN_CHUNK = 64
PEER_HEADS = 8
PEER_NKEYS = 128
PEER_EXPERTS = PEER_NKEYS * PEER_NKEYS
PEER_DKEY = 256
PEER_DHALF = PEER_DKEY // 2
PEER_TOPK = 16
PEER_TOKEN_BLOCK = 256
LN_EPS = 1e-5
RMS_EPS = 1e-6
DN_ALPHA = (2 * DEPTH) ** 0.25
DN_BETA = (8 * DEPTH) ** -0.25

kernel_name = 'hybrid_moba_conformer_hgrn2_peer_step'


def layer_norm(x, g, b):
    xf = x.astype(jnp.float32)
    mu = xf.mean(-1, keepdims=True)
    var = jnp.mean(jnp.square(xf - mu), -1, keepdims=True)
    y = (xf - mu) * lax.rsqrt(var + LN_EPS) * g.astype(jnp.float32) + b.astype(jnp.float32)
    return y.astype(x.dtype)


def conformer_conv(a, gate, buf, w, b, ln_g, ln_b):
    u = a * jax.nn.sigmoid(gate)
    ext = jnp.concatenate([buf.astype(u.dtype), u], axis=1)
    y = lax.conv_general_dilated(ext, w[:, None, :].astype(u.dtype), (1,), 'VALID',
                                 dimension_numbers=('NWC', 'WIO', 'NWC'),
                                 feature_group_count=CONV_CH) + b
    y = layer_norm(y, ln_g, ln_b)
    return y * jax.nn.sigmoid(y), ext[:, -(CONV_WIDTH - 1):]


def moba_core(q, qpos, kmean, gather):
    bq, nq, nh, _ = q.shape
    nb = kmean.shape[1]
    if nb < MOBA_TOPK:
        kmean = jnp.pad(kmean, ((0, 0), (0, MOBA_TOPK - nb), (0, 0), (0, 0)))
        nb = MOBA_TOPK
    qf = q.astype(jnp.float32)
    own = qpos // MOBA_BLOCK
    gate = jnp.einsum('bqhd,bnhd->bqhn', qf, kmean)
    cand = jnp.arange(nb)[None, :] < own[:, None]
    gate = jnp.where(cand[None, :, None, :], gate, -jnp.inf)
    _, top = lax.top_k(gate, MOBA_TOPK)
    valid = jnp.arange(MOBA_TOPK)[None, :] < own[:, None]
    own_b = jnp.broadcast_to(own[None, :, None, None], (bq, nq, nh, 1)).astype(top.dtype)
    blk = jnp.concatenate([jnp.where(valid[None, :, None, :], top, own_b), own_b], -1)
    k, v = gather(blk)
    logits = jnp.einsum('bqhd,bqhtkd->bqhtk', qf, k.astype(jnp.float32)) * MOBA_SCALE
    kpos = blk[..., None] * MOBA_BLOCK + jnp.arange(MOBA_BLOCK, dtype=blk.dtype)
    slot_ok = jnp.concatenate([valid, jnp.ones((nq, 1), bool)], -1)
    mask = slot_ok[None, :, None, :, None] & (kpos <= qpos[None, :, None, None, None])
    logits = jnp.where(mask, logits, -jnp.inf)
    p = jax.nn.softmax(logits.reshape(bq, nq, nh, -1), axis=-1).reshape(logits.shape)
    out = jnp.einsum('bqhtk,bqhtkd->bqhd', p, v.astype(jnp.float32))
    return out.astype(q.dtype)


def moba_prompt(q, k, v):
    bx, s, nh, hd = q.shape
    s_pad = -(-s // MOBA_BLOCK) * MOBA_BLOCK
    nb = s_pad // MOBA_BLOCK
    padw = ((0, 0), (0, s_pad - s), (0, 0), (0, 0))
    kb = jnp.pad(k, padw).reshape(bx, nb, MOBA_BLOCK, nh, hd)
    vb = jnp.pad(v, padw).reshape(bx, nb, MOBA_BLOCK, nh, hd)
    kmean = kb.astype(jnp.float32).mean(axis=2)
    kbt = kb.transpose(0, 3, 1, 2, 4)
    vbt = vb.transpose(0, 3, 1, 2, 4)
    bidx = jnp.arange(bx)[:, None, None, None]
    hidx = jnp.arange(nh)[None, None, :, None]

    def gather(blk):
        return kbt[bidx, hidx, blk], vbt[bidx, hidx, blk]

    nqb = s // MOBA_QUERY_BLOCK
    qb = q.reshape(bx, nqb, MOBA_QUERY_BLOCK, nh, hd).transpose(1, 0, 2, 3, 4)
    pos = jnp.arange(s, dtype=jnp.int32).reshape(nqb, MOBA_QUERY_BLOCK)
    out = lax.map(lambda qp: moba_core(qp[0], qp[1], kmean, gather), (qb, pos))
    return out.transpose(1, 0, 2, 3, 4).reshape(bx, s, nh, hd)


def moba_sample(q, k_new, v_new, k_pool, v_pool, page_table):
    db, L, nh, hd = q.shape
    n_pages = page_table.shape[1]
    past = n_pages * PAGE_SIZE
    total = past + L
    t_pad = -(-total // MOBA_BLOCK) * MOBA_BLOCK
    k_past = k_pool[page_table].reshape(db, past, nh, hd)
    k_all = jnp.concatenate([k_past, k_new.astype(k_past.dtype)], axis=1)
    k_all = jnp.pad(k_all, ((0, 0), (0, t_pad - total), (0, 0), (0, 0)))
    kmean = k_all.astype(jnp.float32).reshape(db, t_pad // MOBA_BLOCK, MOBA_BLOCK, nh, hd).mean(axis=2)
    bidx = jnp.arange(db)[:, None, None, None, None]
    hidx = jnp.arange(nh)[None, None, :, None, None]

    def rows(pool, new, pos):
        phys = page_table[bidx, jnp.clip(pos // PAGE_SIZE, 0, n_pages - 1)]
        from_past = pool[phys, pos % PAGE_SIZE, hidx]
        from_new = new.astype(pool.dtype)[bidx, jnp.clip(pos - past, 0, L - 1), hidx]
        return jnp.where((pos < past)[..., None], from_past, from_new)

    def gather(blk):
        pos = blk[..., None] * MOBA_BLOCK + jnp.arange(MOBA_BLOCK, dtype=blk.dtype)
        return rows(k_pool, k_new, pos), rows(v_pool, v_new, pos)

    qpos = past + jnp.arange(L, dtype=jnp.int32)
    return moba_core(q, qpos, kmean, gather)


def even_mixer(x, w_in, w_out, conv_w, conv_b, cln_g, cln_b, buf, attend):
    bx, L, _ = x.shape
    h = x @ w_in
    q, k, v, a, gt = jnp.split(h, [MOBA_WIDTH, 2 * MOBA_WIDTH, 3 * MOBA_WIDTH,
                                   3 * MOBA_WIDTH + CONV_CH], axis=-1)
    heads = lambda t: t.reshape(bx, L, MOBA_HEADS, MOBA_HEAD_DIM)
    q, k, v = heads(q), heads(k), heads(v)
    att = attend(q, k, v).reshape(bx, L, MOBA_WIDTH)
    cy, new_buf = conformer_conv(a, gt, buf, conv_w, conv_b, cln_g, cln_b)
    y = jnp.concatenate([att, cy.astype(att.dtype)], axis=-1) @ w_out
    return y, k, v, new_buf


def hgrn_chunked(q, k, logf, i):
    bx, s, nh, dk = q.shape
    dv = i.shape[-1]
    nc = s // HGRN_CHUNK
    chunks = lambda t: t.reshape(bx, nc, HGRN_CHUNK, nh, t.shape[-1]).transpose(1, 0, 3, 2, 4)
    causal = jnp.tril(jnp.ones((HGRN_CHUNK, HGRN_CHUNK), bool))

    def step(state, inp):
        qc, kc, lc, ic = inp
        b = jnp.cumsum(lc, axis=2)
        diff = b[:, :, :, None, :] - b[:, :, None, :, :]
        decay = jnp.exp(jnp.where(causal[:, :, None], diff, -jnp.inf))
        att = jnp.einsum('bhtk,bhsk,bhtsk->bhts', qc, kc, decay)
        o = att @ ic + jnp.einsum('bhtk,bhkv->bhtv', qc * jnp.exp(b), state)
        b_last = b[:, :, -1, :]
        state = jnp.exp(b_last)[..., None] * state + jnp.einsum(
            'bhsk,bhsv->bhkv', kc * jnp.exp(b_last[:, :, None, :] - b), ic)
        return state, o

    s0 = jnp.zeros((bx, nh, dk, dv), jnp.float32)
    sf, o = lax.scan(step, s0, (chunks(q), chunks(k), chunks(logf), chunks(i)))
    return o.transpose(1, 0, 3, 2, 4).reshape(bx, s, nh, dv), sf


def hgrn_stepwise(q, k, logf, i, state):
    tm = lambda t: t.transpose(1, 0, 2, 3)

    def step(st, inp):
        qt, kt, lt, it = inp
        st = jnp.exp(lt)[..., None] * st + kt[..., None] * it[..., None, :]
        return st, jnp.einsum('bhk,bhkv->bhv', qt, st)

    sf, o = lax.scan(step, state, (tm(q), tm(k), tm(logf), tm(i)))
    return o.transpose(1, 0, 2, 3), sf


def odd_mixer(x, w_in, w_out, norm_g, lb, recur):
    bx, L, _ = x.shape
    h = x @ w_in
    q, fz, i, g = jnp.split(h, [HGRN_KW, 2 * HGRN_KW, 2 * HGRN_KW + HGRN_VW], axis=-1)
    f = lb + (1.0 - lb) * jax.nn.sigmoid(fz.astype(jnp.float32))
    heads = lambda t, d: t.astype(jnp.float32).reshape(bx, L, HGRN_HEADS, d)
    o, st = recur(heads(q, HGRN_DK), heads(1.0 - f, HGRN_DK), heads(jnp.log(f), HGRN_DK),
                  heads(i, HGRN_DV))
    o = o * lax.rsqrt(jnp.mean(o * o, -1, keepdims=True) + RMS_EPS) * norm_g.astype(jnp.float32)
    o = o.reshape(bx, L, HGRN_VW) * jax.nn.silu(g.astype(jnp.float32))
    return o.astype(x.dtype) @ w_out, st.astype(x.dtype)


def peer(x, wq, keys, u, v):
    t = x.shape[0]
    blk = min(PEER_TOKEN_BLOCK, t)
    pad = (-t) % blk
    xb = jnp.pad(x, ((0, pad), (0, 0))).reshape(-1, blk, D_MODEL)
    k1 = keys[0].astype(jnp.float32)
    k2 = keys[1].astype(jnp.float32)

    def one(xt):
        qh = (xt @ wq).astype(jnp.float32).reshape(blk, PEER_HEADS, 2, PEER_DHALF)
        s1 = jnp.einsum('thd,hnd->thn', qh[:, :, 0], k1)
        s2 = jnp.einsum('thd,hnd->thn', qh[:, :, 1], k2)
        v1, i1 = lax.top_k(s1, PEER_TOPK)
        v2, i2 = lax.top_k(s2, PEER_TOPK)
        cand = (v1[..., :, None] + v2[..., None, :]).reshape(blk, PEER_HEADS, -1)
        cidx = (i1[..., :, None] * PEER_NKEYS + i2[..., None, :]).reshape(blk, PEER_HEADS, -1)
        sc, j = lax.top_k(cand, PEER_TOPK)
        e = jnp.take_along_axis(cidx, j, axis=-1)
        g = jax.nn.softmax(sc, axis=-1)
        act = jax.nn.gelu(jnp.einsum('td,thkd->thk', xt, u[e]).astype(jnp.float32), approximate=False)
        return jnp.einsum('thk,thkd->td', (g * act).astype(xt.dtype), v[e])

    return lax.map(one, xb).reshape(-1, D_MODEL)[:t]


def setup_inputs(seed: int = 0) -> dict:
    key = jax.random.key(seed)
    ks = jax.random.split(key, 24)
    n_pages = PAST_LEN // PAGE_SIZE
    used = DEC_BATCH * n_pages
    n_pool = used + max(1, used // 4)
    nrm = lambda k, shape, s: jax.random.normal(k, shape, jnp.float32) * s
    kv_shape = (N_EVEN, n_pool, PAGE_SIZE, MOBA_HEADS, MOBA_HEAD_DIM)
    page_table = jax.random.permutation(ks[6], n_pool)[:used].reshape(DEC_BATCH, n_pages).astype(jnp.int32)
    return {
        'x_prompt': nrm(ks[0], (BATCH, SEQ, D_MODEL), 1.0),
        'x_sample': nrm(ks[1], (DEC_BATCH, DEC_SEQ, D_MODEL), 1.0),
        'cache_k': nrm(ks[2], kv_shape, 1.0),
        'cache_v': nrm(ks[3], kv_shape, 1.0),
        'state_conv': nrm(ks[4], (N_EVEN, DEC_BATCH, CONV_WIDTH - 1, CONV_CH), 0.5),
        'state_hgrn': nrm(ks[5], (N_ODD, DEC_BATCH, HGRN_HEADS, HGRN_DK, HGRN_DV), 0.5),
        'page_table': page_table,
        'w_in_even': nrm(ks[7], (N_EVEN, D_MODEL, EVEN_IN), D_MODEL ** -0.5),
        'conv_w': nrm(ks[8], (N_EVEN, CONV_WIDTH, CONV_CH), CONV_WIDTH ** -0.5),
        'conv_b': nrm(ks[9], (N_EVEN, CONV_CH), 0.01),
        'conv_ln_g': 1.0 + nrm(ks[10], (N_EVEN, CONV_CH), 0.01),
        'conv_ln_b': nrm(ks[11], (N_EVEN, CONV_CH), 0.01),
        'w_out_even': nrm(ks[12], (N_EVEN, EVEN_MIX, D_MODEL), EVEN_MIX ** -0.5 * DN_BETA),
        'w_in_odd': nrm(ks[13], (N_ODD, D_MODEL, ODD_IN), D_MODEL ** -0.5),
        'hgrn_lb_logits': nrm(ks[14], (DEPTH, HGRN_KW), 0.5),
        'hgrn_norm_g': 1.0 + nrm(ks[15], (N_ODD, HGRN_HEADS, HGRN_DV), 0.01),
        'w_out_odd': nrm(ks[16], (N_ODD, HGRN_VW, D_MODEL), HGRN_VW ** -0.5 * DN_BETA),
        'ln_g': 1.0 + nrm(ks[17], (DEPTH, 2, D_MODEL), 0.01),
        'ln_b': nrm(ks[18], (DEPTH, 2, D_MODEL), 0.01),
        'peer_wq': nrm(ks[19], (DEPTH, D_MODEL, PEER_HEADS * PEER_DKEY), D_MODEL ** -0.5),
        'peer_keys': nrm(ks[20], (DEPTH, 2, PEER_HEADS, PEER_NKEYS, PEER_DHALF), PEER_DHALF ** -0.5),
        'peer_u': nrm(ks[21], (DEPTH, PEER_EXPERTS, D_MODEL), D_MODEL ** -0.5),
        'peer_v': nrm(ks[22], (DEPTH, PEER_EXPERTS, D_MODEL), DN_BETA * PEER_HEADS ** -0.5),
    }


def reference(x_prompt, x_sample, cache_k, cache_v, state_conv, state_hgrn, page_table,
              w_in_even, conv_w, conv_b, conv_ln_g, conv_ln_b, w_out_even,
              w_in_odd, hgrn_lb_logits, hgrn_norm_g, w_out_odd,
              ln_g, ln_b, peer_wq, peer_keys, peer_u, peer_v):
    lb_p = jax.nn.softmax(hgrn_lb_logits.astype(jnp.float32), axis=0)
    lb_all = jnp.cumsum(lb_p, axis=0) - lb_p[0]
    xp, xs = x_prompt, x_sample
    kp_l, vp_l, ks_l, vs_l, cp_l, cs_l, hp_l, hs_l = [], [], [], [], [], [], [], []
    for l in range(DEPTH):
        if l % 2 == 0:
            e = l // 2
            prm = (w_in_even[e], w_out_even[e], conv_w[e], conv_b[e], conv_ln_g[e], conv_ln_b[e])
            zero_buf = jnp.zeros((xp.shape[0], CONV_WIDTH - 1, CONV_CH), xp.dtype)
            mp, kp, vp, bp = even_mixer(xp, *prm, zero_buf, moba_prompt)
            ck, cv = cache_k[e], cache_v[e]
            ms, kn, vn, bs = even_mixer(
                xs, *prm, state_conv[e],
                lambda q, k, v: moba_sample(q, k, v, ck, cv, page_table))
            kp_l.append(kp.reshape(kp.shape[0], -1, PAGE_SIZE, MOBA_HEADS, MOBA_HEAD_DIM))
            vp_l.append(vp.reshape(vp.shape[0], -1, PAGE_SIZE, MOBA_HEADS, MOBA_HEAD_DIM))
            ks_l.append(kn)
            vs_l.append(vn)
            cp_l.append(bp)
            cs_l.append(bs)
        else:
            oi = l // 2
            prm = (w_in_odd[oi], w_out_odd[oi], hgrn_norm_g[oi], lb_all[l])
            mp, sp = odd_mixer(xp, *prm, hgrn_chunked)
            st0 = state_hgrn[oi].astype(jnp.float32)
            ms, ss = odd_mixer(xs, *prm, lambda q, k, lf, i: hgrn_stepwise(q, k, lf, i, st0))
            hp_l.append(sp)
            hs_l.append(ss)
        xp = layer_norm(DN_ALPHA * xp + mp, ln_g[l, 0], ln_b[l, 0])
        xs = layer_norm(DN_ALPHA * xs + ms, ln_g[l, 0], ln_b[l, 0])
        cprm = (peer_wq[l], peer_keys[l], peer_u[l], peer_v[l])
        fp = peer(xp.reshape(-1, D_MODEL), *cprm).reshape(xp.shape)
        fs = peer(xs.reshape(-1, D_MODEL), *cprm).reshape(xs.shape)
        xp = layer_norm(DN_ALPHA * xp + fp, ln_g[l, 1], ln_b[l, 1])
        xs = layer_norm(DN_ALPHA * xs + fs, ln_g[l, 1], ln_b[l, 1])
    return (xp, xs, jnp.stack(kp_l), jnp.stack(vp_l), jnp.stack(ks_l), jnp.stack(vs_l),
            jnp.stack(cp_l), jnp.stack(cs_l), jnp.stack(hp_l), jnp.stack(hs_l))
```

```cpp
#include <hip/hip_runtime.h>
#include <stdint.h>
#include <stdio.h>

#define DI __device__ __forceinline__
typedef unsigned short bf16_t;
typedef short bf16x8 __attribute__((ext_vector_type(8)));
typedef float f32x4 __attribute__((ext_vector_type(4)));
typedef unsigned u32x4 __attribute__((ext_vector_type(4)));
typedef unsigned u32x2 __attribute__((ext_vector_type(2)));

constexpr int NT = 512;
constexpr int TP = 16384, TS = 32, TT = TP + TS, MP = 16640, DM = 1024, SEQ = 8192;
constexpr float DN_ALPHA = 1.4142135623730951f;
constexpr float LN_EPS = 1e-5f, RMS_EPS = 1e-6f;
constexpr size_t OFF_KP = (size_t)TT * DM, OFF_VP = OFF_KP + (size_t)TP * 512, OFF_KS = OFF_VP + (size_t)TP * 512, OFF_VS = OFF_KS + (size_t)TS * 512;

DI float bf2f(bf16_t h) { return __uint_as_float(((unsigned)h) << 16); }
typedef __bf16 bf16x2_t __attribute__((ext_vector_type(2)));
DI unsigned pack_bf2(float lo, float hi) { bf16x2_t v; v[0] = (__bf16)lo; v[1] = (__bf16)hi; return __builtin_bit_cast(unsigned, v); }
DI bf16_t f2bf(float x) { return (bf16_t)(pack_bf2(x, 0.f) & 0xffffu); }
DI float bflo(unsigned u) { return __uint_as_float(u << 16); }
DI float bfhi(unsigned u) { return __uint_as_float(u & 0xffff0000u); }
DI float sigmoidf_(float x) { return 1.f / (1.f + __expf(-x)); }
DI float wave_sum(float v) {
#pragma unroll
    for (int o = 32; o >= 1; o >>= 1) v += __shfl_xor(v, o, 64);
    return v;
}
DI float wave_max(float v) {
#pragma unroll
    for (int o = 32; o >= 1; o >>= 1) v = fmaxf(v, __shfl_xor(v, o, 64));
    return v;
}
#define MFMA16(a, b, c) __builtin_amdgcn_mfma_f32_16x16x32_bf16((a), (b), (c), 0, 0, 0)

struct Params {
    const float* x_prompt; const float* x_sample; const float* cache_k; const float* cache_v;
    const float* state_conv; const float* state_hgrn; const int* page_table;
    const float* w_in_even; const float* conv_w; const float* conv_b; const float* conv_ln_g; const float* conv_ln_b;
    const float* w_out_even; const float* w_in_odd; const float* lb_logits; const float* hgrn_norm_g; const float* w_out_odd;
    const float* ln_g; const float* ln_b; const float* peer_wq; const float* peer_keys; const float* peer_u; const float* peer_v;
    float* y_prompt; float* y_sample; float* k_prompt; float* v_prompt; float* k_sample; float* v_sample;
    float* conv_prompt; float* conv_sample; float* hgrn_prompt; float* hgrn_sample;
    unsigned* bar; float* LB;
    bf16_t* WT_IN_EVEN; bf16_t* WT_OUT_EVEN; bf16_t* WT_IN_ODD; bf16_t* WT_OUT_ODD; bf16_t* WT_WQ; bf16_t* KB;
    bf16_t* UB; bf16_t* VB;
    bf16_t* XB; float* XF; bf16_t* H; float* LF; bf16_t* VT; bf16_t* KMP; bf16_t* KMS;
    bf16_t* MIX; float* T; bf16_t* QH; float* S; int* E; float* G;
    float* UT; float* DEC; bf16_t* ST;
};

DI void transpose_unit(const float* __restrict__ W, int K, int N, bf16_t* __restrict__ Wt, int u, char* lds) {
    float* tile = (float*)lds;
    const int tid = threadIdx.x;
    const int ntn = N >> 6; const int kt = u / ntn, nt = u % ntn;
#pragma unroll
    for (int i = 0; i < 8; ++i) { int idx = tid + NT * i; int r = idx >> 6, c = idx & 63; tile[r * 65 + c] = W[(size_t)(kt * 64 + r) * N + nt * 64 + c]; }
    __syncthreads();
#pragma unroll
    for (int i = 0; i < 8; ++i) { int idx = tid + NT * i; int r = idx >> 6, c = idx & 63; Wt[(size_t)(nt * 64 + r) * K + kt * 64 + c] = f2bf(tile[c * 65 + r]); }
    __syncthreads();
}
DI void convert_range(const float* __restrict__ src, bf16_t* __restrict__ dst, size_t n4, int bid, int nb) {
    for (size_t i = (size_t)bid * NT + threadIdx.x; i < n4; i += (size_t)nb * NT) {
        f32x4 v = *(const f32x4*)(src + 4 * i);
        u32x2 o; o[0] = pack_bf2(v[0], v[1]); o[1] = pack_bf2(v[2], v[3]);
        *(u32x2*)(dst + 4 * i) = o;
    }
}
DI void convert_x(const Params& p, int bid, int nb) {
    const size_t n4 = (size_t)MP * DM / 4;
    for (size_t i = (size_t)bid * NT + threadIdx.x; i < n4; i += (size_t)nb * NT) {
        size_t e = 4 * i; int row = (int)(e >> 10); int col = (int)(e & 1023);
        f32x4 v = {0.f, 0.f, 0.f, 0.f};
        if (row < TP) v = *(const f32x4*)(p.x_prompt + e);
        else if (row < TT) v = *(const f32x4*)(p.x_sample + (size_t)(row - TP) * DM + col);
        *(f32x4*)(p.XF + e) = v;
        u32x2 o; o[0] = pack_bf2(v[0], v[1]); o[1] = pack_bf2(v[2], v[3]);
        *(u32x2*)(p.XB + e) = o;
    }
}
DI void convert_keys(const Params& p, int bid, int nb) {
    const int n = 2 * 2 * 8 * 128 * 128;
    for (int i = bid * NT + threadIdx.x; i < n; i += nb * NT) {
        int d = i & 127, nn = (i >> 7) & 127, j = (i >> 14) & 15, l = i >> 18;
        int h = j >> 1, half = j & 1;
        p.KB[i] = f2bf(p.peer_keys[((((size_t)l * 2 + half) * 8 + h) * 128 + nn) * 128 + d]);
    }
    if (bid == 0) for (int c = threadIdx.x; c < 1024; c += NT) p.LB[c] = sigmoidf_(p.lb_logits[1024 + c] - p.lb_logits[c]);
}
DI void kmean_sample_unit(const Params& p, int u) {
    const int b = u >> 5, blk = u & 31, c = threadIdx.x;
    float acc = 0.f;
#pragma unroll
    for (int pg = 0; pg < 2; ++pg) {
        const int page = p.page_table[b * 64 + blk * 2 + pg];
        const float* src = p.cache_k + (size_t)page * 128 * 512 + c;
#pragma unroll 16
        for (int r = 0; r < 128; ++r) acc += src[(size_t)r * 512];
    }
    p.KMS[(size_t)u * 512 + c] = f2bf(acc * (1.f / 256.f));
}
DI void kmean_prompt_unit(const Params& p, int u) {
    const int c = threadIdx.x;
    const float* src = p.k_prompt + (size_t)u * 256 * 512 + c;
    float acc = 0.f;
#pragma unroll 16
    for (int r = 0; r < 256; ++r) acc += src[(size_t)r * 512];
    p.KMP[(size_t)u * 512 + c] = f2bf(acc * (1.f / 256.f));
}

struct GemmArgs { const bf16_t* A; int lda; const bf16_t* Bt; int ldb; int K; int blockdiag; };
constexpr int GEMM_LDS = 2 * 49152;

template <class Epi>
DI void gemm_unit(const GemmArgs g, int m0, int n0, const Epi epi, char* lds) {
    const int tid = threadIdx.x, lane = tid & 63, w = tid >> 6;
    const int wm = w & 3, wn = w >> 2, lr = lane & 15, lg = lane >> 4;
    const int acol = g.blockdiag ? n0 : 0;
    const int nk = g.K >> 6;
    f32x4 acc[4][4];
#pragma unroll
    for (int i = 0; i < 4; ++i)
#pragma unroll
        for (int j = 0; j < 4; ++j) acc[i][j] = (f32x4){0.f, 0.f, 0.f, 0.f};
    u32x4 ra[4], rb[2];
    auto gload = [&](int kt) {
#pragma unroll
        for (int i = 0; i < 4; ++i) { int id = tid + NT * i; int r = id >> 3, c = id & 7; ra[i] = *(const u32x4*)(g.A + (size_t)(m0 + r) * g.lda + acol + kt * 64 + c * 8); }
#pragma unroll
        for (int i = 0; i < 2; ++i) { int id = tid + NT * i; int r = id >> 3, c = id & 7; rb[i] = *(const u32x4*)(g.Bt + (size_t)(n0 + r) * g.ldb + kt * 64 + c * 8); }
    };
    auto sstore = [&](int st) {
        char* base = lds + st * 49152;
#pragma unroll
        for (int i = 0; i < 4; ++i) { int id = tid + NT * i; int r = id >> 3, c = id & 7; *(u32x4*)(base + r * 128 + ((c ^ (r & 7)) << 4)) = ra[i]; }
#pragma unroll
        for (int i = 0; i < 2; ++i) { int id = tid + NT * i; int r = id >> 3, c = id & 7; *(u32x4*)(base + 32768 + r * 128 + ((c ^ (r & 7)) << 4)) = rb[i]; }
    };
    gload(0); sstore(0); __syncthreads();
    for (int kt = 0; kt < nk; ++kt) {
        if (kt + 1 < nk) gload(kt + 1);
        const char* base = lds + (kt & 1) * 49152;
#pragma unroll
        for (int ks = 0; ks < 2; ++ks) {
            bf16x8 af[4], bfr[4];
#pragma unroll
            for (int i = 0; i < 4; ++i) { int r = wm * 64 + i * 16 + lr; int ch = ks * 4 + lg; af[i] = *(const bf16x8*)(base + r * 128 + ((ch ^ (r & 7)) << 4)); }
#pragma unroll
            for (int i = 0; i < 4; ++i) { int r = wn * 64 + i * 16 + lr; int ch = ks * 4 + lg; bfr[i] = *(const bf16x8*)(base + 32768 + r * 128 + ((ch ^ (r & 7)) << 4)); }
#pragma unroll
            for (int i = 0; i < 4; ++i)
#pragma unroll
                for (int j = 0; j < 4; ++j) acc[i][j] = MFMA16(bfr[j], af[i], acc[i][j]);
        }
        if (kt + 1 < nk) sstore((kt + 1) & 1);
        __syncthreads();
    }
#pragma unroll
    for (int i = 0; i < 4; ++i)
#pragma unroll
        for (int j = 0; j < 4; ++j) epi(m0 + wm * 64 + i * 16 + lr, n0 + wn * 64 + j * 16 + 4 * lg, acc[i][j]);
}

template <class Epi>
DI void gemm_phase(const GemmArgs g, int M, int N, const Epi epi, char* lds, int bid, int nb) {
    const int tn = N >> 7, tm = M >> 8;
    for (int u = bid; u < tm * tn; u += nb) { int mt = u / tn, nt = u % tn; gemm_unit(g, mt * 256, nt * 128, epi, lds); }
}

DI void store_bf4(bf16_t* dst, f32x4 v) { u32x2 o; o[0] = pack_bf2(v[0], v[1]); o[1] = pack_bf2(v[2], v[3]); *(u32x2*)dst = o; }

struct EpiInEven {
    bf16_t* H; float* out; bf16_t* VT;
    DI void operator()(int row, int col, f32x4 v) const {
        store_bf4(H + (size_t)row * 2560 + col, v);
        if (col >= 512 && col < 1536 && row < TT) {
            const bool isv = col >= 1024; const int c = col - (isv ? 1024 : 512);
            const size_t off = row < TP ? (isv ? OFF_VP : OFF_KP) + (size_t)row * 512 + c : (isv ? OFF_VS : OFF_KS) + (size_t)(row - TP) * 512 + c;
            *(f32x4*)(out + off) = v;
            if (isv && row < TP) {
                const int b = row >> 13, s = row & 8191, h = c >> 6, d = c & 63;
                bf16_t* vt = VT + ((size_t)(b * 8 + h) * 64 + d) * 8192 + s;
#pragma unroll
                for (int i = 0; i < 4; ++i) vt[(size_t)i * 8192] = f2bf(v[i]);
            }
        }
    }
};
struct EpiBf16 { bf16_t* O; int ld; DI void operator()(int row, int col, f32x4 v) const { store_bf4(O + (size_t)row * ld + col, v); } };
struct EpiF32 { float* O; int ld; DI void operator()(int row, int col, f32x4 v) const { *(f32x4*)(O + (size_t)row * ld + col) = v; } };
struct EpiResid {
    float* T; const float* XF;
    DI void operator()(int row, int col, f32x4 v) const { f32x4 x = *(const f32x4*)(XF + (size_t)row * DM + col); *(f32x4*)(T + (size_t)row * DM + col) = x * DN_ALPHA + v; }
};
struct EpiInOdd {
    bf16_t* H; float* LF; const float* LB;
    DI void operator()(int row, int col, f32x4 v) const {
        const int sec = col >> 10, c = col & 1023;
        if (sec == 1) {
            f32x4 lb = *(const f32x4*)(LB + c); f32x4 lf, kk;
#pragma unroll
            for (int i = 0; i < 4; ++i) { float f = lb[i] + (1.f - lb[i]) * sigmoidf_(v[i]); lf[i] = __logf(f); kk[i] = 1.f - f; }
            *(f32x4*)(LF + (size_t)row * DM + c) = lf;
            store_bf4(H + (size_t)MP * DM + (size_t)row * DM + c, kk);
        } else {
            store_bf4(H + (size_t)sec * MP * DM + (size_t)row * DM + c, v);
        }
    }
};

DI void conv_unit(const Params& p, int u, char* lds) {
    float* sy = (float*)lds;
    const int c = threadIdx.x, lane = c & 63, w = c >> 6;
    float wj[31];
#pragma unroll
    for (int j = 0; j < 31; ++j) wj[j] = p.conv_w[j * 512 + c];
    const float bias = p.conv_b[c];
    int ntok, row0;
    if (u < 512) {
        const int b = u >> 8, t0 = (u & 255) * 32; ntok = 32; row0 = b * SEQ + t0;
        float uu[62];
#pragma unroll
        for (int r = 0; r < 62; ++r) {
            const int t = t0 - 30 + r; float val = 0.f;
            if (t >= 0) { const size_t row = (size_t)b * SEQ + t; float a = bf2f(p.H[row * 2560 + 1536 + c]); float g = bf2f(p.H[row * 2560 + 2048 + c]); val = a * sigmoidf_(g); }
            uu[r] = val;
            if (t0 == SEQ - 32 && r >= 32) p.conv_prompt[((size_t)b * 30 + (r - 32)) * 512 + c] = val;
        }
#pragma unroll
        for (int tt = 0; tt < 32; ++tt) {
            float acc = bias;
#pragma unroll
            for (int j = 0; j < 31; ++j) acc += wj[j] * uu[tt + j];
            sy[tt * 512 + c] = acc;
        }
    } else {
        const int b = u - 512; ntok = 1; row0 = TP + b;
        const size_t row = (size_t)row0;
        float a = bf2f(p.H[row * 2560 + 1536 + c]); float g = bf2f(p.H[row * 2560 + 2048 + c]);
        const float un = a * sigmoidf_(g);
        float acc = bias + wj[30] * un;
#pragma unroll
        for (int j = 0; j < 30; ++j) {
            float e = p.state_conv[((size_t)b * 30 + j) * 512 + c]; acc += wj[j] * e;
            if (j >= 1) p.conv_sample[((size_t)b * 30 + (j - 1)) * 512 + c] = e;
        }
        p.conv_sample[((size_t)b * 30 + 29) * 512 + c] = un;
        sy[c] = acc;
    }
    __syncthreads();
    for (int tt = w; tt < ntok; tt += 8) {
        float v[8]; float s = 0.f;
#pragma unroll
        for (int i = 0; i < 8; ++i) { v[i] = sy[tt * 512 + lane + 64 * i]; s += v[i]; }
        const float mu = wave_sum(s) * (1.f / 512.f);
        float q = 0.f;
#pragma unroll
        for (int i = 0; i < 8; ++i) { float d = v[i] - mu; q += d * d; }
        const float rs = rsqrtf(wave_sum(q) * (1.f / 512.f) + LN_EPS);
#pragma unroll
        for (int i = 0; i < 8; ++i) {
            const int cc = lane + 64 * i;
            float y = (v[i] - mu) * rs * p.conv_ln_g[cc] + p.conv_ln_b[cc];
            y = y * sigmoidf_(y);
            p.MIX[(size_t)(row0 + tt) * DM + 512 + cc] = f2bf(y);
        }
    }
    __syncthreads();
}

DI void moba_sample_unit(const Params& p, int u, char* lds) {
    float* sq = (float*)lds;
    float* gs = sq + 64;
    int* sel = (int*)(gs + 32);
    float* lg = (float*)(sel + 4);
    float* red = lg + 776;
    float* part = red + 16;
    const int tid = threadIdx.x, lane = tid & 63, w = tid >> 6;
    const int b = u >> 3, h = u & 7; const size_t row = (size_t)TP + b;
    if (tid < 64) sq[tid] = bf2f(p.H[row * 2560 + h * 64 + tid]);
    __syncthreads();
    if (tid < 32) { const bf16_t* km = p.KMS + ((size_t)b * 32 + tid) * 512 + h * 64; float s = 0.f;
#pragma unroll 8
        for (int d = 0; d < 64; ++d) s += sq[d] * bf2f(km[d]);
        gs[tid] = s; }
    __syncthreads();
    if (tid == 0) {
        float v0 = -INFINITY, v1 = -INFINITY, v2 = -INFINITY; int i0 = 0, i1 = 0, i2 = 0;
        for (int j = 0; j < 32; ++j) { float s = gs[j];
            if (s > v0) { v2 = v1; i2 = i1; v1 = v0; i1 = i0; v0 = s; i0 = j; }
            else if (s > v1) { v2 = v1; i2 = i1; v1 = s; i1 = j; }
            else if (s > v2) { v2 = s; i2 = j; } }
        sel[0] = i0; sel[1] = i1; sel[2] = i2;
    }
    __syncthreads();
    for (int idx = tid; idx < 769; idx += NT) {
        float s = 0.f;
        if (idx < 768) {
            const int blk = sel[idx >> 8]; const int pos = blk * 256 + (idx & 255);
            const int page = p.page_table[b * 64 + (pos >> 7)];
            const float* kp = p.cache_k + (((size_t)page * 128 + (pos & 127)) * 8 + h) * 64;
#pragma unroll
            for (int d4 = 0; d4 < 16; ++d4) { f32x4 kv = *(const f32x4*)(kp + 4 * d4); s += sq[4 * d4] * kv[0] + sq[4 * d4 + 1] * kv[1] + sq[4 * d4 + 2] * kv[2] + sq[4 * d4 + 3] * kv[3]; }
        } else {
            const bf16_t* kn = p.H + row * 2560 + 512 + h * 64;
            for (int d = 0; d < 64; ++d) s += sq[d] * bf2f(kn[d]);
        }
        lg[idx] = s * 0.125f;
    }
    __syncthreads();
    float mx = -INFINITY;
    for (int idx = tid; idx < 769; idx += NT) mx = fmaxf(mx, lg[idx]);
    mx = wave_max(mx); if (lane == 0) red[w] = mx;
    __syncthreads();
    mx = red[0];
#pragma unroll
    for (int i = 1; i < 8; ++i) mx = fmaxf(mx, red[i]);
    float sm = 0.f;
    for (int idx = tid; idx < 769; idx += NT) { float e = __expf(lg[idx] - mx); lg[idx] = e; sm += e; }
    sm = wave_sum(sm); if (lane == 0) red[8 + w] = sm;
    __syncthreads();
    sm = 0.f;
#pragma unroll
    for (int i = 0; i < 8; ++i) sm += red[8 + i];
    {
        const int d = lane; float acc = 0.f;
        for (int idx = w; idx < 769; idx += 8) {
            float vv;
            if (idx < 768) { const int blk = sel[idx >> 8]; const int pos = blk * 256 + (idx & 255);
                const int page = p.page_table[b * 64 + (pos >> 7)];
                vv = p.cache_v[(((size_t)page * 128 + (pos & 127)) * 8 + h) * 64 + d]; }
            else vv = bf2f(p.H[row * 2560 + 1024 + h * 64 + d]);
            acc += lg[idx] * vv;
        }
        part[w * 64 + d] = acc;
    }
    __syncthreads();
    if (tid < 64) { float a = 0.f;
#pragma unroll
        for (int i = 0; i < 8; ++i) a += part[i * 64 + tid];
        p.MIX[row * DM + h * 64 + tid] = f2bf(a / sm); }
    __syncthreads();
}

DI void moba_prompt_unit(const Params& p, int bh, int own, char* lds) {
    const int tid = threadIdx.x, lane = tid & 63, w = tid >> 6, lr = lane & 15, lg = lane >> 4;
    const int b = bh >> 3, h = bh & 7;
    float* gsc = (float*)lds + w * 1024;
    unsigned* msk = (unsigned*)(lds + 32768) + w * 36;
    const size_t rowq0 = (size_t)b * SEQ + own * 256 + w * 32;
    bf16x8 qf[2][2];
#pragma unroll
    for (int qt = 0; qt < 2; ++qt)
#pragma unroll
        for (int ks = 0; ks < 2; ++ks) qf[qt][ks] = *(const bf16x8*)(p.H + (rowq0 + qt * 16 + lr) * 2560 + h * 64 + ks * 32 + lg * 8);
    unsigned mq[2]; unsigned wor;
    if (own > 3) {
#pragma unroll
        for (int jt = 0; jt < 2; ++jt) {
            bf16x8 kf[2];
#pragma unroll
            for (int ks = 0; ks < 2; ++ks) kf[ks] = *(const bf16x8*)(p.KMP + ((size_t)b * 32 + jt * 16 + lr) * 512 + h * 64 + ks * 32 + lg * 8);
#pragma unroll
            for (int qt = 0; qt < 2; ++qt) {
                f32x4 a = {0.f, 0.f, 0.f, 0.f};
                a = MFMA16(kf[0], qf[qt][0], a); a = MFMA16(kf[1], qf[qt][1], a);
#pragma unroll
                for (int r = 0; r < 4; ++r) gsc[(qt * 16 + lr) * 32 + jt * 16 + 4 * lg + r] = a[r];
            }
        }
        __builtin_amdgcn_s_waitcnt(0);
        __builtin_amdgcn_wave_barrier();
        unsigned m = 0;
        if (lane < 32) {
            float v0 = -INFINITY, v1 = -INFINITY, v2 = -INFINITY; int i0 = 0, i1 = 0, i2 = 0;
            for (int j = 0; j < own; ++j) { float s = gsc[lane * 32 + j];
                if (s > v0) { v2 = v1; i2 = i1; v1 = v0; i1 = i0; v0 = s; i0 = j; }
                else if (s > v1) { v2 = v1; i2 = i1; v1 = s; i1 = j; }
                else if (s > v2) { v2 = s; i2 = j; } }
            m = (1u << i0) | (1u << i1) | (1u << i2);
            msk[lane] = m;
        }
        unsigned o = m;
#pragma unroll
        for (int s = 32; s >= 1; s >>= 1) o |= (unsigned)__shfl_xor((int)o, s, 64);
        wor = o;
        __builtin_amdgcn_s_waitcnt(0);
        __builtin_amdgcn_wave_barrier();
        mq[0] = msk[lr]; mq[1] = msk[16 + lr];
    } else {
        const unsigned m = (own >= 1) ? ((1u << own) - 1u) : 0u;
        mq[0] = m; mq[1] = m; wor = m;
    }
    wor = (unsigned)__builtin_amdgcn_readfirstlane((int)wor);
    const float SC = 0.125f * 1.4426950408889634f;
    float mrow[2] = {-INFINITY, -INFINITY}, lrow[2] = {0.f, 0.f};
    f32x4 oacc[2][4];
#pragma unroll
    for (int qt = 0; qt < 2; ++qt)
#pragma unroll
        for (int dt = 0; dt < 4; ++dt) oacc[qt][dt] = (f32x4){0.f, 0.f, 0.f, 0.f};
    const bf16_t* Kbase = p.H + (size_t)b * SEQ * 2560 + 512 + h * 64;
    const bf16_t* Vbase = p.VT + (size_t)(b * 8 + h) * 64 * 8192;
    for (int it = -1; it < own; ++it) {
        const int jb = (it < 0) ? own : it;
        const bool isown = it < 0;
        if (!isown && !((wor >> jb) & 1u)) continue;
        const int nst = isown ? (w + 1) : 8;
        for (int st = 0; st < nst; ++st) {
            const int key0 = jb * 256 + st * 32;
            bf16x8 kf[2][2];
#pragma unroll
            for (int kt = 0; kt < 2; ++kt)
#pragma unroll
                for (int ks = 0; ks < 2; ++ks) kf[kt][ks] = *(const bf16x8*)(Kbase + (size_t)(key0 + kt * 16 + lr) * 2560 + ks * 32 + lg * 8);
            bf16x8 vf[4];
#pragma unroll
            for (int dt = 0; dt < 4; ++dt) {
                const bf16_t* vp = Vbase + (size_t)(dt * 16 + lr) * 8192 + key0 + 4 * lg;
                u32x2 lo = *(const u32x2*)vp, hi = *(const u32x2*)(vp + 16);
                u32x4 t; t[0] = lo[0]; t[1] = lo[1]; t[2] = hi[0]; t[3] = hi[1];
                vf[dt] = __builtin_bit_cast(bf16x8, t);
            }
#pragma unroll
            for (int qt = 0; qt < 2; ++qt) {
                f32x4 s[2];
#pragma unroll
                for (int kt = 0; kt < 2; ++kt) { f32x4 a = {0.f, 0.f, 0.f, 0.f}; a = MFMA16(kf[kt][0], qf[qt][0], a); a = MFMA16(kf[kt][1], qf[qt][1], a); s[kt] = a; }
                const bool selq = isown || ((mq[qt] >> jb) & 1u);
                const int qin = w * 32 + qt * 16 + lr;
                float mx = -INFINITY;
#pragma unroll
                for (int kt = 0; kt < 2; ++kt)
#pragma unroll
                    for (int r = 0; r < 4; ++r) {
                        const int kin = st * 32 + kt * 16 + 4 * lg + r;
                        const bool ok = selq && (!isown || kin <= qin);
                        float v = ok ? s[kt][r] * SC : -INFINITY;
                        s[kt][r] = v; mx = fmaxf(mx, v);
                    }
                mx = fmaxf(mx, __shfl_xor(mx, 16, 64)); mx = fmaxf(mx, __shfl_xor(mx, 32, 64));
                const float mnew = fmaxf(mrow[qt], mx);
                const float alpha = __builtin_amdgcn_exp2f(mrow[qt] - mnew);
                float ps = 0.f;
#pragma unroll
                for (int kt = 0; kt < 2; ++kt)
#pragma unroll
                    for (int r = 0; r < 4; ++r) { float e = __builtin_amdgcn_exp2f(s[kt][r] - mnew); s[kt][r] = e; ps += e; }
                ps += __shfl_xor(ps, 16, 64); ps += __shfl_xor(ps, 32, 64);
                lrow[qt] = lrow[qt] * alpha + ps; mrow[qt] = mnew;
                u32x4 pk; pk[0] = pack_bf2(s[0][0], s[0][1]); pk[1] = pack_bf2(s[0][2], s[0][3]); pk[2] = pack_bf2(s[1][0], s[1][1]); pk[3] = pack_bf2(s[1][2], s[1][3]);
                const bf16x8 pf = __builtin_bit_cast(bf16x8, pk);
#pragma unroll
                for (int dt = 0; dt < 4; ++dt) { oacc[qt][dt] = oacc[qt][dt] * alpha; oacc[qt][dt] = MFMA16(vf[dt], pf, oacc[qt][dt]); }
            }
        }
    }
#pragma unroll
    for (int qt = 0; qt < 2; ++qt) {
        const float inv = 1.f / lrow[qt];
#pragma unroll
        for (int dt = 0; dt < 4; ++dt) store_bf4(p.MIX + (rowq0 + qt * 16 + lr) * DM + h * 64 + dt * 16 + 4 * lg, oacc[qt][dt] * inv);
    }
}

DI void ln_rows(const Params& p, const float* g, const float* bb, int bid, int nb, bool final_out) {
    const int lane = threadIdx.x & 63, w = threadIdx.x >> 6;
    for (int row = bid * 8 + w; row < TT; row += nb * 8) {
        f32x4 v[4]; float s = 0.f;
#pragma unroll
        for (int i = 0; i < 4; ++i) { v[i] = *(const f32x4*)(p.T + (size_t)row * DM + 4 * lane + 256 * i); s += v[i][0] + v[i][1] + v[i][2] + v[i][3]; }
        const float mu = wave_sum(s) * (1.f / 1024.f);
        float q = 0.f;
#pragma unroll
        for (int i = 0; i < 4; ++i)
#pragma unroll
            for (int k = 0; k < 4; ++k) { float d = v[i][k] - mu; q += d * d; }
        const float rs = rsqrtf(wave_sum(q) * (1.f / 1024.f) + LN_EPS);
#pragma unroll
        for (int i = 0; i < 4; ++i) {
            const int c = 4 * lane + 256 * i;
            f32x4 gg = *(const f32x4*)(g + c), be = *(const f32x4*)(bb + c), y;
#pragma unroll
            for (int k = 0; k < 4; ++k) y[k] = (v[i][k] - mu) * rs * gg[k] + be[k];
            if (final_out) { float* dst = row < TP ? p.y_prompt + (size_t)row * DM + c : p.y_sample + (size_t)(row - TP) * DM + c; *(f32x4*)dst = y; }
            else { *(f32x4*)(p.XF + (size_t)row * DM + c) = y; store_bf4(p.XB + (size_t)row * DM + c, y); }
        }
    }
}

#define INS16(V, I, tv, ti) { float _v = (V); int _i = (I); _Pragma("unroll") for (int _k = 0; _k < 16; ++_k) { const bool _g = _v > tv[_k]; const float _tv = tv[_k]; const int _ti = ti[_k]; tv[_k] = _g ? _v : _tv; ti[_k] = _g ? _i : _ti; _v = _g ? _tv : _v; _i = _g ? _ti : _i; } }
DI void peer_topk_unit(const Params& p, int u, char* lds) {
    float* lv = (float*)lds;
    int* li = (int*)(lds + 512 * 17 * 4);
    const int tid = threadIdx.x; const int tok = u * 32 + (tid >> 4), j = tid & 15;
    float tv[16]; int ti[16];
#pragma unroll
    for (int k = 0; k < 16; ++k) { tv[k] = -INFINITY; ti[k] = 0; }
    if (tok < TT) {
        const float* s = p.S + (size_t)tok * 2048 + j * 128;
        for (int n4 = 0; n4 < 32; ++n4) {
            f32x4 v = *(const f32x4*)(s + 4 * n4);
            INS16(v[0], 4 * n4, tv, ti); INS16(v[1], 4 * n4 + 1, tv, ti); INS16(v[2], 4 * n4 + 2, tv, ti); INS16(v[3], 4 * n4 + 3, tv, ti);
        }
    }
#pragma unroll
    for (int k = 0; k < 16; ++k) { lv[tid * 17 + k] = tv[k]; li[tid * 17 + k] = ti[k]; }
    __syncthreads();
    if ((j & 1) == 0 && tok < TT) {
        float v2[16]; int i2[16];
#pragma unroll
        for (int k = 0; k < 16; ++k) { v2[k] = lv[(tid + 1) * 17 + k]; i2[k] = li[(tid + 1) * 17 + k]; }
        float sv[16]; int si[16];
#pragma unroll
        for (int k = 0; k < 16; ++k) { sv[k] = -INFINITY; si[k] = 0; }
#pragma unroll
        for (int a = 0; a < 16; ++a)
#pragma unroll
            for (int bq = 0; bq < 16; ++bq)
                if ((a + 1) * (bq + 1) <= 16) INS16(tv[a] + v2[bq], ti[a] * 128 + i2[bq], sv, si);
        float sm = 0.f; float e[16];
#pragma unroll
        for (int k = 0; k < 16; ++k) { e[k] = __expf(sv[k] - sv[0]); sm += e[k]; }
        const float inv = 1.f / sm; const int h = j >> 1;
#pragma unroll
        for (int k = 0; k < 16; ++k) { p.E[(size_t)tok * 128 + h * 16 + k] = si[k]; p.G[(size_t)tok * 128 + h * 16 + k] = e[k] * inv; }
    }
    __syncthreads();
}

DI void peer_gather(const Params& p, int layer, int bid, int nb, bool final_out) {
    const int lane = threadIdx.x & 63, w = threadIdx.x >> 6;
    const bf16_t* U = p.UB + (size_t)layer * 16384 * DM; const bf16_t* V = p.VB + (size_t)layer * 16384 * DM;
    const float* g = p.ln_g + (layer * 2 + 1) * DM; const float* bb = p.ln_b + (layer * 2 + 1) * DM;
    for (int tok = bid * 8 + w; tok < TT; tok += nb * 8) {
        float x[16];
        {
            const float* xr = p.XF + (size_t)tok * DM;
            f32x4 a0 = *(const f32x4*)(xr + 8 * lane), a1 = *(const f32x4*)(xr + 8 * lane + 4), b0 = *(const f32x4*)(xr + 512 + 8 * lane), b1 = *(const f32x4*)(xr + 512 + 8 * lane + 4);
#pragma unroll
            for (int k = 0; k < 4; ++k) { x[k] = a0[k]; x[4 + k] = a1[k]; x[8 + k] = b0[k]; x[12 + k] = b1[k]; }
        }
        const int e0 = p.E[(size_t)tok * 128 + lane], e1 = p.E[(size_t)tok * 128 + 64 + lane];
        const float g0 = p.G[(size_t)tok * 128 + lane], g1 = p.G[(size_t)tok * 128 + 64 + lane];
        float z0 = 0.f, z1 = 0.f;
#pragma unroll 4
        for (int pk = 0; pk < 128; ++pk) {
            const int e = __shfl((pk < 64) ? e0 : e1, pk & 63, 64);
            const bf16_t* ur = U + (size_t)e * DM;
            u32x4 a = *(const u32x4*)(ur + 8 * lane), c = *(const u32x4*)(ur + 512 + 8 * lane);
            float s = 0.f;
#pragma unroll
            for (int k = 0; k < 4; ++k) { s += x[2 * k] * bflo(a[k]) + x[2 * k + 1] * bfhi(a[k]); s += x[8 + 2 * k] * bflo(c[k]) + x[8 + 2 * k + 1] * bfhi(c[k]); }
            s = wave_sum(s);
            if (pk < 64) { if (lane == pk) z0 = s; } else { if (lane == pk - 64) z1 = s; }
        }
        const float h0 = g0 * 0.5f * z0 * (1.f + erff(z0 * 0.70710678118654752f));
        const float h1 = g1 * 0.5f * z1 * (1.f + erff(z1 * 0.70710678118654752f));
        float o[16];
#pragma unroll
        for (int k = 0; k < 16; ++k) o[k] = 0.f;
#pragma unroll 4
        for (int pk = 0; pk < 128; ++pk) {
            const int e = __shfl((pk < 64) ? e0 : e1, pk & 63, 64);
            const float hh = __shfl((pk < 64) ? h0 : h1, pk & 63, 64);
            const bf16_t* vr = V + (size_t)e * DM;
            u32x4 a = *(const u32x4*)(vr + 8 * lane), c = *(const u32x4*)(vr + 512 + 8 * lane);
#pragma unroll
            for (int k = 0; k < 4; ++k) { o[2 * k] += hh * bflo(a[k]); o[2 * k + 1] += hh * bfhi(a[k]); o[8 + 2 * k] += hh * bflo(c[k]); o[8 + 2 * k + 1] += hh * bfhi(c[k]); }
        }
        float s = 0.f;
#pragma unroll
        for (int k = 0; k < 16; ++k) { o[k] = DN_ALPHA * x[k] + o[k]; s += o[k]; }
        const float mu = wave_sum(s) * (1.f / 1024.f);
        float q = 0.f;
#pragma unroll
        for (int k = 0; k < 16; ++k) { float d = o[k] - mu; q += d * d; }
        const float rs = rsqrtf(wave_sum(q) * (1.f / 1024.f) + LN_EPS);
#pragma unroll
        for (int hf = 0; hf < 2; ++hf) {
            const int c = hf * 512 + 8 * lane;
            f32x4 y0, y1;
#pragma unroll
            for (int k = 0; k < 4; ++k) { y0[k] = (o[hf * 8 + k] - mu) * rs * g[c + k] + bb[c + k]; y1[k] = (o[hf * 8 + 4 + k] - mu) * rs * g[c + 4 + k] + bb[c + 4 + k]; }
            if (final_out) { float* dst = tok < TP ? p.y_prompt + (size_t)tok * DM + c : p.y_sample + (size_t)(tok - TP) * DM + c; *(f32x4*)dst = y0; *(f32x4*)(dst + 4) = y1; }
            else { float* dst = p.XF + (size_t)tok * DM + c; *(f32x4*)dst = y0; *(f32x4*)(dst + 4) = y1; store_bf4(p.XB + (size_t)tok * DM + c, y0); store_bf4(p.XB + (size_t)tok * DM + c + 4, y1); }
        }
    }
}

DI void hgrn_cumsum(const Params& p, size_t row0, int h, float* bs, float* tot) {
    const int tid = threadIdx.x;
#pragma unroll
    for (int i = 0; i < 4; ++i) { int id = tid + NT * i; int s = id >> 5, c4 = id & 31; *(f32x4*)(bs + s * 128 + 4 * c4) = *(const f32x4*)(p.LF + (row0 + s) * DM + h * 128 + 4 * c4); }
    __syncthreads();
    const int k = tid & 127, seg = tid >> 7;
    float run = 0.f;
#pragma unroll
    for (int i = 0; i < 16; ++i) { run += bs[(seg * 16 + i) * 128 + k]; bs[(seg * 16 + i) * 128 + k] = run; }
    tot[seg * 128 + k] = run;
    __syncthreads();
    float off = 0.f;
#pragma unroll
    for (int s2 = 0; s2 < 3; ++s2) if (s2 < seg) off += tot[s2 * 128 + k];
    if (seg > 0) {
#pragma unroll
        for (int i = 0; i < 16; ++i) bs[(seg * 16 + i) * 128 + k] += off;
    }
    __syncthreads();
}
constexpr int HG_TS = 72;
constexpr int HG_FS = 136;
DI void hgrn_b1_unit(const Params& p, int u, char* lds) {
    float* bs = (float*)lds;
    float* tot = (float*)(lds + 32768);
    bf16_t* KT = (bf16_t*)(lds + 36864);
    bf16_t* IT = (bf16_t*)(lds + 36864 + 18432);
    const int tid = threadIdx.x, lane = tid & 63, w = tid >> 6, lr = lane & 15, lg = lane >> 4;
    const int bh = u >> 7, c = u & 127, b = bh >> 3, h = bh & 7;
    const size_t row0 = (size_t)b * SEQ + c * 64;
    hgrn_cumsum(p, row0, h, bs, tot);
    const bf16_t* KK = p.H + (size_t)MP * DM; const bf16_t* I1 = p.H + (size_t)2 * MP * DM;
    {
        const int s = tid >> 3, kc = (tid & 7) * 16;
        const bf16_t* kr = KK + (row0 + s) * DM + h * 128 + kc; const bf16_t* ir = I1 + (row0 + s) * DM + h * 128 + kc;
        u32x4 ka = *(const u32x4*)kr, kb = *(const u32x4*)(kr + 8), ia = *(const u32x4*)ir, ib = *(const u32x4*)(ir + 8);
#pragma unroll
        for (int i = 0; i < 16; ++i) {
            const unsigned kw = (i < 8) ? ka[(i & 7) >> 1] : kb[(i & 7) >> 1]; const unsigned iw = (i < 8) ? ia[(i & 7) >> 1] : ib[(i & 7) >> 1];
            const float kv = (i & 1) ? bfhi(kw) : bflo(kw);
            const float e = __expf(fminf(-bs[s * 128 + kc + i], 80.f));
            KT[(kc + i) * HG_TS + s] = f2bf(kv * e);
            IT[(kc + i) * HG_TS + s] = (bf16_t)((i & 1) ? (iw >> 16) : (iw & 0xffffu));
        }
    }
    __syncthreads();
    f32x4 acc[8];
#pragma unroll
    for (int j = 0; j < 8; ++j) acc[j] = (f32x4){0.f, 0.f, 0.f, 0.f};
#pragma unroll
    for (int ks = 0; ks < 2; ++ks) {
        const bf16x8 af = *(const bf16x8*)(KT + (w * 16 + lr) * HG_TS + ks * 32 + lg * 8);
#pragma unroll
        for (int j = 0; j < 8; ++j) { const bf16x8 bfr = *(const bf16x8*)(IT + (j * 16 + lr) * HG_TS + ks * 32 + lg * 8); acc[j] = MFMA16(af, bfr, acc[j]); }
    }
    f32x4 dl;
#pragma unroll
    for (int r = 0; r < 4; ++r) dl[r] = __expf(bs[63 * 128 + w * 16 + 4 * lg + r]);
#pragma unroll
    for (int j = 0; j < 8; ++j) *(f32x4*)(p.UT + ((size_t)u * 128 + j * 16 + lr) * 128 + w * 16 + 4 * lg) = acc[j] * dl;
    if (tid < 128) p.DEC[(size_t)u * 128 + tid] = __expf(bs[63 * 128 + tid]);
    __syncthreads();
}
DI void hgrn_b2(const Params& p, int bid, int nb) {
    for (int e = bid * NT + threadIdx.x; e < 16 * 16384; e += nb * NT) {
        const int bh = e >> 14, vk = e & 16383, k = vk & 127, v = vk >> 7;
        float S = 0.f;
        for (int c0 = 0; c0 < 128; c0 += 8) {
            float uu[8], dd[8];
#pragma unroll
            for (int i = 0; i < 8; ++i) { const size_t un = (size_t)bh * 128 + c0 + i; uu[i] = p.UT[un * 16384 + vk]; dd[i] = p.DEC[un * 128 + k]; }
#pragma unroll
            for (int i = 0; i < 8; ++i) { const size_t un = (size_t)bh * 128 + c0 + i; p.ST[un * 16384 + vk] = f2bf(S); S = dd[i] * S + uu[i]; }
        }
        p.hgrn_prompt[((size_t)bh * 128 + k) * 128 + v] = S;
    }
}
DI void hgrn_b3_unit(const Params& p, int u, char* lds) {
    float* bs = (float*)lds;
    float* tot = (float*)(lds + 32768);
    bf16_t* QH = (bf16_t*)(lds + 36864);
    bf16_t* KH = (bf16_t*)(lds + 36864 + 17408);
    bf16_t* IT = (bf16_t*)(lds + 36864 + 34816);
    bf16_t* AT = (bf16_t*)(lds + 36864 + 34816 + 18432);
    const int tid = threadIdx.x, lane = tid & 63, w = tid >> 6, lr = lane & 15, lg = lane >> 4;
    const int bh = u >> 7, c = u & 127, b = bh >> 3, h = bh & 7;
    const size_t row0 = (size_t)b * SEQ + c * 64;
    hgrn_cumsum(p, row0, h, bs, tot);
    const bf16_t* Q1 = p.H; const bf16_t* KK = p.H + (size_t)MP * DM; const bf16_t* I1 = p.H + (size_t)2 * MP * DM; const bf16_t* G1 = p.H + (size_t)3 * MP * DM;
    {
        const int s = tid >> 3, kc = (tid & 7) * 16;
        const bf16_t* qr = Q1 + (row0 + s) * DM + h * 128 + kc; const bf16_t* kr = KK + (row0 + s) * DM + h * 128 + kc; const bf16_t* ir = I1 + (row0 + s) * DM + h * 128 + kc;
        u32x4 qa = *(const u32x4*)qr, qb = *(const u32x4*)(qr + 8), ka = *(const u32x4*)kr, kb = *(const u32x4*)(kr + 8), ia = *(const u32x4*)ir, ib = *(const u32x4*)(ir + 8);
#pragma unroll
        for (int i = 0; i < 16; ++i) {
            const unsigned qw = (i < 8) ? qa[(i & 7) >> 1] : qb[(i & 7) >> 1]; const unsigned kw = (i < 8) ? ka[(i & 7) >> 1] : kb[(i & 7) >> 1]; const unsigned iw = (i < 8) ? ia[(i & 7) >> 1] : ib[(i & 7) >> 1];
            const float qv = (i & 1) ? bfhi(qw) : bflo(qw); const float kv = (i & 1) ? bfhi(kw) : bflo(kw);
            const float bb = bs[s * 128 + kc + i];
            QH[s * HG_FS + kc + i] = f2bf(qv * __expf(bb));
            KH[s * HG_FS + kc + i] = f2bf(kv * __expf(fminf(-bb, 80.f)));
            IT[(kc + i) * HG_TS + s] = (bf16_t)((i & 1) ? (iw >> 16) : (iw & 0xffffu));
        }
    }
    __syncthreads();
    {
        const int tt = w & 3;
#pragma unroll
        for (int si = 0; si < 2; ++si) {
            const int stile = (w >> 2) * 2 + si;
            f32x4 a = {0.f, 0.f, 0.f, 0.f};
            if (stile <= tt) {
#pragma unroll
                for (int ks = 0; ks < 4; ++ks) {
                    const bf16x8 af = *(const bf16x8*)(KH + (stile * 16 + lr) * HG_FS + ks * 32 + lg * 8);
                    const bf16x8 bfr = *(const bf16x8*)(QH + (tt * 16 + lr) * HG_FS + ks * 32 + lg * 8);
                    a = MFMA16(af, bfr, a);
                }
            }
            const int t = tt * 16 + lr;
#pragma unroll
            for (int r = 0; r < 4; ++r) { const int s = stile * 16 + 4 * lg + r; if (s > t) a[r] = 0.f; }
            store_bf4(AT + t * HG_TS + stile * 16 + 4 * lg, a);
        }
    }
    __syncthreads();
    const int tt = w & 3;
    f32x4 acc[4];
#pragma unroll
    for (int j = 0; j < 4; ++j) acc[j] = (f32x4){0.f, 0.f, 0.f, 0.f};
#pragma unroll
    for (int ks = 0; ks < 2; ++ks) {
        const bf16x8 bfr = *(const bf16x8*)(AT + (tt * 16 + lr) * HG_TS + ks * 32 + lg * 8);
#pragma unroll
        for (int j = 0; j < 4; ++j) { const int vt = (w >> 2) * 4 + j; const bf16x8 af = *(const bf16x8*)(IT + (vt * 16 + lr) * HG_TS + ks * 32 + lg * 8); acc[j] = MFMA16(af, bfr, acc[j]); }
    }
    const bf16_t* STu = p.ST + (size_t)u * 16384;
#pragma unroll
    for (int ks = 0; ks < 4; ++ks) {
        const bf16x8 bfr = *(const bf16x8*)(QH + (tt * 16 + lr) * HG_FS + ks * 32 + lg * 8);
#pragma unroll
        for (int j = 0; j < 4; ++j) { const int vt = (w >> 2) * 4 + j; const bf16x8 af = *(const bf16x8*)(STu + (vt * 16 + lr) * 128 + ks * 32 + lg * 8); acc[j] = MFMA16(af, bfr, acc[j]); }
    }
    float ss = 0.f;
#pragma unroll
    for (int j = 0; j < 4; ++j)
#pragma unroll
        for (int r = 0; r < 4; ++r) ss += acc[j][r] * acc[j][r];
    ss += __shfl_xor(ss, 16, 64); ss += __shfl_xor(ss, 32, 64);
    float* red = tot;
    if (lg == 0) red[(w >> 2) * 64 + tt * 16 + lr] = ss;
    __syncthreads();
    const float rs = rsqrtf((red[tt * 16 + lr] + red[64 + tt * 16 + lr]) * (1.f / 128.f) + RMS_EPS);
    const size_t row = row0 + tt * 16 + lr;
#pragma unroll
    for (int j = 0; j < 4; ++j) {
        const int col = h * 128 + ((w >> 2) * 4 + j) * 16 + 4 * lg;
        const u32x2 gw = *(const u32x2*)(G1 + row * DM + col);
        const f32x4 ng = *(const f32x4*)(p.hgrn_norm_g + col);
        f32x4 o;
        const float gg[4] = {bflo(gw[0]), bfhi(gw[0]), bflo(gw[1]), bfhi(gw[1])};
#pragma unroll
        for (int r = 0; r < 4; ++r) o[r] = acc[j][r] * rs * ng[r] * (gg[r] * sigmoidf_(gg[r]));
        store_bf4(p.MIX + row * DM + col, o);
    }
    __syncthreads();
}
DI void hgrn_sample_unit(const Params& p, int u, char* lds) {
    float* part = (float*)lds;
    float* red = part + 512;
    const int tid = threadIdx.x, lane = tid & 63, w = tid >> 6;
    const int b = u >> 3, h = u & 7; const size_t row = (size_t)TP + b;
    const bf16_t* Q1 = p.H; const bf16_t* KK = p.H + (size_t)MP * DM; const bf16_t* I1 = p.H + (size_t)2 * MP * DM; const bf16_t* G1 = p.H + (size_t)3 * MP * DM;
    const int v = tid & 127, kq = tid >> 7;
    const float iv = bf2f(I1[row * DM + h * 128 + v]);
    float acc = 0.f;
    const float* S0 = p.state_hgrn + (size_t)u * 16384; float* S1 = p.hgrn_sample + (size_t)u * 16384;
#pragma unroll 8
    for (int kk = 0; kk < 32; ++kk) {
        const int k = kq * 32 + kk;
        const float f = __expf(p.LF[row * DM + h * 128 + k]);
        const float kv = bf2f(KK[row * DM + h * 128 + k]);
        const float q = bf2f(Q1[row * DM + h * 128 + k]);
        const float st = f * S0[k * 128 + v] + kv * iv;
        S1[k * 128 + v] = st; acc += q * st;
    }
    part[kq * 128 + v] = acc;
    __syncthreads();
    float o = 0.f, sq = 0.f;
    if (tid < 128) { o = part[tid] + part[128 + tid] + part[256 + tid] + part[384 + tid]; sq = o * o; }
    sq = wave_sum(sq); if (lane == 0) red[w] = sq;
    __syncthreads();
    if (tid < 128) {
        const float rs = rsqrtf((red[0] + red[1]) * (1.f / 128.f) + RMS_EPS);
        const float g = bf2f(G1[row * DM + h * 128 + tid]);
        p.MIX[row * DM + h * 128 + tid] = f2bf(o * rs * p.hgrn_norm_g[h * 128 + tid] * (g * sigmoidf_(g)));
    }
    __syncthreads();
}

constexpr int LDS_BYTES = 131072;
template <int PH> __global__ void __launch_bounds__(NT, 2) k_phase(Params p, int layer) {
    extern __shared__ __attribute__((aligned(16))) char lds[];
    const int bid = blockIdx.x, nb = gridDim.x;
    if constexpr (PH == 0) {
        for (int u = bid; u < 16 * 40; u += nb) transpose_unit(p.w_in_even, 1024, 2560, p.WT_IN_EVEN, u, lds);
        for (int u = bid; u < 16 * 16; u += nb) transpose_unit(p.w_out_even, 1024, 1024, p.WT_OUT_EVEN, u, lds);
        for (int u = bid; u < 16 * 64; u += nb) transpose_unit(p.w_in_odd, 1024, 4096, p.WT_IN_ODD, u, lds);
        for (int u = bid; u < 16 * 16; u += nb) transpose_unit(p.w_out_odd, 1024, 1024, p.WT_OUT_ODD, u, lds);
        for (int u = bid; u < 16 * 32; u += nb) transpose_unit(p.peer_wq, 1024, 2048, p.WT_WQ, u, lds);
        for (int u = bid; u < 16 * 32; u += nb) transpose_unit(p.peer_wq + (size_t)1024 * 2048, 1024, 2048, p.WT_WQ + (size_t)2048 * 1024, u, lds);
    } else if constexpr (PH == 1) {
        convert_x(p, bid, nb);
        convert_keys(p, bid, nb);
        convert_range(p.peer_u, p.UB, (size_t)2 * 16384 * DM / 4, bid, nb);
        convert_range(p.peer_v, p.VB, (size_t)2 * 16384 * DM / 4, bid, nb);
    } else if constexpr (PH == 2) {
        for (int u = bid; u < 1024; u += nb) kmean_sample_unit(p, u);
    } else if constexpr (PH == 3) {
        GemmArgs g{p.XB, DM, p.WT_IN_EVEN, DM, DM, 0};
        EpiInEven epi{p.H, p.y_prompt, p.VT};
        gemm_phase(g, MP, 2560, epi, lds, bid, nb);
    } else if constexpr (PH == 4) {
        for (int u = bid; u < 64; u += nb) kmean_prompt_unit(p, u);
        for (int u = bid; u < 544; u += nb) conv_unit(p, u, lds);
    } else if constexpr (PH == 5) {
        for (int u = bid; u < 512 + 256; u += nb) {
            if (u < 512) { const int bh = (u & 255) >> 4, i = u & 15; const int blk = (u < 256) ? i : 31 - i; moba_prompt_unit(p, bh, blk, lds); }
            else moba_sample_unit(p, u - 512, lds);
        }
    } else if constexpr (PH == 6) {
        GemmArgs g{p.MIX, DM, layer == 0 ? p.WT_OUT_EVEN : p.WT_OUT_ODD, DM, DM, 0};
        EpiResid epi{p.T, p.XF};
        gemm_phase(g, MP, 1024, epi, lds, bid, nb);
    } else if constexpr (PH == 7) {
        ln_rows(p, p.ln_g + (layer * 2) * DM, p.ln_b + (layer * 2) * DM, bid, nb, false);
    } else if constexpr (PH == 8) {
        GemmArgs g{p.XB, DM, p.WT_WQ + (size_t)layer * 2048 * 1024, DM, DM, 0};
        EpiBf16 epi{p.QH, 2048};
        gemm_phase(g, MP, 2048, epi, lds, bid, nb);
    } else if constexpr (PH == 9) {
        GemmArgs g{p.QH, 2048, p.KB + (size_t)layer * 2048 * 128, 128, 128, 1};
        EpiF32 epi{p.S, 2048};
        gemm_phase(g, MP, 2048, epi, lds, bid, nb);
    } else if constexpr (PH == 10) {
        for (int u = bid; u < (TT + 31) / 32; u += nb) peer_topk_unit(p, u, lds);
    } else if constexpr (PH == 11) {
        peer_gather(p, layer, bid, nb, layer == 1);
    } else if constexpr (PH == 12) {
        GemmArgs g{p.XB, DM, p.WT_IN_ODD, DM, DM, 0};
        EpiInOdd epi{p.H, p.LF, p.LB};
        gemm_phase(g, MP, 4096, epi, lds, bid, nb);
    } else if constexpr (PH == 13) {
        for (int u = bid; u < 2048 + 256; u += nb) { if (u < 2048) hgrn_b1_unit(p, u, lds); else hgrn_sample_unit(p, u - 2048, lds); }
    } else if constexpr (PH == 14) {
        hgrn_b2(p, bid, nb);
    } else if constexpr (PH == 15) {
        for (int u = bid; u < 2048; u += nb) hgrn_b3_unit(p, u, lds);
    }
}

template <int PH> static void launch(const Params& p, int layer, int grid, hipStream_t s) {
    static bool attr = false;
    if (!attr) { (void)hipFuncSetAttribute((const void*)k_phase<PH>, hipFuncAttributeMaxDynamicSharedMemorySize, LDS_BYTES); attr = true; }
    hipLaunchKernelGGL(k_phase<PH>, dim3(grid), dim3(NT), LDS_BYTES, s, p, layer);
}

extern "C" void kernel_launch(void* const* d_in, const int* in_sizes, int n_in, void* d_out, int out_size, void* d_ws, size_t ws_size, hipStream_t stream) {
    Params p{};
    p.x_prompt = (const float*)d_in[0]; p.x_sample = (const float*)d_in[1]; p.cache_k = (const float*)d_in[2]; p.cache_v = (const float*)d_in[3];
    p.state_conv = (const float*)d_in[4]; p.state_hgrn = (const float*)d_in[5]; p.page_table = (const int*)d_in[6];
    p.w_in_even = (const float*)d_in[7]; p.conv_w = (const float*)d_in[8]; p.conv_b = (const float*)d_in[9]; p.conv_ln_g = (const float*)d_in[10]; p.conv_ln_b = (const float*)d_in[11];
    p.w_out_even = (const float*)d_in[12]; p.w_in_odd = (const float*)d_in[13]; p.lb_logits = (const float*)d_in[14]; p.hgrn_norm_g = (const float*)d_in[15]; p.w_out_odd = (const float*)d_in[16];
    p.ln_g = (const float*)d_in[17]; p.ln_b = (const float*)d_in[18]; p.peer_wq = (const float*)d_in[19]; p.peer_keys = (const float*)d_in[20]; p.peer_u = (const float*)d_in[21]; p.peer_v = (const float*)d_in[22];
    float* o = (float*)d_out;
    p.y_prompt = o; o += (size_t)TP * DM; p.y_sample = o; o += (size_t)TS * DM;
    p.k_prompt = o; o += (size_t)TP * 512; p.v_prompt = o; o += (size_t)TP * 512; p.k_sample = o; o += (size_t)TS * 512; p.v_sample = o; o += (size_t)TS * 512;
    p.conv_prompt = o; o += 2 * 30 * 512; p.conv_sample = o; o += 32 * 30 * 512; p.hgrn_prompt = o; o += 2 * 8 * 128 * 128; p.hgrn_sample = o;
    char* ws = (char*)d_ws; size_t off = 0;
    auto take = [&](size_t bytes) { char* r = ws + off; off += (bytes + 255) & ~(size_t)255; return r; };
    p.bar = (unsigned*)take(16384); p.LB = (float*)take(4096);
    p.WT_IN_EVEN = (bf16_t*)take((size_t)2560 * 1024 * 2); p.WT_OUT_EVEN = (bf16_t*)take((size_t)1024 * 1024 * 2);
    p.WT_IN_ODD = (bf16_t*)take((size_t)4096 * 1024 * 2); p.WT_OUT_ODD = (bf16_t*)take((size_t)1024 * 1024 * 2);
    p.WT_WQ = (bf16_t*)take((size_t)2 * 2048 * 1024 * 2); p.KB = (bf16_t*)take((size_t)2 * 2048 * 128 * 2);
    p.UB = (bf16_t*)take((size_t)2 * 16384 * DM * 2); p.VB = (bf16_t*)take((size_t)2 * 16384 * DM * 2);
    p.XB = (bf16_t*)take((size_t)MP * DM * 2); p.XF = (float*)take((size_t)MP * DM * 4);
    p.H = (bf16_t*)take((size_t)MP * 4096 * 2); p.LF = (float*)take((size_t)MP * DM * 4);
    p.VT = (bf16_t*)take((size_t)16 * 64 * 8192 * 2); p.KMP = (bf16_t*)take((size_t)64 * 512 * 2); p.KMS = (bf16_t*)take((size_t)1024 * 512 * 2);
    p.MIX = (bf16_t*)take((size_t)MP * DM * 2); p.T = (float*)take((size_t)MP * DM * 4);
    p.QH = (bf16_t*)take((size_t)MP * 2048 * 2); p.S = (float*)take((size_t)MP * 2048 * 4);
    p.E = (int*)take((size_t)MP * 128 * 4); p.G = (float*)take((size_t)MP * 128 * 4);
    p.UT = (float*)take((size_t)2048 * 16384 * 4); p.DEC = (float*)take((size_t)2048 * 128 * 4); p.ST = (bf16_t*)take((size_t)2048 * 16384 * 2);
    if (off > ws_size) { fprintf(stderr, "workspace too small: need %zu have %zu\n", off, ws_size); return; }

    const int G = 512;
    launch<0>(p, 0, G, stream);
    launch<1>(p, 0, 1024, stream);
    launch<2>(p, 0, 1024, stream);
    launch<3>(p, 0, G, stream);
    launch<4>(p, 0, 544, stream);
    launch<5>(p, 0, 768, stream);
    launch<6>(p, 0, G, stream);
    launch<7>(p, 0, 1024, stream);
    launch<8>(p, 0, G, stream);
    launch<9>(p, 0, G, stream);
    launch<10>(p, 0, G, stream);
    launch<11>(p, 0, 1024, stream);
    launch<12>(p, 1, G, stream);
    launch<13>(p, 1, 1024, stream);
    launch<14>(p, 1, 512, stream);
    launch<15>(p, 1, 1024, stream);
    launch<6>(p, 1, G, stream);
    launch<7>(p, 1, 1024, stream);
    launch<8>(p, 1, G, stream);
    launch<9>(p, 1, G, stream);
    launch<10>(p, 1, G, stream);
    launch<11>(p, 1, 1024, stream);
}
```

```cpp
#include <hip/hip_runtime.h>
#include <stdint.h>
#include <stdio.h>

#define DI __device__ __forceinline__
typedef unsigned short bf16_t;
typedef short bf16x8 __attribute__((ext_vector_type(8)));
typedef float f32x4 __attribute__((ext_vector_type(4)));
typedef unsigned u32x4 __attribute__((ext_vector_type(4)));
typedef unsigned u32x2 __attribute__((ext_vector_type(2)));

constexpr int NT = 512;
constexpr int TP = 16384, TS = 32, TT = TP + TS, MP = 16640, DM = 1024, SEQ = 8192;
constexpr float DN_ALPHA = 1.4142135623730951f;
constexpr float LN_EPS = 1e-5f, RMS_EPS = 1e-6f;
constexpr size_t OFF_KP = (size_t)TT * DM, OFF_VP = OFF_KP + (size_t)TP * 512, OFF_KS = OFF_VP + (size_t)TP * 512, OFF_VS = OFF_KS + (size_t)TS * 512;

DI float bf2f(bf16_t h) { return __uint_as_float(((unsigned)h) << 16); }
typedef __bf16 bf16x2_t __attribute__((ext_vector_type(2)));
DI unsigned pack_bf2(float lo, float hi) { bf16x2_t v; v[0] = (__bf16)lo; v[1] = (__bf16)hi; return __builtin_bit_cast(unsigned, v); }
DI bf16_t f2bf(float x) { return (bf16_t)(pack_bf2(x, 0.f) & 0xffffu); }
DI float bflo(unsigned u) { return __uint_as_float(u << 16); }
DI float bfhi(unsigned u) { return __uint_as_float(u & 0xffff0000u); }
DI float sigmoidf_(float x) { return 1.f / (1.f + __expf(-x)); }
DI float wave_sum(float v) {
#pragma unroll
    for (int o = 32; o >= 1; o >>= 1) v += __shfl_xor(v, o, 64);
    return v;
}
DI float wave_max(float v) {
#pragma unroll
    for (int o = 32; o >= 1; o >>= 1) v = fmaxf(v, __shfl_xor(v, o, 64));
    return v;
}
#define MFMA16(a, b, c) __builtin_amdgcn_mfma_f32_16x16x32_bf16((a), (b), (c), 0, 0, 0)

struct Params {
    const float* x_prompt; const float* x_sample; const float* cache_k; const float* cache_v;
    const float* state_conv; const float* state_hgrn; const int* page_table;
    const float* w_in_even; const float* conv_w; const float* conv_b; const float* conv_ln_g; const float* conv_ln_b;
    const float* w_out_even; const float* w_in_odd; const float* lb_logits; const float* hgrn_norm_g; const float* w_out_odd;
    const float* ln_g; const float* ln_b; const float* peer_wq; const float* peer_keys; const float* peer_u; const float* peer_v;
    float* y_prompt; float* y_sample; float* k_prompt; float* v_prompt; float* k_sample; float* v_sample;
    float* conv_prompt; float* conv_sample; float* hgrn_prompt; float* hgrn_sample;
    unsigned* bar; float* LB;
    bf16_t* WT_IN_EVEN; bf16_t* WT_OUT_EVEN; bf16_t* WT_IN_ODD; bf16_t* WT_OUT_ODD; bf16_t* WT_WQ; bf16_t* KB;
    bf16_t* UB; bf16_t* VB;
    bf16_t* XB; float* XF; bf16_t* H; float* LF; bf16_t* VT; bf16_t* KMP; bf16_t* KMS;
    bf16_t* MIX; float* T; bf16_t* QH; float* S; int* E; float* G;
    float* UT; float* DEC; bf16_t* ST;
};


#define XB_TMO      128
#define XB_XCNT(j)  (256  + 64 * (j))
#define XB_XSUB(j)  (1280 + 64 * (j))
#define XB_XGEN(j)  (2304 + 64 * (j))
#define XB_TOP      3328
#define XB_TOPGEN   3392
#define XCD_BAR_WORDS 3456
#define XB_SPIN_CAP (1u << 18)
#define LAS __attribute__((address_space(3)))
__device__ __forceinline__ unsigned xb_ld(unsigned* p)              { return __hip_atomic_load(p, __ATOMIC_RELAXED, __HIP_MEMORY_SCOPE_AGENT); }
__device__ __forceinline__ unsigned xb_add(unsigned* p, unsigned v) { return __hip_atomic_fetch_add(p, v, __ATOMIC_RELAXED, __HIP_MEMORY_SCOPE_AGENT); }
__device__ __forceinline__ unsigned xb_xcc_id() { return (unsigned)__builtin_amdgcn_s_getreg((3 << 11) | 20) & 0xFu; }
#define XB_SPIN(cond, bar) do { unsigned _sp = 0; while (cond) { __builtin_amdgcn_s_sleep(1); \
    if ((++_sp & 255u) == 0u) { if (xb_ld(&(bar)[XB_TMO])) break; if (_sp > XB_SPIN_CAP) { atomicAdd(&(bar)[XB_TMO], 1u); break; } } } } while (0)
struct XcdBarrier { unsigned* bar; unsigned x; volatile LAS unsigned* st; };
__device__ __forceinline__ XcdBarrier xcd_barrier_post(unsigned* bar, volatile LAS unsigned* st) {
    XcdBarrier b; b.bar = bar; b.x = xb_xcc_id(); b.st = st;
    if (threadIdx.x == 0) (void)xb_add(&bar[XB_XCNT(b.x)], 1u);
    return b;
}
__device__ __forceinline__ void xcd_barrier_complete(unsigned* bar, unsigned x, unsigned& nloc, unsigned& nx) {
    const unsigned G = gridDim.x * gridDim.y * gridDim.z;
    unsigned sum, cnt, mine, sp = 0u;
    for (;;) {
        sum = 0u; cnt = 0u; mine = 0u;
#pragma unroll
        for (unsigned j = 0; j < 16; ++j) { const unsigned c = xb_ld(&bar[XB_XCNT(j)]); sum += c; cnt += (c > 0u) ? 1u : 0u; mine = (j == x) ? c : mine; }
        if (sum == G) break;
        __builtin_amdgcn_s_sleep(1);
        if ((++sp & 255u) == 0u) { if (xb_ld(&bar[XB_TMO])) break; if (sp > XB_SPIN_CAP) { atomicAdd(&bar[XB_TMO], 1u); break; } }
    }
    nloc = mine > 0u ? mine : 1u; nx = cnt > 0u ? cnt : 1u;
}
__device__ __forceinline__ void xcd_barrier(const XcdBarrier& b) {
    asm volatile("s_waitcnt vmcnt(0)" ::: "memory");
    __syncthreads();
    if (threadIdx.x == 0) {
        unsigned* bar = b.bar;
        __builtin_amdgcn_s_waitcnt(0);
        unsigned nloc = b.st[0], nx = b.st[1];
        if (nloc == 0u) { xcd_barrier_complete(bar, b.x, nloc, nx); b.st[0] = nloc; b.st[1] = nx; }
        const unsigned old = xb_add(&bar[XB_XSUB(b.x)], 1u);
        const unsigned gen = old / nloc;
        if (old + 1u == (gen + 1u) * nloc) {
            __builtin_amdgcn_fence(__ATOMIC_RELEASE, "agent");
            asm volatile("s_waitcnt vmcnt(0)" ::: "memory");
            const unsigned og = xb_add(&bar[XB_TOP], 1u);
            const unsigned tg = og / nx;
            if (og + 1u == (tg + 1u) * nx) xb_add(&bar[XB_TOPGEN], 1u);
            else XB_SPIN(xb_ld(&bar[XB_TOPGEN]) == tg, bar);
            __builtin_amdgcn_fence(__ATOMIC_ACQUIRE, "agent");
            xb_add(&bar[XB_XGEN(b.x)], 1u);
            asm volatile("s_waitcnt vmcnt(0)" ::: "memory");
        } else {
            XB_SPIN(xb_ld(&bar[XB_XGEN(b.x)]) == gen, bar);
            __builtin_amdgcn_fence(__ATOMIC_ACQUIRE, "agent");
            asm volatile("s_waitcnt vmcnt(0)" ::: "memory");
        }
    }
    __syncthreads();
}

DI void transpose_unit(const float* __restrict__ W, int K, int N, bf16_t* __restrict__ Wt, int u, char* lds) {
    float* tile = (float*)lds;
    const int tid = threadIdx.x;
    const int ntn = N >> 6; const int kt = u / ntn, nt = u % ntn;
#pragma unroll
    for (int i = 0; i < 8; ++i) { int idx = tid + NT * i; int r = idx >> 6, c = idx & 63; tile[r * 65 + c] = W[(size_t)(kt * 64 + r) * N + nt * 64 + c]; }
    __syncthreads();
#pragma unroll
    for (int i = 0; i < 8; ++i) { int idx = tid + NT * i; int r = idx >> 6, c = idx & 63; Wt[(size_t)(nt * 64 + r) * K + kt * 64 + c] = f2bf(tile[c * 65 + r]); }
    __syncthreads();
}
DI void convert_range(const float* __restrict__ src, bf16_t* __restrict__ dst, size_t n4, int bid, int nb) {
    for (size_t i = (size_t)bid * NT + threadIdx.x; i < n4; i += (size_t)nb * NT) {
        f32x4 v = *(const f32x4*)(src + 4 * i);
        u32x2 o; o[0] = pack_bf2(v[0], v[1]); o[1] = pack_bf2(v[2], v[3]);
        *(u32x2*)(dst + 4 * i) = o;
    }
}
DI void convert_x(const Params& p, int bid, int nb) {
    const size_t n4 = (size_t)MP * DM / 4;
    for (size_t i = (size_t)bid * NT + threadIdx.x; i < n4; i += (size_t)nb * NT) {
        size_t e = 4 * i; int row = (int)(e >> 10); int col = (int)(e & 1023);
        f32x4 v = {0.f, 0.f, 0.f, 0.f};
        if (row < TP) v = *(const f32x4*)(p.x_prompt + e);
        else if (row < TT) v = *(const f32x4*)(p.x_sample + (size_t)(row - TP) * DM + col);
        *(f32x4*)(p.XF + e) = v;
        u32x2 o; o[0] = pack_bf2(v[0], v[1]); o[1] = pack_bf2(v[2], v[3]);
        *(u32x2*)(p.XB + e) = o;
    }
}
DI void convert_keys(const Params& p, int bid, int nb) {
    const int n = 2 * 2 * 8 * 128 * 128;
    for (int i = bid * NT + threadIdx.x; i < n; i += nb * NT) {
        int d = i & 127, nn = (i >> 7) & 127, j = (i >> 14) & 15, l = i >> 18;
        int h = j >> 1, half = j & 1;
        p.KB[i] = f2bf(p.peer_keys[((((size_t)l * 2 + half) * 8 + h) * 128 + nn) * 128 + d]);
    }
    if (bid == 0) for (int c = threadIdx.x; c < 1024; c += NT) p.LB[c] = sigmoidf_(p.lb_logits[1024 + c] - p.lb_logits[c]);
}
DI void kmean_sample_unit(const Params& p, int u) {
    const int b = u >> 5, blk = u & 31, c = threadIdx.x;
    float acc = 0.f;
#pragma unroll
    for (int pg = 0; pg < 2; ++pg) {
        const int page = p.page_table[b * 64 + blk * 2 + pg];
        const float* src = p.cache_k + (size_t)page * 128 * 512 + c;
#pragma unroll 16
        for (int r = 0; r < 128; ++r) acc += src[(size_t)r * 512];
    }
    p.KMS[(size_t)u * 512 + c] = f2bf(acc * (1.f / 256.f));
}
DI void kmean_prompt_unit(const Params& p, int u) {
    const int c = threadIdx.x;
    const float* src = p.k_prompt + (size_t)u * 256 * 512 + c;
    float acc = 0.f;
#pragma unroll 16
    for (int r = 0; r < 256; ++r) acc += src[(size_t)r * 512];
    p.KMP[(size_t)u * 512 + c] = f2bf(acc * (1.f / 256.f));
}

struct GemmArgs { const bf16_t* A; int lda; const bf16_t* Bt; int ldb; int K; int blockdiag; };
constexpr int GEMM_LDS = 2 * 49152;

template <class Epi>
DI void gemm_unit(const GemmArgs g, int m0, int n0, const Epi epi, char* lds) {
    const int tid = threadIdx.x, lane = tid & 63, w = tid >> 6;
    const int wm = w & 3, wn = w >> 2, lr = lane & 15, lg = lane >> 4;
    const int acol = g.blockdiag ? n0 : 0;
    const int nk = g.K >> 6;
    f32x4 acc[4][4];
#pragma unroll
    for (int i = 0; i < 4; ++i)
#pragma unroll
        for (int j = 0; j < 4; ++j) acc[i][j] = (f32x4){0.f, 0.f, 0.f, 0.f};
    u32x4 ra[4], rb[2];
    auto gload = [&](int kt) {
#pragma unroll
        for (int i = 0; i < 4; ++i) { int id = tid + NT * i; int r = id >> 3, c = id & 7; ra[i] = *(const u32x4*)(g.A + (size_t)(m0 + r) * g.lda + acol + kt * 64 + c * 8); }
#pragma unroll
        for (int i = 0; i < 2; ++i) { int id = tid + NT * i; int r = id >> 3, c = id & 7; rb[i] = *(const u32x4*)(g.Bt + (size_t)(n0 + r) * g.ldb + kt * 64 + c * 8); }
    };
    auto sstore = [&](int st) {
        char* base = lds + st * 49152;
#pragma unroll
        for (int i = 0; i < 4; ++i) { int id = tid + NT * i; int r = id >> 3, c = id & 7; *(u32x4*)(base + r * 128 + ((c ^ (r & 7)) << 4)) = ra[i]; }
#pragma unroll
        for (int i = 0; i < 2; ++i) { int id = tid + NT * i; int r = id >> 3, c = id & 7; *(u32x4*)(base + 32768 + r * 128 + ((c ^ (r & 7)) << 4)) = rb[i]; }
    };
    gload(0); sstore(0); __syncthreads();
    for (int kt = 0; kt < nk; ++kt) {
        if (kt + 1 < nk) gload(kt + 1);
        const char* base = lds + (kt & 1) * 49152;
#pragma unroll
        for (int ks = 0; ks < 2; ++ks) {
            bf16x8 af[4], bfr[4];
#pragma unroll
            for (int i = 0; i < 4; ++i) { int r = wm * 64 + i * 16 + lr; int ch = ks * 4 + lg; af[i] = *(const bf16x8*)(base + r * 128 + ((ch ^ (r & 7)) << 4)); }
#pragma unroll
            for (int i = 0; i < 4; ++i) { int r = wn * 64 + i * 16 + lr; int ch = ks * 4 + lg; bfr[i] = *(const bf16x8*)(base + 32768 + r * 128 + ((ch ^ (r & 7)) << 4)); }
#pragma unroll
            for (int i = 0; i < 4; ++i)
#pragma unroll
                for (int j = 0; j < 4; ++j) acc[i][j] = MFMA16(bfr[j], af[i], acc[i][j]);
        }
        if (kt + 1 < nk) sstore((kt + 1) & 1);
        __syncthreads();
    }
#pragma unroll
    for (int i = 0; i < 4; ++i)
#pragma unroll
        for (int j = 0; j < 4; ++j) epi(m0 + wm * 64 + i * 16 + lr, n0 + wn * 64 + j * 16 + 4 * lg, acc[i][j]);
}

template <class Epi>
DI void gemm_phase(const GemmArgs g, int M, int N, const Epi epi, char* lds, int bid, int nb) {
    const int tn = N >> 7, tm = M >> 8;
    for (int u = bid; u < tm * tn; u += nb) { int mt = u / tn, nt = u % tn; gemm_unit(g, mt * 256, nt * 128, epi, lds); }
}

DI void store_bf4(bf16_t* dst, f32x4 v) { u32x2 o; o[0] = pack_bf2(v[0], v[1]); o[1] = pack_bf2(v[2], v[3]); *(u32x2*)dst = o; }

struct EpiInEven {
    bf16_t* H; float* out; bf16_t* VT;
    DI void operator()(int row, int col, f32x4 v) const {
        store_bf4(H + (size_t)row * 2560 + col, v);
        if (col >= 512 && col < 1536 && row < TT) {
            const bool isv = col >= 1024; const int c = col - (isv ? 1024 : 512);
            const size_t off = row < TP ? (isv ? OFF_VP : OFF_KP) + (size_t)row * 512 + c : (isv ? OFF_VS : OFF_KS) + (size_t)(row - TP) * 512 + c;
            *(f32x4*)(out + off) = v;
            if (isv && row < TP) {
                const int b = row >> 13, s = row & 8191, h = c >> 6, d = c & 63;
                bf16_t* vt = VT + ((size_t)(b * 8 + h) * 64 + d) * 8192 + s;
#pragma unroll
                for (int i = 0; i < 4; ++i) vt[(size_t)i * 8192] = f2bf(v[i]);
            }
        }
    }
};
struct EpiBf16 { bf16_t* O; int ld; DI void operator()(int row, int col, f32x4 v) const { store_bf4(O + (size_t)row * ld + col, v); } };
struct EpiF32 { float* O; int ld; DI void operator()(int row, int col, f32x4 v) const { *(f32x4*)(O + (size_t)row * ld + col) = v; } };
struct EpiResid {
    float* T; const float* XF;
    DI void operator()(int row, int col, f32x4 v) const { f32x4 x = *(const f32x4*)(XF + (size_t)row * DM + col); *(f32x4*)(T + (size_t)row * DM + col) = x * DN_ALPHA + v; }
};
struct EpiInOdd {
    bf16_t* H; float* LF; const float* LB;
    DI void operator()(int row, int col, f32x4 v) const {
        const int sec = col >> 10, c = col & 1023;
        if (sec == 1) {
            f32x4 lb = *(const f32x4*)(LB + c); f32x4 lf, kk;
#pragma unroll
            for (int i = 0; i < 4; ++i) { float f = lb[i] + (1.f - lb[i]) * sigmoidf_(v[i]); lf[i] = __logf(f); kk[i] = 1.f - f; }
            *(f32x4*)(LF + (size_t)row * DM + c) = lf;
            store_bf4(H + (size_t)MP * DM + (size_t)row * DM + c, kk);
        } else {
            store_bf4(H + (size_t)sec * MP * DM + (size_t)row * DM + c, v);
        }
    }
};

DI void conv_unit(const Params& p, int u, char* lds) {
    float* sy = (float*)lds;
    const int c = threadIdx.x, lane = c & 63, w = c >> 6;
    float wj[31];
#pragma unroll
    for (int j = 0; j < 31; ++j) wj[j] = p.conv_w[j * 512 + c];
    const float bias = p.conv_b[c];
    int ntok, row0;
    if (u < 512) {
        const int b = u >> 8, t0 = (u & 255) * 32; ntok = 32; row0 = b * SEQ + t0;
        float uu[62];
#pragma unroll
        for (int r = 0; r < 62; ++r) {
            const int t = t0 - 30 + r; float val = 0.f;
            if (t >= 0) { const size_t row = (size_t)b * SEQ + t; float a = bf2f(p.H[row * 2560 + 1536 + c]); float g = bf2f(p.H[row * 2560 + 2048 + c]); val = a * sigmoidf_(g); }
            uu[r] = val;
            if (t0 == SEQ - 32 && r >= 32) p.conv_prompt[((size_t)b * 30 + (r - 32)) * 512 + c] = val;
        }
#pragma unroll
        for (int tt = 0; tt < 32; ++tt) {
            float acc = bias;
#pragma unroll
            for (int j = 0; j < 31; ++j) acc += wj[j] * uu[tt + j];
            sy[tt * 512 + c] = acc;
        }
    } else {
        const int b = u - 512; ntok = 1; row0 = TP + b;
        const size_t row = (size_t)row0;
        float a = bf2f(p.H[row * 2560 + 1536 + c]); float g = bf2f(p.H[row * 2560 + 2048 + c]);
        const float un = a * sigmoidf_(g);
        float acc = bias + wj[30] * un;
#pragma unroll
        for (int j = 0; j < 30; ++j) {
            float e = p.state_conv[((size_t)b * 30 + j) * 512 + c]; acc += wj[j] * e;
            if (j >= 1) p.conv_sample[((size_t)b * 30 + (j - 1)) * 512 + c] = e;
        }
        p.conv_sample[((size_t)b * 30 + 29) * 512 + c] = un;
        sy[c] = acc;
    }
    __syncthreads();
    for (int tt = w; tt < ntok; tt += 8) {
        float v[8]; float s = 0.f;
#pragma unroll
        for (int i = 0; i < 8; ++i) { v[i] = sy[tt * 512 + lane + 64 * i]; s += v[i]; }
        const float mu = wave_sum(s) * (1.f / 512.f);
        float q = 0.f;
#pragma unroll
        for (int i = 0; i < 8; ++i) { float d = v[i] - mu; q += d * d; }
        const float rs = rsqrtf(wave_sum(q) * (1.f / 512.f) + LN_EPS);
#pragma unroll
        for (int i = 0; i < 8; ++i) {
            const int cc = lane + 64 * i;
            float y = (v[i] - mu) * rs * p.conv_ln_g[cc] + p.conv_ln_b[cc];
            y = y * sigmoidf_(y);
            p.MIX[(size_t)(row0 + tt) * DM + 512 + cc] = f2bf(y);
        }
    }
    __syncthreads();
}

DI void moba_sample_unit(const Params& p, int u, char* lds) {
    float* sq = (float*)lds;
    float* gs = sq + 64;
    int* sel = (int*)(gs + 32);
    float* lg = (float*)(sel + 4);
    float* red = lg + 776;
    float* part = red + 16;
    const int tid = threadIdx.x, lane = tid & 63, w = tid >> 6;
    const int b = u >> 3, h = u & 7; const size_t row = (size_t)TP + b;
    if (tid < 64) sq[tid] = bf2f(p.H[row * 2560 + h * 64 + tid]);
    __syncthreads();
    if (tid < 32) { const bf16_t* km = p.KMS + ((size_t)b * 32 + tid) * 512 + h * 64; float s = 0.f;
#pragma unroll 8
        for (int d = 0; d < 64; ++d) s += sq[d] * bf2f(km[d]);
        gs[tid] = s; }
    __syncthreads();
    if (tid == 0) {
        float v0 = -INFINITY, v1 = -INFINITY, v2 = -INFINITY; int i0 = 0, i1 = 0, i2 = 0;
        for (int j = 0; j < 32; ++j) { float s = gs[j];
            if (s > v0) { v2 = v1; i2 = i1; v1 = v0; i1 = i0; v0 = s; i0 = j; }
            else if (s > v1) { v2 = v1; i2 = i1; v1 = s; i1 = j; }
            else if (s > v2) { v2 = s; i2 = j; } }
        sel[0] = i0; sel[1] = i1; sel[2] = i2;
    }
    __syncthreads();
    for (int idx = tid; idx < 769; idx += NT) {
        float s = 0.f;
        if (idx < 768) {
            const int blk = sel[idx >> 8]; const int pos = blk * 256 + (idx & 255);
            const int page = p.page_table[b * 64 + (pos >> 7)];
            const float* kp = p.cache_k + (((size_t)page * 128 + (pos & 127)) * 8 + h) * 64;
#pragma unroll
            for (int d4 = 0; d4 < 16; ++d4) { f32x4 kv = *(const f32x4*)(kp + 4 * d4); s += sq[4 * d4] * kv[0] + sq[4 * d4 + 1] * kv[1] + sq[4 * d4 + 2] * kv[2] + sq[4 * d4 + 3] * kv[3]; }
        } else {
            const bf16_t* kn = p.H + row * 2560 + 512 + h * 64;
            for (int d = 0; d < 64; ++d) s += sq[d] * bf2f(kn[d]);
        }
        lg[idx] = s * 0.125f;
    }
    __syncthreads();
    float mx = -INFINITY;
    for (int idx = tid; idx < 769; idx += NT) mx = fmaxf(mx, lg[idx]);
    mx = wave_max(mx); if (lane == 0) red[w] = mx;
    __syncthreads();
    mx = red[0];
#pragma unroll
    for (int i = 1; i < 8; ++i) mx = fmaxf(mx, red[i]);
    float sm = 0.f;
    for (int idx = tid; idx < 769; idx += NT) { float e = __expf(lg[idx] - mx); lg[idx] = e; sm += e; }
    sm = wave_sum(sm); if (lane == 0) red[8 + w] = sm;
    __syncthreads();
    sm = 0.f;
#pragma unroll
    for (int i = 0; i < 8; ++i) sm += red[8 + i];
    {
        const int d = lane; float acc = 0.f;
        for (int idx = w; idx < 769; idx += 8) {
            float vv;
            if (idx < 768) { const int blk = sel[idx >> 8]; const int pos = blk * 256 + (idx & 255);
                const int page = p.page_table[b * 64 + (pos >> 7)];
                vv = p.cache_v[(((size_t)page * 128 + (pos & 127)) * 8 + h) * 64 + d]; }
            else vv = bf2f(p.H[row * 2560 + 1024 + h * 64 + d]);
            acc += lg[idx] * vv;
        }
        part[w * 64 + d] = acc;
    }
    __syncthreads();
    if (tid < 64) { float a = 0.f;
#pragma unroll
        for (int i = 0; i < 8; ++i) a += part[i * 64 + tid];
        p.MIX[row * DM + h * 64 + tid] = f2bf(a / sm); }
    __syncthreads();
}

DI void moba_prompt_unit(const Params& p, int bh, int own, char* lds) {
    const int tid = threadIdx.x, lane = tid & 63, w = tid >> 6, lr = lane & 15, lg = lane >> 4;
    const int b = bh >> 3, h = bh & 7;
    float* gsc = (float*)lds + w * 1024;
    unsigned* msk = (unsigned*)(lds + 32768) + w * 36;
    const size_t rowq0 = (size_t)b * SEQ + own * 256 + w * 32;
    bf16x8 qf[2][2];
#pragma unroll
    for (int qt = 0; qt < 2; ++qt)
#pragma unroll
        for (int ks = 0; ks < 2; ++ks) qf[qt][ks] = *(const bf16x8*)(p.H + (rowq0 + qt * 16 + lr) * 2560 + h * 64 + ks * 32 + lg * 8);
    unsigned mq[2]; unsigned wor;
    if (own > 3) {
#pragma unroll
        for (int jt = 0; jt < 2; ++jt) {
            bf16x8 kf[2];
#pragma unroll
            for (int ks = 0; ks < 2; ++ks) kf[ks] = *(const bf16x8*)(p.KMP + ((size_t)b * 32 + jt * 16 + lr) * 512 + h * 64 + ks * 32 + lg * 8);
#pragma unroll
            for (int qt = 0; qt < 2; ++qt) {
                f32x4 a = {0.f, 0.f, 0.f, 0.f};
                a = MFMA16(kf[0], qf[qt][0], a); a = MFMA16(kf[1], qf[qt][1], a);
#pragma unroll
                for (int r = 0; r < 4; ++r) gsc[(qt * 16 + lr) * 32 + jt * 16 + 4 * lg + r] = a[r];
            }
        }
        __builtin_amdgcn_s_waitcnt(0);
        __builtin_amdgcn_wave_barrier();
        unsigned m = 0;
        if (lane < 32) {
            float v0 = -INFINITY, v1 = -INFINITY, v2 = -INFINITY; int i0 = 0, i1 = 0, i2 = 0;
            for (int j = 0; j < own; ++j) { float s = gsc[lane * 32 + j];
                if (s > v0) { v2 = v1; i2 = i1; v1 = v0; i1 = i0; v0 = s; i0 = j; }
                else if (s > v1) { v2 = v1; i2 = i1; v1 = s; i1 = j; }
                else if (s > v2) { v2 = s; i2 = j; } }
            m = (1u << i0) | (1u << i1) | (1u << i2);
            msk[lane] = m;
        }
        unsigned o = m;
#pragma unroll
        for (int s = 32; s >= 1; s >>= 1) o |= (unsigned)__shfl_xor((int)o, s, 64);
        wor = o;
        __builtin_amdgcn_s_waitcnt(0);
        __builtin_amdgcn_wave_barrier();
        mq[0] = msk[lr]; mq[1] = msk[16 + lr];
    } else {
        const unsigned m = (own >= 1) ? ((1u << own) - 1u) : 0u;
        mq[0] = m; mq[1] = m; wor = m;
    }
    wor = (unsigned)__builtin_amdgcn_readfirstlane((int)wor);
    const float SC = 0.125f * 1.4426950408889634f;
    float mrow[2] = {-INFINITY, -INFINITY}, lrow[2] = {0.f, 0.f};
    f32x4 oacc[2][4];
#pragma unroll
    for (int qt = 0; qt < 2; ++qt)
#pragma unroll
        for (int dt = 0; dt < 4; ++dt) oacc[qt][dt] = (f32x4){0.f, 0.f, 0.f, 0.f};
    const bf16_t* Kbase = p.H + (size_t)b * SEQ * 2560 + 512 + h * 64;
    const bf16_t* Vbase = p.VT + (size_t)(b * 8 + h) * 64 * 8192;
    for (int it = -1; it < own; ++it) {
        const int jb = (it < 0) ? own : it;
        const bool isown = it < 0;
        if (!isown && !((wor >> jb) & 1u)) continue;
        const int nst = isown ? (w + 1) : 8;
        for (int st = 0; st < nst; ++st) {
            const int key0 = jb * 256 + st * 32;
            bf16x8 kf[2][2];
#pragma unroll
            for (int kt = 0; kt < 2; ++kt)
#pragma unroll
                for (int ks = 0; ks < 2; ++ks) kf[kt][ks] = *(const bf16x8*)(Kbase + (size_t)(key0 + kt * 16 + lr) * 2560 + ks * 32 + lg * 8);
            bf16x8 vf[4];
#pragma unroll
            for (int dt = 0; dt < 4; ++dt) {
                const bf16_t* vp = Vbase + (size_t)(dt * 16 + lr) * 8192 + key0 + 4 * lg;
                u32x2 lo = *(const u32x2*)vp, hi = *(const u32x2*)(vp + 16);
                u32x4 t; t[0] = lo[0]; t[1] = lo[1]; t[2] = hi[0]; t[3] = hi[1];
                vf[dt] = __builtin_bit_cast(bf16x8, t);
            }
#pragma unroll
            for (int qt = 0; qt < 2; ++qt) {
                f32x4 s[2];
#pragma unroll
                for (int kt = 0; kt < 2; ++kt) { f32x4 a = {0.f, 0.f, 0.f, 0.f}; a = MFMA16(kf[kt][0], qf[qt][0], a); a = MFMA16(kf[kt][1], qf[qt][1], a); s[kt] = a; }
                const bool selq = isown || ((mq[qt] >> jb) & 1u);
                const int qin = w * 32 + qt * 16 + lr;
                float mx = -INFINITY;
#pragma unroll
                for (int kt = 0; kt < 2; ++kt)
#pragma unroll
                    for (int r = 0; r < 4; ++r) {
                        const int kin = st * 32 + kt * 16 + 4 * lg + r;
                        const bool ok = selq && (!isown || kin <= qin);
                        float v = ok ? s[kt][r] * SC : -INFINITY;
                        s[kt][r] = v; mx = fmaxf(mx, v);
                    }
                mx = fmaxf(mx, __shfl_xor(mx, 16, 64)); mx = fmaxf(mx, __shfl_xor(mx, 32, 64));
                const float mnew = fmaxf(mrow[qt], mx);
                const float alpha = __builtin_amdgcn_exp2f(mrow[qt] - mnew);
                float ps = 0.f;
#pragma unroll
                for (int kt = 0; kt < 2; ++kt)
#pragma unroll
                    for (int r = 0; r < 4; ++r) { float e = __builtin_amdgcn_exp2f(s[kt][r] - mnew); s[kt][r] = e; ps += e; }
                ps += __shfl_xor(ps, 16, 64); ps += __shfl_xor(ps, 32, 64);
                lrow[qt] = lrow[qt] * alpha + ps; mrow[qt] = mnew;
                u32x4 pk; pk[0] = pack_bf2(s[0][0], s[0][1]); pk[1] = pack_bf2(s[0][2], s[0][3]); pk[2] = pack_bf2(s[1][0], s[1][1]); pk[3] = pack_bf2(s[1][2], s[1][3]);
                const bf16x8 pf = __builtin_bit_cast(bf16x8, pk);
#pragma unroll
                for (int dt = 0; dt < 4; ++dt) { oacc[qt][dt] = oacc[qt][dt] * alpha; oacc[qt][dt] = MFMA16(vf[dt], pf, oacc[qt][dt]); }
            }
        }
    }
#pragma unroll
    for (int qt = 0; qt < 2; ++qt) {
        const float inv = 1.f / lrow[qt];
#pragma unroll
        for (int dt = 0; dt < 4; ++dt) store_bf4(p.MIX + (rowq0 + qt * 16 + lr) * DM + h * 64 + dt * 16 + 4 * lg, oacc[qt][dt] * inv);
    }
}

DI void ln_rows(const Params& p, const float* g, const float* bb, int bid, int nb, bool final_out) {
    const int lane = threadIdx.x & 63, w = threadIdx.x >> 6;
    for (int row = bid * 8 + w; row < TT; row += nb * 8) {
        f32x4 v[4]; float s = 0.f;
#pragma unroll
        for (int i = 0; i < 4; ++i) { v[i] = *(const f32x4*)(p.T + (size_t)row * DM + 4 * lane + 256 * i); s += v[i][0] + v[i][1] + v[i][2] + v[i][3]; }
        const float mu = wave_sum(s) * (1.f / 1024.f);
        float q = 0.f;
#pragma unroll
        for (int i = 0; i < 4; ++i)
#pragma unroll
            for (int k = 0; k < 4; ++k) { float d = v[i][k] - mu; q += d * d; }
        const float rs = rsqrtf(wave_sum(q) * (1.f / 1024.f) + LN_EPS);
#pragma unroll
        for (int i = 0; i < 4; ++i) {
            const int c = 4 * lane + 256 * i;
            f32x4 gg = *(const f32x4*)(g + c), be = *(const f32x4*)(bb + c), y;
#pragma unroll
            for (int k = 0; k < 4; ++k) y[k] = (v[i][k] - mu) * rs * gg[k] + be[k];
            if (final_out) { float* dst = row < TP ? p.y_prompt + (size_t)row * DM + c : p.y_sample + (size_t)(row - TP) * DM + c; *(f32x4*)dst = y; }
            else { *(f32x4*)(p.XF + (size_t)row * DM + c) = y; store_bf4(p.XB + (size_t)row * DM + c, y); }
        }
    }
}

#define INS16(V, I, tv, ti) { float _v = (V); int _i = (I); _Pragma("unroll") for (int _k = 0; _k < 16; ++_k) { const bool _g = _v > tv[_k]; const float _tv = tv[_k]; const int _ti = ti[_k]; tv[_k] = _g ? _v : _tv; ti[_k] = _g ? _i : _ti; _v = _g ? _tv : _v; _i = _g ? _ti : _i; } }
DI void peer_topk_unit(const Params& p, int u, char* lds) {
    float* lv = (float*)lds;
    int* li = (int*)(lds + 512 * 17 * 4);
    const int tid = threadIdx.x; const int tok = u * 32 + (tid >> 4), j = tid & 15;
    float tv[16]; int ti[16];
#pragma unroll
    for (int k = 0; k < 16; ++k) { tv[k] = -INFINITY; ti[k] = 0; }
    if (tok < TT) {
        const float* s = p.S + (size_t)tok * 2048 + j * 128;
        for (int n4 = 0; n4 < 32; ++n4) {
            f32x4 v = *(const f32x4*)(s + 4 * n4);
            INS16(v[0], 4 * n4, tv, ti); INS16(v[1], 4 * n4 + 1, tv, ti); INS16(v[2], 4 * n4 + 2, tv, ti); INS16(v[3], 4 * n4 + 3, tv, ti);
        }
    }
#pragma unroll
    for (int k = 0; k < 16; ++k) { lv[tid * 17 + k] = tv[k]; li[tid * 17 + k] = ti[k]; }
    __syncthreads();
    if ((j & 1) == 0 && tok < TT) {
        float v2[16]; int i2[16];
#pragma unroll
        for (int k = 0; k < 16; ++k) { v2[k] = lv[(tid + 1) * 17 + k]; i2[k] = li[(tid + 1) * 17 + k]; }
        float sv[16]; int si[16];
#pragma unroll
        for (int k = 0; k < 16; ++k) { sv[k] = -INFINITY; si[k] = 0; }
#pragma unroll
        for (int a = 0; a < 16; ++a)
#pragma unroll
            for (int bq = 0; bq < 16; ++bq)
                if ((a + 1) * (bq + 1) <= 16) INS16(tv[a] + v2[bq], ti[a] * 128 + i2[bq], sv, si);
        float sm = 0.f; float e[16];
#pragma unroll
        for (int k = 0; k < 16; ++k) { e[k] = __expf(sv[k] - sv[0]); sm += e[k]; }
        const float inv = 1.f / sm; const int h = j >> 1;
#pragma unroll
        for (int k = 0; k < 16; ++k) { p.E[(size_t)tok * 128 + h * 16 + k] = si[k]; p.G[(size_t)tok * 128 + h * 16 + k] = e[k] * inv; }
    }
    __syncthreads();
}

DI void peer_gather(const Params& p, int layer, int bid, int nb, bool final_out) {
    const int lane = threadIdx.x & 63, w = threadIdx.x >> 6;
    const bf16_t* U = p.UB + (size_t)layer * 16384 * DM; const bf16_t* V = p.VB + (size_t)layer * 16384 * DM;
    const float* g = p.ln_g + (layer * 2 + 1) * DM; const float* bb = p.ln_b + (layer * 2 + 1) * DM;
    for (int tok = bid * 8 + w; tok < TT; tok += nb * 8) {
        float x[16];
        {
            const float* xr = p.XF + (size_t)tok * DM;
            f32x4 a0 = *(const f32x4*)(xr + 8 * lane), a1 = *(const f32x4*)(xr + 8 * lane + 4), b0 = *(const f32x4*)(xr + 512 + 8 * lane), b1 = *(const f32x4*)(xr + 512 + 8 * lane + 4);
#pragma unroll
            for (int k = 0; k < 4; ++k) { x[k] = a0[k]; x[4 + k] = a1[k]; x[8 + k] = b0[k]; x[12 + k] = b1[k]; }
        }
        const int e0 = p.E[(size_t)tok * 128 + lane], e1 = p.E[(size_t)tok * 128 + 64 + lane];
        const float g0 = p.G[(size_t)tok * 128 + lane], g1 = p.G[(size_t)tok * 128 + 64 + lane];
        float z0 = 0.f, z1 = 0.f;
#pragma unroll 4
        for (int pk = 0; pk < 128; ++pk) {
            const int e = __shfl((pk < 64) ? e0 : e1, pk & 63, 64);
            const bf16_t* ur = U + (size_t)e * DM;
            u32x4 a = *(const u32x4*)(ur + 8 * lane), c = *(const u32x4*)(ur + 512 + 8 * lane);
            float s = 0.f;
#pragma unroll
            for (int k = 0; k < 4; ++k) { s += x[2 * k] * bflo(a[k]) + x[2 * k + 1] * bfhi(a[k]); s += x[8 + 2 * k] * bflo(c[k]) + x[8 + 2 * k + 1] * bfhi(c[k]); }
            s = wave_sum(s);
            if (pk < 64) { if (lane == pk) z0 = s; } else { if (lane == pk - 64) z1 = s; }
        }
        const float h0 = g0 * 0.5f * z0 * (1.f + erff(z0 * 0.70710678118654752f));
        const float h1 = g1 * 0.5f * z1 * (1.f + erff(z1 * 0.70710678118654752f));
        float o[16];
#pragma unroll
        for (int k = 0; k < 16; ++k) o[k] = 0.f;
#pragma unroll 4
        for (int pk = 0; pk < 128; ++pk) {
            const int e = __shfl((pk < 64) ? e0 : e1, pk & 63, 64);
            const float hh = __shfl((pk < 64) ? h0 : h1, pk & 63, 64);
            const bf16_t* vr = V + (size_t)e * DM;
            u32x4 a = *(const u32x4*)(vr + 8 * lane), c = *(const u32x4*)(vr + 512 + 8 * lane);
#pragma unroll
            for (int k = 0; k < 4; ++k) { o[2 * k] += hh * bflo(a[k]); o[2 * k + 1] += hh * bfhi(a[k]); o[8 + 2 * k] += hh * bflo(c[k]); o[8 + 2 * k + 1] += hh * bfhi(c[k]); }
        }
        float s = 0.f;
#pragma unroll
        for (int k = 0; k < 16; ++k) { o[k] = DN_ALPHA * x[k] + o[k]; s += o[k]; }
        const float mu = wave_sum(s) * (1.f / 1024.f);
        float q = 0.f;
#pragma unroll
        for (int k = 0; k < 16; ++k) { float d = o[k] - mu; q += d * d; }
        const float rs = rsqrtf(wave_sum(q) * (1.f / 1024.f) + LN_EPS);
#pragma unroll
        for (int hf = 0; hf < 2; ++hf) {
            const int c = hf * 512 + 8 * lane;
            f32x4 y0, y1;
#pragma unroll
            for (int k = 0; k < 4; ++k) { y0[k] = (o[hf * 8 + k] - mu) * rs * g[c + k] + bb[c + k]; y1[k] = (o[hf * 8 + 4 + k] - mu) * rs * g[c + 4 + k] + bb[c + 4 + k]; }
            if (final_out) { float* dst = tok < TP ? p.y_prompt + (size_t)tok * DM + c : p.y_sample + (size_t)(tok - TP) * DM + c; *(f32x4*)dst = y0; *(f32x4*)(dst + 4) = y1; }
            else { float* dst = p.XF + (size_t)tok * DM + c; *(f32x4*)dst = y0; *(f32x4*)(dst + 4) = y1; store_bf4(p.XB + (size_t)tok * DM + c, y0); store_bf4(p.XB + (size_t)tok * DM + c + 4, y1); }
        }
    }
}

DI void hgrn_cumsum(const Params& p, size_t row0, int h, float* bs, float* tot) {
    const int tid = threadIdx.x;
#pragma unroll
    for (int i = 0; i < 4; ++i) { int id = tid + NT * i; int s = id >> 5, c4 = id & 31; *(f32x4*)(bs + s * 128 + 4 * c4) = *(const f32x4*)(p.LF + (row0 + s) * DM + h * 128 + 4 * c4); }
    __syncthreads();
    const int k = tid & 127, seg = tid >> 7;
    float run = 0.f;
#pragma unroll
    for (int i = 0; i < 16; ++i) { run += bs[(seg * 16 + i) * 128 + k]; bs[(seg * 16 + i) * 128 + k] = run; }
    tot[seg * 128 + k] = run;
    __syncthreads();
    float off = 0.f;
#pragma unroll
    for (int s2 = 0; s2 < 3; ++s2) if (s2 < seg) off += tot[s2 * 128 + k];
    if (seg > 0) {
#pragma unroll
        for (int i = 0; i < 16; ++i) bs[(seg * 16 + i) * 128 + k] += off;
    }
    __syncthreads();
}
constexpr int HG_TS = 72;
constexpr int HG_FS = 136;
DI void hgrn_b1_unit(const Params& p, int u, char* lds) {
    float* bs = (float*)lds;
    float* tot = (float*)(lds + 32768);
    bf16_t* KT = (bf16_t*)(lds + 36864);
    bf16_t* IT = (bf16_t*)(lds + 36864 + 18432);
    const int tid = threadIdx.x, lane = tid & 63, w = tid >> 6, lr = lane & 15, lg = lane >> 4;
    const int bh = u >> 7, c = u & 127, b = bh >> 3, h = bh & 7;
    const size_t row0 = (size_t)b * SEQ + c * 64;
    hgrn_cumsum(p, row0, h, bs, tot);
    const bf16_t* KK = p.H + (size_t)MP * DM; const bf16_t* I1 = p.H + (size_t)2 * MP * DM;
    {
        const int s = tid >> 3, kc = (tid & 7) * 16;
        const bf16_t* kr = KK + (row0 + s) * DM + h * 128 + kc; const bf16_t* ir = I1 + (row0 + s) * DM + h * 128 + kc;
        u32x4 ka = *(const u32x4*)kr, kb = *(const u32x4*)(kr + 8), ia = *(const u32x4*)ir, ib = *(const u32x4*)(ir + 8);
#pragma unroll
        for (int i = 0; i < 16; ++i) {
            const unsigned kw = (i < 8) ? ka[(i & 7) >> 1] : kb[(i & 7) >> 1]; const unsigned iw = (i < 8) ? ia[(i & 7) >> 1] : ib[(i & 7) >> 1];
            const float kv = (i & 1) ? bfhi(kw) : bflo(kw);
            const float e = __expf(fminf(-bs[s * 128 + kc + i], 80.f));
            KT[(kc + i) * HG_TS + s] = f2bf(kv * e);
            IT[(kc + i) * HG_TS + s] = (bf16_t)((i & 1) ? (iw >> 16) : (iw & 0xffffu));
        }
    }
    __syncthreads();
    f32x4 acc[8];
#pragma unroll
    for (int j = 0; j < 8; ++j) acc[j] = (f32x4){0.f, 0.f, 0.f, 0.f};
#pragma unroll
    for (int ks = 0; ks < 2; ++ks) {
        const bf16x8 af = *(const bf16x8*)(KT + (w * 16 + lr) * HG_TS + ks * 32 + lg * 8);
#pragma unroll
        for (int j = 0; j < 8; ++j) { const bf16x8 bfr = *(const bf16x8*)(IT + (j * 16 + lr) * HG_TS + ks * 32 + lg * 8); acc[j] = MFMA16(af, bfr, acc[j]); }
    }
    f32x4 dl;
#pragma unroll
    for (int r = 0; r < 4; ++r) dl[r] = __expf(bs[63 * 128 + w * 16 + 4 * lg + r]);
#pragma unroll
    for (int j = 0; j < 8; ++j) *(f32x4*)(p.UT + ((size_t)u * 128 + j * 16 + lr) * 128 + w * 16 + 4 * lg) = acc[j] * dl;
    if (tid < 128) p.DEC[(size_t)u * 128 + tid] = __expf(bs[63 * 128 + tid]);
    __syncthreads();
}
DI void hgrn_b2(const Params& p, int bid, int nb) {
    for (int e = bid * NT + threadIdx.x; e < 16 * 16384; e += nb * NT) {
        const int bh = e >> 14, vk = e & 16383, k = vk & 127, v = vk >> 7;
        float S = 0.f;
        for (int c0 = 0; c0 < 128; c0 += 8) {
            float uu[8], dd[8];
#pragma unroll
            for (int i = 0; i < 8; ++i) { const size_t un = (size_t)bh * 128 + c0 + i; uu[i] = p.UT[un * 16384 + vk]; dd[i] = p.DEC[un * 128 + k]; }
#pragma unroll
            for (int i = 0; i < 8; ++i) { const size_t un = (size_t)bh * 128 + c0 + i; p.ST[un * 16384 + vk] = f2bf(S); S = dd[i] * S + uu[i]; }
        }
        p.hgrn_prompt[((size_t)bh * 128 + k) * 128 + v] = S;
    }
}
DI void hgrn_b3_unit(const Params& p, int u, char* lds) {
    float* bs = (float*)lds;
    float* tot = (float*)(lds + 32768);
    bf16_t* QH = (bf16_t*)(lds + 36864);
    bf16_t* KH = (bf16_t*)(lds + 36864 + 17408);
    bf16_t* IT = (bf16_t*)(lds + 36864 + 34816);
    bf16_t* AT = (bf16_t*)(lds + 36864 + 34816 + 18432);
    const int tid = threadIdx.x, lane = tid & 63, w = tid >> 6, lr = lane & 15, lg = lane >> 4;
    const int bh = u >> 7, c = u & 127, b = bh >> 3, h = bh & 7;
    const size_t row0 = (size_t)b * SEQ + c * 64;
    hgrn_cumsum(p, row0, h, bs, tot);
    const bf16_t* Q1 = p.H; const bf16_t* KK = p.H + (size_t)MP * DM; const bf16_t* I1 = p.H + (size_t)2 * MP * DM; const bf16_t* G1 = p.H + (size_t)3 * MP * DM;
    {
        const int s = tid >> 3, kc = (tid & 7) * 16;
        const bf16_t* qr = Q1 + (row0 + s) * DM + h * 128 + kc; const bf16_t* kr = KK + (row0 + s) * DM + h * 128 + kc; const bf16_t* ir = I1 + (row0 + s) * DM + h * 128 + kc;
        u32x4 qa = *(const u32x4*)qr, qb = *(const u32x4*)(qr + 8), ka = *(const u32x4*)kr, kb = *(const u32x4*)(kr + 8), ia = *(const u32x4*)ir, ib = *(const u32x4*)(ir + 8);
#pragma unroll
        for (int i = 0; i < 16; ++i) {
            const unsigned qw = (i < 8) ? qa[(i & 7) >> 1] : qb[(i & 7) >> 1]; const unsigned kw = (i < 8) ? ka[(i & 7) >> 1] : kb[(i & 7) >> 1]; const unsigned iw = (i < 8) ? ia[(i & 7) >> 1] : ib[(i & 7) >> 1];
            const float qv = (i & 1) ? bfhi(qw) : bflo(qw); const float kv = (i & 1) ? bfhi(kw) : bflo(kw);
            const float bb = bs[s * 128 + kc + i];
            QH[s * HG_FS + kc + i] = f2bf(qv * __expf(bb));
            KH[s * HG_FS + kc + i] = f2bf(kv * __expf(fminf(-bb, 80.f)));
            IT[(kc + i) * HG_TS + s] = (bf16_t)((i & 1) ? (iw >> 16) : (iw & 0xffffu));
        }
    }
    __syncthreads();
    {
        const int tt = w & 3;
#pragma unroll
        for (int si = 0; si < 2; ++si) {
            const int stile = (w >> 2) * 2 + si;
            f32x4 a = {0.f, 0.f, 0.f, 0.f};
            if (stile <= tt) {
#pragma unroll
                for (int ks = 0; ks < 4; ++ks) {
                    const bf16x8 af = *(const bf16x8*)(KH + (stile * 16 + lr) * HG_FS + ks * 32 + lg * 8);
                    const bf16x8 bfr = *(const bf16x8*)(QH + (tt * 16 + lr) * HG_FS + ks * 32 + lg * 8);
                    a = MFMA16(af, bfr, a);
                }
            }
            const int t = tt * 16 + lr;
#pragma unroll
            for (int r = 0; r < 4; ++r) { const int s = stile * 16 + 4 * lg + r; if (s > t) a[r] = 0.f; }
            store_bf4(AT + t * HG_TS + stile * 16 + 4 * lg, a);
        }
    }
    __syncthreads();
    const int tt = w & 3;
    f32x4 acc[4];
#pragma unroll
    for (int j = 0; j < 4; ++j) acc[j] = (f32x4){0.f, 0.f, 0.f, 0.f};
#pragma unroll
    for (int ks = 0; ks < 2; ++ks) {
        const bf16x8 bfr = *(const bf16x8*)(AT + (tt * 16 + lr) * HG_TS + ks * 32 + lg * 8);
#pragma unroll
        for (int j = 0; j < 4; ++j) { const int vt = (w >> 2) * 4 + j; const bf16x8 af = *(const bf16x8*)(IT + (vt * 16 + lr) * HG_TS + ks * 32 + lg * 8); acc[j] = MFMA16(af, bfr, acc[j]); }
    }
    const bf16_t* STu = p.ST + (size_t)u * 16384;
#pragma unroll
    for (int ks = 0; ks < 4; ++ks) {
        const bf16x8 bfr = *(const bf16x8*)(QH + (tt * 16 + lr) * HG_FS + ks * 32 + lg * 8);
#pragma unroll
        for (int j = 0; j < 4; ++j) { const int vt = (w >> 2) * 4 + j; const bf16x8 af = *(const bf16x8*)(STu + (vt * 16 + lr) * 128 + ks * 32 + lg * 8); acc[j] = MFMA16(af, bfr, acc[j]); }
    }
    float ss = 0.f;
#pragma unroll
    for (int j = 0; j < 4; ++j)
#pragma unroll
        for (int r = 0; r < 4; ++r) ss += acc[j][r] * acc[j][r];
    ss += __shfl_xor(ss, 16, 64); ss += __shfl_xor(ss, 32, 64);
    float* red = tot;
    if (lg == 0) red[(w >> 2) * 64 + tt * 16 + lr] = ss;
    __syncthreads();
    const float rs = rsqrtf((red[tt * 16 + lr] + red[64 + tt * 16 + lr]) * (1.f / 128.f) + RMS_EPS);
    const size_t row = row0 + tt * 16 + lr;
#pragma unroll
    for (int j = 0; j < 4; ++j) {
        const int col = h * 128 + ((w >> 2) * 4 + j) * 16 + 4 * lg;
        const u32x2 gw = *(const u32x2*)(G1 + row * DM + col);
        const f32x4 ng = *(const f32x4*)(p.hgrn_norm_g + col);
        f32x4 o;
        const float gg[4] = {bflo(gw[0]), bfhi(gw[0]), bflo(gw[1]), bfhi(gw[1])};
#pragma unroll
        for (int r = 0; r < 4; ++r) o[r] = acc[j][r] * rs * ng[r] * (gg[r] * sigmoidf_(gg[r]));
        store_bf4(p.MIX + row * DM + col, o);
    }
    __syncthreads();
}
DI void hgrn_sample_unit(const Params& p, int u, char* lds) {
    float* part = (float*)lds;
    float* red = part + 512;
    const int tid = threadIdx.x, lane = tid & 63, w = tid >> 6;
    const int b = u >> 3, h = u & 7; const size_t row = (size_t)TP + b;
    const bf16_t* Q1 = p.H; const bf16_t* KK = p.H + (size_t)MP * DM; const bf16_t* I1 = p.H + (size_t)2 * MP * DM; const bf16_t* G1 = p.H + (size_t)3 * MP * DM;
    const int v = tid & 127, kq = tid >> 7;
    const float iv = bf2f(I1[row * DM + h * 128 + v]);
    float acc = 0.f;
    const float* S0 = p.state_hgrn + (size_t)u * 16384; float* S1 = p.hgrn_sample + (size_t)u * 16384;
#pragma unroll 8
    for (int kk = 0; kk < 32; ++kk) {
        const int k = kq * 32 + kk;
        const float f = __expf(p.LF[row * DM + h * 128 + k]);
        const float kv = bf2f(KK[row * DM + h * 128 + k]);
        const float q = bf2f(Q1[row * DM + h * 128 + k]);
        const float st = f * S0[k * 128 + v] + kv * iv;
        S1[k * 128 + v] = st; acc += q * st;
    }
    part[kq * 128 + v] = acc;
    __syncthreads();
    float o = 0.f, sq = 0.f;
    if (tid < 128) { o = part[tid] + part[128 + tid] + part[256 + tid] + part[384 + tid]; sq = o * o; }
    sq = wave_sum(sq); if (lane == 0) red[w] = sq;
    __syncthreads();
    if (tid < 128) {
        const float rs = rsqrtf((red[0] + red[1]) * (1.f / 128.f) + RMS_EPS);
        const float g = bf2f(G1[row * DM + h * 128 + tid]);
        p.MIX[row * DM + h * 128 + tid] = f2bf(o * rs * p.hgrn_norm_g[h * 128 + tid] * (g * sigmoidf_(g)));
    }
    __syncthreads();
}

constexpr int LDS_BYTES = 131072 + 256;

template <int LAYER> DI void peer_phases(const Params& p, char* lds, int bid, int nb, const XcdBarrier& bar) {
    {
        GemmArgs g{p.XB, DM, p.WT_WQ + (size_t)LAYER * 2048 * 1024, DM, DM, 0};
        EpiBf16 epi{p.QH, 2048};
        gemm_phase(g, MP, 2048, epi, lds, bid, nb);
    }
    xcd_barrier(bar);
    {
        GemmArgs g{p.QH, 2048, p.KB + (size_t)LAYER * 2048 * 128, 128, 128, 1};
        EpiF32 epi{p.S, 2048};
        gemm_phase(g, MP, 2048, epi, lds, bid, nb);
    }
    xcd_barrier(bar);
    for (int u = bid; u < (TT + 31) / 32; u += nb) peer_topk_unit(p, u, lds);
    xcd_barrier(bar);
    peer_gather(p, LAYER, bid, nb, LAYER == 1);
}

__global__ void __launch_bounds__(NT, 2) mega(Params p) {
    extern __shared__ __attribute__((aligned(16))) char lds[];
    const int bid = blockIdx.x, nb = gridDim.x;
    if (threadIdx.x == 0) *(uint4*)(lds + 131072) = make_uint4(0u, 0u, 0u, 0u);
    __syncthreads();
    XcdBarrier bar = xcd_barrier_post(p.bar, (volatile LAS unsigned*)(lds + 131072));
    for (int u = bid; u < 16 * 40; u += nb) transpose_unit(p.w_in_even, 1024, 2560, p.WT_IN_EVEN, u, lds);
    for (int u = bid; u < 16 * 16; u += nb) transpose_unit(p.w_out_even, 1024, 1024, p.WT_OUT_EVEN, u, lds);
    for (int u = bid; u < 16 * 64; u += nb) transpose_unit(p.w_in_odd, 1024, 4096, p.WT_IN_ODD, u, lds);
    for (int u = bid; u < 16 * 16; u += nb) transpose_unit(p.w_out_odd, 1024, 1024, p.WT_OUT_ODD, u, lds);
    for (int u = bid; u < 16 * 32; u += nb) transpose_unit(p.peer_wq, 1024, 2048, p.WT_WQ, u, lds);
    for (int u = bid; u < 16 * 32; u += nb) transpose_unit(p.peer_wq + (size_t)1024 * 2048, 1024, 2048, p.WT_WQ + (size_t)2048 * 1024, u, lds);
    convert_x(p, bid, nb);
    convert_keys(p, bid, nb);
    convert_range(p.peer_u, p.UB, (size_t)2 * 16384 * DM / 4, bid, nb);
    convert_range(p.peer_v, p.VB, (size_t)2 * 16384 * DM / 4, bid, nb);
    for (int u = bid; u < 1024; u += nb) kmean_sample_unit(p, u);
    xcd_barrier(bar);
    {
        GemmArgs g{p.XB, DM, p.WT_IN_EVEN, DM, DM, 0};
        EpiInEven epi{p.H, p.y_prompt, p.VT};
        gemm_phase(g, MP, 2560, epi, lds, bid, nb);
    }
    xcd_barrier(bar);
    for (int u = bid; u < 64; u += nb) kmean_prompt_unit(p, u);
    for (int u = bid; u < 544; u += nb) conv_unit(p, u, lds);
    xcd_barrier(bar);
    for (int u = bid; u < 512 + 256; u += nb) {
        if (u < 512) { const int bh = (u & 255) >> 4, i = u & 15; const int blk = (u < 256) ? i : 31 - i; moba_prompt_unit(p, bh, blk, lds); __syncthreads(); }
        else moba_sample_unit(p, u - 512, lds);
    }
    xcd_barrier(bar);
    {
        GemmArgs g{p.MIX, DM, p.WT_OUT_EVEN, DM, DM, 0};
        EpiResid epi{p.T, p.XF};
        gemm_phase(g, MP, 1024, epi, lds, bid, nb);
    }
    xcd_barrier(bar);
    ln_rows(p, p.ln_g, p.ln_b, bid, nb, false);
    xcd_barrier(bar);
    peer_phases<0>(p, lds, bid, nb, bar);
    xcd_barrier(bar);
    {
        GemmArgs g{p.XB, DM, p.WT_IN_ODD, DM, DM, 0};
        EpiInOdd epi{p.H, p.LF, p.LB};
        gemm_phase(g, MP, 4096, epi, lds, bid, nb);
    }
    xcd_barrier(bar);
    for (int u = bid; u < 2048 + 256; u += nb) { if (u < 2048) hgrn_b1_unit(p, u, lds); else hgrn_sample_unit(p, u - 2048, lds); }
    xcd_barrier(bar);
    hgrn_b2(p, bid, nb);
    xcd_barrier(bar);
    for (int u = bid; u < 2048; u += nb) hgrn_b3_unit(p, u, lds);
    xcd_barrier(bar);
    {
        GemmArgs g{p.MIX, DM, p.WT_OUT_ODD, DM, DM, 0};
        EpiResid epi{p.T, p.XF};
        gemm_phase(g, MP, 1024, epi, lds, bid, nb);
    }
    xcd_barrier(bar);
    ln_rows(p, p.ln_g + 2 * DM, p.ln_b + 2 * DM, bid, nb, false);
    xcd_barrier(bar);
    peer_phases<1>(p, lds, bid, nb, bar);
}

extern "C" void kernel_launch(void* const* d_in, const int* in_sizes, int n_in, void* d_out, int out_size, void* d_ws, size_t ws_size, hipStream_t stream) {
    Params p{};
    p.x_prompt = (const float*)d_in[0]; p.x_sample = (const float*)d_in[1]; p.cache_k = (const float*)d_in[2]; p.cache_v = (const float*)d_in[3];
    p.state_conv = (const float*)d_in[4]; p.state_hgrn = (const float*)d_in[5]; p.page_table = (const int*)d_in[6];
    p.w_in_even = (const float*)d_in[7]; p.conv_w = (const float*)d_in[8]; p.conv_b = (const float*)d_in[9]; p.conv_ln_g = (const float*)d_in[10]; p.conv_ln_b = (const float*)d_in[11];
    p.w_out_even = (const float*)d_in[12]; p.w_in_odd = (const float*)d_in[13]; p.lb_logits = (const float*)d_in[14]; p.hgrn_norm_g = (const float*)d_in[15]; p.w_out_odd = (const float*)d_in[16];
    p.ln_g = (const float*)d_in[17]; p.ln_b = (const float*)d_in[18]; p.peer_wq = (const float*)d_in[19]; p.peer_keys = (const float*)d_in[20]; p.peer_u = (const float*)d_in[21]; p.peer_v = (const float*)d_in[22];
    float* o = (float*)d_out;
    p.y_prompt = o; o += (size_t)TP * DM; p.y_sample = o; o += (size_t)TS * DM;
    p.k_prompt = o; o += (size_t)TP * 512; p.v_prompt = o; o += (size_t)TP * 512; p.k_sample = o; o += (size_t)TS * 512; p.v_sample = o; o += (size_t)TS * 512;
    p.conv_prompt = o; o += 2 * 30 * 512; p.conv_sample = o; o += 32 * 30 * 512; p.hgrn_prompt = o; o += 2 * 8 * 128 * 128; p.hgrn_sample = o;
    char* ws = (char*)d_ws; size_t off = 0;
    auto take = [&](size_t bytes) { char* r = ws + off; off += (bytes + 255) & ~(size_t)255; return r; };
    p.bar = (unsigned*)take(16384); p.LB = (float*)take(4096);
    p.WT_IN_EVEN = (bf16_t*)take((size_t)2560 * 1024 * 2); p.WT_OUT_EVEN = (bf16_t*)take((size_t)1024 * 1024 * 2);
    p.WT_IN_ODD = (bf16_t*)take((size_t)4096 * 1024 * 2); p.WT_OUT_ODD = (bf16_t*)take((size_t)1024 * 1024 * 2);
    p.WT_WQ = (bf16_t*)take((size_t)2 * 2048 * 1024 * 2); p.KB = (bf16_t*)take((size_t)2 * 2048 * 128 * 2);
    p.UB = (bf16_t*)take((size_t)2 * 16384 * DM * 2); p.VB = (bf16_t*)take((size_t)2 * 16384 * DM * 2);
    p.XB = (bf16_t*)take((size_t)MP * DM * 2); p.XF = (float*)take((size_t)MP * DM * 4);
    p.H = (bf16_t*)take((size_t)MP * 4096 * 2); p.LF = (float*)take((size_t)MP * DM * 4);
    p.VT = (bf16_t*)take((size_t)16 * 64 * 8192 * 2); p.KMP = (bf16_t*)take((size_t)64 * 512 * 2); p.KMS = (bf16_t*)take((size_t)1024 * 512 * 2);
    p.MIX = (bf16_t*)take((size_t)MP * DM * 2); p.T = (float*)take((size_t)MP * DM * 4);
    p.QH = (bf16_t*)take((size_t)MP * 2048 * 2); p.S = (float*)take((size_t)MP * 2048 * 4);
    p.E = (int*)take((size_t)MP * 128 * 4); p.G = (float*)take((size_t)MP * 128 * 4);
    p.UT = (float*)take((size_t)2048 * 16384 * 4); p.DEC = (float*)take((size_t)2048 * 128 * 4); p.ST = (bf16_t*)take((size_t)2048 * 16384 * 2);
    if (off > ws_size) { fprintf(stderr, "workspace too small: need %zu have %zu\n", off, ws_size); return; }

    static int grid = 0;
    if (!grid) {
        int dev = 0, cus = 0, per_cu = 0;
        (void)hipGetDevice(&dev);
        (void)hipDeviceGetAttribute(&cus, hipDeviceAttributeMultiprocessorCount, dev);
        (void)hipFuncSetAttribute((const void*)mega, hipFuncAttributeMaxDynamicSharedMemorySize, LDS_BYTES);
        (void)hipOccupancyMaxActiveBlocksPerMultiprocessor(&per_cu, (const void*)mega, NT, LDS_BYTES);
        grid = cus * (per_cu < 1 ? per_cu : 1);
        if (grid <= 0) { fprintf(stderr, "mega kernel not resident: cus %d per_cu %d\n", cus, per_cu); grid = 0; return; }
    }
    (void)hipMemsetAsync(p.bar, 0, XCD_BAR_WORDS * sizeof(unsigned), stream);
    hipLaunchKernelGGL(mega, dim3(grid), dim3(NT), LDS_BYTES, stream, p);
}
```

```cpp
#include <hip/hip_runtime.h>
#include <stdint.h>
#include <stdio.h>

#define DI __device__ __forceinline__
typedef unsigned short bf16_t;
typedef short bf16x8 __attribute__((ext_vector_type(8)));
typedef float f32x4 __attribute__((ext_vector_type(4)));
typedef unsigned u32x4 __attribute__((ext_vector_type(4)));
typedef unsigned u32x2 __attribute__((ext_vector_type(2)));
typedef int i32x4 __attribute__((ext_vector_type(4)));

constexpr int NT = 512;
constexpr int TP = 16384, TS = 32, TT = TP + TS, MP = 16640, DM = 1024, SEQ = 8192;
constexpr float DN_ALPHA = 1.4142135623730951f;
constexpr float LN_EPS = 1e-5f, RMS_EPS = 1e-6f;
constexpr size_t OFF_KP = (size_t)TT * DM, OFF_VP = OFF_KP + (size_t)TP * 512, OFF_KS = OFF_VP + (size_t)TP * 512, OFF_VS = OFF_KS + (size_t)TS * 512;

DI float bf2f(bf16_t h) { return __uint_as_float(((unsigned)h) << 16); }
typedef __bf16 bf16x2_t __attribute__((ext_vector_type(2)));
DI unsigned pack_bf2(float lo, float hi) { bf16x2_t v; v[0] = (__bf16)lo; v[1] = (__bf16)hi; return __builtin_bit_cast(unsigned, v); }
DI bf16_t f2bf(float x) { return (bf16_t)(pack_bf2(x, 0.f) & 0xffffu); }
DI float bflo(unsigned u) { return __uint_as_float(u << 16); }
DI float bfhi(unsigned u) { return __uint_as_float(u & 0xffff0000u); }
DI float sigmoidf_(float x) { return 1.f / (1.f + __expf(-x)); }
DI float wave_sum(float v) {
#pragma unroll
    for (int o = 32; o >= 1; o >>= 1) v += __shfl_xor(v, o, 64);
    return v;
}
DI float wave_max(float v) {
#pragma unroll
    for (int o = 32; o >= 1; o >>= 1) v = fmaxf(v, __shfl_xor(v, o, 64));
    return v;
}
#define MFMA16(a, b, c) __builtin_amdgcn_mfma_f32_16x16x32_bf16((a), (b), (c), 0, 0, 0)

struct Params {
    const float* x_prompt; const float* x_sample; const float* cache_k; const float* cache_v;
    const float* state_conv; const float* state_hgrn; const int* page_table;
    const float* w_in_even; const float* conv_w; const float* conv_b; const float* conv_ln_g; const float* conv_ln_b;
    const float* w_out_even; const float* w_in_odd; const float* lb_logits; const float* hgrn_norm_g; const float* w_out_odd;
    const float* ln_g; const float* ln_b; const float* peer_wq; const float* peer_keys; const float* peer_u; const float* peer_v;
    float* y_prompt; float* y_sample; float* k_prompt; float* v_prompt; float* k_sample; float* v_sample;
    float* conv_prompt; float* conv_sample; float* hgrn_prompt; float* hgrn_sample;
    unsigned* bar; float* LB;
    bf16_t* WT_IN_EVEN; bf16_t* WT_OUT_EVEN; bf16_t* WT_IN_ODD; bf16_t* WT_OUT_ODD; bf16_t* WT_WQ; bf16_t* KB;
    unsigned char* U8; unsigned char* V8; float* SU; float* SV;
    bf16_t* XB; float* XF; bf16_t* H; float* LF; bf16_t* VT; bf16_t* KMP; bf16_t* KMS;
    bf16_t* MIX; float* T; bf16_t* QH; float* S; int* E; float* G;
    float* UT; float* DEC; bf16_t* ST;
};


#define XB_TMO      128
#define XB_XCNT(j)  (256  + 64 * (j))
#define XB_XSUB(j)  (1280 + 64 * (j))
#define XB_XGEN(j)  (2304 + 64 * (j))
#define XB_TOP      3328
#define XB_TOPGEN   3392
#define XCD_BAR_WORDS 3456
#define XB_SPIN_CAP (1u << 18)
#define LAS __attribute__((address_space(3)))
__device__ __forceinline__ unsigned xb_ld(unsigned* p)              { return __hip_atomic_load(p, __ATOMIC_RELAXED, __HIP_MEMORY_SCOPE_AGENT); }
__device__ __forceinline__ unsigned xb_add(unsigned* p, unsigned v) { return __hip_atomic_fetch_add(p, v, __ATOMIC_RELAXED, __HIP_MEMORY_SCOPE_AGENT); }
__device__ __forceinline__ unsigned xb_xcc_id() { return (unsigned)__builtin_amdgcn_s_getreg((3 << 11) | 20) & 0xFu; }
#define XB_SPIN(cond, bar) do { unsigned _sp = 0; while (cond) { __builtin_amdgcn_s_sleep(1); \
    if ((++_sp & 255u) == 0u) { if (xb_ld(&(bar)[XB_TMO])) break; if (_sp > XB_SPIN_CAP) { atomicAdd(&(bar)[XB_TMO], 1u); break; } } } } while (0)
struct XcdBarrier { unsigned* bar; unsigned x; volatile LAS unsigned* st; };
__device__ __forceinline__ XcdBarrier xcd_barrier_post(unsigned* bar, volatile LAS unsigned* st) {
    XcdBarrier b; b.bar = bar; b.x = xb_xcc_id(); b.st = st;
    if (threadIdx.x == 0) (void)xb_add(&bar[XB_XCNT(b.x)], 1u);
    return b;
}
__device__ __forceinline__ void xcd_barrier_complete(unsigned* bar, unsigned x, unsigned& nloc, unsigned& nx) {
    const unsigned G = gridDim.x * gridDim.y * gridDim.z;
    unsigned sum, cnt, mine, sp = 0u;
    for (;;) {
        sum = 0u; cnt = 0u; mine = 0u;
#pragma unroll
        for (unsigned j = 0; j < 16; ++j) { const unsigned c = xb_ld(&bar[XB_XCNT(j)]); sum += c; cnt += (c > 0u) ? 1u : 0u; mine = (j == x) ? c : mine; }
        if (sum == G) break;
        __builtin_amdgcn_s_sleep(1);
        if ((++sp & 255u) == 0u) { if (xb_ld(&bar[XB_TMO])) break; if (sp > XB_SPIN_CAP) { atomicAdd(&bar[XB_TMO], 1u); break; } }
    }
    nloc = mine > 0u ? mine : 1u; nx = cnt > 0u ? cnt : 1u;
}
__device__ __forceinline__ void xcd_barrier(const XcdBarrier& b) {
    asm volatile("s_waitcnt vmcnt(0)" ::: "memory");
    __syncthreads();
    if (threadIdx.x == 0) {
        unsigned* bar = b.bar;
        __builtin_amdgcn_s_waitcnt(0);
        unsigned nloc = b.st[0], nx = b.st[1];
        if (nloc == 0u) { xcd_barrier_complete(bar, b.x, nloc, nx); b.st[0] = nloc; b.st[1] = nx; }
        const unsigned old = xb_add(&bar[XB_XSUB(b.x)], 1u);
        const unsigned gen = old / nloc;
        if (old + 1u == (gen + 1u) * nloc) {
            __builtin_amdgcn_fence(__ATOMIC_RELEASE, "agent");
            asm volatile("s_waitcnt vmcnt(0)" ::: "memory");
            const unsigned og = xb_add(&bar[XB_TOP], 1u);
            const unsigned tg = og / nx;
            if (og + 1u == (tg + 1u) * nx) xb_add(&bar[XB_TOPGEN], 1u);
            else XB_SPIN(xb_ld(&bar[XB_TOPGEN]) == tg, bar);
            __builtin_amdgcn_fence(__ATOMIC_ACQUIRE, "agent");
            xb_add(&bar[XB_XGEN(b.x)], 1u);
            asm volatile("s_waitcnt vmcnt(0)" ::: "memory");
        } else {
            XB_SPIN(xb_ld(&bar[XB_XGEN(b.x)]) == gen, bar);
            __builtin_amdgcn_fence(__ATOMIC_ACQUIRE, "agent");
            asm volatile("s_waitcnt vmcnt(0)" ::: "memory");
        }
    }
    __syncthreads();
}

DI void transpose_unit(const float* __restrict__ W, int K, int N, bf16_t* __restrict__ Wt, int u, char* lds) {
    float* tile = (float*)lds;
    const int tid = threadIdx.x;
    const int ntn = N >> 6; const int kt = u / ntn, nt = u % ntn;
#pragma unroll
    for (int i = 0; i < 8; ++i) { int idx = tid + NT * i; int r = idx >> 6, c = idx & 63; tile[r * 65 + c] = W[(size_t)(kt * 64 + r) * N + nt * 64 + c]; }
    __syncthreads();
#pragma unroll
    for (int i = 0; i < 8; ++i) { int idx = tid + NT * i; int r = idx >> 6, c = idx & 63; Wt[(size_t)(nt * 64 + r) * K + kt * 64 + c] = f2bf(tile[c * 65 + r]); }
    __syncthreads();
}
DI void convert_range(const float* __restrict__ src, bf16_t* __restrict__ dst, size_t n4, int bid, int nb) {
    for (size_t i = (size_t)bid * NT + threadIdx.x; i < n4; i += (size_t)nb * NT) {
        f32x4 v = *(const f32x4*)(src + 4 * i);
        u32x2 o; o[0] = pack_bf2(v[0], v[1]); o[1] = pack_bf2(v[2], v[3]);
        *(u32x2*)(dst + 4 * i) = o;
    }
}

template <int OFFS> DI void quant_rows(const float* __restrict__ src, unsigned char* __restrict__ dst, float* __restrict__ inv, int R, int bid, int nb) {
    const int lane = threadIdx.x & 63, w = threadIdx.x >> 6;
    for (int row = bid * 8 + w; row < R; row += nb * 8) {
        f32x4 v[4]; float am = 0.f;
#pragma unroll
        for (int i = 0; i < 4; ++i) { v[i] = *(const f32x4*)(src + (size_t)row * DM + 4 * lane + 256 * i); am = fmaxf(am, fmaxf(fmaxf(fabsf(v[i][0]), fabsf(v[i][1])), fmaxf(fabsf(v[i][2]), fabsf(v[i][3])))); }
        am = wave_max(am);
        const float sc = am > 0.f ? 127.f / am : 0.f;
#pragma unroll
        for (int i = 0; i < 4; ++i) {
            unsigned pk = 0;
#pragma unroll
            for (int k = 0; k < 4; ++k) { const int q = (int)rintf(v[i][k] * sc) + OFFS; pk |= ((unsigned)q & 0xffu) << (8 * k); }
            *(unsigned*)(dst + (size_t)row * DM + 4 * lane + 256 * i) = pk;
        }
        if (lane == 0) inv[row] = am * (1.f / 127.f);
    }
}
DI void convert_x(const Params& p, int bid, int nb) {
    const size_t n4 = (size_t)MP * DM / 4;
    for (size_t i = (size_t)bid * NT + threadIdx.x; i < n4; i += (size_t)nb * NT) {
        size_t e = 4 * i; int row = (int)(e >> 10); int col = (int)(e & 1023);
        f32x4 v = {0.f, 0.f, 0.f, 0.f};
        if (row < TP) v = *(const f32x4*)(p.x_prompt + e);
        else if (row < TT) v = *(const f32x4*)(p.x_sample + (size_t)(row - TP) * DM + col);
        *(f32x4*)(p.XF + e) = v;
        u32x2 o; o[0] = pack_bf2(v[0], v[1]); o[1] = pack_bf2(v[2], v[3]);
        *(u32x2*)(p.XB + e) = o;
    }
}
DI void convert_keys(const Params& p, int bid, int nb) {
    const int n = 2 * 2 * 8 * 128 * 128;
    for (int i = bid * NT + threadIdx.x; i < n; i += nb * NT) {
        int d = i & 127, nn = (i >> 7) & 127, j = (i >> 14) & 15, l = i >> 18;
        int h = j >> 1, half = j & 1;
        p.KB[i] = f2bf(p.peer_keys[((((size_t)l * 2 + half) * 8 + h) * 128 + nn) * 128 + d]);
    }
    if (bid == 0) for (int c = threadIdx.x; c < 1024; c += NT) p.LB[c] = sigmoidf_(p.lb_logits[1024 + c] - p.lb_logits[c]);
}
DI void kmean_sample_unit(const Params& p, int u) {
    const int b = u >> 5, blk = u & 31, c = threadIdx.x;
    float acc = 0.f;
#pragma unroll
    for (int pg = 0; pg < 2; ++pg) {
        const int page = p.page_table[b * 64 + blk * 2 + pg];
        const float* src = p.cache_k + (size_t)page * 128 * 512 + c;
#pragma unroll 16
        for (int r = 0; r < 128; ++r) acc += src[(size_t)r * 512];
    }
    p.KMS[(size_t)u * 512 + c] = f2bf(acc * (1.f / 256.f));
}
DI void kmean_prompt_unit(const Params& p, int u) {
    const int c = threadIdx.x;
    const float* src = p.k_prompt + (size_t)u * 256 * 512 + c;
    float acc = 0.f;
#pragma unroll 16
    for (int r = 0; r < 256; ++r) acc += src[(size_t)r * 512];
    p.KMP[(size_t)u * 512 + c] = f2bf(acc * (1.f / 256.f));
}

struct GemmArgs { const bf16_t* A; int lda; const bf16_t* Bt; int ldb; int K; int blockdiag; };
constexpr int GEMM_LDS = 2 * 49152;

template <class Epi>
DI void gemm_unit(const GemmArgs g, int m0, int n0, const Epi epi, char* lds) {
    const int tid = threadIdx.x, lane = tid & 63, w = tid >> 6;
    const int wm = w & 3, wn = w >> 2, lr = lane & 15, lg = lane >> 4;
    const int acol = g.blockdiag ? n0 : 0;
    const int nk = g.K >> 6;
    f32x4 acc[4][4];
#pragma unroll
    for (int i = 0; i < 4; ++i)
#pragma unroll
        for (int j = 0; j < 4; ++j) acc[i][j] = (f32x4){0.f, 0.f, 0.f, 0.f};
    u32x4 ra[4], rb[2];
    auto gload = [&](int kt) {
#pragma unroll
        for (int i = 0; i < 4; ++i) { int id = tid + NT * i; int r = id >> 3, c = id & 7; ra[i] = *(const u32x4*)(g.A + (size_t)(m0 + r) * g.lda + acol + kt * 64 + c * 8); }
#pragma unroll
        for (int i = 0; i < 2; ++i) { int id = tid + NT * i; int r = id >> 3, c = id & 7; rb[i] = *(const u32x4*)(g.Bt + (size_t)(n0 + r) * g.ldb + kt * 64 + c * 8); }
    };
    auto sstore = [&](int st) {
        char* base = lds + st * 49152;
#pragma unroll
        for (int i = 0; i < 4; ++i) { int id = tid + NT * i; int r = id >> 3, c = id & 7; *(u32x4*)(base + r * 128 + ((c ^ (r & 7)) << 4)) = ra[i]; }
#pragma unroll
        for (int i = 0; i < 2; ++i) { int id = tid + NT * i; int r = id >> 3, c = id & 7; *(u32x4*)(base + 32768 + r * 128 + ((c ^ (r & 7)) << 4)) = rb[i]; }
    };
    gload(0); sstore(0); __syncthreads();
    for (int kt = 0; kt < nk; ++kt) {
        if (kt + 1 < nk) gload(kt + 1);
        const char* base = lds + (kt & 1) * 49152;
#pragma unroll
        for (int ks = 0; ks < 2; ++ks) {
            bf16x8 af[4], bfr[4];
#pragma unroll
            for (int i = 0; i < 4; ++i) { int r = wm * 64 + i * 16 + lr; int ch = ks * 4 + lg; af[i] = *(const bf16x8*)(base + r * 128 + ((ch ^ (r & 7)) << 4)); }
#pragma unroll
            for (int i = 0; i < 4; ++i) { int r = wn * 64 + i * 16 + lr; int ch = ks * 4 + lg; bfr[i] = *(const bf16x8*)(base + 32768 + r * 128 + ((ch ^ (r & 7)) << 4)); }
#pragma unroll
            for (int i = 0; i < 4; ++i)
#pragma unroll
                for (int j = 0; j < 4; ++j) acc[i][j] = MFMA16(bfr[j], af[i], acc[i][j]);
        }
        if (kt + 1 < nk) sstore((kt + 1) & 1);
        __syncthreads();
    }
#pragma unroll
    for (int i = 0; i < 4; ++i)
#pragma unroll
        for (int j = 0; j < 4; ++j) epi(m0 + wm * 64 + i * 16 + lr, n0 + wn * 64 + j * 16 + 4 * lg, acc[i][j]);
}

template <class Epi>
DI void gemm_phase(const GemmArgs g, int M, int N, const Epi epi, char* lds, int bid, int nb) {
    const int tn = N >> 7, tm = M >> 8;
    for (int u = bid; u < tm * tn; u += nb) { int mt = u / tn, nt = u % tn; gemm_unit(g, mt * 256, nt * 128, epi, lds); }
}

DI void store_bf4(bf16_t* dst, f32x4 v) { u32x2 o; o[0] = pack_bf2(v[0], v[1]); o[1] = pack_bf2(v[2], v[3]); *(u32x2*)dst = o; }

struct EpiInEven {
    bf16_t* H; float* out; bf16_t* VT;
    DI void operator()(int row, int col, f32x4 v) const {
        store_bf4(H + (size_t)row * 2560 + col, v);
        if (col >= 512 && col < 1536 && row < TT) {
            const bool isv = col >= 1024; const int c = col - (isv ? 1024 : 512);
            const size_t off = row < TP ? (isv ? OFF_VP : OFF_KP) + (size_t)row * 512 + c : (isv ? OFF_VS : OFF_KS) + (size_t)(row - TP) * 512 + c;
            *(f32x4*)(out + off) = v;
            if (isv && row < TP) {
                const int b = row >> 13, s = row & 8191, h = c >> 6, d = c & 63;
                bf16_t* vt = VT + ((size_t)(b * 8 + h) * 64 + d) * 8192 + s;
#pragma unroll
                for (int i = 0; i < 4; ++i) vt[(size_t)i * 8192] = f2bf(v[i]);
            }
        }
    }
};
struct EpiBf16 { bf16_t* O; int ld; DI void operator()(int row, int col, f32x4 v) const { store_bf4(O + (size_t)row * ld + col, v); } };
struct EpiF32 { float* O; int ld; DI void operator()(int row, int col, f32x4 v) const { *(f32x4*)(O + (size_t)row * ld + col) = v; } };
struct EpiResid {
    float* T; const float* XF;
    DI void operator()(int row, int col, f32x4 v) const { f32x4 x = *(const f32x4*)(XF + (size_t)row * DM + col); *(f32x4*)(T + (size_t)row * DM + col) = x * DN_ALPHA + v; }
};
struct EpiInOdd {
    bf16_t* H; float* LF; const float* LB;
    DI void operator()(int row, int col, f32x4 v) const {
        const int sec = col >> 10, c = col & 1023;
        if (sec == 1) {
            f32x4 lb = *(const f32x4*)(LB + c); f32x4 lf, kk;
#pragma unroll
            for (int i = 0; i < 4; ++i) { float f = lb[i] + (1.f - lb[i]) * sigmoidf_(v[i]); lf[i] = __logf(f); kk[i] = 1.f - f; }
            *(f32x4*)(LF + (size_t)row * DM + c) = lf;
            store_bf4(H + (size_t)MP * DM + (size_t)row * DM + c, kk);
        } else {
            store_bf4(H + (size_t)sec * MP * DM + (size_t)row * DM + c, v);
        }
    }
};

DI void conv_unit(const Params& p, int u, char* lds) {
    float* sy = (float*)lds;
    const int c = threadIdx.x, lane = c & 63, w = c >> 6;
    float wj[31];
#pragma unroll
    for (int j = 0; j < 31; ++j) wj[j] = p.conv_w[j * 512 + c];
    const float bias = p.conv_b[c];
    int ntok, row0;
    if (u < 512) {
        const int b = u >> 8, t0 = (u & 255) * 32; ntok = 32; row0 = b * SEQ + t0;
        float uu[62];
#pragma unroll
        for (int r = 0; r < 62; ++r) {
            const int t = t0 - 30 + r; float val = 0.f;
            if (t >= 0) { const size_t row = (size_t)b * SEQ + t; float a = bf2f(p.H[row * 2560 + 1536 + c]); float g = bf2f(p.H[row * 2560 + 2048 + c]); val = a * sigmoidf_(g); }
            uu[r] = val;
            if (t0 == SEQ - 32 && r >= 32) p.conv_prompt[((size_t)b * 30 + (r - 32)) * 512 + c] = val;
        }
#pragma unroll
        for (int tt = 0; tt < 32; ++tt) {
            float acc = bias;
#pragma unroll
            for (int j = 0; j < 31; ++j) acc += wj[j] * uu[tt + j];
            sy[tt * 512 + c] = acc;
        }
    } else {
        const int b = u - 512; ntok = 1; row0 = TP + b;
        const size_t row = (size_t)row0;
        float a = bf2f(p.H[row * 2560 + 1536 + c]); float g = bf2f(p.H[row * 2560 + 2048 + c]);
        const float un = a * sigmoidf_(g);
        float acc = bias + wj[30] * un;
#pragma unroll
        for (int j = 0; j < 30; ++j) {
            float e = p.state_conv[((size_t)b * 30 + j) * 512 + c]; acc += wj[j] * e;
            if (j >= 1) p.conv_sample[((size_t)b * 30 + (j - 1)) * 512 + c] = e;
        }
        p.conv_sample[((size_t)b * 30 + 29) * 512 + c] = un;
        sy[c] = acc;
    }
    __syncthreads();
    for (int tt = w; tt < ntok; tt += 8) {
        float v[8]; float s = 0.f;
#pragma unroll
        for (int i = 0; i < 8; ++i) { v[i] = sy[tt * 512 + lane + 64 * i]; s += v[i]; }
        const float mu = wave_sum(s) * (1.f / 512.f);
        float q = 0.f;
#pragma unroll
        for (int i = 0; i < 8; ++i) { float d = v[i] - mu; q += d * d; }
        const float rs = rsqrtf(wave_sum(q) * (1.f / 512.f) + LN_EPS);
#pragma unroll
        for (int i = 0; i < 8; ++i) {
            const int cc = lane + 64 * i;
            float y = (v[i] - mu) * rs * p.conv_ln_g[cc] + p.conv_ln_b[cc];
            y = y * sigmoidf_(y);
            p.MIX[(size_t)(row0 + tt) * DM + 512 + cc] = f2bf(y);
        }
    }
    __syncthreads();
}

DI void moba_sample_unit(const Params& p, int u, char* lds) {
    float* sq = (float*)lds;
    float* gs = sq + 64;
    int* sel = (int*)(gs + 32);
    float* lg = (float*)(sel + 4);
    float* red = lg + 776;
    float* part = red + 16;
    const int tid = threadIdx.x, lane = tid & 63, w = tid >> 6;
    const int b = u >> 3, h = u & 7; const size_t row = (size_t)TP + b;
    if (tid < 64) sq[tid] = bf2f(p.H[row * 2560 + h * 64 + tid]);
    __syncthreads();
    if (tid < 32) { const bf16_t* km = p.KMS + ((size_t)b * 32 + tid) * 512 + h * 64; float s = 0.f;
#pragma unroll 8
        for (int d = 0; d < 64; ++d) s += sq[d] * bf2f(km[d]);
        gs[tid] = s; }
    __syncthreads();
    if (tid == 0) {
        float v0 = -INFINITY, v1 = -INFINITY, v2 = -INFINITY; int i0 = 0, i1 = 0, i2 = 0;
        for (int j = 0; j < 32; ++j) { float s = gs[j];
            if (s > v0) { v2 = v1; i2 = i1; v1 = v0; i1 = i0; v0 = s; i0 = j; }
            else if (s > v1) { v2 = v1; i2 = i1; v1 = s; i1 = j; }
            else if (s > v2) { v2 = s; i2 = j; } }
        sel[0] = i0; sel[1] = i1; sel[2] = i2;
    }
    __syncthreads();
    for (int idx = tid; idx < 769; idx += NT) {
        float s = 0.f;
        if (idx < 768) {
            const int blk = sel[idx >> 8]; const int pos = blk * 256 + (idx & 255);
            const int page = p.page_table[b * 64 + (pos >> 7)];
            const float* kp = p.cache_k + (((size_t)page * 128 + (pos & 127)) * 8 + h) * 64;
#pragma unroll
            for (int d4 = 0; d4 < 16; ++d4) { f32x4 kv = *(const f32x4*)(kp + 4 * d4); s += sq[4 * d4] * kv[0] + sq[4 * d4 + 1] * kv[1] + sq[4 * d4 + 2] * kv[2] + sq[4 * d4 + 3] * kv[3]; }
        } else {
            const bf16_t* kn = p.H + row * 2560 + 512 + h * 64;
            for (int d = 0; d < 64; ++d) s += sq[d] * bf2f(kn[d]);
        }
        lg[idx] = s * 0.125f;
    }
    __syncthreads();
    float mx = -INFINITY;
    for (int idx = tid; idx < 769; idx += NT) mx = fmaxf(mx, lg[idx]);
    mx = wave_max(mx); if (lane == 0) red[w] = mx;
    __syncthreads();
    mx = red[0];
#pragma unroll
    for (int i = 1; i < 8; ++i) mx = fmaxf(mx, red[i]);
    float sm = 0.f;
    for (int idx = tid; idx < 769; idx += NT) { float e = __expf(lg[idx] - mx); lg[idx] = e; sm += e; }
    sm = wave_sum(sm); if (lane == 0) red[8 + w] = sm;
    __syncthreads();
    sm = 0.f;
#pragma unroll
    for (int i = 0; i < 8; ++i) sm += red[8 + i];
    {
        const int d = lane; float acc = 0.f;
        for (int idx = w; idx < 769; idx += 8) {
            float vv;
            if (idx < 768) { const int blk = sel[idx >> 8]; const int pos = blk * 256 + (idx & 255);
                const int page = p.page_table[b * 64 + (pos >> 7)];
                vv = p.cache_v[(((size_t)page * 128 + (pos & 127)) * 8 + h) * 64 + d]; }
            else vv = bf2f(p.H[row * 2560 + 1024 + h * 64 + d]);
            acc += lg[idx] * vv;
        }
        part[w * 64 + d] = acc;
    }
    __syncthreads();
    if (tid < 64) { float a = 0.f;
#pragma unroll
        for (int i = 0; i < 8; ++i) a += part[i * 64 + tid];
        p.MIX[row * DM + h * 64 + tid] = f2bf(a / sm); }
    __syncthreads();
}

DI void moba_prompt_unit(const Params& p, int bh, int own, char* lds) {
    const int tid = threadIdx.x, lane = tid & 63, w = tid >> 6, lr = lane & 15, lg = lane >> 4;
    const int b = bh >> 3, h = bh & 7;
    float* gsc = (float*)lds + w * 1024;
    unsigned* msk = (unsigned*)(lds + 32768) + w * 36;
    const size_t rowq0 = (size_t)b * SEQ + own * 256 + w * 32;
    bf16x8 qf[2][2];
#pragma unroll
    for (int qt = 0; qt < 2; ++qt)
#pragma unroll
        for (int ks = 0; ks < 2; ++ks) qf[qt][ks] = *(const bf16x8*)(p.H + (rowq0 + qt * 16 + lr) * 2560 + h * 64 + ks * 32 + lg * 8);
    unsigned mq[2]; unsigned wor;
    if (own > 3) {
#pragma unroll
        for (int jt = 0; jt < 2; ++jt) {
            bf16x8 kf[2];
#pragma unroll
            for (int ks = 0; ks < 2; ++ks) kf[ks] = *(const bf16x8*)(p.KMP + ((size_t)b * 32 + jt * 16 + lr) * 512 + h * 64 + ks * 32 + lg * 8);
#pragma unroll
            for (int qt = 0; qt < 2; ++qt) {
                f32x4 a = {0.f, 0.f, 0.f, 0.f};
                a = MFMA16(kf[0], qf[qt][0], a); a = MFMA16(kf[1], qf[qt][1], a);
#pragma unroll
                for (int r = 0; r < 4; ++r) gsc[(qt * 16 + lr) * 32 + jt * 16 + 4 * lg + r] = a[r];
            }
        }
        __builtin_amdgcn_s_waitcnt(0);
        __builtin_amdgcn_wave_barrier();
        unsigned m = 0;
        if (lane < 32) {
            float v0 = -INFINITY, v1 = -INFINITY, v2 = -INFINITY; int i0 = 0, i1 = 0, i2 = 0;
            for (int j = 0; j < own; ++j) { float s = gsc[lane * 32 + j];
                if (s > v0) { v2 = v1; i2 = i1; v1 = v0; i1 = i0; v0 = s; i0 = j; }
                else if (s > v1) { v2 = v1; i2 = i1; v1 = s; i1 = j; }
                else if (s > v2) { v2 = s; i2 = j; } }
            m = (1u << i0) | (1u << i1) | (1u << i2);
            msk[lane] = m;
        }
        unsigned o = m;
#pragma unroll
        for (int s = 32; s >= 1; s >>= 1) o |= (unsigned)__shfl_xor((int)o, s, 64);
        wor = o;
        __builtin_amdgcn_s_waitcnt(0);
        __builtin_amdgcn_wave_barrier();
        mq[0] = msk[lr]; mq[1] = msk[16 + lr];
    } else {
        const unsigned m = (own >= 1) ? ((1u << own) - 1u) : 0u;
        mq[0] = m; mq[1] = m; wor = m;
    }
    wor = (unsigned)__builtin_amdgcn_readfirstlane((int)wor);
    const float SC = 0.125f * 1.4426950408889634f;
    float mrow[2] = {-INFINITY, -INFINITY}, lrow[2] = {0.f, 0.f};
    f32x4 oacc[2][4];
#pragma unroll
    for (int qt = 0; qt < 2; ++qt)
#pragma unroll
        for (int dt = 0; dt < 4; ++dt) oacc[qt][dt] = (f32x4){0.f, 0.f, 0.f, 0.f};
    const bf16_t* Kbase = p.H + (size_t)b * SEQ * 2560 + 512 + h * 64;
    const bf16_t* Vbase = p.VT + (size_t)(b * 8 + h) * 64 * 8192;
    for (int it = -1; it < own; ++it) {
        const int jb = (it < 0) ? own : it;
        const bool isown = it < 0;
        if (!isown && !((wor >> jb) & 1u)) continue;
        const int nst = isown ? (w + 1) : 8;
        for (int st = 0; st < nst; ++st) {
            const int key0 = jb * 256 + st * 32;
            bf16x8 kf[2][2];
#pragma unroll
            for (int kt = 0; kt < 2; ++kt)
#pragma unroll
                for (int ks = 0; ks < 2; ++ks) kf[kt][ks] = *(const bf16x8*)(Kbase + (size_t)(key0 + kt * 16 + lr) * 2560 + ks * 32 + lg * 8);
            bf16x8 vf[4];
#pragma unroll
            for (int dt = 0; dt < 4; ++dt) {
                const bf16_t* vp = Vbase + (size_t)(dt * 16 + lr) * 8192 + key0 + 4 * lg;
                u32x2 lo = *(const u32x2*)vp, hi = *(const u32x2*)(vp + 16);
                u32x4 t; t[0] = lo[0]; t[1] = lo[1]; t[2] = hi[0]; t[3] = hi[1];
                vf[dt] = __builtin_bit_cast(bf16x8, t);
            }
#pragma unroll
            for (int qt = 0; qt < 2; ++qt) {
                f32x4 s[2];
#pragma unroll
                for (int kt = 0; kt < 2; ++kt) { f32x4 a = {0.f, 0.f, 0.f, 0.f}; a = MFMA16(kf[kt][0], qf[qt][0], a); a = MFMA16(kf[kt][1], qf[qt][1], a); s[kt] = a; }
                const bool selq = isown || ((mq[qt] >> jb) & 1u);
                const int qin = w * 32 + qt * 16 + lr;
                float mx = -INFINITY;
#pragma unroll
                for (int kt = 0; kt < 2; ++kt)
#pragma unroll
                    for (int r = 0; r < 4; ++r) {
                        const int kin = st * 32 + kt * 16 + 4 * lg + r;
                        const bool ok = selq && (!isown || kin <= qin);
                        float v = ok ? s[kt][r] * SC : -INFINITY;
                        s[kt][r] = v; mx = fmaxf(mx, v);
                    }
                mx = fmaxf(mx, __shfl_xor(mx, 16, 64)); mx = fmaxf(mx, __shfl_xor(mx, 32, 64));
                const float mnew = fmaxf(mrow[qt], mx);
                const float alpha = __builtin_amdgcn_exp2f(mrow[qt] - mnew);
                float ps = 0.f;
#pragma unroll
                for (int kt = 0; kt < 2; ++kt)
#pragma unroll
                    for (int r = 0; r < 4; ++r) { float e = __builtin_amdgcn_exp2f(s[kt][r] - mnew); s[kt][r] = e; ps += e; }
                ps += __shfl_xor(ps, 16, 64); ps += __shfl_xor(ps, 32, 64);
                lrow[qt] = lrow[qt] * alpha + ps; mrow[qt] = mnew;
                u32x4 pk; pk[0] = pack_bf2(s[0][0], s[0][1]); pk[1] = pack_bf2(s[0][2], s[0][3]); pk[2] = pack_bf2(s[1][0], s[1][1]); pk[3] = pack_bf2(s[1][2], s[1][3]);
                const bf16x8 pf = __builtin_bit_cast(bf16x8, pk);
#pragma unroll
                for (int dt = 0; dt < 4; ++dt) { oacc[qt][dt] = oacc[qt][dt] * alpha; oacc[qt][dt] = MFMA16(vf[dt], pf, oacc[qt][dt]); }
            }
        }
    }
#pragma unroll
    for (int qt = 0; qt < 2; ++qt) {
        const float inv = 1.f / lrow[qt];
#pragma unroll
        for (int dt = 0; dt < 4; ++dt) store_bf4(p.MIX + (rowq0 + qt * 16 + lr) * DM + h * 64 + dt * 16 + 4 * lg, oacc[qt][dt] * inv);
    }
}

DI void ln_rows(const Params& p, const float* g, const float* bb, int bid, int nb, bool final_out) {
    const int lane = threadIdx.x & 63, w = threadIdx.x >> 6;
    for (int row = bid * 8 + w; row < TT; row += nb * 8) {
        f32x4 v[4]; float s = 0.f;
#pragma unroll
        for (int i = 0; i < 4; ++i) { v[i] = *(const f32x4*)(p.T + (size_t)row * DM + 4 * lane + 256 * i); s += v[i][0] + v[i][1] + v[i][2] + v[i][3]; }
        const float mu = wave_sum(s) * (1.f / 1024.f);
        float q = 0.f;
#pragma unroll
        for (int i = 0; i < 4; ++i)
#pragma unroll
            for (int k = 0; k < 4; ++k) { float d = v[i][k] - mu; q += d * d; }
        const float rs = rsqrtf(wave_sum(q) * (1.f / 1024.f) + LN_EPS);
#pragma unroll
        for (int i = 0; i < 4; ++i) {
            const int c = 4 * lane + 256 * i;
            f32x4 gg = *(const f32x4*)(g + c), be = *(const f32x4*)(bb + c), y;
#pragma unroll
            for (int k = 0; k < 4; ++k) y[k] = (v[i][k] - mu) * rs * gg[k] + be[k];
            if (final_out) { float* dst = row < TP ? p.y_prompt + (size_t)row * DM + c : p.y_sample + (size_t)(row - TP) * DM + c; *(f32x4*)dst = y; }
            else { *(f32x4*)(p.XF + (size_t)row * DM + c) = y; store_bf4(p.XB + (size_t)row * DM + c, y); }
        }
    }
}

#define INS16(V, I, tv, ti) { float _v = (V); int _i = (I); _Pragma("unroll") for (int _k = 0; _k < 16; ++_k) { const bool _g = _v > tv[_k]; const float _tv = tv[_k]; const int _ti = ti[_k]; tv[_k] = _g ? _v : _tv; ti[_k] = _g ? _i : _ti; _v = _g ? _tv : _v; _i = _g ? _ti : _i; } }
DI void peer_topk_unit(const Params& p, int u, char* lds) {
    float* lv = (float*)lds;
    int* li = (int*)(lds + 512 * 17 * 4);
    const int tid = threadIdx.x; const int tok = u * 32 + (tid >> 4), j = tid & 15;
    float tv[16]; int ti[16];
#pragma unroll
    for (int k = 0; k < 16; ++k) { tv[k] = -INFINITY; ti[k] = 0; }
    if (tok < TT) {
        const float* s = p.S + (size_t)tok * 2048 + j * 128;
        for (int n4 = 0; n4 < 32; ++n4) {
            f32x4 v = *(const f32x4*)(s + 4 * n4);
            INS16(v[0], 4 * n4, tv, ti); INS16(v[1], 4 * n4 + 1, tv, ti); INS16(v[2], 4 * n4 + 2, tv, ti); INS16(v[3], 4 * n4 + 3, tv, ti);
        }
    }
#pragma unroll
    for (int k = 0; k < 16; ++k) { lv[tid * 17 + k] = tv[k]; li[tid * 17 + k] = ti[k]; }
    __syncthreads();
    if ((j & 1) == 0 && tok < TT) {
        float v2[16]; int i2[16];
#pragma unroll
        for (int k = 0; k < 16; ++k) { v2[k] = lv[(tid + 1) * 17 + k]; i2[k] = li[(tid + 1) * 17 + k]; }
        float sv[16]; int si[16];
#pragma unroll
        for (int k = 0; k < 16; ++k) { sv[k] = -INFINITY; si[k] = 0; }
#pragma unroll
        for (int a = 0; a < 16; ++a)
#pragma unroll
            for (int bq = 0; bq < 16; ++bq)
                if ((a + 1) * (bq + 1) <= 16) INS16(tv[a] + v2[bq], ti[a] * 128 + i2[bq], sv, si);
        float sm = 0.f; float e[16];
#pragma unroll
        for (int k = 0; k < 16; ++k) { e[k] = __expf(sv[k] - sv[0]); sm += e[k]; }
        const float inv = 1.f / sm; const int h = j >> 1;
#pragma unroll
        for (int k = 0; k < 16; ++k) { p.E[(size_t)tok * 128 + h * 16 + k] = si[k]; p.G[(size_t)tok * 128 + h * 16 + k] = e[k] * inv; }
    }
    __syncthreads();
}

constexpr int EHS = 129;
constexpr int PEER_EH = 65536, PEER_TOK = 65536 + 64 * EHS * 8, PEER_END = PEER_TOK + 1024;
DI float gelu_exact(float z) { return 0.5f * z * (1.f + erff(z * 0.70710678118654752f)); }
#define FMA4U(ACC, O, H, W) { ACC[O] += H * (float)((W) & 0xffu); ACC[O + 1] += H * (float)(((W) >> 8) & 0xffu); ACC[O + 2] += H * (float)(((W) >> 16) & 0xffu); ACC[O + 3] += H * (float)((W) >> 24); }

DI void peer_tile(const Params& p, int layer, int tile, char* lds, bool final_out) {
    const int lane = threadIdx.x & 63, w = threadIdx.x >> 6, lr = lane & 15, lg = lane >> 4;
    unsigned char* X8 = (unsigned char*)lds; int2* EH = (int2*)(lds + PEER_EH); float* TOK = (float*)(lds + PEER_TOK);
    const unsigned char* U8 = p.U8 + (size_t)layer * 16384 * DM; const unsigned char* V8 = p.V8 + (size_t)layer * 16384 * DM;
    const float* SUi = p.SU + layer * 16384; const float* SVi = p.SV + layer * 16384;
    const float* lng = p.ln_g + (layer * 2 + 1) * DM; const float* lnb = p.ln_b + (layer * 2 + 1) * DM;
    const int t0 = tile * 64 + w * 8;
    for (int i = 0; i < 8; ++i) {
        const int t = t0 + i, tk = w * 8 + i;
        f32x4 v[4]; float am = 0.f;
#pragma unroll
        for (int k = 0; k < 4; ++k) { v[k] = *(const f32x4*)(p.XF + (size_t)t * DM + 4 * lane + 256 * k); am = fmaxf(am, fmaxf(fmaxf(fabsf(v[k][0]), fabsf(v[k][1])), fmaxf(fabsf(v[k][2]), fabsf(v[k][3])))); }
        am = wave_max(am);
        const float sc = am > 0.f ? 127.f / am : 0.f;
#pragma unroll
        for (int k = 0; k < 4; ++k) {
            unsigned pk = 0;
#pragma unroll
            for (int q = 0; q < 4; ++q) { const int qi = (int)rintf(v[k][q] * sc); pk |= ((unsigned)qi & 0xffu) << (8 * q); }
            *(unsigned*)(X8 + tk * 1024 + 4 * lane + 256 * k) = pk;
        }
        if (lane == 0) TOK[tk * 2] = am * (1.f / 127.f);
        EH[tk * EHS + lane] = make_int2(p.E[(size_t)t * 128 + lane], 0);
        EH[tk * EHS + 64 + lane] = make_int2(p.E[(size_t)t * 128 + 64 + lane], 0);
    }
    for (int c = 0; c < 8; ++c) {
        for (int i = 0; i < 8; ++i) {
            const int tk = w * 8 + i;
            const i32x4 xb0 = *(const i32x4*)(X8 + tk * 1024 + c * 128 + 16 * lg), xb1 = *(const i32x4*)(X8 + tk * 1024 + c * 128 + 64 + 16 * lg);
            i32x4 a[8][2];
#pragma unroll
            for (int mt = 0; mt < 8; ++mt) {
                const int e = EH[tk * EHS + mt * 16 + lr].x;
                const unsigned char* base = U8 + (size_t)e * DM + c * 128 + 16 * lg;
                a[mt][0] = *(const i32x4*)base; a[mt][1] = *(const i32x4*)(base + 64);
            }
#pragma unroll
            for (int mt = 0; mt < 8; ++mt) {
                i32x4 acc = {0, 0, 0, 0};
                acc = __builtin_amdgcn_mfma_i32_16x16x64_i8(a[mt][0], xb0, acc, 0, 0, 0);
                acc = __builtin_amdgcn_mfma_i32_16x16x64_i8(a[mt][1], xb1, acc, 0, 0, 0);
                if (lr == 0) {
#pragma unroll
                    for (int r = 0; r < 4; ++r) { int2* q = EH + tk * EHS + mt * 16 + 4 * lg + r; q->y += acc[r]; }
                }
            }
        }
    }
    for (int i = 0; i < 8; ++i) {
        const int t = t0 + i, tk = w * 8 + i;
        const float sxi = TOK[tk * 2];
        float sum = 0.f;
#pragma unroll
        for (int hf = 0; hf < 2; ++hf) {
            const int pi = hf * 64 + lane;
            const int2 eh = EH[tk * EHS + pi];
            const float z = (float)eh.y * SUi[eh.x] * sxi;
            const float hp = p.G[(size_t)t * 128 + pi] * gelu_exact(z) * SVi[eh.x];
            EH[tk * EHS + pi].y = __float_as_int(hp);
            sum += hp;
        }
        sum = wave_sum(sum);
        if (lane == 0) TOK[tk * 2 + 1] = sum;
    }
    const int gq = lane >> 3, li = lane & 7, tk = w * 8 + gq, t = t0 + gq;
    const float sumh128 = 128.f * TOK[tk * 2 + 1];
    float s1 = 0.f, s2 = 0.f;
    for (int c = 0; c < 8; ++c) {
        float acc[16];
#pragma unroll
        for (int k = 0; k < 16; ++k) acc[k] = 0.f;
        const unsigned char* vb = V8 + c * 128 + li * 16;
        for (int p0 = 0; p0 < 128; p0 += 8) {
            int2 eh[8]; u32x4 vv[8];
#pragma unroll
            for (int j = 0; j < 8; ++j) eh[j] = EH[tk * EHS + p0 + j];
#pragma unroll
            for (int j = 0; j < 8; ++j) vv[j] = *(const u32x4*)(vb + (size_t)eh[j].x * DM);
#pragma unroll
            for (int j = 0; j < 8; ++j) { const float h = __int_as_float(eh[j].y); FMA4U(acc, 0, h, vv[j][0]); FMA4U(acc, 4, h, vv[j][1]); FMA4U(acc, 8, h, vv[j][2]); FMA4U(acc, 12, h, vv[j][3]); }
        }
        const int col = c * 128 + li * 16;
#pragma unroll
        for (int k4 = 0; k4 < 4; ++k4) {
            const f32x4 x = *(const f32x4*)(p.XF + (size_t)t * DM + col + 4 * k4);
            f32x4 y;
#pragma unroll
            for (int k = 0; k < 4; ++k) { y[k] = DN_ALPHA * x[k] + (acc[4 * k4 + k] - sumh128); s1 += y[k]; s2 += y[k] * y[k]; }
            *(f32x4*)(p.T + (size_t)t * DM + col + 4 * k4) = y;
        }
    }
#pragma unroll
    for (int o = 1; o <= 4; o <<= 1) { s1 += __shfl_xor(s1, o, 64); s2 += __shfl_xor(s2, o, 64); }
    const float mu = s1 * (1.f / 1024.f);
    const float rs = rsqrtf(fmaxf(s2 * (1.f / 1024.f) - mu * mu, 0.f) + LN_EPS);
    for (int c = 0; c < 8; ++c) {
        const int col = c * 128 + li * 16;
#pragma unroll
        for (int k4 = 0; k4 < 4; ++k4) {
            const f32x4 y = *(const f32x4*)(p.T + (size_t)t * DM + col + 4 * k4);
            const f32x4 gg = *(const f32x4*)(lng + col + 4 * k4), be = *(const f32x4*)(lnb + col + 4 * k4);
            f32x4 o;
#pragma unroll
            for (int k = 0; k < 4; ++k) o[k] = (y[k] - mu) * rs * gg[k] + be[k];
            if (final_out) *(f32x4*)(p.y_prompt + (size_t)t * DM + col + 4 * k4) = o;
            else { *(f32x4*)(p.XF + (size_t)t * DM + col + 4 * k4) = o; store_bf4(p.XB + (size_t)t * DM + col + 4 * k4, o); }
        }
    }
}

DI void peer_sample(const Params& p, int layer, int sidx, char* lds, bool final_out) {
    const int tid = threadIdx.x, lane = tid & 63, w = tid >> 6, lr = lane & 15, lg = lane >> 4;
    unsigned char* X8 = (unsigned char*)lds; int2* EH = (int2*)(lds + 1024); float* Z = (float*)(lds + 1024 + 1024); float* Y = Z + 128; float* PART = Y + 1024;
    const unsigned char* U8 = p.U8 + (size_t)layer * 16384 * DM; const unsigned char* V8 = p.V8 + (size_t)layer * 16384 * DM;
    const float* SUi = p.SU + layer * 16384; const float* SVi = p.SV + layer * 16384;
    const float* lng = p.ln_g + (layer * 2 + 1) * DM; const float* lnb = p.ln_b + (layer * 2 + 1) * DM;
    const int t = TP + sidx;
    __syncthreads();
    if (w == 0) {
        f32x4 v[4]; float am = 0.f;
#pragma unroll
        for (int k = 0; k < 4; ++k) { v[k] = *(const f32x4*)(p.XF + (size_t)t * DM + 4 * lane + 256 * k); am = fmaxf(am, fmaxf(fmaxf(fabsf(v[k][0]), fabsf(v[k][1])), fmaxf(fabsf(v[k][2]), fabsf(v[k][3])))); }
        am = wave_max(am);
        const float sc = am > 0.f ? 127.f / am : 0.f;
#pragma unroll
        for (int k = 0; k < 4; ++k) {
            unsigned pk = 0;
#pragma unroll
            for (int q = 0; q < 4; ++q) { const int qi = (int)rintf(v[k][q] * sc); pk |= ((unsigned)qi & 0xffu) << (8 * q); }
            *(unsigned*)(X8 + 4 * lane + 256 * k) = pk;
        }
        if (lane == 0) PART[24] = am * (1.f / 127.f);
    }
    __syncthreads();
    {
        const int e = p.E[(size_t)t * 128 + w * 16 + lr];
        i32x4 acc = {0, 0, 0, 0};
#pragma unroll
        for (int ch = 0; ch < 16; ++ch) {
            const i32x4 a = *(const i32x4*)(U8 + (size_t)e * DM + ch * 64 + 16 * lg);
            const i32x4 xb = *(const i32x4*)(X8 + ch * 64 + 16 * lg);
            acc = __builtin_amdgcn_mfma_i32_16x16x64_i8(a, xb, acc, 0, 0, 0);
        }
        if (lr == 0) {
#pragma unroll
            for (int r = 0; r < 4; ++r) Z[w * 16 + 4 * lg + r] = (float)acc[r];
        }
        __builtin_amdgcn_s_waitcnt(0);
        __builtin_amdgcn_wave_barrier();
        float hp = 0.f;
        if (lane < 16) {
            const int pi = w * 16 + lane;
            const float z = Z[pi] * SUi[e] * PART[24];
            hp = p.G[(size_t)t * 128 + pi] * gelu_exact(z) * SVi[e];
            EH[pi] = make_int2(e, __float_as_int(hp));
        }
        hp = wave_sum(hp);
        if (lane == 0) PART[w] = hp;
    }
    __syncthreads();
    float sumh = 0.f;
#pragma unroll
    for (int i = 0; i < 8; ++i) sumh += PART[i];
    {
        const int c = w, pg = lane >> 3, li = lane & 7;
        float acc[16];
#pragma unroll
        for (int k = 0; k < 16; ++k) acc[k] = 0.f;
        const unsigned char* vb = V8 + c * 128 + li * 16;
        for (int p0 = 0; p0 < 16; p0 += 8) {
            int2 eh[8]; u32x4 vv[8];
#pragma unroll
            for (int j = 0; j < 8; ++j) eh[j] = EH[pg * 16 + p0 + j];
#pragma unroll
            for (int j = 0; j < 8; ++j) vv[j] = *(const u32x4*)(vb + (size_t)eh[j].x * DM);
#pragma unroll
            for (int j = 0; j < 8; ++j) { const float h = __int_as_float(eh[j].y); FMA4U(acc, 0, h, vv[j][0]); FMA4U(acc, 4, h, vv[j][1]); FMA4U(acc, 8, h, vv[j][2]); FMA4U(acc, 12, h, vv[j][3]); }
        }
#pragma unroll
        for (int k = 0; k < 16; ++k) { float a = acc[k]; a += __shfl_xor(a, 8, 64); a += __shfl_xor(a, 16, 64); a += __shfl_xor(a, 32, 64); acc[k] = a; }
        float s1 = 0.f, s2 = 0.f;
        if (pg == 0) {
            const int col = c * 128 + li * 16;
#pragma unroll
            for (int k = 0; k < 16; ++k) { const float y = DN_ALPHA * p.XF[(size_t)t * DM + col + k] + (acc[k] - 128.f * sumh); Y[col + k] = y; s1 += y; s2 += y * y; }
        }
        s1 = wave_sum(s1); s2 = wave_sum(s2);
        if (lane == 0) { PART[8 + w] = s1; PART[16 + w] = s2; }
    }
    __syncthreads();
    float s1 = 0.f, s2 = 0.f;
#pragma unroll
    for (int i = 0; i < 8; ++i) { s1 += PART[8 + i]; s2 += PART[16 + i]; }
    const float mu = s1 * (1.f / 1024.f);
    const float rs = rsqrtf(fmaxf(s2 * (1.f / 1024.f) - mu * mu, 0.f) + LN_EPS);
#pragma unroll
    for (int k = 0; k < 2; ++k) {
        const int col = tid + NT * k;
        const float o = (Y[col] - mu) * rs * lng[col] + lnb[col];
        if (final_out) p.y_sample[(size_t)sidx * DM + col] = o;
        else { p.XF[(size_t)t * DM + col] = o; p.XB[(size_t)t * DM + col] = f2bf(o); }
    }
    __syncthreads();
}

DI void peer_expert_phase(const Params& p, int layer, char* lds, int bid, int nb, bool final_out) {
    for (int tile = bid; tile < 256; tile += nb) peer_tile(p, layer, tile, lds, final_out);
    for (int sidx = bid; sidx < TS; sidx += nb) peer_sample(p, layer, sidx, lds, final_out);
}

DI void hgrn_cumsum(const Params& p, size_t row0, int h, float* bs, float* tot) {
    const int tid = threadIdx.x;
#pragma unroll
    for (int i = 0; i < 4; ++i) { int id = tid + NT * i; int s = id >> 5, c4 = id & 31; *(f32x4*)(bs + s * 128 + 4 * c4) = *(const f32x4*)(p.LF + (row0 + s) * DM + h * 128 + 4 * c4); }
    __syncthreads();
    const int k = tid & 127, seg = tid >> 7;
    float run = 0.f;
#pragma unroll
    for (int i = 0; i < 16; ++i) { run += bs[(seg * 16 + i) * 128 + k]; bs[(seg * 16 + i) * 128 + k] = run; }
    tot[seg * 128 + k] = run;
    __syncthreads();
    float off = 0.f;
#pragma unroll
    for (int s2 = 0; s2 < 3; ++s2) if (s2 < seg) off += tot[s2 * 128 + k];
    if (seg > 0) {
#pragma unroll
        for (int i = 0; i < 16; ++i) bs[(seg * 16 + i) * 128 + k] += off;
    }
    __syncthreads();
}
constexpr int HG_TS = 72;
constexpr int HG_FS = 136;
DI void hgrn_b1_unit(const Params& p, int u, char* lds) {
    float* bs = (float*)lds;
    float* tot = (float*)(lds + 32768);
    bf16_t* KT = (bf16_t*)(lds + 36864);
    bf16_t* IT = (bf16_t*)(lds + 36864 + 18432);
    const int tid = threadIdx.x, lane = tid & 63, w = tid >> 6, lr = lane & 15, lg = lane >> 4;
    const int bh = u >> 7, c = u & 127, b = bh >> 3, h = bh & 7;
    const size_t row0 = (size_t)b * SEQ + c * 64;
    hgrn_cumsum(p, row0, h, bs, tot);
    const bf16_t* KK = p.H + (size_t)MP * DM; const bf16_t* I1 = p.H + (size_t)2 * MP * DM;
    {
        const int s = tid >> 3, kc = (tid & 7) * 16;
        const bf16_t* kr = KK + (row0 + s) * DM + h * 128 + kc; const bf16_t* ir = I1 + (row0 + s) * DM + h * 128 + kc;
        u32x4 ka = *(const u32x4*)kr, kb = *(const u32x4*)(kr + 8), ia = *(const u32x4*)ir, ib = *(const u32x4*)(ir + 8);
#pragma unroll
        for (int i = 0; i < 16; ++i) {
            const unsigned kw = (i < 8) ? ka[(i & 7) >> 1] : kb[(i & 7) >> 1]; const unsigned iw = (i < 8) ? ia[(i & 7) >> 1] : ib[(i & 7) >> 1];
            const float kv = (i & 1) ? bfhi(kw) : bflo(kw);
            const float e = __expf(fminf(-bs[s * 128 + kc + i], 80.f));
            KT[(kc + i) * HG_TS + s] = f2bf(kv * e);
            IT[(kc + i) * HG_TS + s] = (bf16_t)((i & 1) ? (iw >> 16) : (iw & 0xffffu));
        }
    }
    __syncthreads();
    f32x4 acc[8];
#pragma unroll
    for (int j = 0; j < 8; ++j) acc[j] = (f32x4){0.f, 0.f, 0.f, 0.f};
#pragma unroll
    for (int ks = 0; ks < 2; ++ks) {
        const bf16x8 af = *(const bf16x8*)(KT + (w * 16 + lr) * HG_TS + ks * 32 + lg * 8);
#pragma unroll
        for (int j = 0; j < 8; ++j) { const bf16x8 bfr = *(const bf16x8*)(IT + (j * 16 + lr) * HG_TS + ks * 32 + lg * 8); acc[j] = MFMA16(af, bfr, acc[j]); }
    }
    f32x4 dl;
#pragma unroll
    for (int r = 0; r < 4; ++r) dl[r] = __expf(bs[63 * 128 + w * 16 + 4 * lg + r]);
#pragma unroll
    for (int j = 0; j < 8; ++j) *(f32x4*)(p.UT + ((size_t)u * 128 + j * 16 + lr) * 128 + w * 16 + 4 * lg) = acc[j] * dl;
    if (tid < 128) p.DEC[(size_t)u * 128 + tid] = __expf(bs[63 * 128 + tid]);
    __syncthreads();
}
DI void hgrn_b2(const Params& p, int bid, int nb) {
    for (int e = bid * NT + threadIdx.x; e < 16 * 16384; e += nb * NT) {
        const int bh = e >> 14, vk = e & 16383, k = vk & 127, v = vk >> 7;
        float S = 0.f;
        for (int c0 = 0; c0 < 128; c0 += 8) {
            float uu[8], dd[8];
#pragma unroll
            for (int i = 0; i < 8; ++i) { const size_t un = (size_t)bh * 128 + c0 + i; uu[i] = p.UT[un * 16384 + vk]; dd[i] = p.DEC[un * 128 + k]; }
#pragma unroll
            for (int i = 0; i < 8; ++i) { const size_t un = (size_t)bh * 128 + c0 + i; p.ST[un * 16384 + vk] = f2bf(S); S = dd[i] * S + uu[i]; }
        }
        p.hgrn_prompt[((size_t)bh * 128 + k) * 128 + v] = S;
    }
}
DI void hgrn_b3_unit(const Params& p, int u, char* lds) {
    float* bs = (float*)lds;
    float* tot = (float*)(lds + 32768);
    bf16_t* QH = (bf16_t*)(lds + 36864);
    bf16_t* KH = (bf16_t*)(lds + 36864 + 17408);
    bf16_t* IT = (bf16_t*)(lds + 36864 + 34816);
    bf16_t* AT = (bf16_t*)(lds + 36864 + 34816 + 18432);
    const int tid = threadIdx.x, lane = tid & 63, w = tid >> 6, lr = lane & 15, lg = lane >> 4;
    const int bh = u >> 7, c = u & 127, b = bh >> 3, h = bh & 7;
    const size_t row0 = (size_t)b * SEQ + c * 64;
    hgrn_cumsum(p, row0, h, bs, tot);
    const bf16_t* Q1 = p.H; const bf16_t* KK = p.H + (size_t)MP * DM; const bf16_t* I1 = p.H + (size_t)2 * MP * DM; const bf16_t* G1 = p.H + (size_t)3 * MP * DM;
    {
        const int s = tid >> 3, kc = (tid & 7) * 16;
        const bf16_t* qr = Q1 + (row0 + s) * DM + h * 128 + kc; const bf16_t* kr = KK + (row0 + s) * DM + h * 128 + kc; const bf16_t* ir = I1 + (row0 + s) * DM + h * 128 + kc;
        u32x4 qa = *(const u32x4*)qr, qb = *(const u32x4*)(qr + 8), ka = *(const u32x4*)kr, kb = *(const u32x4*)(kr + 8), ia = *(const u32x4*)ir, ib = *(const u32x4*)(ir + 8);
#pragma unroll
        for (int i = 0; i < 16; ++i) {
            const unsigned qw = (i < 8) ? qa[(i & 7) >> 1] : qb[(i & 7) >> 1]; const unsigned kw = (i < 8) ? ka[(i & 7) >> 1] : kb[(i & 7) >> 1]; const unsigned iw = (i < 8) ? ia[(i & 7) >> 1] : ib[(i & 7) >> 1];
            const float qv = (i & 1) ? bfhi(qw) : bflo(qw); const float kv = (i & 1) ? bfhi(kw) : bflo(kw);
            const float bb = bs[s * 128 + kc + i];
            QH[s * HG_FS + kc + i] = f2bf(qv * __expf(bb));
            KH[s * HG_FS + kc + i] = f2bf(kv * __expf(fminf(-bb, 80.f)));
            IT[(kc + i) * HG_TS + s] = (bf16_t)((i & 1) ? (iw >> 16) : (iw & 0xffffu));
        }
    }
    __syncthreads();
    {
        const int tt = w & 3;
#pragma unroll
        for (int si = 0; si < 2; ++si) {
            const int stile = (w >> 2) * 2 + si;
            f32x4 a = {0.f, 0.f, 0.f, 0.f};
            if (stile <= tt) {
#pragma unroll
                for (int ks = 0; ks < 4; ++ks) {
                    const bf16x8 af = *(const bf16x8*)(KH + (stile * 16 + lr) * HG_FS + ks * 32 + lg * 8);
                    const bf16x8 bfr = *(const bf16x8*)(QH + (tt * 16 + lr) * HG_FS + ks * 32 + lg * 8);
                    a = MFMA16(af, bfr, a);
                }
            }
            const int t = tt * 16 + lr;
#pragma unroll
            for (int r = 0; r < 4; ++r) { const int s = stile * 16 + 4 * lg + r; if (s > t) a[r] = 0.f; }
            store_bf4(AT + t * HG_TS + stile * 16 + 4 * lg, a);
        }
    }
    __syncthreads();
    const int tt = w & 3;
    f32x4 acc[4];
#pragma unroll
    for (int j = 0; j < 4; ++j) acc[j] = (f32x4){0.f, 0.f, 0.f, 0.f};
#pragma unroll
    for (int ks = 0; ks < 2; ++ks) {
        const bf16x8 bfr = *(const bf16x8*)(AT + (tt * 16 + lr) * HG_TS + ks * 32 + lg * 8);
#pragma unroll
        for (int j = 0; j < 4; ++j) { const int vt = (w >> 2) * 4 + j; const bf16x8 af = *(const bf16x8*)(IT + (vt * 16 + lr) * HG_TS + ks * 32 + lg * 8); acc[j] = MFMA16(af, bfr, acc[j]); }
    }
    const bf16_t* STu = p.ST + (size_t)u * 16384;
#pragma unroll
    for (int ks = 0; ks < 4; ++ks) {
        const bf16x8 bfr = *(const bf16x8*)(QH + (tt * 16 + lr) * HG_FS + ks * 32 + lg * 8);
#pragma unroll
        for (int j = 0; j < 4; ++j) { const int vt = (w >> 2) * 4 + j; const bf16x8 af = *(const bf16x8*)(STu + (vt * 16 + lr) * 128 + ks * 32 + lg * 8); acc[j] = MFMA16(af, bfr, acc[j]); }
    }
    float ss = 0.f;
#pragma unroll
    for (int j = 0; j < 4; ++j)
#pragma unroll
        for (int r = 0; r < 4; ++r) ss += acc[j][r] * acc[j][r];
    ss += __shfl_xor(ss, 16, 64); ss += __shfl_xor(ss, 32, 64);
    float* red = tot;
    if (lg == 0) red[(w >> 2) * 64 + tt * 16 + lr] = ss;
    __syncthreads();
    const float rs = rsqrtf((red[tt * 16 + lr] + red[64 + tt * 16 + lr]) * (1.f / 128.f) + RMS_EPS);
    const size_t row = row0 + tt * 16 + lr;
#pragma unroll
    for (int j = 0; j < 4; ++j) {
        const int col = h * 128 + ((w >> 2) * 4 + j) * 16 + 4 * lg;
        const u32x2 gw = *(const u32x2*)(G1 + row * DM + col);
        const f32x4 ng = *(const f32x4*)(p.hgrn_norm_g + col);
        f32x4 o;
        const float gg[4] = {bflo(gw[0]), bfhi(gw[0]), bflo(gw[1]), bfhi(gw[1])};
#pragma unroll
        for (int r = 0; r < 4; ++r) o[r] = acc[j][r] * rs * ng[r] * (gg[r] * sigmoidf_(gg[r]));
        store_bf4(p.MIX + row * DM + col, o);
    }
    __syncthreads();
}
DI void hgrn_sample_unit(const Params& p, int u, char* lds) {
    float* part = (float*)lds;
    float* red = part + 512;
    const int tid = threadIdx.x, lane = tid & 63, w = tid >> 6;
    const int b = u >> 3, h = u & 7; const size_t row = (size_t)TP + b;
    const bf16_t* Q1 = p.H; const bf16_t* KK = p.H + (size_t)MP * DM; const bf16_t* I1 = p.H + (size_t)2 * MP * DM; const bf16_t* G1 = p.H + (size_t)3 * MP * DM;
    const int v = tid & 127, kq = tid >> 7;
    const float iv = bf2f(I1[row * DM + h * 128 + v]);
    float acc = 0.f;
    const float* S0 = p.state_hgrn + (size_t)u * 16384; float* S1 = p.hgrn_sample + (size_t)u * 16384;
#pragma unroll 8
    for (int kk = 0; kk < 32; ++kk) {
        const int k = kq * 32 + kk;
        const float f = __expf(p.LF[row * DM + h * 128 + k]);
        const float kv = bf2f(KK[row * DM + h * 128 + k]);
        const float q = bf2f(Q1[row * DM + h * 128 + k]);
        const float st = f * S0[k * 128 + v] + kv * iv;
        S1[k * 128 + v] = st; acc += q * st;
    }
    part[kq * 128 + v] = acc;
    __syncthreads();
    float o = 0.f, sq = 0.f;
    if (tid < 128) { o = part[tid] + part[128 + tid] + part[256 + tid] + part[384 + tid]; sq = o * o; }
    sq = wave_sum(sq); if (lane == 0) red[w] = sq;
    __syncthreads();
    if (tid < 128) {
        const float rs = rsqrtf((red[0] + red[1]) * (1.f / 128.f) + RMS_EPS);
        const float g = bf2f(G1[row * DM + h * 128 + tid]);
        p.MIX[row * DM + h * 128 + tid] = f2bf(o * rs * p.hgrn_norm_g[h * 128 + tid] * (g * sigmoidf_(g)));
    }
    __syncthreads();
}

constexpr int LDS_BAR = 135168;
constexpr int LDS_BYTES = LDS_BAR + 256;

template <int LAYER> DI void peer_phases(const Params& p, char* lds, int bid, int nb, const XcdBarrier& bar) {
    {
        GemmArgs g{p.XB, DM, p.WT_WQ + (size_t)LAYER * 2048 * 1024, DM, DM, 0};
        EpiBf16 epi{p.QH, 2048};
        gemm_phase(g, MP, 2048, epi, lds, bid, nb);
    }
    xcd_barrier(bar);
    {
        GemmArgs g{p.QH, 2048, p.KB + (size_t)LAYER * 2048 * 128, 128, 128, 1};
        EpiF32 epi{p.S, 2048};
        gemm_phase(g, MP, 2048, epi, lds, bid, nb);
    }
    xcd_barrier(bar);
    for (int u = bid; u < (TT + 31) / 32; u += nb) peer_topk_unit(p, u, lds);
    xcd_barrier(bar);
    peer_expert_phase(p, LAYER, lds, bid, nb, LAYER == 1);
}

__global__ void __launch_bounds__(NT, 2) mega(Params p) {
    extern __shared__ __attribute__((aligned(16))) char lds[];
    const int bid = blockIdx.x, nb = gridDim.x;
    if (threadIdx.x == 0) *(uint4*)(lds + LDS_BAR) = make_uint4(0u, 0u, 0u, 0u);
    __syncthreads();
    XcdBarrier bar = xcd_barrier_post(p.bar, (volatile LAS unsigned*)(lds + LDS_BAR));
    for (int u = bid; u < 16 * 40; u += nb) transpose_unit(p.w_in_even, 1024, 2560, p.WT_IN_EVEN, u, lds);
    for (int u = bid; u < 16 * 16; u += nb) transpose_unit(p.w_out_even, 1024, 1024, p.WT_OUT_EVEN, u, lds);
    for (int u = bid; u < 16 * 64; u += nb) transpose_unit(p.w_in_odd, 1024, 4096, p.WT_IN_ODD, u, lds);
    for (int u = bid; u < 16 * 16; u += nb) transpose_unit(p.w_out_odd, 1024, 1024, p.WT_OUT_ODD, u, lds);
    for (int u = bid; u < 16 * 32; u += nb) transpose_unit(p.peer_wq, 1024, 2048, p.WT_WQ, u, lds);
    for (int u = bid; u < 16 * 32; u += nb) transpose_unit(p.peer_wq + (size_t)1024 * 2048, 1024, 2048, p.WT_WQ + (size_t)2048 * 1024, u, lds);
    convert_x(p, bid, nb);
    convert_keys(p, bid, nb);
    quant_rows<0>(p.peer_u, p.U8, p.SU, 2 * 16384, bid, nb);
    quant_rows<128>(p.peer_v, p.V8, p.SV, 2 * 16384, bid, nb);
    for (int u = bid; u < 1024; u += nb) kmean_sample_unit(p, u);
    xcd_barrier(bar);
    {
        GemmArgs g{p.XB, DM, p.WT_IN_EVEN, DM, DM, 0};
        EpiInEven epi{p.H, p.y_prompt, p.VT};
        gemm_phase(g, MP, 2560, epi, lds, bid, nb);
    }
    xcd_barrier(bar);
    for (int u = bid; u < 64; u += nb) kmean_prompt_unit(p, u);
    for (int u = bid; u < 544; u += nb) conv_unit(p, u, lds);
    xcd_barrier(bar);
    for (int u = bid; u < 512 + 256; u += nb) {
        if (u < 512) { const int bh = (u & 255) >> 4, i = u & 15; const int blk = (u < 256) ? i : 31 - i; moba_prompt_unit(p, bh, blk, lds); __syncthreads(); }
        else moba_sample_unit(p, u - 512, lds);
    }
    xcd_barrier(bar);
    {
        GemmArgs g{p.MIX, DM, p.WT_OUT_EVEN, DM, DM, 0};
        EpiResid epi{p.T, p.XF};
        gemm_phase(g, MP, 1024, epi, lds, bid, nb);
    }
    xcd_barrier(bar);
    ln_rows(p, p.ln_g, p.ln_b, bid, nb, false);
    xcd_barrier(bar);
    peer_phases<0>(p, lds, bid, nb, bar);
    xcd_barrier(bar);
    {
        GemmArgs g{p.XB, DM, p.WT_IN_ODD, DM, DM, 0};
        EpiInOdd epi{p.H, p.LF, p.LB};
        gemm_phase(g, MP, 4096, epi, lds, bid, nb);
    }
    xcd_barrier(bar);
    for (int u = bid; u < 2048 + 256; u += nb) { if (u < 2048) hgrn_b1_unit(p, u, lds); else hgrn_sample_unit(p, u - 2048, lds); }
    xcd_barrier(bar);
    hgrn_b2(p, bid, nb);
    xcd_barrier(bar);
    for (int u = bid; u < 2048; u += nb) hgrn_b3_unit(p, u, lds);
    xcd_barrier(bar);
    {
        GemmArgs g{p.MIX, DM, p.WT_OUT_ODD, DM, DM, 0};
        EpiResid epi{p.T, p.XF};
        gemm_phase(g, MP, 1024, epi, lds, bid, nb);
    }
    xcd_barrier(bar);
    ln_rows(p, p.ln_g + 2 * DM, p.ln_b + 2 * DM, bid, nb, false);
    xcd_barrier(bar);
    peer_phases<1>(p, lds, bid, nb, bar);
}

extern "C" void kernel_launch(void* const* d_in, const int* in_sizes, int n_in, void* d_out, int out_size, void* d_ws, size_t ws_size, hipStream_t stream) {
    Params p{};
    p.x_prompt = (const float*)d_in[0]; p.x_sample = (const float*)d_in[1]; p.cache_k = (const float*)d_in[2]; p.cache_v = (const float*)d_in[3];
    p.state_conv = (const float*)d_in[4]; p.state_hgrn = (const float*)d_in[5]; p.page_table = (const int*)d_in[6];
    p.w_in_even = (const float*)d_in[7]; p.conv_w = (const float*)d_in[8]; p.conv_b = (const float*)d_in[9]; p.conv_ln_g = (const float*)d_in[10]; p.conv_ln_b = (const float*)d_in[11];
    p.w_out_even = (const float*)d_in[12]; p.w_in_odd = (const float*)d_in[13]; p.lb_logits = (const float*)d_in[14]; p.hgrn_norm_g = (const float*)d_in[15]; p.w_out_odd = (const float*)d_in[16];
    p.ln_g = (const float*)d_in[17]; p.ln_b = (const float*)d_in[18]; p.peer_wq = (const float*)d_in[19]; p.peer_keys = (const float*)d_in[20]; p.peer_u = (const float*)d_in[21]; p.peer_v = (const float*)d_in[22];
    float* o = (float*)d_out;
    p.y_prompt = o; o += (size_t)TP * DM; p.y_sample = o; o += (size_t)TS * DM;
    p.k_prompt = o; o += (size_t)TP * 512; p.v_prompt = o; o += (size_t)TP * 512; p.k_sample = o; o += (size_t)TS * 512; p.v_sample = o; o += (size_t)TS * 512;
    p.conv_prompt = o; o += 2 * 30 * 512; p.conv_sample = o; o += 32 * 30 * 512; p.hgrn_prompt = o; o += 2 * 8 * 128 * 128; p.hgrn_sample = o;
    char* ws = (char*)d_ws; size_t off = 0;
    auto take = [&](size_t bytes) { char* r = ws + off; off += (bytes + 255) & ~(size_t)255; return r; };
    p.bar = (unsigned*)take(16384); p.LB = (float*)take(4096);
    p.WT_IN_EVEN = (bf16_t*)take((size_t)2560 * 1024 * 2); p.WT_OUT_EVEN = (bf16_t*)take((size_t)1024 * 1024 * 2);
    p.WT_IN_ODD = (bf16_t*)take((size_t)4096 * 1024 * 2); p.WT_OUT_ODD = (bf16_t*)take((size_t)1024 * 1024 * 2);
    p.WT_WQ = (bf16_t*)take((size_t)2 * 2048 * 1024 * 2); p.KB = (bf16_t*)take((size_t)2 * 2048 * 128 * 2);
    p.U8 = (unsigned char*)take((size_t)2 * 16384 * DM); p.V8 = (unsigned char*)take((size_t)2 * 16384 * DM); p.SU = (float*)take(2 * 16384 * 4); p.SV = (float*)take(2 * 16384 * 4);
    p.XB = (bf16_t*)take((size_t)MP * DM * 2); p.XF = (float*)take((size_t)MP * DM * 4);
    p.H = (bf16_t*)take((size_t)MP * 4096 * 2); p.LF = (float*)take((size_t)MP * DM * 4);
    p.VT = (bf16_t*)take((size_t)16 * 64 * 8192 * 2); p.KMP = (bf16_t*)take((size_t)64 * 512 * 2); p.KMS = (bf16_t*)take((size_t)1024 * 512 * 2);
    p.MIX = (bf16_t*)take((size_t)MP * DM * 2); p.T = (float*)take((size_t)MP * DM * 4);
    p.QH = (bf16_t*)take((size_t)MP * 2048 * 2); p.S = (float*)take((size_t)MP * 2048 * 4);
    p.E = (int*)take((size_t)MP * 128 * 4); p.G = (float*)take((size_t)MP * 128 * 4);
    p.UT = (float*)take((size_t)2048 * 16384 * 4); p.DEC = (float*)take((size_t)2048 * 128 * 4); p.ST = (bf16_t*)take((size_t)2048 * 16384 * 2);
    if (off > ws_size) { fprintf(stderr, "workspace too small: need %zu have %zu\n", off, ws_size); return; }

    static int grid = 0;
    if (!grid) {
        int dev = 0, cus = 0, per_cu = 0;
        (void)hipGetDevice(&dev);
        (void)hipDeviceGetAttribute(&cus, hipDeviceAttributeMultiprocessorCount, dev);
        (void)hipFuncSetAttribute((const void*)mega, hipFuncAttributeMaxDynamicSharedMemorySize, LDS_BYTES);
        (void)hipOccupancyMaxActiveBlocksPerMultiprocessor(&per_cu, (const void*)mega, NT, LDS_BYTES);
        grid = cus * (per_cu < 1 ? per_cu : 1);
        if (grid <= 0) { fprintf(stderr, "mega kernel not resident: cus %d per_cu %d\n", cus, per_cu); grid = 0; return; }
    }
    (void)hipMemsetAsync(p.bar, 0, XCD_BAR_WORDS * sizeof(unsigned), stream);
    hipLaunchKernelGGL(mega, dim3(grid), dim3(NT), LDS_BYTES, stream, p);
}
```

```cpp
#include <hip/hip_runtime.h>
#include <stdint.h>
#include <stdio.h>

#define DI __device__ __forceinline__
__device__ __forceinline__ int tid_opaque() { int t = threadIdx.x; asm volatile("" : "+v"(t)); return t; }
#define TIDX tid_opaque()
typedef unsigned short bf16_t;
typedef short bf16x8 __attribute__((ext_vector_type(8)));
typedef float f32x4 __attribute__((ext_vector_type(4)));
typedef unsigned u32x4 __attribute__((ext_vector_type(4)));
typedef unsigned u32x2 __attribute__((ext_vector_type(2)));
typedef int i32x4 __attribute__((ext_vector_type(4)));
typedef float f32x2 __attribute__((ext_vector_type(2)));

constexpr int NT = 512;
constexpr int TP = 16384, TS = 32, TT = TP + TS, MP = 16640, DM = 1024, SEQ = 8192;
constexpr float DN_ALPHA = 1.4142135623730951f;
constexpr float LN_EPS = 1e-5f, RMS_EPS = 1e-6f;
constexpr size_t OFF_KP = (size_t)TT * DM, OFF_VP = OFF_KP + (size_t)TP * 512, OFF_KS = OFF_VP + (size_t)TP * 512, OFF_VS = OFF_KS + (size_t)TS * 512;

DI float bf2f(bf16_t h) { return __uint_as_float(((unsigned)h) << 16); }
typedef __bf16 bf16x2_t __attribute__((ext_vector_type(2)));
DI unsigned pack_bf2(float lo, float hi) { bf16x2_t v; v[0] = (__bf16)lo; v[1] = (__bf16)hi; return __builtin_bit_cast(unsigned, v); }
DI bf16_t f2bf(float x) { return (bf16_t)(pack_bf2(x, 0.f) & 0xffffu); }
DI float bflo(unsigned u) { return __uint_as_float(u << 16); }
DI float bfhi(unsigned u) { return __uint_as_float(u & 0xffff0000u); }
DI float sigmoidf_(float x) { return 1.f / (1.f + __expf(-x)); }
DI float wave_sum(float v) {
#pragma unroll
    for (int o = 32; o >= 1; o >>= 1) v += __shfl_xor(v, o, 64);
    return v;
}
DI float wave_max(float v) {
#pragma unroll
    for (int o = 32; o >= 1; o >>= 1) v = fmaxf(v, __shfl_xor(v, o, 64));
    return v;
}

DI float red_max_16_32(float x) {
    u32x2 r = __builtin_amdgcn_permlane16_swap(__float_as_uint(x), __float_as_uint(x), false, false);
    x = fmaxf(__uint_as_float(r[0]), __uint_as_float(r[1]));
    r = __builtin_amdgcn_permlane32_swap(__float_as_uint(x), __float_as_uint(x), false, false);
    return fmaxf(__uint_as_float(r[0]), __uint_as_float(r[1]));
}
DI float red_sum_16_32(float x) {
    u32x2 r = __builtin_amdgcn_permlane16_swap(__float_as_uint(x), __float_as_uint(x), false, false);
    x = __uint_as_float(r[0]) + __uint_as_float(r[1]);
    r = __builtin_amdgcn_permlane32_swap(__float_as_uint(x), __float_as_uint(x), false, false);
    return __uint_as_float(r[0]) + __uint_as_float(r[1]);
}
#define MFMA16(a, b, c) __builtin_amdgcn_mfma_f32_16x16x32_bf16((a), (b), (c), 0, 0, 0)

#ifndef REP_PRO
#define REP_PRO 1
#endif
#ifndef REP_GEMM
#define REP_GEMM 1
#endif
#ifndef REP_CONV
#define REP_CONV 1
#endif
#ifndef REP_MOBAP
#define REP_MOBAP 1
#endif
#ifndef REP_MOBAS
#define REP_MOBAS 1
#endif
#ifndef REP_TOPK
#define REP_TOPK 1
#endif
#ifndef REP_PEER1
#define REP_PEER1 1
#endif
#ifndef REP_USW
#define REP_USW 1
#endif
#ifndef REP_VSW
#define REP_VSW 1
#endif
#ifndef REP_HGRN
#define REP_HGRN 1
#endif
#define REPEAT(N) _Pragma("unroll 1") for (int rep_ = 0; rep_ < (N); ++rep_)
struct Params {
    const float* x_prompt; const float* x_sample; const float* cache_k; const float* cache_v;
    const float* state_conv; const float* state_hgrn; const int* page_table;
    const float* w_in_even; const float* conv_w; const float* conv_b; const float* conv_ln_g; const float* conv_ln_b;
    const float* w_out_even; const float* w_in_odd; const float* lb_logits; const float* hgrn_norm_g; const float* w_out_odd;
    const float* ln_g; const float* ln_b; const float* peer_wq; const float* peer_keys; const float* peer_u; const float* peer_v;
    float* y_prompt; float* y_sample; float* k_prompt; float* v_prompt; float* k_sample; float* v_sample;
    float* conv_prompt; float* conv_sample; float* hgrn_prompt; float* hgrn_sample;
    unsigned* bar; float* LB;
    bf16_t* WT_IN_EVEN; bf16_t* WT_OUT_EVEN; bf16_t* WT_IN_ODD; bf16_t* WT_OUT_ODD; bf16_t* WT_WQ; bf16_t* KB;
    unsigned char* U8; unsigned char* V8; float* SU; float* SV;
    bf16_t* XB; float* XF; bf16_t* H; float* LF; bf16_t* VT; float* KMPP; bf16_t* KMS;
    bf16_t* MIX; float* T; bf16_t* QH; float* S; int* E; float* G;
    float* UT; float* DEC; bf16_t* ST;
};


#define XB_TMO      128
#define XB_XCNT(j)  (256  + 64 * (j))
#define XB_XSUB(j)  (1280 + 64 * (j))
#define XB_XGEN(j)  (2304 + 64 * (j))
#define XB_TOP      3328
#define XB_TOPGEN   3392
#define XCD_BAR_WORDS 3456
#define XB_SPIN_CAP (1u << 18)
#define LAS __attribute__((address_space(3)))
__device__ __forceinline__ unsigned xb_ld(unsigned* p)              { return __hip_atomic_load(p, __ATOMIC_RELAXED, __HIP_MEMORY_SCOPE_AGENT); }
__device__ __forceinline__ unsigned xb_add(unsigned* p, unsigned v) { return __hip_atomic_fetch_add(p, v, __ATOMIC_RELAXED, __HIP_MEMORY_SCOPE_AGENT); }
__device__ __forceinline__ unsigned xb_xcc_id() { return (unsigned)__builtin_amdgcn_s_getreg((3 << 11) | 20) & 0xFu; }
#define XB_SPIN(cond, bar) do { unsigned _sp = 0; while (cond) { __builtin_amdgcn_s_sleep(1); \
    if ((++_sp & 255u) == 0u) { if (xb_ld(&(bar)[XB_TMO])) break; if (_sp > XB_SPIN_CAP) { atomicAdd(&(bar)[XB_TMO], 1u); break; } } } } while (0)
struct XcdBarrier { unsigned* bar; unsigned x; volatile LAS unsigned* st; };
__device__ __forceinline__ XcdBarrier xcd_barrier_post(unsigned* bar, volatile LAS unsigned* st) {
    XcdBarrier b; b.bar = bar; b.x = xb_xcc_id(); b.st = st;
    if (threadIdx.x == 0) (void)xb_add(&bar[XB_XCNT(b.x)], 1u);
    return b;
}
__device__ __forceinline__ void xcd_barrier_complete(unsigned* bar, unsigned x, unsigned& nloc, unsigned& nx) {
    const unsigned G = gridDim.x * gridDim.y * gridDim.z;
    unsigned sum, cnt, mine, sp = 0u;
    for (;;) {
        sum = 0u; cnt = 0u; mine = 0u;
#pragma unroll
        for (unsigned j = 0; j < 16; ++j) { const unsigned c = xb_ld(&bar[XB_XCNT(j)]); sum += c; cnt += (c > 0u) ? 1u : 0u; mine = (j == x) ? c : mine; }
        if (sum == G) break;
        __builtin_amdgcn_s_sleep(1);
        if ((++sp & 255u) == 0u) { if (xb_ld(&bar[XB_TMO])) break; if (sp > XB_SPIN_CAP) { atomicAdd(&bar[XB_TMO], 1u); break; } }
    }
    nloc = mine > 0u ? mine : 1u; nx = cnt > 0u ? cnt : 1u;
}
__device__ __forceinline__ void xcd_barrier(const XcdBarrier& b) {
    asm volatile("s_waitcnt vmcnt(0)" ::: "memory");
    __syncthreads();
    if (threadIdx.x == 0) {
        unsigned* bar = b.bar;
        __builtin_amdgcn_s_waitcnt(0);
        unsigned nloc = b.st[0], nx = b.st[1];
        if (nloc == 0u) { xcd_barrier_complete(bar, b.x, nloc, nx); b.st[0] = nloc; b.st[1] = nx; }
        const unsigned old = xb_add(&bar[XB_XSUB(b.x)], 1u);
        const unsigned gen = old / nloc;
        if (old + 1u == (gen + 1u) * nloc) {
            __builtin_amdgcn_fence(__ATOMIC_RELEASE, "agent");
            asm volatile("s_waitcnt vmcnt(0)" ::: "memory");
            const unsigned og = xb_add(&bar[XB_TOP], 1u);
            const unsigned tg = og / nx;
            if (og + 1u == (tg + 1u) * nx) xb_add(&bar[XB_TOPGEN], 1u);
            else XB_SPIN(xb_ld(&bar[XB_TOPGEN]) == tg, bar);
            __builtin_amdgcn_fence(__ATOMIC_ACQUIRE, "agent");
            xb_add(&bar[XB_XGEN(b.x)], 1u);
            asm volatile("s_waitcnt vmcnt(0)" ::: "memory");
        } else {
            XB_SPIN(xb_ld(&bar[XB_XGEN(b.x)]) == gen, bar);
            __builtin_amdgcn_fence(__ATOMIC_ACQUIRE, "agent");
            asm volatile("s_waitcnt vmcnt(0)" ::: "memory");
        }
    }
    __syncthreads();
}

DI void transpose_unit(const float* __restrict__ W, int K, int N, bf16_t* __restrict__ Wt, int u, char* lds) {
    float* tile = (float*)lds;
    const int tid = TIDX;
    const int ntn = N >> 6; const int kt = u / ntn, nt = u % ntn;
#pragma unroll
    for (int i = 0; i < 8; ++i) { int idx = tid + NT * i; int r = idx >> 6, c = idx & 63; tile[r * 65 + c] = W[(size_t)(kt * 64 + r) * N + nt * 64 + c]; }
    __syncthreads();
#pragma unroll
    for (int i = 0; i < 8; ++i) { int idx = tid + NT * i; int r = idx >> 6, c = idx & 63; Wt[(size_t)(nt * 64 + r) * K + kt * 64 + c] = f2bf(tile[c * 65 + r]); }
    __syncthreads();
}
DI void convert_range(const float* __restrict__ src, bf16_t* __restrict__ dst, size_t n4, int bid, int nb) {
    for (size_t i = (size_t)bid * NT + TIDX; i < n4; i += (size_t)nb * NT) {
        f32x4 v = *(const f32x4*)(src + 4 * i);
        u32x2 o; o[0] = pack_bf2(v[0], v[1]); o[1] = pack_bf2(v[2], v[3]);
        *(u32x2*)(dst + 4 * i) = o;
    }
}

template <int OFFS> DI void quant_rows(const float* __restrict__ src, unsigned char* __restrict__ dst, float* __restrict__ inv, int R, int bid, int nb) {
    const int lane = TIDX & 63, w = TIDX >> 6;
    for (int row = bid * 8 + w; row < R; row += nb * 8) {
        f32x4 v[4]; float am = 0.f;
#pragma unroll
        for (int i = 0; i < 4; ++i) { v[i] = *(const f32x4*)(src + (size_t)row * DM + 4 * lane + 256 * i); am = fmaxf(am, fmaxf(fmaxf(fabsf(v[i][0]), fabsf(v[i][1])), fmaxf(fabsf(v[i][2]), fabsf(v[i][3])))); }
        am = wave_max(am);
        const float sc = am > 0.f ? 127.f / am : 0.f;
#pragma unroll
        for (int i = 0; i < 4; ++i) {
            unsigned pk = 0;
#pragma unroll
            for (int k = 0; k < 4; ++k) { const int q = (int)rintf(v[i][k] * sc) + OFFS; pk |= ((unsigned)q & 0xffu) << (8 * k); }
            const int col = 4 * lane + 256 * i;
            *(unsigned*)(dst + (size_t)(row >> 14) * 16384 * DM + (size_t)(col >> 7) * (16384 * 128) + (size_t)(row & 16383) * 128 + (col & 127)) = pk;
        }
        if (lane == 0) inv[row] = am * (1.f / 127.f);
    }
}
DI void quant_rows_fp8(const float* __restrict__ src, unsigned char* __restrict__ dst, float* __restrict__ inv, int R, int bid, int nb) {
    const int lane = TIDX & 63, w = TIDX >> 6;
    for (int row = bid * 8 + w; row < R; row += nb * 8) {
        f32x4 v[4]; float am = 0.f;
#pragma unroll
        for (int i = 0; i < 4; ++i) { v[i] = *(const f32x4*)(src + (size_t)row * DM + 4 * lane + 256 * i); am = fmaxf(am, fmaxf(fmaxf(fabsf(v[i][0]), fabsf(v[i][1])), fmaxf(fabsf(v[i][2]), fabsf(v[i][3])))); }
        am = wave_max(am);
        const float sc = am > 0.f ? 416.f / am : 0.f;
#pragma unroll
        for (int i = 0; i < 4; ++i) {
            int pk = 0;
            pk = __builtin_amdgcn_cvt_pk_fp8_f32(v[i][0] * sc, v[i][1] * sc, pk, false);
            pk = __builtin_amdgcn_cvt_pk_fp8_f32(v[i][2] * sc, v[i][3] * sc, pk, true);
            const int col = 4 * lane + 256 * i;
            *(int*)(dst + (size_t)(row >> 14) * 16384 * DM + (size_t)(col >> 7) * (16384 * 128) + (size_t)(row & 16383) * 128 + (col & 127)) = pk;
        }
        if (lane == 0) inv[row] = am * (1.f / 416.f);
    }
}
DI void convert_x(const Params& p, int bid, int nb) {
    const size_t n4 = (size_t)MP * DM / 4;
    for (size_t i = (size_t)bid * NT + TIDX; i < n4; i += (size_t)nb * NT) {
        size_t e = 4 * i; int row = (int)(e >> 10); int col = (int)(e & 1023);
        f32x4 v = {0.f, 0.f, 0.f, 0.f};
        if (row < TP) v = *(const f32x4*)(p.x_prompt + e);
        else if (row < TT) v = *(const f32x4*)(p.x_sample + (size_t)(row - TP) * DM + col);
        *(f32x4*)(p.XF + e) = v;
        u32x2 o; o[0] = pack_bf2(v[0], v[1]); o[1] = pack_bf2(v[2], v[3]);
        *(u32x2*)(p.XB + e) = o;
    }
}
DI void convert_keys(const Params& p, int bid, int nb) {
    const int n = 2 * 2 * 8 * 128 * 128;
    for (int i = bid * NT + TIDX; i < n; i += nb * NT) {
        int d = i & 127, nn = (i >> 7) & 127, j = (i >> 14) & 15, l = i >> 18;
        int h = j >> 1, half = j & 1;
        p.KB[i] = f2bf(p.peer_keys[((((size_t)l * 2 + half) * 8 + h) * 128 + nn) * 128 + d]);
    }
    if (bid == 0) for (int c = TIDX; c < 1024; c += NT) p.LB[c] = sigmoidf_(p.lb_logits[1024 + c] - p.lb_logits[c]);
}
DI void kmean_sample_unit(const Params& p, int u) {
    const int b = u >> 5, blk = u & 31, c = TIDX;
    float acc = 0.f;
#pragma unroll
    for (int pg = 0; pg < 2; ++pg) {
        const int page = p.page_table[b * 64 + blk * 2 + pg];
        const float* src = p.cache_k + (size_t)page * 128 * 512 + c;
#pragma unroll 16
        for (int r = 0; r < 128; ++r) acc += src[(size_t)r * 512];
    }
    p.KMS[(size_t)u * 512 + c] = f2bf(acc * (1.f / 256.f));
}
DI void kmean_prompt_unit(const Params& p, int u) {
    const int c = TIDX;
    const float* src = p.k_prompt + (size_t)u * 32 * 512 + c;
    float acc = 0.f;
#pragma unroll
    for (int r = 0; r < 32; ++r) acc += src[(size_t)r * 512];
    p.KMPP[(size_t)u * 512 + c] = acc;
}

struct GemmArgs { const bf16_t* A; int lda; const bf16_t* Bt; int ldb; int K; int blockdiag; };
constexpr int GEMM_LDS = 2 * 49152;

template <class Epi>
DI void gemm_unit(const GemmArgs g, int m0, int n0, const Epi epi, char* lds) {
    const int tid = TIDX, lane = tid & 63, w = tid >> 6;
    const int wm = w & 3, wn = w >> 2, lr = lane & 15, lg = lane >> 4;
    const int acol = g.blockdiag ? n0 : 0;
    const int nk = g.K >> 6;
    f32x4 acc[4][4];
#pragma unroll
    for (int i = 0; i < 4; ++i)
#pragma unroll
        for (int j = 0; j < 4; ++j) acc[i][j] = (f32x4){0.f, 0.f, 0.f, 0.f};
    u32x4 ra[4], rb[2];
    auto gload = [&](int kt) {
#pragma unroll
        for (int i = 0; i < 4; ++i) { int id = tid + NT * i; int r = id >> 3, c = id & 7; ra[i] = *(const u32x4*)(g.A + (size_t)(m0 + r) * g.lda + acol + kt * 64 + c * 8); }
#pragma unroll
        for (int i = 0; i < 2; ++i) { int id = tid + NT * i; int r = id >> 3, c = id & 7; rb[i] = *(const u32x4*)(g.Bt + (size_t)(n0 + r) * g.ldb + kt * 64 + c * 8); }
    };
    auto sstore = [&](int st) {
        char* base = lds + st * 49152;
#pragma unroll
        for (int i = 0; i < 4; ++i) { int id = tid + NT * i; int r = id >> 3, c = id & 7; *(u32x4*)(base + r * 128 + ((c ^ (r & 7)) << 4)) = ra[i]; }
#pragma unroll
        for (int i = 0; i < 2; ++i) { int id = tid + NT * i; int r = id >> 3, c = id & 7; *(u32x4*)(base + 32768 + r * 128 + ((c ^ (r & 7)) << 4)) = rb[i]; }
    };
    gload(0); sstore(0); __syncthreads();
    for (int kt = 0; kt < nk; ++kt) {
        if (kt + 1 < nk) gload(kt + 1);
        const char* base = lds + (kt & 1) * 49152;
#pragma unroll
        for (int ks = 0; ks < 2; ++ks) {
            bf16x8 af[4], bfr[4];
#pragma unroll
            for (int i = 0; i < 4; ++i) { int r = wm * 64 + i * 16 + lr; int ch = ks * 4 + lg; af[i] = *(const bf16x8*)(base + r * 128 + ((ch ^ (r & 7)) << 4)); }
#pragma unroll
            for (int i = 0; i < 4; ++i) { int r = wn * 64 + i * 16 + lr; int ch = ks * 4 + lg; bfr[i] = *(const bf16x8*)(base + 32768 + r * 128 + ((ch ^ (r & 7)) << 4)); }
#pragma unroll
            for (int i = 0; i < 4; ++i)
#pragma unroll
                for (int j = 0; j < 4; ++j) acc[i][j] = MFMA16(bfr[j], af[i], acc[i][j]);
        }
        if (kt + 1 < nk) sstore((kt + 1) & 1);
        __syncthreads();
    }
#pragma unroll
    for (int i = 0; i < 4; ++i)
#pragma unroll
        for (int j = 0; j < 4; ++j) epi(m0 + wm * 64 + i * 16 + lr, n0 + wn * 64 + j * 16 + 4 * lg, acc[i][j]);
}

template <class Epi>
DI void gemm_phase(const GemmArgs g, int M, int N, const Epi epi, char* lds, int bid, int nb) {
    const int tn = N >> 7, tm = M >> 8;
    for (int u = bid; u < tm * tn; u += nb) { int mt = u / tn, nt = u % tn; gemm_unit(g, mt * 256, nt * 128, epi, lds); }
}

DI void store_bf4(bf16_t* dst, f32x4 v) { u32x2 o; o[0] = pack_bf2(v[0], v[1]); o[1] = pack_bf2(v[2], v[3]); *(u32x2*)dst = o; }

struct EpiInEven {
    bf16_t* H; float* out; bf16_t* VT;
    DI void operator()(int row, int col, f32x4 v) const {
        store_bf4(H + (size_t)row * 2560 + col, v);
        if (col >= 512 && col < 1536 && row < TT) {
            const bool isv = col >= 1024; const int c = col - (isv ? 1024 : 512);
            const size_t off = row < TP ? (isv ? OFF_VP : OFF_KP) + (size_t)row * 512 + c : (isv ? OFF_VS : OFF_KS) + (size_t)(row - TP) * 512 + c;
            *(f32x4*)(out + off) = v;
            if (isv && row < TP) {
                const int b = row >> 13, s = row & 8191, h = c >> 6, d = c & 63;
                bf16_t* vt = VT + ((size_t)(b * 8 + h) * 64 + d) * 8192 + s;
#pragma unroll
                for (int i = 0; i < 4; ++i) vt[(size_t)i * 8192] = f2bf(v[i]);
            }
        }
    }
};
struct EpiBf16 { bf16_t* O; int ld; DI void operator()(int row, int col, f32x4 v) const { store_bf4(O + (size_t)row * ld + col, v); } };
struct EpiF32 { float* O; int ld; DI void operator()(int row, int col, f32x4 v) const { *(f32x4*)(O + (size_t)row * ld + col) = v; } };
struct EpiResid {
    float* T; const float* XF;
    DI void operator()(int row, int col, f32x4 v) const { f32x4 x = *(const f32x4*)(XF + (size_t)row * DM + col); *(f32x4*)(T + (size_t)row * DM + col) = x * DN_ALPHA + v; }
};
struct EpiInOdd {
    bf16_t* H; float* LF; const float* LB;
    DI void operator()(int row, int col, f32x4 v) const {
        const int sec = col >> 10, c = col & 1023;
        if (sec == 1) {
            f32x4 lb = *(const f32x4*)(LB + c); f32x4 lf, kk;
#pragma unroll
            for (int i = 0; i < 4; ++i) { float f = lb[i] + (1.f - lb[i]) * sigmoidf_(v[i]); lf[i] = __logf(f); kk[i] = 1.f - f; }
            *(f32x4*)(LF + (size_t)row * DM + c) = lf;
            store_bf4(H + (size_t)MP * DM + (size_t)row * DM + c, kk);
        } else {
            store_bf4(H + (size_t)sec * MP * DM + (size_t)row * DM + c, v);
        }
    }
};

namespace pg8 {
#define PG8_LAS __attribute__((address_space(3)))
typedef unsigned short bf16_t;
typedef short bf16x8 __attribute__((ext_vector_type(8)));
typedef float f32x4 __attribute__((ext_vector_type(4)));
typedef unsigned u32x4 __attribute__((ext_vector_type(4)));
constexpr int BM = 256, BK = 64, HALF = 128, HTB = HALF * BK * 2  , STAGE_BYTES = 8 * HTB, NXCD = 8, WGM = 8;

__host__ __device__ __forceinline__ int lds_byte(int r, int c) { const int st = (r >> 4) * 2 + (c >> 5), rr = r & 15, cc = c & 31, ob = rr * 64 + cc * 2; return st * 1024 + (ob ^ (((ob >> 9) & 1) << 5)); }
__host__ __device__ __forceinline__ void stage_rc(int b, int& R, int& C) { const int st = b / 1024, sb = b % 1024, swz = sb ^ (((sb >> 9) & 1) << 5); R = (st >> 1) * 16 + swz / 64; C = (st & 1) * 32 + (swz % 64) / 2; }
__host__ __device__ __forceinline__ int perm32(int rho) { const int n = rho >> 4, i = rho & 15; return 8 * (i >> 2) + 4 * n + (i & 3); }

struct Unit { int pm, pn; };
struct Gemm { const bf16_t* A; const bf16_t* Bt; int M, N, K; };

struct StaticOrder {
    int nM, nN, nwg, G, c;
    __host__ __device__ void init(int M, int N, int G_, int c_) { nM = M / BM; nN = N / BM; nwg = nM * nN; G = G_; c = c_; }
    __host__ __device__ bool next(int i, Unit& u) const {
        const long L = (long)i * G + c; if (L >= nwg) return false;
        int wgid = (int)L; { const int q = nwg / NXCD, r = nwg % NXCD, xcd = wgid % NXCD, off = wgid / NXCD; wgid = (xcd < r ? xcd * (q + 1) : r * (q + 1) + (xcd - r) * q) + off; }
        const int nig = WGM * nN, gid = wgid / nig, fm = gid * WGM, gsz = (nM - fm) < WGM ? (nM - fm) : WGM;
        u.pm = fm + ((wgid % nig) % gsz); u.pn = (wgid % nig) / gsz; return true;
    }
    __device__ __forceinline__ void a_ready(const Unit&) const {}
    __device__ __forceinline__ void done(const Unit&) const {}
};

template <class Epi, class Sched, bool STAMP = false>
__device__ __forceinline__ void gemm_phase(PG8_LAS unsigned char* lds, const Gemm g, const Sched& S, const Epi& E, unsigned long long* stamps) {
    const int tid = TIDX, wid = __builtin_amdgcn_readfirstlane(tid >> 6), lane = tid & 63, wr = wid >> 2, wc = wid & 3, fr = lane & 15, fq = lane >> 4;
    const int K = g.K, nt = K / BK;
    int ts_lo = 0, ts_hi = 0, nts = 0; const unsigned long long rt_entry = STAMP ? (unsigned long long)wall_clock64() : 0ull;
#define PG8_STAMP() do { if (STAMP && wid == 0 && nts < 64) { const unsigned long long _c = (unsigned long long)clock64(); \
        ts_lo = (lane == nts) ? (int)(unsigned)_c : ts_lo; ts_hi = (lane == nts) ? (int)(unsigned)(_c >> 32) : ts_hi; ++nts; } } while (0)
    PG8_STAMP();
    unsigned voffA[2], voffB[2];
#pragma unroll
    for (int i = 0; i < 2; ++i) { int R, C; stage_rc(tid * 16 + i * 8192, R, C); const int Rb = Epi::PERM ? ((R & ~31) + perm32(R & 31)) : R;
        voffA[i] = (unsigned)(R * K + C) * 2u; voffB[i] = (unsigned)(Rb * K + C) * 2u; }
    const size_t kstep = (size_t)(BK * 2);
    const size_t hstep = (size_t)HALF * K * 2;
    const size_t tstep = 2 * hstep;
    const unsigned ldsw = (unsigned)wid * 1024u;
    const int aoff = lds_byte(wr * 64 + fr, fq * 8), boff = lds_byte(wc * 32 + fr, fq * 8);
#define PG8_SA(b, h) (((b) * 2 + (h)) * HTB)
#define PG8_SB(b, h) ((4 + (b) * 2 + (h)) * HTB)
#define PG8_STAGE(bufoff, gbase, voff) do { _Pragma("unroll") for (int _i = 0; _i < 2; ++_i) \
        __builtin_amdgcn_global_load_lds((const unsigned*)((const char*)(gbase) + (voff)[_i]), (PG8_LAS unsigned*)(lds + (bufoff) + ldsw + _i * 8192), 16, 0, 0); } while (0)
#define PG8_LDA(dst, b, h) do { _Pragma("unroll") for (int m = 0; m < 4; ++m) _Pragma("unroll") for (int k = 0; k < 2; ++k) dst[m][k] = *(const PG8_LAS bf16x8*)(lds + PG8_SA(b, h) + aoff + m * 2048 + k * 1024); } while (0)
#define PG8_LDB(dst, b, h) do { _Pragma("unroll") for (int n = 0; n < 2; ++n) _Pragma("unroll") for (int k = 0; k < 2; ++k) dst[n][k] = *(const PG8_LAS bf16x8*)(lds + PG8_SB(b, h) + boff + n * 2048 + k * 1024); } while (0)
#define PG8_MMA(ai, bj, At, Bt) do { __builtin_amdgcn_s_setprio(1); _Pragma("unroll") for (int m = 0; m < 4; ++m) _Pragma("unroll") for (int n = 0; n < 2; ++n) _Pragma("unroll") for (int k = 0; k < 2; ++k) \
        acc[ai][bj][m][n] = __builtin_amdgcn_mfma_f32_16x16x32_bf16(Bt[n][k], At[m][k], acc[ai][bj][m][n], 0, 0, 0); __builtin_amdgcn_s_setprio(0); } while (0)
#define PG8_WAIT_V(n) asm volatile("s_waitcnt vmcnt(" #n ")" ::: "memory")
#define PG8_WAIT_L(n) asm volatile("s_waitcnt lgkmcnt(" #n ")" ::: "memory")
#define PG8_BAR __builtin_amdgcn_s_barrier()
#define PG8_SCHED __builtin_amdgcn_sched_barrier(0)
    Unit cur, nxt; int ui = 0;
    if (!S.next(0, cur)) return;
    f32x4 acc[2][2][4][2];
#pragma unroll
    for (int a = 0; a < 2; ++a)
#pragma unroll
        for (int b = 0; b < 2; ++b)
#pragma unroll
            for (int m = 0; m < 4; ++m)
#pragma unroll
                for (int n = 0; n < 2; ++n) acc[a][b][m][n] = (f32x4){0.f, 0.f, 0.f, 0.f};
    bf16x8 At[4][2], B0[2][2], B1[2][2];
    const char* cA = (const char*)g.A + (size_t)cur.pm * tstep; const char* cB = (const char*)g.Bt + (size_t)cur.pn * tstep;
    S.a_ready(cur);
    PG8_STAGE(PG8_SB(0, 0), cB, voffB); PG8_STAGE(PG8_SA(0, 0), cA, voffA); PG8_STAGE(PG8_SB(0, 1), cB + hstep, voffB); PG8_STAGE(PG8_SA(0, 1), cA + hstep, voffA);
    if (wr == 1) PG8_BAR;
    PG8_WAIT_V(4); PG8_BAR;
    PG8_STAGE(PG8_SB(1, 0), cB + kstep, voffB); PG8_STAGE(PG8_SA(1, 0), cA + kstep, voffA); PG8_STAGE(PG8_SB(1, 1), cB + hstep + kstep, voffB);
    PG8_WAIT_V(6); PG8_BAR;
    PG8_STAMP();
    for (;;) {
        const bool has_next = S.next(ui + 1, nxt);
        const char* nA = has_next ? (const char*)g.A + (size_t)nxt.pm * tstep : cA; const char* nB = has_next ? (const char*)g.Bt + (size_t)nxt.pn * tstep : cB;
        for (int t = 0; t < nt; t += 2) {
            const bool last = (t == nt - 2);
            const char* a1 = cA + (size_t)(t + 1) * kstep;
            const char* a2 = last ? nA : cA + (size_t)(t + 2) * kstep; const char* b2 = last ? nB : cB + (size_t)(t + 2) * kstep;
            const char* a3 = a2 + kstep; const char* b3 = b2 + kstep;
            if (last && has_next) S.a_ready(nxt);
            PG8_LDB(B0, 0, 0); PG8_SCHED; PG8_LDA(At, 0, 0); PG8_STAGE(PG8_SA(1, 1), a1 + hstep, voffA);
            PG8_WAIT_L(8); PG8_BAR; PG8_WAIT_L(0); PG8_MMA(0, 0, At, B0); PG8_BAR; PG8_SCHED;
            PG8_LDB(B1, 0, 1); PG8_STAGE(PG8_SB(0, 0), b2, voffB);
            PG8_BAR; PG8_WAIT_L(0); PG8_MMA(0, 1, At, B1); PG8_BAR;
            PG8_LDA(At, 0, 1); PG8_STAGE(PG8_SA(0, 0), a2, voffA);
            PG8_BAR; PG8_WAIT_L(0); PG8_MMA(1, 0, At, B0); PG8_BAR; PG8_SCHED;
            PG8_STAGE(PG8_SB(0, 1), b2 + hstep, voffB);
            PG8_WAIT_V(6); PG8_BAR; PG8_MMA(1, 1, At, B1); PG8_BAR;
            PG8_LDB(B0, 1, 0); PG8_SCHED; PG8_LDA(At, 1, 0); PG8_STAGE(PG8_SA(0, 1), a2 + hstep, voffA);
            PG8_WAIT_L(8); PG8_BAR; PG8_WAIT_L(0); PG8_MMA(0, 0, At, B0); PG8_BAR; PG8_SCHED;
            PG8_LDB(B1, 1, 1); PG8_STAGE(PG8_SB(1, 0), b3, voffB);
            PG8_BAR; PG8_WAIT_L(0); PG8_MMA(0, 1, At, B1); PG8_BAR;
            PG8_LDA(At, 1, 1); PG8_STAGE(PG8_SA(1, 0), a3, voffA);
            PG8_BAR; PG8_WAIT_L(0); PG8_MMA(1, 0, At, B0); PG8_BAR; PG8_SCHED;
            PG8_STAGE(PG8_SB(1, 1), b3 + hstep, voffB);
            PG8_WAIT_V(6); PG8_BAR; PG8_MMA(1, 1, At, B1); PG8_BAR;
        }
        PG8_STAMP();
        if constexpr (!Epi::AFTER_DRAIN) { E(acc, cur, wr, wc, fr, fq); S.done(cur); }
        PG8_STAMP();
        if (!has_next) break;
#pragma unroll
        for (int a = 0; a < 2; ++a)
#pragma unroll
            for (int b = 0; b < 2; ++b)
#pragma unroll
                for (int m = 0; m < 4; ++m)
#pragma unroll
                    for (int n = 0; n < 2; ++n) acc[a][b][m][n] = (f32x4){0.f, 0.f, 0.f, 0.f};
        cur = nxt; cA = nA; cB = nB; ++ui;
    }
    PG8_WAIT_V(0);
    if (wr == 0) PG8_BAR;
    PG8_BAR;
    if constexpr (Epi::AFTER_DRAIN) { E.fused(acc, cur, wr, wc, fr, fq, lds, wid, lane); S.done(cur); }
    PG8_STAMP();
    if (STAMP && wid == 0) { stamps[lane] = lane < nts ? (((unsigned long long)(unsigned)ts_hi << 32) | (unsigned)ts_lo) : 0ull;
        if (lane == 62) stamps[62] = rt_entry; if (lane == 63) stamps[63] = (unsigned long long)wall_clock64(); }
#undef PG8_STAMP
#undef PG8_SA
#undef PG8_SB
#undef PG8_STAGE
#undef PG8_LDA
#undef PG8_LDB
#undef PG8_MMA
#undef PG8_WAIT_V
#undef PG8_WAIT_L
#undef PG8_BAR
#undef PG8_SCHED
}
}

template <class MyEpi> struct Pg8Epi {
    static constexpr bool PERM = false, AFTER_DRAIN = false;
    MyEpi e;
    __device__ __forceinline__ void operator()(const pg8::f32x4 (&acc)[2][2][4][2], const pg8::Unit& u, int wr, int wc, int fr, int fq) const {
#pragma unroll
        for (int ai = 0; ai < 2; ++ai)
#pragma unroll
            for (int m = 0; m < 4; ++m) {
                const int row = u.pm * 256 + ai * 128 + wr * 64 + m * 16 + fr;
#pragma unroll
                for (int bj = 0; bj < 2; ++bj)
#pragma unroll
                    for (int n = 0; n < 2; ++n) e(row, u.pn * 256 + bj * 128 + wc * 32 + n * 16 + 4 * fq, acc[ai][bj][m][n]);
            }
    }
};

template <class E> DI void gemm_small32_unit(const bf16_t* A, int lda, const bf16_t* Bt, int ldb, int K, int m0, int n0, const E epi) {
    const int tid = TIDX, lane = tid & 63, w = tid >> 6, lr = lane & 15, lg = lane >> 4;
    const bf16_t* a0 = A + (size_t)(m0 + lr) * lda + lg * 8; const bf16_t* a1 = a0 + (size_t)16 * lda;
    const bf16_t* b0 = Bt + (size_t)(n0 + w * 16 + lr) * ldb + lg * 8;
    f32x4 acc0 = {0.f, 0.f, 0.f, 0.f}, acc1 = {0.f, 0.f, 0.f, 0.f};
#pragma unroll 1
    for (int k0 = 0; k0 < K; k0 += 256) {
        bf16x8 fa0[8], fa1[8], fb[8];
#pragma unroll
        for (int i = 0; i < 8; ++i) { fa0[i] = *(const bf16x8*)(a0 + k0 + i * 32); fa1[i] = *(const bf16x8*)(a1 + k0 + i * 32); fb[i] = *(const bf16x8*)(b0 + k0 + i * 32); }
#pragma unroll
        for (int i = 0; i < 8; ++i) { acc0 = MFMA16(fb[i], fa0[i], acc0); acc1 = MFMA16(fb[i], fa1[i], acc1); }
    }
    epi(m0 + lr, n0 + w * 16 + 4 * lg, acc0);
    epi(m0 + 16 + lr, n0 + w * 16 + 4 * lg, acc1);
}
template <class E> DI void gemm_big(const bf16_t* A, const bf16_t* Bt, int N, const E epi, char* lds, int bid, int nb) {
    {
        pg8::Gemm g{A, Bt, TP, N, DM};
        pg8::StaticOrder S; S.init(TP, N, nb, bid);
        Pg8Epi<E> pe{epi};
        pg8::gemm_phase<Pg8Epi<E>, pg8::StaticOrder, false>((PG8_LAS unsigned char*)lds, g, S, pe, nullptr);
    }
    __syncthreads();
    for (int u = nb - 1 - bid; u < (N >> 7); u += nb) gemm_small32_unit(A, DM, Bt, DM, DM, TP, u * 128, epi);
}

DI void conv_unit(const Params& p, int u, char* lds) {
    float* sy = (float*)lds;
    const int c = TIDX, lane = c & 63, w = c >> 6;
    float wj[31];
#pragma unroll
    for (int j = 0; j < 31; ++j) wj[j] = p.conv_w[j * 512 + c];
    const float bias = p.conv_b[c];
    int ntok, row0;
    if (u < 512) {
        const int b = u >> 8, t0 = (u & 255) * 32; ntok = 32; row0 = b * SEQ + t0;
        float uu[62];
#pragma unroll
        for (int r = 0; r < 62; ++r) {
            const int t = t0 - 30 + r; float val = 0.f;
            if (t >= 0) { const size_t row = (size_t)b * SEQ + t; float a = bf2f(p.H[row * 2560 + 1536 + c]); float g = bf2f(p.H[row * 2560 + 2048 + c]); val = a * sigmoidf_(g); }
            uu[r] = val;
            if (t0 == SEQ - 32 && r >= 32) p.conv_prompt[((size_t)b * 30 + (r - 32)) * 512 + c] = val;
        }
#pragma unroll
        for (int tt = 0; tt < 32; ++tt) {
            float acc = bias;
#pragma unroll
            for (int j = 0; j < 31; ++j) acc += wj[j] * uu[tt + j];
            sy[tt * 512 + c] = acc;
        }
    } else {
        const int b = u - 512; ntok = 1; row0 = TP + b;
        const size_t row = (size_t)row0;
        float a = bf2f(p.H[row * 2560 + 1536 + c]); float g = bf2f(p.H[row * 2560 + 2048 + c]);
        const float un = a * sigmoidf_(g);
        float acc = bias + wj[30] * un;
#pragma unroll
        for (int j = 0; j < 30; ++j) {
            float e = p.state_conv[((size_t)b * 30 + j) * 512 + c]; acc += wj[j] * e;
            if (j >= 1) p.conv_sample[((size_t)b * 30 + (j - 1)) * 512 + c] = e;
        }
        p.conv_sample[((size_t)b * 30 + 29) * 512 + c] = un;
        sy[c] = acc;
    }
    __syncthreads();
    for (int tt = w; tt < ntok; tt += 8) {
        float v[8]; float s = 0.f;
#pragma unroll
        for (int i = 0; i < 8; ++i) { v[i] = sy[tt * 512 + lane + 64 * i]; s += v[i]; }
        const float mu = wave_sum(s) * (1.f / 512.f);
        float q = 0.f;
#pragma unroll
        for (int i = 0; i < 8; ++i) { float d = v[i] - mu; q += d * d; }
        const float rs = rsqrtf(wave_sum(q) * (1.f / 512.f) + LN_EPS);
#pragma unroll
        for (int i = 0; i < 8; ++i) {
            const int cc = lane + 64 * i;
            float y = (v[i] - mu) * rs * p.conv_ln_g[cc] + p.conv_ln_b[cc];
            y = y * sigmoidf_(y);
            p.MIX[(size_t)(row0 + tt) * DM + 512 + cc] = f2bf(y);
        }
    }
    __syncthreads();
}

DI void moba_sample_unit(const Params& p, int u, char* lds) {
    float* sq = (float*)lds;
    float* gs = sq + 64;
    int* sel = (int*)(gs + 32);
    float* lg = (float*)(sel + 4);
    float* red = lg + 776;
    unsigned* roff = (unsigned*)(red + 16);
    float* part = (float*)(roff + 776);
    const int tid = TIDX, lane = tid & 63, w = tid >> 6;
    const int b = u >> 3, h = u & 7; const size_t row = (size_t)TP + b;
    __syncthreads();
    if (tid < 64) sq[tid] = bf2f(p.H[row * 2560 + h * 64 + tid]);
    __syncthreads();
    if (tid < 32) { const bf16_t* km = p.KMS + ((size_t)b * 32 + tid) * 512 + h * 64; float s = 0.f;
#pragma unroll 8
        for (int d = 0; d < 64; ++d) s += sq[d] * bf2f(km[d]);
        gs[tid] = s; }
    __syncthreads();
    if (tid == 0) {
        float v0 = -INFINITY, v1 = -INFINITY, v2 = -INFINITY; int i0 = 0, i1 = 0, i2 = 0;
        for (int j = 0; j < 32; ++j) { float s = gs[j];
            if (s > v0) { v2 = v1; i2 = i1; v1 = v0; i1 = i0; v0 = s; i0 = j; }
            else if (s > v1) { v2 = v1; i2 = i1; v1 = s; i1 = j; }
            else if (s > v2) { v2 = s; i2 = j; } }
        sel[0] = i0; sel[1] = i1; sel[2] = i2;
    }
    __syncthreads();
    for (int idx = tid; idx < 769; idx += NT) {
        float s = 0.f;
        if (idx < 768) {
            const int blk = sel[idx >> 8]; const int pos = blk * 256 + (idx & 255);
            const int page = p.page_table[b * 64 + (pos >> 7)];
            const unsigned ro = ((unsigned)page * 128u + (unsigned)(pos & 127)) * 8u + (unsigned)h;
            roff[idx] = ro;
            const float* kp = p.cache_k + (size_t)ro * 64;
            f32x4 kv[16];
#pragma unroll
            for (int d4 = 0; d4 < 16; ++d4) kv[d4] = *(const f32x4*)(kp + 4 * d4);
#pragma unroll
            for (int d4 = 0; d4 < 16; ++d4) s += sq[4 * d4] * kv[d4][0] + sq[4 * d4 + 1] * kv[d4][1] + sq[4 * d4 + 2] * kv[d4][2] + sq[4 * d4 + 3] * kv[d4][3];
        } else {
            const bf16_t* kn = p.H + row * 2560 + 512 + h * 64;
            for (int d = 0; d < 64; ++d) s += sq[d] * bf2f(kn[d]);
        }
        lg[idx] = s * 0.125f;
    }
    __syncthreads();
    float mx = -INFINITY;
    for (int idx = tid; idx < 769; idx += NT) mx = fmaxf(mx, lg[idx]);
    mx = wave_max(mx); if (lane == 0) red[w] = mx;
    __syncthreads();
    mx = red[0];
#pragma unroll
    for (int i = 1; i < 8; ++i) mx = fmaxf(mx, red[i]);
    float sm = 0.f;
    for (int idx = tid; idx < 769; idx += NT) { float e = __expf(lg[idx] - mx); lg[idx] = e; sm += e; }
    sm = wave_sum(sm); if (lane == 0) red[8 + w] = sm;
    __syncthreads();
    sm = 0.f;
#pragma unroll
    for (int i = 0; i < 8; ++i) sm += red[8 + i];
    {
        const int d4 = tid & 15, kg = tid >> 4;
        f32x4 acc = {0.f, 0.f, 0.f, 0.f};
#pragma unroll
        for (int i0 = 0; i0 < 24; i0 += 8) {
            f32x4 vv[8]; float pp[8];
#pragma unroll
            for (int i = 0; i < 8; ++i) { const int idx = kg + 32 * (i0 + i); pp[i] = lg[idx]; vv[i] = *(const f32x4*)(p.cache_v + (size_t)roff[idx] * 64 + 4 * d4); }
#pragma unroll
            for (int i = 0; i < 8; ++i) acc += vv[i] * pp[i];
        }
        if (kg == 0) {
            const bf16_t* vn = p.H + row * 2560 + 1024 + h * 64 + 4 * d4; const float pn = lg[768];
            acc[0] += pn * bf2f(vn[0]); acc[1] += pn * bf2f(vn[1]); acc[2] += pn * bf2f(vn[2]); acc[3] += pn * bf2f(vn[3]);
        }
        *(f32x4*)(part + kg * 64 + 4 * d4) = acc;
    }
    __syncthreads();
    if (tid < 64) { float a = 0.f;
#pragma unroll
        for (int i = 0; i < 32; ++i) a += part[i * 64 + tid];
        p.MIX[row * DM + h * 64 + tid] = f2bf(a / sm); }
}

constexpr int MB_K = 0, MB_V = 65536, MB_VROW = 528, MB_WOR = 65536 + 2 * 64 * MB_VROW;
DI void moba_prompt_unit(const Params& p, int bh, int own, char* lds) {
    const int tid = TIDX, lane = tid & 63, w = tid >> 6, lr = lane & 15, lg = lane >> 4;
    const int b = bh >> 3, h = bh & 7;
    float* gsc = (float*)lds + w * 1024;
    unsigned* msk = (unsigned*)(lds + 32768) + w * 36;
    unsigned* worl = (unsigned*)(lds + MB_WOR);
    const int wv = __builtin_amdgcn_readfirstlane(w);
    const size_t rowq0 = (size_t)b * SEQ + own * 256 + w * 32;
    __syncthreads();
    bf16x8 qf[2][2];
#pragma unroll
    for (int qt = 0; qt < 2; ++qt)
#pragma unroll
        for (int ks = 0; ks < 2; ++ks) qf[qt][ks] = *(const bf16x8*)(p.H + (rowq0 + qt * 16 + lr) * 2560 + h * 64 + ks * 32 + lg * 8);
    unsigned mq[2]; unsigned wor;
    if (own > 3) {
        bf16_t* kml = (bf16_t*)(lds + 36864);
        {
            const int j = tid >> 4, d4 = tid & 15;
            f32x4 a = {0.f, 0.f, 0.f, 0.f};
#pragma unroll
            for (int part = 0; part < 8; ++part) a += *(const f32x4*)(p.KMPP + (((size_t)b * 32 + j) * 8 + part) * 512 + h * 64 + 4 * d4);
            store_bf4(kml + j * 64 + 4 * d4, a * (1.f / 256.f));
        }
        __syncthreads();
#pragma unroll
        for (int jt = 0; jt < 2; ++jt) {
            bf16x8 kf[2];
#pragma unroll
            for (int ks = 0; ks < 2; ++ks) kf[ks] = *(const bf16x8*)(kml + (jt * 16 + lr) * 64 + ks * 32 + lg * 8);
#pragma unroll
            for (int qt = 0; qt < 2; ++qt) {
                f32x4 a = {0.f, 0.f, 0.f, 0.f};
                a = MFMA16(kf[0], qf[qt][0], a); a = MFMA16(kf[1], qf[qt][1], a);
#pragma unroll
                for (int r = 0; r < 4; ++r) gsc[(qt * 16 + lr) * 32 + jt * 16 + 4 * lg + r] = a[r];
            }
        }
        __builtin_amdgcn_s_waitcnt(0);
        __builtin_amdgcn_wave_barrier();
        unsigned m = 0;
        if (lane < 32) {
            float v0 = -INFINITY, v1 = -INFINITY, v2 = -INFINITY; int i0 = 0, i1 = 0, i2 = 0;
            for (int j = 0; j < own; ++j) { float sc = gsc[lane * 32 + j];
                if (sc > v0) { v2 = v1; i2 = i1; v1 = v0; i1 = i0; v0 = sc; i0 = j; }
                else if (sc > v1) { v2 = v1; i2 = i1; v1 = sc; i1 = j; }
                else if (sc > v2) { v2 = sc; i2 = j; } }
            m = (1u << i0) | (1u << i1) | (1u << i2);
            msk[lane] = m;
        }
        unsigned o = m;
#pragma unroll
        for (int sft = 32; sft >= 1; sft >>= 1) o |= (unsigned)__shfl_xor((int)o, sft, 64);
        wor = o;
        __builtin_amdgcn_s_waitcnt(0);
        __builtin_amdgcn_wave_barrier();
        mq[0] = msk[lr]; mq[1] = msk[16 + lr];
    } else {
        const unsigned m = (own >= 1) ? ((1u << own) - 1u) : 0u;
        mq[0] = m; mq[1] = m; wor = m;
    }
    wor = (unsigned)__builtin_amdgcn_readfirstlane((int)wor);
    if (lane == 0) worl[w] = wor;
    __syncthreads();
    unsigned bor = 0;
#pragma unroll
    for (int i = 0; i < 8; ++i) bor |= worl[i];
    bor = (unsigned)__builtin_amdgcn_readfirstlane((int)bor);

    const bf16_t* Kbase = p.H + (size_t)b * SEQ * 2560 + 512 + h * 64;
    const bf16_t* Vbase = p.VT + (size_t)(b * 8 + h) * 64 * 8192;
    u32x4 rk[4], rv[4];
    auto gload = [&](int jb) {
#pragma unroll
        for (int i = 0; i < 4; ++i) { const int id = tid + NT * i; const int r = id >> 3, c = id & 7; rk[i] = *(const u32x4*)(Kbase + (size_t)(jb * 256 + r) * 2560 + c * 8); }
#pragma unroll
        for (int i = 0; i < 4; ++i) { const int id = tid + NT * i; const int d = id >> 5, c = id & 31; rv[i] = *(const u32x4*)(Vbase + (size_t)d * 8192 + jb * 256 + c * 8); }
    };
    auto sstore = [&](int buf) {
#pragma unroll
        for (int i = 0; i < 4; ++i) { const int id = tid + NT * i; const int r = id >> 3, c = id & 7; *(u32x4*)(lds + MB_K + buf * 32768 + r * 128 + ((c ^ (r & 7)) << 4)) = rk[i]; }
#pragma unroll
        for (int i = 0; i < 4; ++i) { const int id = tid + NT * i; const int d = id >> 5, c = id & 31; *(u32x4*)(lds + MB_V + buf * (64 * MB_VROW) + d * MB_VROW + c * 16) = rv[i]; }
    };
    const float SC = 0.125f * 1.4426950408889634f;
    float mrow[2] = {-INFINITY, -INFINITY}, lrow[2] = {0.f, 0.f};
    f32x4 oacc[2][4];
#pragma unroll
    for (int qt = 0; qt < 2; ++qt)
#pragma unroll
        for (int dt = 0; dt < 4; ++dt) oacc[qt][dt] = (f32x4){0.f, 0.f, 0.f, 0.f};
    int cur = own, buf = 0;
    gload(cur); sstore(0); __syncthreads();
    int nxt_scan = 0;
    while (cur >= 0) {
        int nxt = -1;
        while (nxt_scan < own) { const int j = nxt_scan++; if ((bor >> j) & 1u) { nxt = j; break; } }
        if (nxt >= 0) gload(nxt);
        const bool isown = (cur == own);
        if (isown || ((wor >> cur) & 1u)) {
            const char* KB = lds + MB_K + buf * 32768; const char* VB = lds + MB_V + buf * (64 * MB_VROW);
            const int nst = isown ? (wv + 1) : 8;
            const bool sel0 = isown || ((mq[0] >> cur) & 1u), sel1 = isown || ((mq[1] >> cur) & 1u);
            for (int st = 0; st < nst; ++st) {
                bf16x8 kf[2][2];
#pragma unroll
                for (int kt = 0; kt < 2; ++kt)
#pragma unroll
                    for (int ks = 0; ks < 2; ++ks) { const int r = st * 32 + kt * 16 + lr, ch = ks * 4 + lg; kf[kt][ks] = *(const bf16x8*)(KB + r * 128 + ((ch ^ (r & 7)) << 4)); }
                bf16x8 pf[2]; float alph[2];
#pragma unroll
                for (int qt = 0; qt < 2; ++qt) {
                    f32x4 sv[2];
#pragma unroll
                    for (int kt = 0; kt < 2; ++kt) { f32x4 a = {0.f, 0.f, 0.f, 0.f}; a = MFMA16(kf[kt][0], qf[qt][0], a); a = MFMA16(kf[kt][1], qf[qt][1], a); sv[kt] = a; }
                    const bool selq = qt ? sel1 : sel0;
                    if (isown) {
                        const int qin = wv * 32 + qt * 16 + lr;
#pragma unroll
                        for (int kt = 0; kt < 2; ++kt)
#pragma unroll
                            for (int r = 0; r < 4; ++r) { const int kin = st * 32 + kt * 16 + 4 * lg + r; sv[kt][r] = (kin <= qin) ? sv[kt][r] : -INFINITY; }
                    }
                    float mx = fmaxf(fmaxf(fmaxf(sv[0][0], sv[0][1]), fmaxf(sv[0][2], sv[0][3])), fmaxf(fmaxf(sv[1][0], sv[1][1]), fmaxf(sv[1][2], sv[1][3]))) * SC;
                    mx = red_max_16_32(mx);
                    mx = selq ? mx : -INFINITY;
                    const float mnew = fmaxf(mrow[qt], mx);
                    alph[qt] = __builtin_amdgcn_exp2f(mrow[qt] - mnew);
                    const float mneg = selq ? -mnew : -INFINITY;
                    float ps = 0.f;
#pragma unroll
                    for (int kt = 0; kt < 2; ++kt)
#pragma unroll
                        for (int r = 0; r < 4; ++r) { const float e = __builtin_amdgcn_exp2f(__builtin_fmaf(sv[kt][r], SC, mneg)); sv[kt][r] = e; ps += e; }
                    ps = red_sum_16_32(ps);
                    lrow[qt] = lrow[qt] * alph[qt] + ps; mrow[qt] = mnew;
                    u32x4 pk; pk[0] = pack_bf2(sv[0][0], sv[0][1]); pk[1] = pack_bf2(sv[0][2], sv[0][3]); pk[2] = pack_bf2(sv[1][0], sv[1][1]); pk[3] = pack_bf2(sv[1][2], sv[1][3]);
                    pf[qt] = __builtin_bit_cast(bf16x8, pk);
                }
                if (__any((alph[0] != 1.f) || (alph[1] != 1.f))) {
#pragma unroll
                    for (int qt = 0; qt < 2; ++qt)
#pragma unroll
                        for (int dt = 0; dt < 4; ++dt) oacc[qt][dt] = oacc[qt][dt] * alph[qt];
                }
#pragma unroll
                for (int dt = 0; dt < 4; ++dt) {
                    const char* vp = VB + (dt * 16 + lr) * MB_VROW + st * 64 + 8 * lg;
                    const u32x2 lo = *(const u32x2*)vp, hi = *(const u32x2*)(vp + 32);
                    u32x4 t4; t4[0] = lo[0]; t4[1] = lo[1]; t4[2] = hi[0]; t4[3] = hi[1];
                    const bf16x8 vf = __builtin_bit_cast(bf16x8, t4);
#pragma unroll
                    for (int qt = 0; qt < 2; ++qt) oacc[qt][dt] = MFMA16(vf, pf[qt], oacc[qt][dt]);
                }
            }
        }
        if (nxt >= 0) sstore(buf ^ 1);
        __syncthreads();
        cur = nxt; buf ^= 1;
    }
#pragma unroll
    for (int qt = 0; qt < 2; ++qt) {
        const float inv = 1.f / lrow[qt];
#pragma unroll
        for (int dt = 0; dt < 4; ++dt) store_bf4(p.MIX + (rowq0 + qt * 16 + lr) * DM + h * 64 + dt * 16 + 4 * lg, oacc[qt][dt] * inv);
    }
}

DI void ln_rows(const Params& p, const float* g, const float* bb, int bid, int nb, bool final_out) {
    const int lane = TIDX & 63, w = TIDX >> 6;
    for (int row = bid * 8 + w; row < TT; row += nb * 8) {
        f32x4 v[4]; float s = 0.f;
#pragma unroll
        for (int i = 0; i < 4; ++i) { v[i] = *(const f32x4*)(p.T + (size_t)row * DM + 4 * lane + 256 * i); s += v[i][0] + v[i][1] + v[i][2] + v[i][3]; }
        const float mu = wave_sum(s) * (1.f / 1024.f);
        float q = 0.f;
#pragma unroll
        for (int i = 0; i < 4; ++i)
#pragma unroll
            for (int k = 0; k < 4; ++k) { float d = v[i][k] - mu; q += d * d; }
        const float rs = rsqrtf(wave_sum(q) * (1.f / 1024.f) + LN_EPS);
#pragma unroll
        for (int i = 0; i < 4; ++i) {
            const int c = 4 * lane + 256 * i;
            f32x4 gg = *(const f32x4*)(g + c), be = *(const f32x4*)(bb + c), y;
#pragma unroll
            for (int k = 0; k < 4; ++k) y[k] = (v[i][k] - mu) * rs * gg[k] + be[k];
            if (final_out) { float* dst = row < TP ? p.y_prompt + (size_t)row * DM + c : p.y_sample + (size_t)(row - TP) * DM + c; *(f32x4*)dst = y; }
            else { *(f32x4*)(p.XF + (size_t)row * DM + c) = y; store_bf4(p.XB + (size_t)row * DM + c, y); }
        }
    }
}

#define INS16(V, I, tv, ti) { float _v = (V); int _i = (I); _Pragma("unroll") for (int _k = 0; _k < 16; ++_k) { const bool _g = _v > tv[_k]; const float _tv = tv[_k]; const int _ti = ti[_k]; tv[_k] = _g ? _v : _tv; ti[_k] = _g ? _i : _ti; _v = _g ? _tv : _v; _i = _g ? _ti : _i; } }
DI void peer_topk_unit(const Params& p, int u, char* lds) {
    float* lv = (float*)lds;
    int* li = (int*)(lds + 512 * 17 * 4);
    const int tid = TIDX; const int tok = u * 32 + (tid >> 4), j = tid & 15;
    float tv[16]; int ti[16];
#pragma unroll
    for (int k = 0; k < 16; ++k) { tv[k] = -INFINITY; ti[k] = 0; }
    if (tok < TT) {
        const float* s = p.S + (size_t)tok * 2048 + j * 128;
        for (int n4 = 0; n4 < 32; ++n4) {
            f32x4 v = *(const f32x4*)(s + 4 * n4);
            INS16(v[0], 4 * n4, tv, ti); INS16(v[1], 4 * n4 + 1, tv, ti); INS16(v[2], 4 * n4 + 2, tv, ti); INS16(v[3], 4 * n4 + 3, tv, ti);
        }
    }
#pragma unroll
    for (int k = 0; k < 16; ++k) { lv[tid * 17 + k] = tv[k]; li[tid * 17 + k] = ti[k]; }
    __syncthreads();
    if ((j & 1) == 0 && tok < TT) {
        float v2[16]; int i2[16];
#pragma unroll
        for (int k = 0; k < 16; ++k) { v2[k] = lv[(tid + 1) * 17 + k]; i2[k] = li[(tid + 1) * 17 + k]; }
        float sv[16]; int si[16];
#pragma unroll
        for (int k = 0; k < 16; ++k) { sv[k] = -INFINITY; si[k] = 0; }
#pragma unroll
        for (int a = 0; a < 16; ++a)
#pragma unroll
            for (int bq = 0; bq < 16; ++bq)
                if ((a + 1) * (bq + 1) <= 16) INS16(tv[a] + v2[bq], ti[a] * 128 + i2[bq], sv, si);
        float sm = 0.f; float e[16];
#pragma unroll
        for (int k = 0; k < 16; ++k) { e[k] = __expf(sv[k] - sv[0]); sm += e[k]; }
        const float inv = 1.f / sm; const int h = j >> 1;
#pragma unroll
        for (int k = 0; k < 16; ++k) { p.E[(size_t)tok * 128 + h * 16 + k] = si[k]; p.G[(size_t)tok * 128 + h * 16 + k] = e[k] * inv; }
    }
    __syncthreads();
}

constexpr int EHS = 129;
constexpr int PEER_EH = 65536, PEER_TOK = 65536 + 64 * EHS * 8, PEER_END = PEER_TOK + 1024;
DI float gelu_exact(float z) { return 0.5f * z * (1.f + erff(z * 0.70710678118654752f)); }
#define FMA4U(ACC, O, H, W) { ACC[O] += H * (float)((W) & 0xffu); ACC[O + 1] += H * (float)(((W) >> 8) & 0xffu); ACC[O + 2] += H * (float)(((W) >> 16) & 0xffu); ACC[O + 3] += H * (float)((W) >> 24); }

DI void peer_tile(const Params& p, int layer, int tile, char* lds, bool final_out) {
    const int lane = TIDX & 63, w = TIDX >> 6, lr = lane & 15, lg = lane >> 4;
    unsigned char* X8 = (unsigned char*)lds; int2* EH = (int2*)(lds + PEER_EH); float* TOK = (float*)(lds + PEER_TOK);
    const unsigned char* U8 = p.U8 + (size_t)layer * 16384 * DM; const unsigned char* V8 = p.V8 + (size_t)layer * 16384 * DM;
    const float* SUi = p.SU + layer * 16384; const float* SVi = p.SV + layer * 16384;
    const float* lng = p.ln_g + (layer * 2 + 1) * DM; const float* lnb = p.ln_b + (layer * 2 + 1) * DM;
    const int t0 = tile * 64 + w * 8;
#pragma unroll 1
    for (int i = 0; i < 8; ++i) {
        const int t = t0 + i, tk = w * 8 + i;
        f32x4 v[4]; float am = 0.f;
#pragma unroll
        for (int k = 0; k < 4; ++k) { v[k] = *(const f32x4*)(p.XF + (size_t)t * DM + 4 * lane + 256 * k); am = fmaxf(am, fmaxf(fmaxf(fabsf(v[k][0]), fabsf(v[k][1])), fmaxf(fabsf(v[k][2]), fabsf(v[k][3])))); }
        am = wave_max(am);
        const float sc = am > 0.f ? 127.f / am : 0.f;
#pragma unroll
        for (int k = 0; k < 4; ++k) {
            unsigned pk = 0;
#pragma unroll
            for (int q = 0; q < 4; ++q) { const int qi = (int)rintf(v[k][q] * sc); pk |= ((unsigned)qi & 0xffu) << (8 * q); }
            *(unsigned*)(X8 + tk * 1024 + 4 * lane + 256 * k) = pk;
        }
        if (lane == 0) TOK[tk * 2] = am * (1.f / 127.f);
        EH[tk * EHS + lane] = make_int2(p.E[(size_t)t * 128 + lane], 0);
        EH[tk * EHS + 64 + lane] = make_int2(p.E[(size_t)t * 128 + 64 + lane], 0);
    }
#pragma unroll 1
    for (int r = 0; r < 4; ++r) {
        const int tk0 = w * 8 + 2 * r;
        unsigned eoff[2][8];
#pragma unroll
        for (int tok = 0; tok < 2; ++tok)
#pragma unroll
            for (int mt = 0; mt < 8; ++mt) eoff[tok][mt] = (unsigned)EH[(tk0 + tok) * EHS + mt * 16 + lr].x * 128u + 16u * lg;
        i32x4 acc[2][8];
#pragma unroll
        for (int tok = 0; tok < 2; ++tok)
#pragma unroll
            for (int mt = 0; mt < 8; ++mt) acc[tok][mt] = (i32x4){0, 0, 0, 0};
        auto uload = [&](int c, int tok, int mh, i32x4 (&a)[4][2]) {
            const unsigned char* Uc = U8 + (size_t)c * (16384 * 128);
#pragma unroll
            for (int m4 = 0; m4 < 4; ++m4) { const unsigned char* base = Uc + eoff[tok][mh * 4 + m4]; a[m4][0] = *(const i32x4*)base; a[m4][1] = *(const i32x4*)(base + 64); }
        };
        auto ucomp = [&](int c, int tok, int mh, i32x4 (&a)[4][2]) {
            const unsigned char* xr = X8 + (tk0 + tok) * 1024 + c * 128 + 16 * lg;
            const i32x4 xb0 = *(const i32x4*)xr, xb1 = *(const i32x4*)(xr + 64);
#pragma unroll
            for (int m4 = 0; m4 < 4; ++m4) {
                acc[tok][mh * 4 + m4] = __builtin_amdgcn_mfma_i32_16x16x64_i8(a[m4][0], xb0, acc[tok][mh * 4 + m4], 0, 0, 0);
                acc[tok][mh * 4 + m4] = __builtin_amdgcn_mfma_i32_16x16x64_i8(a[m4][1], xb1, acc[tok][mh * 4 + m4], 0, 0, 0);
            }
        };
        i32x4 A[4][2], B[4][2];
        uload(0, 0, 0, A);
#pragma unroll 1
        for (int c = 0; c < 8; ++c) {
            uload(c, 0, 1, B); ucomp(c, 0, 0, A);
            uload(c, 1, 0, A); ucomp(c, 0, 1, B);
            uload(c, 1, 1, B); ucomp(c, 1, 0, A);
            if (c < 7) uload(c + 1, 0, 0, A);
            ucomp(c, 1, 1, B);
        }
        if (lr == 0) {
#pragma unroll
            for (int tok = 0; tok < 2; ++tok)
#pragma unroll
                for (int mt = 0; mt < 8; ++mt)
#pragma unroll
                    for (int q = 0; q < 4; ++q) EH[(tk0 + tok) * EHS + mt * 16 + 4 * lg + q].y = acc[tok][mt][q];
        }
    }
#pragma unroll 1
    for (int i = 0; i < 8; ++i) {
        const int t = t0 + i, tk = w * 8 + i;
        const float sxi = TOK[tk * 2];
#pragma unroll
        for (int hf = 0; hf < 2; ++hf) {
            const int pi = hf * 64 + lane;
            const int2 eh = EH[tk * EHS + pi];
            const float z = (float)eh.y * SUi[eh.x] * sxi;
            const float hp = p.G[(size_t)t * 128 + pi] * gelu_exact(z) * SVi[eh.x];
            EH[tk * EHS + pi].y = __float_as_int(hp);
        }
    }
    const int gq = lane >> 3, li = lane & 7, tk = w * 8 + gq, t = t0 + gq;
    float s1 = 0.f, s2 = 0.f;
    auto vload = [&](int c, int p0, float (&hh)[4], u32x4 (&vv)[4]) {
        const unsigned char* Vc = V8 + (size_t)c * (16384 * 128);
#pragma unroll
        for (int j = 0; j < 4; ++j) { const int2 eh = EH[tk * EHS + p0 + j]; hh[j] = __int_as_float(eh.y); vv[j] = *(const u32x4*)(Vc + ((unsigned)eh.x * 128u + 16u * li)); }
    };
    auto vcomp = [&](float (&hh)[4], u32x4 (&vv)[4], f32x2 (&acc)[8]) {
#pragma unroll
        for (int j = 0; j < 4; ++j) {
            const f32x2 h2 = {hh[j], hh[j]};
#pragma unroll
            for (int q = 0; q < 4; ++q) {
                const f32x2 a = __builtin_amdgcn_cvt_pk_f32_fp8((int)vv[j][q], false), b = __builtin_amdgcn_cvt_pk_f32_fp8((int)vv[j][q], true);
                acc[2 * q] = h2 * a + acc[2 * q]; acc[2 * q + 1] = h2 * b + acc[2 * q + 1];
            }
        }
    };
    float ehA[4], ehB[4]; u32x4 vvA[4], vvB[4];
    vload(0, 0, ehA, vvA);
#pragma unroll 1
    for (int c = 0; c < 8; ++c) {
        f32x2 acc[8];
#pragma unroll
        for (int k = 0; k < 8; ++k) acc[k] = (f32x2){0.f, 0.f};
#pragma unroll 1
        for (int p0 = 0; p0 < 128; p0 += 8) {
            vload(c, p0 + 4, ehB, vvB);
            vcomp(ehA, vvA, acc);
            if (p0 + 8 < 128) vload(c, p0 + 8, ehA, vvA); else if (c < 7) vload(c + 1, 0, ehA, vvA);
            vcomp(ehB, vvB, acc);
        }
        const int col = c * 128 + li * 16;
#pragma unroll
        for (int k4 = 0; k4 < 4; ++k4) {
            const f32x4 x = *(const f32x4*)(p.XF + (size_t)t * DM + col + 4 * k4);
            f32x4 y;
#pragma unroll
            for (int k = 0; k < 4; ++k) { y[k] = DN_ALPHA * x[k] + acc[2 * k4 + (k >> 1)][k & 1]; s1 += y[k]; s2 += y[k] * y[k]; }
            *(f32x4*)(p.T + (size_t)t * DM + col + 4 * k4) = y;
        }
    }
#pragma unroll
    for (int o = 1; o <= 4; o <<= 1) { s1 += __shfl_xor(s1, o, 64); s2 += __shfl_xor(s2, o, 64); }
    const float mu = s1 * (1.f / 1024.f);
    const float rs = rsqrtf(fmaxf(s2 * (1.f / 1024.f) - mu * mu, 0.f) + LN_EPS);
#pragma unroll 1
    for (int c = 0; c < 8; ++c) {
        const int col = c * 128 + li * 16;
#pragma unroll
        for (int k4 = 0; k4 < 4; ++k4) {
            const f32x4 y = *(const f32x4*)(p.T + (size_t)t * DM + col + 4 * k4);
            const f32x4 gg = *(const f32x4*)(lng + col + 4 * k4), be = *(const f32x4*)(lnb + col + 4 * k4);
            f32x4 o;
#pragma unroll
            for (int k = 0; k < 4; ++k) o[k] = (y[k] - mu) * rs * gg[k] + be[k];
            if (final_out) *(f32x4*)(p.y_prompt + (size_t)t * DM + col + 4 * k4) = o;
            else { *(f32x4*)(p.XF + (size_t)t * DM + col + 4 * k4) = o; store_bf4(p.XB + (size_t)t * DM + col + 4 * k4, o); }
        }
    }
}

DI void peer_sample(const Params& p, int layer, int sidx, char* lds, bool final_out) {
    const int tid = TIDX, lane = tid & 63, w = tid >> 6, lr = lane & 15, lg = lane >> 4;
    unsigned char* X8 = (unsigned char*)lds; int2* EH = (int2*)(lds + 1024); float* Z = (float*)(lds + 1024 + 1024); float* Y = Z + 128; float* PART = Y + 1024;
    const unsigned char* U8 = p.U8 + (size_t)layer * 16384 * DM; const unsigned char* V8 = p.V8 + (size_t)layer * 16384 * DM;
    const float* SUi = p.SU + layer * 16384; const float* SVi = p.SV + layer * 16384;
    const float* lng = p.ln_g + (layer * 2 + 1) * DM; const float* lnb = p.ln_b + (layer * 2 + 1) * DM;
    const int t = TP + sidx;
    __syncthreads();
    if (w == 0) {
        f32x4 v[4]; float am = 0.f;
#pragma unroll
        for (int k = 0; k < 4; ++k) { v[k] = *(const f32x4*)(p.XF + (size_t)t * DM + 4 * lane + 256 * k); am = fmaxf(am, fmaxf(fmaxf(fabsf(v[k][0]), fabsf(v[k][1])), fmaxf(fabsf(v[k][2]), fabsf(v[k][3])))); }
        am = wave_max(am);
        const float sc = am > 0.f ? 127.f / am : 0.f;
#pragma unroll
        for (int k = 0; k < 4; ++k) {
            unsigned pk = 0;
#pragma unroll
            for (int q = 0; q < 4; ++q) { const int qi = (int)rintf(v[k][q] * sc); pk |= ((unsigned)qi & 0xffu) << (8 * q); }
            *(unsigned*)(X8 + 4 * lane + 256 * k) = pk;
        }
        if (lane == 0) PART[24] = am * (1.f / 127.f);
    }
    __syncthreads();
    {
        const int e = p.E[(size_t)t * 128 + w * 16 + lr];
        i32x4 acc = {0, 0, 0, 0};
#pragma unroll
        for (int ch = 0; ch < 16; ++ch) {
            const i32x4 a = *(const i32x4*)(U8 + (size_t)(ch >> 1) * (16384 * 128) + (size_t)e * 128 + (ch & 1) * 64 + 16 * lg);
            const i32x4 xb = *(const i32x4*)(X8 + ch * 64 + 16 * lg);
            acc = __builtin_amdgcn_mfma_i32_16x16x64_i8(a, xb, acc, 0, 0, 0);
        }
        if (lr == 0) {
#pragma unroll
            for (int r = 0; r < 4; ++r) Z[w * 16 + 4 * lg + r] = (float)acc[r];
        }
        __builtin_amdgcn_s_waitcnt(0);
        __builtin_amdgcn_wave_barrier();
        float hp = 0.f;
        if (lane < 16) {
            const int pi = w * 16 + lane;
            const float z = Z[pi] * SUi[e] * PART[24];
            hp = p.G[(size_t)t * 128 + pi] * gelu_exact(z) * SVi[e];
            EH[pi] = make_int2(e, __float_as_int(hp));
        }
        hp = wave_sum(hp);
        if (lane == 0) PART[w] = hp;
    }
    __syncthreads();
    float sumh = 0.f;
#pragma unroll
    for (int i = 0; i < 8; ++i) sumh += PART[i];
    {
        const int c = w, pg = lane >> 3, li = lane & 7;
        float acc[16];
#pragma unroll
        for (int k = 0; k < 16; ++k) acc[k] = 0.f;
        const unsigned char* vb = V8 + (size_t)c * (16384 * 128) + li * 16;
        for (int p0 = 0; p0 < 16; p0 += 8) {
            int2 eh[8]; u32x4 vv[8];
#pragma unroll
            for (int j = 0; j < 8; ++j) eh[j] = EH[pg * 16 + p0 + j];
#pragma unroll
            for (int j = 0; j < 8; ++j) vv[j] = *(const u32x4*)(vb + (size_t)eh[j].x * 128);
#pragma unroll
            for (int j = 0; j < 8; ++j) { const float h = __int_as_float(eh[j].y);
#pragma unroll
                for (int q = 0; q < 4; ++q) { const f32x2 a = __builtin_amdgcn_cvt_pk_f32_fp8((int)vv[j][q], false), bq = __builtin_amdgcn_cvt_pk_f32_fp8((int)vv[j][q], true);
                    acc[4 * q] += h * a[0]; acc[4 * q + 1] += h * a[1]; acc[4 * q + 2] += h * bq[0]; acc[4 * q + 3] += h * bq[1]; } }
        }
#pragma unroll
        for (int k = 0; k < 16; ++k) { float a = acc[k]; a += __shfl_xor(a, 8, 64); a += __shfl_xor(a, 16, 64); a += __shfl_xor(a, 32, 64); acc[k] = a; }
        float s1 = 0.f, s2 = 0.f;
        if (pg == 0) {
            const int col = c * 128 + li * 16;
#pragma unroll
            for (int k = 0; k < 16; ++k) { const float y = DN_ALPHA * p.XF[(size_t)t * DM + col + k] + acc[k]; Y[col + k] = y; s1 += y; s2 += y * y; }
        }
        s1 = wave_sum(s1); s2 = wave_sum(s2);
        if (lane == 0) { PART[8 + w] = s1; PART[16 + w] = s2; }
    }
    __syncthreads();
    float s1 = 0.f, s2 = 0.f;
#pragma unroll
    for (int i = 0; i < 8; ++i) { s1 += PART[8 + i]; s2 += PART[16 + i]; }
    const float mu = s1 * (1.f / 1024.f);
    const float rs = rsqrtf(fmaxf(s2 * (1.f / 1024.f) - mu * mu, 0.f) + LN_EPS);
#pragma unroll
    for (int k = 0; k < 2; ++k) {
        const int col = tid + NT * k;
        const float o = (Y[col] - mu) * rs * lng[col] + lnb[col];
        if (final_out) p.y_sample[(size_t)sidx * DM + col] = o;
        else { p.XF[(size_t)t * DM + col] = o; p.XB[(size_t)t * DM + col] = f2bf(o); }
    }
    __syncthreads();
}

DI void peer_expert_phase(const Params& p, int layer, char* lds, int bid, int nb, bool final_out) {
    for (int tile = bid; tile < 256; tile += nb) peer_tile(p, layer, tile, lds, final_out);
    for (int sidx = bid; sidx < TS; sidx += nb) peer_sample(p, layer, sidx, lds, final_out);
}

DI void hgrn_cumsum(const Params& p, size_t row0, int h, float* bs, float* tot) {
    const int tid = TIDX;
#pragma unroll
    for (int i = 0; i < 4; ++i) { int id = tid + NT * i; int s = id >> 5, c4 = id & 31; *(f32x4*)(bs + s * 128 + 4 * c4) = *(const f32x4*)(p.LF + (row0 + s) * DM + h * 128 + 4 * c4); }
    __syncthreads();
    const int k = tid & 127, seg = tid >> 7;
    float run = 0.f;
#pragma unroll
    for (int i = 0; i < 16; ++i) { run += bs[(seg * 16 + i) * 128 + k]; bs[(seg * 16 + i) * 128 + k] = run; }
    tot[seg * 128 + k] = run;
    __syncthreads();
    float off = 0.f;
#pragma unroll
    for (int s2 = 0; s2 < 3; ++s2) if (s2 < seg) off += tot[s2 * 128 + k];
    if (seg > 0) {
#pragma unroll
        for (int i = 0; i < 16; ++i) bs[(seg * 16 + i) * 128 + k] += off;
    }
    __syncthreads();
}
constexpr int HG_TS = 72;
constexpr int HG_FS = 136;
DI void hgrn_b1_unit(const Params& p, int u, char* lds) {
    float* bs = (float*)lds;
    float* tot = (float*)(lds + 32768);
    bf16_t* KT = (bf16_t*)(lds + 36864);
    bf16_t* IT = (bf16_t*)(lds + 36864 + 18432);
    const int tid = TIDX, lane = tid & 63, w = tid >> 6, lr = lane & 15, lg = lane >> 4;
    const int bh = u >> 7, c = u & 127, b = bh >> 3, h = bh & 7;
    const size_t row0 = (size_t)b * SEQ + c * 64;
    hgrn_cumsum(p, row0, h, bs, tot);
    const bf16_t* KK = p.H + (size_t)MP * DM; const bf16_t* I1 = p.H + (size_t)2 * MP * DM;
    {
        const int s = tid >> 3, kc = (tid & 7) * 16;
        const bf16_t* kr = KK + (row0 + s) * DM + h * 128 + kc; const bf16_t* ir = I1 + (row0 + s) * DM + h * 128 + kc;
        u32x4 ka = *(const u32x4*)kr, kb = *(const u32x4*)(kr + 8), ia = *(const u32x4*)ir, ib = *(const u32x4*)(ir + 8);
#pragma unroll
        for (int i = 0; i < 16; ++i) {
            const unsigned kw = (i < 8) ? ka[(i & 7) >> 1] : kb[(i & 7) >> 1]; const unsigned iw = (i < 8) ? ia[(i & 7) >> 1] : ib[(i & 7) >> 1];
            const float kv = (i & 1) ? bfhi(kw) : bflo(kw);
            const float e = __expf(fminf(-bs[s * 128 + kc + i], 80.f));
            KT[(kc + i) * HG_TS + s] = f2bf(kv * e);
            IT[(kc + i) * HG_TS + s] = (bf16_t)((i & 1) ? (iw >> 16) : (iw & 0xffffu));
        }
    }
    __syncthreads();
    f32x4 acc[8];
#pragma unroll
    for (int j = 0; j < 8; ++j) acc[j] = (f32x4){0.f, 0.f, 0.f, 0.f};
#pragma unroll
    for (int ks = 0; ks < 2; ++ks) {
        const bf16x8 af = *(const bf16x8*)(KT + (w * 16 + lr) * HG_TS + ks * 32 + lg * 8);
#pragma unroll
        for (int j = 0; j < 8; ++j) { const bf16x8 bfr = *(const bf16x8*)(IT + (j * 16 + lr) * HG_TS + ks * 32 + lg * 8); acc[j] = MFMA16(af, bfr, acc[j]); }
    }
    f32x4 dl;
#pragma unroll
    for (int r = 0; r < 4; ++r) dl[r] = __expf(bs[63 * 128 + w * 16 + 4 * lg + r]);
#pragma unroll
    for (int j = 0; j < 8; ++j) *(f32x4*)(p.UT + ((size_t)u * 128 + j * 16 + lr) * 128 + w * 16 + 4 * lg) = acc[j] * dl;
    if (tid < 128) p.DEC[(size_t)u * 128 + tid] = __expf(bs[63 * 128 + tid]);
    __syncthreads();
}
DI void hgrn_b2(const Params& p, int bid, int nb) {
    for (int e = bid * NT + TIDX; e < 16 * 16384; e += nb * NT) {
        const int bh = e >> 14, vk = e & 16383, k = vk & 127, v = vk >> 7;
        float S = 0.f;
        for (int c0 = 0; c0 < 128; c0 += 8) {
            float uu[8], dd[8];
#pragma unroll
            for (int i = 0; i < 8; ++i) { const size_t un = (size_t)bh * 128 + c0 + i; uu[i] = p.UT[un * 16384 + vk]; dd[i] = p.DEC[un * 128 + k]; }
#pragma unroll
            for (int i = 0; i < 8; ++i) { const size_t un = (size_t)bh * 128 + c0 + i; p.ST[un * 16384 + vk] = f2bf(S); S = dd[i] * S + uu[i]; }
        }
        p.hgrn_prompt[((size_t)bh * 128 + k) * 128 + v] = S;
    }
}
DI void hgrn_b3_unit(const Params& p, int u, char* lds) {
    float* bs = (float*)lds;
    float* tot = (float*)(lds + 32768);
    bf16_t* QH = (bf16_t*)(lds + 36864);
    bf16_t* KH = (bf16_t*)(lds + 36864 + 17408);
    bf16_t* IT = (bf16_t*)(lds + 36864 + 34816);
    bf16_t* AT = (bf16_t*)(lds + 36864 + 34816 + 18432);
    const int tid = TIDX, lane = tid & 63, w = tid >> 6, lr = lane & 15, lg = lane >> 4;
    const int bh = u >> 7, c = u & 127, b = bh >> 3, h = bh & 7;
    const size_t row0 = (size_t)b * SEQ + c * 64;
    hgrn_cumsum(p, row0, h, bs, tot);
    const bf16_t* Q1 = p.H; const bf16_t* KK = p.H + (size_t)MP * DM; const bf16_t* I1 = p.H + (size_t)2 * MP * DM; const bf16_t* G1 = p.H + (size_t)3 * MP * DM;
    {
        const int s = tid >> 3, kc = (tid & 7) * 16;
        const bf16_t* qr = Q1 + (row0 + s) * DM + h * 128 + kc; const bf16_t* kr = KK + (row0 + s) * DM + h * 128 + kc; const bf16_t* ir = I1 + (row0 + s) * DM + h * 128 + kc;
        u32x4 qa = *(const u32x4*)qr, qb = *(const u32x4*)(qr + 8), ka = *(const u32x4*)kr, kb = *(const u32x4*)(kr + 8), ia = *(const u32x4*)ir, ib = *(const u32x4*)(ir + 8);
#pragma unroll
        for (int i = 0; i < 16; ++i) {
            const unsigned qw = (i < 8) ? qa[(i & 7) >> 1] : qb[(i & 7) >> 1]; const unsigned kw = (i < 8) ? ka[(i & 7) >> 1] : kb[(i & 7) >> 1]; const unsigned iw = (i < 8) ? ia[(i & 7) >> 1] : ib[(i & 7) >> 1];
            const float qv = (i & 1) ? bfhi(qw) : bflo(qw); const float kv = (i & 1) ? bfhi(kw) : bflo(kw);
            const float bb = bs[s * 128 + kc + i];
            QH[s * HG_FS + kc + i] = f2bf(qv * __expf(bb));
            KH[s * HG_FS + kc + i] = f2bf(kv * __expf(fminf(-bb, 80.f)));
            IT[(kc + i) * HG_TS + s] = (bf16_t)((i & 1) ? (iw >> 16) : (iw & 0xffffu));
        }
    }
    __syncthreads();
    {
        const int tt = w & 3;
#pragma unroll
        for (int si = 0; si < 2; ++si) {
            const int stile = (w >> 2) * 2 + si;
            f32x4 a = {0.f, 0.f, 0.f, 0.f};
            if (stile <= tt) {
#pragma unroll
                for (int ks = 0; ks < 4; ++ks) {
                    const bf16x8 af = *(const bf16x8*)(KH + (stile * 16 + lr) * HG_FS + ks * 32 + lg * 8);
                    const bf16x8 bfr = *(const bf16x8*)(QH + (tt * 16 + lr) * HG_FS + ks * 32 + lg * 8);
                    a = MFMA16(af, bfr, a);
                }
            }
            const int t = tt * 16 + lr;
#pragma unroll
            for (int r = 0; r < 4; ++r) { const int s = stile * 16 + 4 * lg + r; if (s > t) a[r] = 0.f; }
            store_bf4(AT + t * HG_TS + stile * 16 + 4 * lg, a);
        }
    }
    __syncthreads();
    const int tt = w & 3;
    f32x4 acc[4];
#pragma unroll
    for (int j = 0; j < 4; ++j) acc[j] = (f32x4){0.f, 0.f, 0.f, 0.f};
#pragma unroll
    for (int ks = 0; ks < 2; ++ks) {
        const bf16x8 bfr = *(const bf16x8*)(AT + (tt * 16 + lr) * HG_TS + ks * 32 + lg * 8);
#pragma unroll
        for (int j = 0; j < 4; ++j) { const int vt = (w >> 2) * 4 + j; const bf16x8 af = *(const bf16x8*)(IT + (vt * 16 + lr) * HG_TS + ks * 32 + lg * 8); acc[j] = MFMA16(af, bfr, acc[j]); }
    }
    const bf16_t* STu = p.ST + (size_t)u * 16384;
#pragma unroll
    for (int ks = 0; ks < 4; ++ks) {
        const bf16x8 bfr = *(const bf16x8*)(QH + (tt * 16 + lr) * HG_FS + ks * 32 + lg * 8);
#pragma unroll
        for (int j = 0; j < 4; ++j) { const int vt = (w >> 2) * 4 + j; const bf16x8 af = *(const bf16x8*)(STu + (vt * 16 + lr) * 128 + ks * 32 + lg * 8); acc[j] = MFMA16(af, bfr, acc[j]); }
    }
    float ss = 0.f;
#pragma unroll
    for (int j = 0; j < 4; ++j)
#pragma unroll
        for (int r = 0; r < 4; ++r) ss += acc[j][r] * acc[j][r];
    ss += __shfl_xor(ss, 16, 64); ss += __shfl_xor(ss, 32, 64);
    float* red = tot;
    if (lg == 0) red[(w >> 2) * 64 + tt * 16 + lr] = ss;
    __syncthreads();
    const float rs = rsqrtf((red[tt * 16 + lr] + red[64 + tt * 16 + lr]) * (1.f / 128.f) + RMS_EPS);
    const size_t row = row0 + tt * 16 + lr;
#pragma unroll
    for (int j = 0; j < 4; ++j) {
        const int col = h * 128 + ((w >> 2) * 4 + j) * 16 + 4 * lg;
        const u32x2 gw = *(const u32x2*)(G1 + row * DM + col);
        const f32x4 ng = *(const f32x4*)(p.hgrn_norm_g + col);
        f32x4 o;
        const float gg[4] = {bflo(gw[0]), bfhi(gw[0]), bflo(gw[1]), bfhi(gw[1])};
#pragma unroll
        for (int r = 0; r < 4; ++r) o[r] = acc[j][r] * rs * ng[r] * (gg[r] * sigmoidf_(gg[r]));
        store_bf4(p.MIX + row * DM + col, o);
    }
    __syncthreads();
}
DI void hgrn_sample_unit(const Params& p, int u, char* lds) {
    float* part = (float*)lds;
    float* red = part + 512;
    const int tid = TIDX, lane = tid & 63, w = tid >> 6;
    const int b = u >> 3, h = u & 7; const size_t row = (size_t)TP + b;
    const bf16_t* Q1 = p.H; const bf16_t* KK = p.H + (size_t)MP * DM; const bf16_t* I1 = p.H + (size_t)2 * MP * DM; const bf16_t* G1 = p.H + (size_t)3 * MP * DM;
    const int v = tid & 127, kq = tid >> 7;
    const float iv = bf2f(I1[row * DM + h * 128 + v]);
    float acc = 0.f;
    const float* S0 = p.state_hgrn + (size_t)u * 16384; float* S1 = p.hgrn_sample + (size_t)u * 16384;
#pragma unroll 8
    for (int kk = 0; kk < 32; ++kk) {
        const int k = kq * 32 + kk;
        const float f = __expf(p.LF[row * DM + h * 128 + k]);
        const float kv = bf2f(KK[row * DM + h * 128 + k]);
        const float q = bf2f(Q1[row * DM + h * 128 + k]);
        const float st = f * S0[k * 128 + v] + kv * iv;
        S1[k * 128 + v] = st; acc += q * st;
    }
    part[kq * 128 + v] = acc;
    __syncthreads();
    float o = 0.f, sq = 0.f;
    if (tid < 128) { o = part[tid] + part[128 + tid] + part[256 + tid] + part[384 + tid]; sq = o * o; }
    sq = wave_sum(sq); if (lane == 0) red[w] = sq;
    __syncthreads();
    if (tid < 128) {
        const float rs = rsqrtf((red[0] + red[1]) * (1.f / 128.f) + RMS_EPS);
        const float g = bf2f(G1[row * DM + h * 128 + tid]);
        p.MIX[row * DM + h * 128 + tid] = f2bf(o * rs * p.hgrn_norm_g[h * 128 + tid] * (g * sigmoidf_(g)));
    }
    __syncthreads();
}

constexpr int LDS_BAR = 135168;
constexpr int LDS_BYTES = LDS_BAR + 256;

template <int LAYER> DI void peer_phases(const Params& p, char* lds, int bid, int nb, const XcdBarrier& bar) {
    REPEAT(REP_GEMM) {
        EpiBf16 epi{p.QH, 2048};
        gemm_big(p.XB, p.WT_WQ + (size_t)LAYER * 2048 * 1024, 2048, epi, lds, bid, nb);
    }
    xcd_barrier(bar);
    REPEAT(REP_GEMM) {
        GemmArgs g{p.QH, 2048, p.KB + (size_t)LAYER * 2048 * 128, 128, 128, 1};
        EpiF32 epi{p.S, 2048};
        gemm_phase(g, MP, 2048, epi, lds, bid, nb);
    }
    xcd_barrier(bar);
    REPEAT(REP_TOPK) for (int u = bid; u < (TT + 31) / 32; u += nb) peer_topk_unit(p, u, lds);
    xcd_barrier(bar);
    REPEAT(LAYER == 1 ? REP_PEER1 : 1) peer_expert_phase(p, LAYER, lds, bid, nb, LAYER == 1);
}

__global__ void __launch_bounds__(NT, 2) mega(Params p) {
    extern __shared__ __attribute__((aligned(16))) char lds[];
    const int bid = blockIdx.x, nb = gridDim.x;
    if (TIDX == 0) *(uint4*)(lds + LDS_BAR) = make_uint4(0u, 0u, 0u, 0u);
    __syncthreads();
    XcdBarrier bar = xcd_barrier_post(p.bar, (volatile LAS unsigned*)(lds + LDS_BAR));
    REPEAT(REP_PRO) {
    for (int u = bid; u < 16 * 40; u += nb) transpose_unit(p.w_in_even, 1024, 2560, p.WT_IN_EVEN, u, lds);
    for (int u = bid; u < 16 * 16; u += nb) transpose_unit(p.w_out_even, 1024, 1024, p.WT_OUT_EVEN, u, lds);
    for (int u = bid; u < 16 * 64; u += nb) transpose_unit(p.w_in_odd, 1024, 4096, p.WT_IN_ODD, u, lds);
    for (int u = bid; u < 16 * 16; u += nb) transpose_unit(p.w_out_odd, 1024, 1024, p.WT_OUT_ODD, u, lds);
    for (int u = bid; u < 16 * 32; u += nb) transpose_unit(p.peer_wq, 1024, 2048, p.WT_WQ, u, lds);
    for (int u = bid; u < 16 * 32; u += nb) transpose_unit(p.peer_wq + (size_t)1024 * 2048, 1024, 2048, p.WT_WQ + (size_t)2048 * 1024, u, lds);
    convert_x(p, bid, nb);
    convert_keys(p, bid, nb);
    quant_rows<0>(p.peer_u, p.U8, p.SU, 2 * 16384, bid, nb);
    quant_rows_fp8(p.peer_v, p.V8, p.SV, 2 * 16384, bid, nb);
    for (int u = bid; u < 1024; u += nb) kmean_sample_unit(p, u);
    }
    xcd_barrier(bar);
    REPEAT(REP_GEMM) {
        EpiInEven epi{p.H, p.y_prompt, p.VT};
        gemm_big(p.XB, p.WT_IN_EVEN, 2560, epi, lds, bid, nb);
    }
    xcd_barrier(bar);
    REPEAT(REP_CONV) {
    for (int u = bid; u < 512; u += nb) kmean_prompt_unit(p, u);
    for (int u = bid; u < 544; u += nb) conv_unit(p, u, lds);
    }
    xcd_barrier(bar);
    REPEAT(REP_MOBAP) for (int u = bid; u < 512; u += nb) { const int bh = (u & 255) >> 4, i = u & 15; const int blk = (u < 256) ? i : 31 - i; moba_prompt_unit(p, bh, blk, lds); }
    REPEAT(REP_MOBAS) for (int u = bid; u < 256; u += nb) moba_sample_unit(p, u, lds);
    xcd_barrier(bar);
    REPEAT(REP_GEMM) {
        EpiResid epi{p.T, p.XF};
        gemm_big(p.MIX, p.WT_OUT_EVEN, 1024, epi, lds, bid, nb);
    }
    xcd_barrier(bar);
    ln_rows(p, p.ln_g, p.ln_b, bid, nb, false);
    xcd_barrier(bar);
    peer_phases<0>(p, lds, bid, nb, bar);
    xcd_barrier(bar);
    REPEAT(REP_GEMM) {
        EpiInOdd epi{p.H, p.LF, p.LB};
        gemm_big(p.XB, p.WT_IN_ODD, 4096, epi, lds, bid, nb);
    }
    xcd_barrier(bar);
    REPEAT(REP_HGRN) for (int u = bid; u < 2048 + 256; u += nb) { if (u < 2048) hgrn_b1_unit(p, u, lds); else hgrn_sample_unit(p, u - 2048, lds); }
    xcd_barrier(bar);
    REPEAT(REP_HGRN) hgrn_b2(p, bid, nb);
    xcd_barrier(bar);
    REPEAT(REP_HGRN) for (int u = bid; u < 2048; u += nb) hgrn_b3_unit(p, u, lds);
    xcd_barrier(bar);
    REPEAT(REP_GEMM) {
        EpiResid epi{p.T, p.XF};
        gemm_big(p.MIX, p.WT_OUT_ODD, 1024, epi, lds, bid, nb);
    }
    xcd_barrier(bar);
    ln_rows(p, p.ln_g + 2 * DM, p.ln_b + 2 * DM, bid, nb, false);
    xcd_barrier(bar);
    peer_phases<1>(p, lds, bid, nb, bar);
}

extern "C" void kernel_launch(void* const* d_in, const int* in_sizes, int n_in, void* d_out, int out_size, void* d_ws, size_t ws_size, hipStream_t stream) {
    Params p{};
    p.x_prompt = (const float*)d_in[0]; p.x_sample = (const float*)d_in[1]; p.cache_k = (const float*)d_in[2]; p.cache_v = (const float*)d_in[3];
    p.state_conv = (const float*)d_in[4]; p.state_hgrn = (const float*)d_in[5]; p.page_table = (const int*)d_in[6];
    p.w_in_even = (const float*)d_in[7]; p.conv_w = (const float*)d_in[8]; p.conv_b = (const float*)d_in[9]; p.conv_ln_g = (const float*)d_in[10]; p.conv_ln_b = (const float*)d_in[11];
    p.w_out_even = (const float*)d_in[12]; p.w_in_odd = (const float*)d_in[13]; p.lb_logits = (const float*)d_in[14]; p.hgrn_norm_g = (const float*)d_in[15]; p.w_out_odd = (const float*)d_in[16];
    p.ln_g = (const float*)d_in[17]; p.ln_b = (const float*)d_in[18]; p.peer_wq = (const float*)d_in[19]; p.peer_keys = (const float*)d_in[20]; p.peer_u = (const float*)d_in[21]; p.peer_v = (const float*)d_in[22];
    float* o = (float*)d_out;
    p.y_prompt = o; o += (size_t)TP * DM; p.y_sample = o; o += (size_t)TS * DM;
    p.k_prompt = o; o += (size_t)TP * 512; p.v_prompt = o; o += (size_t)TP * 512; p.k_sample = o; o += (size_t)TS * 512; p.v_sample = o; o += (size_t)TS * 512;
    p.conv_prompt = o; o += 2 * 30 * 512; p.conv_sample = o; o += 32 * 30 * 512; p.hgrn_prompt = o; o += 2 * 8 * 128 * 128; p.hgrn_sample = o;
    char* ws = (char*)d_ws; size_t off = 0;
    auto take = [&](size_t bytes) { char* r = ws + off; off += (bytes + 255) & ~(size_t)255; return r; };
    p.bar = (unsigned*)take(16384); p.LB = (float*)take(4096);
    p.WT_IN_EVEN = (bf16_t*)take((size_t)2560 * 1024 * 2); p.WT_OUT_EVEN = (bf16_t*)take((size_t)1024 * 1024 * 2);
    p.WT_IN_ODD = (bf16_t*)take((size_t)4096 * 1024 * 2); p.WT_OUT_ODD = (bf16_t*)take((size_t)1024 * 1024 * 2);
    p.WT_WQ = (bf16_t*)take((size_t)2 * 2048 * 1024 * 2); p.KB = (bf16_t*)take((size_t)2 * 2048 * 128 * 2);
    p.U8 = (unsigned char*)take((size_t)2 * 16384 * DM); p.V8 = (unsigned char*)take((size_t)2 * 16384 * DM); p.SU = (float*)take(2 * 16384 * 4); p.SV = (float*)take(2 * 16384 * 4);
    p.XB = (bf16_t*)take((size_t)MP * DM * 2); p.XF = (float*)take((size_t)MP * DM * 4);
    p.H = (bf16_t*)take((size_t)MP * 4096 * 2); p.LF = (float*)take((size_t)MP * DM * 4);
    p.VT = (bf16_t*)take((size_t)16 * 64 * 8192 * 2); p.KMPP = (float*)take((size_t)512 * 512 * 4); p.KMS = (bf16_t*)take((size_t)1024 * 512 * 2);
    p.MIX = (bf16_t*)take((size_t)MP * DM * 2); p.T = (float*)take((size_t)MP * DM * 4);
    p.QH = (bf16_t*)take((size_t)MP * 2048 * 2); p.S = (float*)take((size_t)MP * 2048 * 4);
    p.E = (int*)take((size_t)MP * 128 * 4); p.G = (float*)take((size_t)MP * 128 * 4);
    p.UT = (float*)take((size_t)2048 * 16384 * 4); p.DEC = (float*)take((size_t)2048 * 128 * 4); p.ST = (bf16_t*)take((size_t)2048 * 16384 * 2);
    if (off > ws_size) { fprintf(stderr, "workspace too small: need %zu have %zu\n", off, ws_size); return; }

    static int grid = 0;
    if (!grid) {
        int dev = 0, cus = 0, per_cu = 0;
        (void)hipGetDevice(&dev);
        (void)hipDeviceGetAttribute(&cus, hipDeviceAttributeMultiprocessorCount, dev);
        (void)hipFuncSetAttribute((const void*)mega, hipFuncAttributeMaxDynamicSharedMemorySize, LDS_BYTES);
        (void)hipOccupancyMaxActiveBlocksPerMultiprocessor(&per_cu, (const void*)mega, NT, LDS_BYTES);
        grid = cus * (per_cu < 1 ? per_cu : 1);
        if (grid <= 0) { fprintf(stderr, "mega kernel not resident: cus %d per_cu %d\n", cus, per_cu); grid = 0; return; }
    }
    (void)hipMemsetAsync(p.bar, 0, XCD_BAR_WORDS * sizeof(unsigned), stream);
    hipLaunchKernelGGL(mega, dim3(grid), dim3(NT), LDS_BYTES, stream, p);
}
```

```cpp
#include <hip/hip_runtime.h>
#include <stdint.h>
#include <stdio.h>

#define DI __device__ __forceinline__
__device__ __forceinline__ int tid_opaque() { int t = threadIdx.x; asm volatile("" : "+v"(t)); return t; }
#define TIDX tid_opaque()
typedef unsigned short bf16_t;
typedef short bf16x8 __attribute__((ext_vector_type(8)));
typedef float f32x4 __attribute__((ext_vector_type(4)));
typedef unsigned u32x4 __attribute__((ext_vector_type(4)));
typedef unsigned u32x2 __attribute__((ext_vector_type(2)));
typedef int i32x4 __attribute__((ext_vector_type(4)));
typedef float f32x2 __attribute__((ext_vector_type(2)));

constexpr int NT = 512;
constexpr int TP = 16384, TS = 32, TT = TP + TS, MP = 16640, DM = 1024, SEQ = 8192;
constexpr float DN_ALPHA = 1.4142135623730951f;
constexpr float LN_EPS = 1e-5f, RMS_EPS = 1e-6f;
constexpr size_t OFF_KP = (size_t)TT * DM, OFF_VP = OFF_KP + (size_t)TP * 512, OFF_KS = OFF_VP + (size_t)TP * 512, OFF_VS = OFF_KS + (size_t)TS * 512;

DI float bf2f(bf16_t h) { return __uint_as_float(((unsigned)h) << 16); }
typedef __bf16 bf16x2_t __attribute__((ext_vector_type(2)));
DI unsigned pack_bf2(float lo, float hi) { bf16x2_t v; v[0] = (__bf16)lo; v[1] = (__bf16)hi; return __builtin_bit_cast(unsigned, v); }
DI bf16_t f2bf(float x) { return (bf16_t)(pack_bf2(x, 0.f) & 0xffffu); }
DI float bflo(unsigned u) { return __uint_as_float(u << 16); }
DI float bfhi(unsigned u) { return __uint_as_float(u & 0xffff0000u); }
DI float sigmoidf_(float x) { return 1.f / (1.f + __expf(-x)); }
DI float wave_sum(float v) {
#pragma unroll
    for (int o = 32; o >= 1; o >>= 1) v += __shfl_xor(v, o, 64);
    return v;
}
DI float wave_max(float v) {
#pragma unroll
    for (int o = 32; o >= 1; o >>= 1) v = fmaxf(v, __shfl_xor(v, o, 64));
    return v;
}

DI float red_max_16_32(float x) {
    u32x2 r = __builtin_amdgcn_permlane16_swap(__float_as_uint(x), __float_as_uint(x), false, false);
    x = fmaxf(__uint_as_float(r[0]), __uint_as_float(r[1]));
    r = __builtin_amdgcn_permlane32_swap(__float_as_uint(x), __float_as_uint(x), false, false);
    return fmaxf(__uint_as_float(r[0]), __uint_as_float(r[1]));
}
DI float red_sum_16_32(float x) {
    u32x2 r = __builtin_amdgcn_permlane16_swap(__float_as_uint(x), __float_as_uint(x), false, false);
    x = __uint_as_float(r[0]) + __uint_as_float(r[1]);
    r = __builtin_amdgcn_permlane32_swap(__float_as_uint(x), __float_as_uint(x), false, false);
    return __uint_as_float(r[0]) + __uint_as_float(r[1]);
}
#define MFMA16(a, b, c) __builtin_amdgcn_mfma_f32_16x16x32_bf16((a), (b), (c), 0, 0, 0)

#ifndef REP_PRO
#define REP_PRO 1
#endif
#ifndef REP_GEMM
#define REP_GEMM 1
#endif
#ifndef REP_CONV
#define REP_CONV 1
#endif
#ifndef REP_MOBAP
#define REP_MOBAP 1
#endif
#ifndef REP_MOBAS
#define REP_MOBAS 1
#endif
#ifndef REP_TOPK
#define REP_TOPK 1
#endif
#ifndef REP_PEER1
#define REP_PEER1 1
#endif
#ifndef REP_USW
#define REP_USW 1
#endif
#ifndef REP_VSW
#define REP_VSW 1
#endif
#ifndef REP_HGRN
#define REP_HGRN 1
#endif
#define REPEAT(N) _Pragma("unroll 1") for (int rep_ = 0; rep_ < (N); ++rep_)
struct Params {
    const float* x_prompt; const float* x_sample; const float* cache_k; const float* cache_v;
    const float* state_conv; const float* state_hgrn; const int* page_table;
    const float* w_in_even; const float* conv_w; const float* conv_b; const float* conv_ln_g; const float* conv_ln_b;
    const float* w_out_even; const float* w_in_odd; const float* lb_logits; const float* hgrn_norm_g; const float* w_out_odd;
    const float* ln_g; const float* ln_b; const float* peer_wq; const float* peer_keys; const float* peer_u; const float* peer_v;
    float* y_prompt; float* y_sample; float* k_prompt; float* v_prompt; float* k_sample; float* v_sample;
    float* conv_prompt; float* conv_sample; float* hgrn_prompt; float* hgrn_sample;
    unsigned* bar; float* LB;
    bf16_t* WT_IN_EVEN; bf16_t* WT_OUT_EVEN; bf16_t* WT_IN_ODD; bf16_t* WT_OUT_ODD; bf16_t* WT_WQ; bf16_t* KB;
    unsigned char* U8; unsigned char* V8; float* SU; float* SV;
    bf16_t* XB; float* XF; bf16_t* H; float* LF; bf16_t* VT; float* KMPP; bf16_t* KMS;
    bf16_t* MIX; float* T; bf16_t* QH; float* S; int* E; float* G;
    float* UT; float* DEC; bf16_t* ST;
};


#define XB_TMO      128
#define XB_XCNT(j)  (256  + 64 * (j))
#define XB_XSUB(j)  (1280 + 64 * (j))
#define XB_XGEN(j)  (2304 + 64 * (j))
#define XB_TOP      3328
#define XB_TOPGEN   3392
#define XCD_BAR_WORDS 3456
#define XB_SPIN_CAP (1u << 18)
#define LAS __attribute__((address_space(3)))
__device__ __forceinline__ unsigned xb_ld(unsigned* p)              { return __hip_atomic_load(p, __ATOMIC_RELAXED, __HIP_MEMORY_SCOPE_AGENT); }
__device__ __forceinline__ unsigned xb_add(unsigned* p, unsigned v) { return __hip_atomic_fetch_add(p, v, __ATOMIC_RELAXED, __HIP_MEMORY_SCOPE_AGENT); }
__device__ __forceinline__ unsigned xb_xcc_id() { return (unsigned)__builtin_amdgcn_s_getreg((3 << 11) | 20) & 0xFu; }
#define XB_SPIN(cond, bar) do { unsigned _sp = 0; while (cond) { __builtin_amdgcn_s_sleep(1); \
    if ((++_sp & 255u) == 0u) { if (xb_ld(&(bar)[XB_TMO])) break; if (_sp > XB_SPIN_CAP) { atomicAdd(&(bar)[XB_TMO], 1u); break; } } } } while (0)
struct XcdBarrier { unsigned* bar; unsigned x; volatile LAS unsigned* st; };
__device__ __forceinline__ XcdBarrier xcd_barrier_post(unsigned* bar, volatile LAS unsigned* st) {
    XcdBarrier b; b.bar = bar; b.x = xb_xcc_id(); b.st = st;
    if (threadIdx.x == 0) (void)xb_add(&bar[XB_XCNT(b.x)], 1u);
    return b;
}
__device__ __forceinline__ void xcd_barrier_complete(unsigned* bar, unsigned x, unsigned& nloc, unsigned& nx) {
    const unsigned G = gridDim.x * gridDim.y * gridDim.z;
    unsigned sum, cnt, mine, sp = 0u;
    for (;;) {
        sum = 0u; cnt = 0u; mine = 0u;
#pragma unroll
        for (unsigned j = 0; j < 16; ++j) { const unsigned c = xb_ld(&bar[XB_XCNT(j)]); sum += c; cnt += (c > 0u) ? 1u : 0u; mine = (j == x) ? c : mine; }
        if (sum == G) break;
        __builtin_amdgcn_s_sleep(1);
        if ((++sp & 255u) == 0u) { if (xb_ld(&bar[XB_TMO])) break; if (sp > XB_SPIN_CAP) { atomicAdd(&bar[XB_TMO], 1u); break; } }
    }
    nloc = mine > 0u ? mine : 1u; nx = cnt > 0u ? cnt : 1u;
}
__device__ __forceinline__ void xcd_barrier(const XcdBarrier& b) {
    asm volatile("s_waitcnt vmcnt(0)" ::: "memory");
    __syncthreads();
    if (threadIdx.x == 0) {
        unsigned* bar = b.bar;
        __builtin_amdgcn_s_waitcnt(0);
        unsigned nloc = b.st[0], nx = b.st[1];
        if (nloc == 0u) { xcd_barrier_complete(bar, b.x, nloc, nx); b.st[0] = nloc; b.st[1] = nx; }
        const unsigned old = xb_add(&bar[XB_XSUB(b.x)], 1u);
        const unsigned gen = old / nloc;
        if (old + 1u == (gen + 1u) * nloc) {
            __builtin_amdgcn_fence(__ATOMIC_RELEASE, "agent");
            asm volatile("s_waitcnt vmcnt(0)" ::: "memory");
            const unsigned og = xb_add(&bar[XB_TOP], 1u);
            const unsigned tg = og / nx;
            if (og + 1u == (tg + 1u) * nx) xb_add(&bar[XB_TOPGEN], 1u);
            else XB_SPIN(xb_ld(&bar[XB_TOPGEN]) == tg, bar);
            __builtin_amdgcn_fence(__ATOMIC_ACQUIRE, "agent");
            xb_add(&bar[XB_XGEN(b.x)], 1u);
            asm volatile("s_waitcnt vmcnt(0)" ::: "memory");
        } else {
            XB_SPIN(xb_ld(&bar[XB_XGEN(b.x)]) == gen, bar);
            __builtin_amdgcn_fence(__ATOMIC_ACQUIRE, "agent");
            asm volatile("s_waitcnt vmcnt(0)" ::: "memory");
        }
    }
    __syncthreads();
}

DI void transpose_unit(const float* __restrict__ W, int K, int N, bf16_t* __restrict__ Wt, int u, char* lds) {
    float* tile = (float*)lds;
    const int tid = TIDX;
    const int ntn = N >> 6; const int kt = u / ntn, nt = u % ntn;
#pragma unroll
    for (int i = 0; i < 8; ++i) { int idx = tid + NT * i; int r = idx >> 6, c = idx & 63; tile[r * 65 + c] = W[(size_t)(kt * 64 + r) * N + nt * 64 + c]; }
    __syncthreads();
#pragma unroll
    for (int i = 0; i < 8; ++i) { int idx = tid + NT * i; int r = idx >> 6, c = idx & 63; Wt[(size_t)(nt * 64 + r) * K + kt * 64 + c] = f2bf(tile[c * 65 + r]); }
    __syncthreads();
}
DI void convert_range(const float* __restrict__ src, bf16_t* __restrict__ dst, size_t n4, int bid, int nb) {
    for (size_t i = (size_t)bid * NT + TIDX; i < n4; i += (size_t)nb * NT) {
        f32x4 v = *(const f32x4*)(src + 4 * i);
        u32x2 o; o[0] = pack_bf2(v[0], v[1]); o[1] = pack_bf2(v[2], v[3]);
        *(u32x2*)(dst + 4 * i) = o;
    }
}

template <int OFFS> DI void quant_rows(const float* __restrict__ src, unsigned char* __restrict__ dst, float* __restrict__ inv, int R, int bid, int nb) {
    const int lane = TIDX & 63, w = TIDX >> 6;
    for (int row = bid * 8 + w; row < R; row += nb * 8) {
        f32x4 v[4]; float am = 0.f;
#pragma unroll
        for (int i = 0; i < 4; ++i) { v[i] = *(const f32x4*)(src + (size_t)row * DM + 4 * lane + 256 * i); am = fmaxf(am, fmaxf(fmaxf(fabsf(v[i][0]), fabsf(v[i][1])), fmaxf(fabsf(v[i][2]), fabsf(v[i][3])))); }
        am = wave_max(am);
        const float sc = am > 0.f ? 127.f / am : 0.f;
#pragma unroll
        for (int i = 0; i < 4; ++i) {
            unsigned pk = 0;
#pragma unroll
            for (int k = 0; k < 4; ++k) { const int q = (int)rintf(v[i][k] * sc) + OFFS; pk |= ((unsigned)q & 0xffu) << (8 * k); }
            const int col = 4 * lane + 256 * i;
            *(unsigned*)(dst + (size_t)(row >> 14) * 16384 * DM + (size_t)(col >> 7) * (16384 * 128) + (size_t)(row & 16383) * 128 + (col & 127)) = pk;
        }
        if (lane == 0) inv[row] = am * (1.f / 127.f);
    }
}
DI void quant_rows_fp8(const float* __restrict__ src, unsigned char* __restrict__ dst, float* __restrict__ inv, int R, int bid, int nb) {
    const int lane = TIDX & 63, w = TIDX >> 6;
    for (int row = bid * 8 + w; row < R; row += nb * 8) {
        f32x4 v[4]; float am = 0.f;
#pragma unroll
        for (int i = 0; i < 4; ++i) { v[i] = *(const f32x4*)(src + (size_t)row * DM + 4 * lane + 256 * i); am = fmaxf(am, fmaxf(fmaxf(fabsf(v[i][0]), fabsf(v[i][1])), fmaxf(fabsf(v[i][2]), fabsf(v[i][3])))); }
        am = wave_max(am);
        const float sc = am > 0.f ? 416.f / am : 0.f;
#pragma unroll
        for (int i = 0; i < 4; ++i) {
            int pk = 0;
            pk = __builtin_amdgcn_cvt_pk_fp8_f32(v[i][0] * sc, v[i][1] * sc, pk, false);
            pk = __builtin_amdgcn_cvt_pk_fp8_f32(v[i][2] * sc, v[i][3] * sc, pk, true);
            const int col = 4 * lane + 256 * i;
            *(int*)(dst + (size_t)(row >> 14) * 16384 * DM + (size_t)(col >> 7) * (16384 * 128) + (size_t)(row & 16383) * 128 + (col & 127)) = pk;
        }
        if (lane == 0) inv[row] = am * (1.f / 416.f);
    }
}
DI void convert_x(const Params& p, int bid, int nb) {
    const size_t n4 = (size_t)MP * DM / 4;
    for (size_t i = (size_t)bid * NT + TIDX; i < n4; i += (size_t)nb * NT) {
        size_t e = 4 * i; int row = (int)(e >> 10); int col = (int)(e & 1023);
        f32x4 v = {0.f, 0.f, 0.f, 0.f};
        if (row < TP) v = *(const f32x4*)(p.x_prompt + e);
        else if (row < TT) v = *(const f32x4*)(p.x_sample + (size_t)(row - TP) * DM + col);
        *(f32x4*)(p.XF + e) = v;
        u32x2 o; o[0] = pack_bf2(v[0], v[1]); o[1] = pack_bf2(v[2], v[3]);
        *(u32x2*)(p.XB + e) = o;
    }
}
DI void convert_keys(const Params& p, int bid, int nb) {
    const int n = 2 * 2 * 8 * 128 * 128;
    for (int i = bid * NT + TIDX; i < n; i += nb * NT) {
        int d = i & 127, nn = (i >> 7) & 127, j = (i >> 14) & 15, l = i >> 18;
        int h = j >> 1, half = j & 1;
        p.KB[i] = f2bf(p.peer_keys[((((size_t)l * 2 + half) * 8 + h) * 128 + nn) * 128 + d]);
    }
    if (bid == 0) for (int c = TIDX; c < 1024; c += NT) p.LB[c] = sigmoidf_(p.lb_logits[1024 + c] - p.lb_logits[c]);
}
DI void kmean_sample_unit(const Params& p, int u) {
    const int b = u >> 5, blk = u & 31, c = TIDX;
    float acc = 0.f;
#pragma unroll
    for (int pg = 0; pg < 2; ++pg) {
        const int page = p.page_table[b * 64 + blk * 2 + pg];
        const float* src = p.cache_k + (size_t)page * 128 * 512 + c;
#pragma unroll 16
        for (int r = 0; r < 128; ++r) acc += src[(size_t)r * 512];
    }
    p.KMS[(size_t)u * 512 + c] = f2bf(acc * (1.f / 256.f));
}
DI void kmean_prompt_unit(const Params& p, int u) {
    const int c = TIDX;
    const float* src = p.k_prompt + (size_t)u * 32 * 512 + c;
    float acc = 0.f;
#pragma unroll
    for (int r = 0; r < 32; ++r) acc += src[(size_t)r * 512];
    p.KMPP[(size_t)u * 512 + c] = acc;
}

struct GemmArgs { const bf16_t* A; int lda; const bf16_t* Bt; int ldb; int K; int blockdiag; };
constexpr int GEMM_LDS = 2 * 49152;

template <class Epi>
DI void gemm_unit(const GemmArgs g, int m0, int n0, const Epi epi, char* lds) {
    const int tid = TIDX, lane = tid & 63, w = tid >> 6;
    const int wm = w & 3, wn = w >> 2, lr = lane & 15, lg = lane >> 4;
    const int acol = g.blockdiag ? n0 : 0;
    const int nk = g.K >> 6;
    f32x4 acc[4][4];
#pragma unroll
    for (int i = 0; i < 4; ++i)
#pragma unroll
        for (int j = 0; j < 4; ++j) acc[i][j] = (f32x4){0.f, 0.f, 0.f, 0.f};
    u32x4 ra[4], rb[2];
    auto gload = [&](int kt) {
#pragma unroll
        for (int i = 0; i < 4; ++i) { int id = tid + NT * i; int r = id >> 3, c = id & 7; ra[i] = *(const u32x4*)(g.A + (size_t)(m0 + r) * g.lda + acol + kt * 64 + c * 8); }
#pragma unroll
        for (int i = 0; i < 2; ++i) { int id = tid + NT * i; int r = id >> 3, c = id & 7; rb[i] = *(const u32x4*)(g.Bt + (size_t)(n0 + r) * g.ldb + kt * 64 + c * 8); }
    };
    auto sstore = [&](int st) {
        char* base = lds + st * 49152;
#pragma unroll
        for (int i = 0; i < 4; ++i) { int id = tid + NT * i; int r = id >> 3, c = id & 7; *(u32x4*)(base + r * 128 + ((c ^ (r & 7)) << 4)) = ra[i]; }
#pragma unroll
        for (int i = 0; i < 2; ++i) { int id = tid + NT * i; int r = id >> 3, c = id & 7; *(u32x4*)(base + 32768 + r * 128 + ((c ^ (r & 7)) << 4)) = rb[i]; }
    };
    gload(0); sstore(0); __syncthreads();
    for (int kt = 0; kt < nk; ++kt) {
        if (kt + 1 < nk) gload(kt + 1);
        const char* base = lds + (kt & 1) * 49152;
#pragma unroll
        for (int ks = 0; ks < 2; ++ks) {
            bf16x8 af[4], bfr[4];
#pragma unroll
            for (int i = 0; i < 4; ++i) { int r = wm * 64 + i * 16 + lr; int ch = ks * 4 + lg; af[i] = *(const bf16x8*)(base + r * 128 + ((ch ^ (r & 7)) << 4)); }
#pragma unroll
            for (int i = 0; i < 4; ++i) { int r = wn * 64 + i * 16 + lr; int ch = ks * 4 + lg; bfr[i] = *(const bf16x8*)(base + 32768 + r * 128 + ((ch ^ (r & 7)) << 4)); }
#pragma unroll
            for (int i = 0; i < 4; ++i)
#pragma unroll
                for (int j = 0; j < 4; ++j) acc[i][j] = MFMA16(bfr[j], af[i], acc[i][j]);
        }
        if (kt + 1 < nk) sstore((kt + 1) & 1);
        __syncthreads();
    }
#pragma unroll
    for (int i = 0; i < 4; ++i)
#pragma unroll
        for (int j = 0; j < 4; ++j) epi(m0 + wm * 64 + i * 16 + lr, n0 + wn * 64 + j * 16 + 4 * lg, acc[i][j]);
}

template <class Epi>
DI void gemm_phase(const GemmArgs g, int M, int N, const Epi epi, char* lds, int bid, int nb) {
    const int tn = N >> 7, tm = M >> 8;
    for (int u = bid; u < tm * tn; u += nb) { int mt = u / tn, nt = u % tn; gemm_unit(g, mt * 256, nt * 128, epi, lds); }
}

DI void store_bf4(bf16_t* dst, f32x4 v) { u32x2 o; o[0] = pack_bf2(v[0], v[1]); o[1] = pack_bf2(v[2], v[3]); *(u32x2*)dst = o; }

struct EpiInEven {
    bf16_t* H; float* out; bf16_t* VT;
    DI void operator()(int row, int col, f32x4 v) const {
        store_bf4(H + (size_t)row * 2560 + col, v);
        if (col >= 512 && col < 1536 && row < TT) {
            const bool isv = col >= 1024; const int c = col - (isv ? 1024 : 512);
            const size_t off = row < TP ? (isv ? OFF_VP : OFF_KP) + (size_t)row * 512 + c : (isv ? OFF_VS : OFF_KS) + (size_t)(row - TP) * 512 + c;
            *(f32x4*)(out + off) = v;
            if (isv && row < TP) {
                const int b = row >> 13, s = row & 8191, h = c >> 6, d = c & 63;
                bf16_t* vt = VT + ((size_t)(b * 8 + h) * 64 + d) * 8192 + s;
#pragma unroll
                for (int i = 0; i < 4; ++i) vt[(size_t)i * 8192] = f2bf(v[i]);
            }
        }
    }
};
struct EpiBf16 { bf16_t* O; int ld; DI void operator()(int row, int col, f32x4 v) const { store_bf4(O + (size_t)row * ld + col, v); } };
struct EpiF32 { float* O; int ld; DI void operator()(int row, int col, f32x4 v) const { *(f32x4*)(O + (size_t)row * ld + col) = v; } };
struct EpiResid {
    float* T; const float* XF;
    DI void operator()(int row, int col, f32x4 v) const { f32x4 x = *(const f32x4*)(XF + (size_t)row * DM + col); *(f32x4*)(T + (size_t)row * DM + col) = x * DN_ALPHA + v; }
};
struct EpiInOdd {
    bf16_t* H; float* LF; const float* LB;
    DI void operator()(int row, int col, f32x4 v) const {
        const int sec = col >> 10, c = col & 1023;
        if (sec == 1) {
            f32x4 lb = *(const f32x4*)(LB + c); f32x4 lf, kk;
#pragma unroll
            for (int i = 0; i < 4; ++i) { float f = lb[i] + (1.f - lb[i]) * sigmoidf_(v[i]); lf[i] = __logf(f); kk[i] = 1.f - f; }
            *(f32x4*)(LF + (size_t)row * DM + c) = lf;
            store_bf4(H + (size_t)MP * DM + (size_t)row * DM + c, kk);
        } else {
            store_bf4(H + (size_t)sec * MP * DM + (size_t)row * DM + c, v);
        }
    }
};

namespace pg8 {
#define PG8_LAS __attribute__((address_space(3)))
typedef unsigned short bf16_t;
typedef short bf16x8 __attribute__((ext_vector_type(8)));
typedef float f32x4 __attribute__((ext_vector_type(4)));
typedef unsigned u32x4 __attribute__((ext_vector_type(4)));
constexpr int BM = 256, BK = 64, HALF = 128, HTB = HALF * BK * 2  , STAGE_BYTES = 8 * HTB, NXCD = 8, WGM = 8;

__host__ __device__ __forceinline__ int lds_byte(int r, int c) { const int st = (r >> 4) * 2 + (c >> 5), rr = r & 15, cc = c & 31, ob = rr * 64 + cc * 2; return st * 1024 + (ob ^ (((ob >> 9) & 1) << 5)); }
__host__ __device__ __forceinline__ void stage_rc(int b, int& R, int& C) { const int st = b / 1024, sb = b % 1024, swz = sb ^ (((sb >> 9) & 1) << 5); R = (st >> 1) * 16 + swz / 64; C = (st & 1) * 32 + (swz % 64) / 2; }
__host__ __device__ __forceinline__ int perm32(int rho) { const int n = rho >> 4, i = rho & 15; return 8 * (i >> 2) + 4 * n + (i & 3); }

struct Unit { int pm, pn; };
struct Gemm { const bf16_t* A; const bf16_t* Bt; int M, N, K; };

struct StaticOrder {
    int nM, nN, nwg, G, c;
    __host__ __device__ void init(int M, int N, int G_, int c_) { nM = M / BM; nN = N / BM; nwg = nM * nN; G = G_; c = c_; }
    __host__ __device__ bool next(int i, Unit& u) const {
        const long L = (long)i * G + c; if (L >= nwg) return false;
        int wgid = (int)L; { const int q = nwg / NXCD, r = nwg % NXCD, xcd = wgid % NXCD, off = wgid / NXCD; wgid = (xcd < r ? xcd * (q + 1) : r * (q + 1) + (xcd - r) * q) + off; }
        const int nig = WGM * nN, gid = wgid / nig, fm = gid * WGM, gsz = (nM - fm) < WGM ? (nM - fm) : WGM;
        u.pm = fm + ((wgid % nig) % gsz); u.pn = (wgid % nig) / gsz; return true;
    }
    __device__ __forceinline__ void a_ready(const Unit&) const {}
    __device__ __forceinline__ void done(const Unit&) const {}
};

template <class Epi, class Sched, bool STAMP = false>
__device__ __forceinline__ void gemm_phase(PG8_LAS unsigned char* lds, const Gemm g, const Sched& S, const Epi& E, unsigned long long* stamps) {
    const int tid = TIDX, wid = __builtin_amdgcn_readfirstlane(tid >> 6), lane = tid & 63, wr = wid >> 2, wc = wid & 3, fr = lane & 15, fq = lane >> 4;
    const int K = g.K, nt = K / BK;
    int ts_lo = 0, ts_hi = 0, nts = 0; const unsigned long long rt_entry = STAMP ? (unsigned long long)wall_clock64() : 0ull;
#define PG8_STAMP() do { if (STAMP && wid == 0 && nts < 64) { const unsigned long long _c = (unsigned long long)clock64(); \
        ts_lo = (lane == nts) ? (int)(unsigned)_c : ts_lo; ts_hi = (lane == nts) ? (int)(unsigned)(_c >> 32) : ts_hi; ++nts; } } while (0)
    PG8_STAMP();
    unsigned voffA[2], voffB[2];
#pragma unroll
    for (int i = 0; i < 2; ++i) { int R, C; stage_rc(tid * 16 + i * 8192, R, C); const int Rb = Epi::PERM ? ((R & ~31) + perm32(R & 31)) : R;
        voffA[i] = (unsigned)(R * K + C) * 2u; voffB[i] = (unsigned)(Rb * K + C) * 2u; }
    const size_t kstep = (size_t)(BK * 2);
    const size_t hstep = (size_t)HALF * K * 2;
    const size_t tstep = 2 * hstep;
    const unsigned ldsw = (unsigned)wid * 1024u;
    const int aoff = lds_byte(wr * 64 + fr, fq * 8), boff = lds_byte(wc * 32 + fr, fq * 8);
#define PG8_SA(b, h) (((b) * 2 + (h)) * HTB)
#define PG8_SB(b, h) ((4 + (b) * 2 + (h)) * HTB)
#define PG8_STAGE(bufoff, gbase, voff) do { _Pragma("unroll") for (int _i = 0; _i < 2; ++_i) \
        __builtin_amdgcn_global_load_lds((const unsigned*)((const char*)(gbase) + (voff)[_i]), (PG8_LAS unsigned*)(lds + (bufoff) + ldsw + _i * 8192), 16, 0, 0); } while (0)
#define PG8_LDA(dst, b, h) do { _Pragma("unroll") for (int m = 0; m < 4; ++m) _Pragma("unroll") for (int k = 0; k < 2; ++k) dst[m][k] = *(const PG8_LAS bf16x8*)(lds + PG8_SA(b, h) + aoff + m * 2048 + k * 1024); } while (0)
#define PG8_LDB(dst, b, h) do { _Pragma("unroll") for (int n = 0; n < 2; ++n) _Pragma("unroll") for (int k = 0; k < 2; ++k) dst[n][k] = *(const PG8_LAS bf16x8*)(lds + PG8_SB(b, h) + boff + n * 2048 + k * 1024); } while (0)
#define PG8_MMA(ai, bj, At, Bt) do { __builtin_amdgcn_s_setprio(1); _Pragma("unroll") for (int m = 0; m < 4; ++m) _Pragma("unroll") for (int n = 0; n < 2; ++n) _Pragma("unroll") for (int k = 0; k < 2; ++k) \
        acc[ai][bj][m][n] = __builtin_amdgcn_mfma_f32_16x16x32_bf16(Bt[n][k], At[m][k], acc[ai][bj][m][n], 0, 0, 0); __builtin_amdgcn_s_setprio(0); } while (0)
#define PG8_WAIT_V(n) asm volatile("s_waitcnt vmcnt(" #n ")" ::: "memory")
#define PG8_WAIT_L(n) asm volatile("s_waitcnt lgkmcnt(" #n ")" ::: "memory")
#define PG8_BAR __builtin_amdgcn_s_barrier()
#define PG8_SCHED __builtin_amdgcn_sched_barrier(0)
    Unit cur, nxt; int ui = 0;
    if (!S.next(0, cur)) return;
    f32x4 acc[2][2][4][2];
#pragma unroll
    for (int a = 0; a < 2; ++a)
#pragma unroll
        for (int b = 0; b < 2; ++b)
#pragma unroll
            for (int m = 0; m < 4; ++m)
#pragma unroll
                for (int n = 0; n < 2; ++n) acc[a][b][m][n] = (f32x4){0.f, 0.f, 0.f, 0.f};
    bf16x8 At[4][2], B0[2][2], B1[2][2];
    const char* cA = (const char*)g.A + (size_t)cur.pm * tstep; const char* cB = (const char*)g.Bt + (size_t)cur.pn * tstep;
    S.a_ready(cur);
    PG8_STAGE(PG8_SB(0, 0), cB, voffB); PG8_STAGE(PG8_SA(0, 0), cA, voffA); PG8_STAGE(PG8_SB(0, 1), cB + hstep, voffB); PG8_STAGE(PG8_SA(0, 1), cA + hstep, voffA);
    if (wr == 1) PG8_BAR;
    PG8_WAIT_V(4); PG8_BAR;
    PG8_STAGE(PG8_SB(1, 0), cB + kstep, voffB); PG8_STAGE(PG8_SA(1, 0), cA + kstep, voffA); PG8_STAGE(PG8_SB(1, 1), cB + hstep + kstep, voffB);
    PG8_WAIT_V(6); PG8_BAR;
    PG8_STAMP();
    for (;;) {
        const bool has_next = S.next(ui + 1, nxt);
        const char* nA = has_next ? (const char*)g.A + (size_t)nxt.pm * tstep : cA; const char* nB = has_next ? (const char*)g.Bt + (size_t)nxt.pn * tstep : cB;
        for (int t = 0; t < nt; t += 2) {
            const bool last = (t == nt - 2);
            const char* a1 = cA + (size_t)(t + 1) * kstep;
            const char* a2 = last ? nA : cA + (size_t)(t + 2) * kstep; const char* b2 = last ? nB : cB + (size_t)(t + 2) * kstep;
            const char* a3 = a2 + kstep; const char* b3 = b2 + kstep;
            if (last && has_next) S.a_ready(nxt);
            PG8_LDB(B0, 0, 0); PG8_SCHED; PG8_LDA(At, 0, 0); PG8_STAGE(PG8_SA(1, 1), a1 + hstep, voffA);
            PG8_WAIT_L(8); PG8_BAR; PG8_WAIT_L(0); PG8_MMA(0, 0, At, B0); PG8_BAR; PG8_SCHED;
            PG8_LDB(B1, 0, 1); PG8_STAGE(PG8_SB(0, 0), b2, voffB);
            PG8_BAR; PG8_WAIT_L(0); PG8_MMA(0, 1, At, B1); PG8_BAR;
            PG8_LDA(At, 0, 1); PG8_STAGE(PG8_SA(0, 0), a2, voffA);
            PG8_BAR; PG8_WAIT_L(0); PG8_MMA(1, 0, At, B0); PG8_BAR; PG8_SCHED;
            PG8_STAGE(PG8_SB(0, 1), b2 + hstep, voffB);
            PG8_WAIT_V(6); PG8_BAR; PG8_MMA(1, 1, At, B1); PG8_BAR;
            PG8_LDB(B0, 1, 0); PG8_SCHED; PG8_LDA(At, 1, 0); PG8_STAGE(PG8_SA(0, 1), a2 + hstep, voffA);
            PG8_WAIT_L(8); PG8_BAR; PG8_WAIT_L(0); PG8_MMA(0, 0, At, B0); PG8_BAR; PG8_SCHED;
            PG8_LDB(B1, 1, 1); PG8_STAGE(PG8_SB(1, 0), b3, voffB);
            PG8_BAR; PG8_WAIT_L(0); PG8_MMA(0, 1, At, B1); PG8_BAR;
            PG8_LDA(At, 1, 1); PG8_STAGE(PG8_SA(1, 0), a3, voffA);
            PG8_BAR; PG8_WAIT_L(0); PG8_MMA(1, 0, At, B0); PG8_BAR; PG8_SCHED;
            PG8_STAGE(PG8_SB(1, 1), b3 + hstep, voffB);
            PG8_WAIT_V(6); PG8_BAR; PG8_MMA(1, 1, At, B1); PG8_BAR;
        }
        PG8_STAMP();
        if constexpr (!Epi::AFTER_DRAIN) { E(acc, cur, wr, wc, fr, fq); S.done(cur); }
        PG8_STAMP();
        if (!has_next) break;
#pragma unroll
        for (int a = 0; a < 2; ++a)
#pragma unroll
            for (int b = 0; b < 2; ++b)
#pragma unroll
                for (int m = 0; m < 4; ++m)
#pragma unroll
                    for (int n = 0; n < 2; ++n) acc[a][b][m][n] = (f32x4){0.f, 0.f, 0.f, 0.f};
        cur = nxt; cA = nA; cB = nB; ++ui;
    }
    PG8_WAIT_V(0);
    if (wr == 0) PG8_BAR;
    PG8_BAR;
    if constexpr (Epi::AFTER_DRAIN) { E.fused(acc, cur, wr, wc, fr, fq, lds, wid, lane); S.done(cur); }
    PG8_STAMP();
    if (STAMP && wid == 0) { stamps[lane] = lane < nts ? (((unsigned long long)(unsigned)ts_hi << 32) | (unsigned)ts_lo) : 0ull;
        if (lane == 62) stamps[62] = rt_entry; if (lane == 63) stamps[63] = (unsigned long long)wall_clock64(); }
#undef PG8_STAMP
#undef PG8_SA
#undef PG8_SB
#undef PG8_STAGE
#undef PG8_LDA
#undef PG8_LDB
#undef PG8_MMA
#undef PG8_WAIT_V
#undef PG8_WAIT_L
#undef PG8_BAR
#undef PG8_SCHED
}
}

template <class MyEpi> struct Pg8Epi {
    static constexpr bool PERM = false, AFTER_DRAIN = false;
    MyEpi e;
    __device__ __forceinline__ void operator()(const pg8::f32x4 (&acc)[2][2][4][2], const pg8::Unit& u, int wr, int wc, int fr, int fq) const {
#pragma unroll
        for (int ai = 0; ai < 2; ++ai)
#pragma unroll
            for (int m = 0; m < 4; ++m) {
                const int row = u.pm * 256 + ai * 128 + wr * 64 + m * 16 + fr;
#pragma unroll
                for (int bj = 0; bj < 2; ++bj)
#pragma unroll
                    for (int n = 0; n < 2; ++n) e(row, u.pn * 256 + bj * 128 + wc * 32 + n * 16 + 4 * fq, acc[ai][bj][m][n]);
            }
    }
};

template <class E> DI void gemm_small32_unit(const bf16_t* A, int lda, const bf16_t* Bt, int ldb, int K, int m0, int n0, const E epi) {
    const int tid = TIDX, lane = tid & 63, w = tid >> 6, lr = lane & 15, lg = lane >> 4;
    const bf16_t* a0 = A + (size_t)(m0 + lr) * lda + lg * 8; const bf16_t* a1 = a0 + (size_t)16 * lda;
    const bf16_t* b0 = Bt + (size_t)(n0 + w * 16 + lr) * ldb + lg * 8;
    f32x4 acc0 = {0.f, 0.f, 0.f, 0.f}, acc1 = {0.f, 0.f, 0.f, 0.f};
#pragma unroll 1
    for (int k0 = 0; k0 < K; k0 += 256) {
        bf16x8 fa0[8], fa1[8], fb[8];
#pragma unroll
        for (int i = 0; i < 8; ++i) { fa0[i] = *(const bf16x8*)(a0 + k0 + i * 32); fa1[i] = *(const bf16x8*)(a1 + k0 + i * 32); fb[i] = *(const bf16x8*)(b0 + k0 + i * 32); }
#pragma unroll
        for (int i = 0; i < 8; ++i) { acc0 = MFMA16(fb[i], fa0[i], acc0); acc1 = MFMA16(fb[i], fa1[i], acc1); }
    }
    epi(m0 + lr, n0 + w * 16 + 4 * lg, acc0);
    epi(m0 + 16 + lr, n0 + w * 16 + 4 * lg, acc1);
}
template <class E> DI void gemm_big(const bf16_t* A, const bf16_t* Bt, int N, const E epi, char* lds, int bid, int nb) {
    {
        pg8::Gemm g{A, Bt, TP, N, DM};
        pg8::StaticOrder S; S.init(TP, N, nb, bid);
        Pg8Epi<E> pe{epi};
        pg8::gemm_phase<Pg8Epi<E>, pg8::StaticOrder, false>((PG8_LAS unsigned char*)lds, g, S, pe, nullptr);
    }
    __syncthreads();
    for (int u = nb - 1 - bid; u < (N >> 7); u += nb) gemm_small32_unit(A, DM, Bt, DM, DM, TP, u * 128, epi);
}

DI void conv_unit(const Params& p, int u, char* lds) {
    float* sy = (float*)lds;
    const int c = TIDX, lane = c & 63, w = c >> 6;
    float wj[31];
#pragma unroll
    for (int j = 0; j < 31; ++j) wj[j] = p.conv_w[j * 512 + c];
    const float bias = p.conv_b[c];
    int ntok, row0;
    if (u < 512) {
        const int b = u >> 8, t0 = (u & 255) * 32; ntok = 32; row0 = b * SEQ + t0;
        float uu[62];
#pragma unroll
        for (int r = 0; r < 62; ++r) {
            const int t = t0 - 30 + r; float val = 0.f;
            if (t >= 0) { const size_t row = (size_t)b * SEQ + t; float a = bf2f(p.H[row * 2560 + 1536 + c]); float g = bf2f(p.H[row * 2560 + 2048 + c]); val = a * sigmoidf_(g); }
            uu[r] = val;
            if (t0 == SEQ - 32 && r >= 32) p.conv_prompt[((size_t)b * 30 + (r - 32)) * 512 + c] = val;
        }
#pragma unroll
        for (int tt = 0; tt < 32; ++tt) {
            float acc = bias;
#pragma unroll
            for (int j = 0; j < 31; ++j) acc += wj[j] * uu[tt + j];
            sy[tt * 512 + c] = acc;
        }
    } else {
        const int b = u - 512; ntok = 1; row0 = TP + b;
        const size_t row = (size_t)row0;
        float a = bf2f(p.H[row * 2560 + 1536 + c]); float g = bf2f(p.H[row * 2560 + 2048 + c]);
        const float un = a * sigmoidf_(g);
        float acc = bias + wj[30] * un;
#pragma unroll
        for (int j = 0; j < 30; ++j) {
            float e = p.state_conv[((size_t)b * 30 + j) * 512 + c]; acc += wj[j] * e;
            if (j >= 1) p.conv_sample[((size_t)b * 30 + (j - 1)) * 512 + c] = e;
        }
        p.conv_sample[((size_t)b * 30 + 29) * 512 + c] = un;
        sy[c] = acc;
    }
    __syncthreads();
    for (int tt = w; tt < ntok; tt += 8) {
        float v[8]; float s = 0.f;
#pragma unroll
        for (int i = 0; i < 8; ++i) { v[i] = sy[tt * 512 + lane + 64 * i]; s += v[i]; }
        const float mu = wave_sum(s) * (1.f / 512.f);
        float q = 0.f;
#pragma unroll
        for (int i = 0; i < 8; ++i) { float d = v[i] - mu; q += d * d; }
        const float rs = rsqrtf(wave_sum(q) * (1.f / 512.f) + LN_EPS);
#pragma unroll
        for (int i = 0; i < 8; ++i) {
            const int cc = lane + 64 * i;
            float y = (v[i] - mu) * rs * p.conv_ln_g[cc] + p.conv_ln_b[cc];
            y = y * sigmoidf_(y);
            p.MIX[(size_t)(row0 + tt) * DM + 512 + cc] = f2bf(y);
        }
    }
    __syncthreads();
}

DI void moba_sample_unit(const Params& p, int u, char* lds) {
    float* sq = (float*)lds;
    float* gs = sq + 64;
    int* sel = (int*)(gs + 32);
    float* lg = (float*)(sel + 4);
    float* red = lg + 776;
    unsigned* roff = (unsigned*)(red + 16);
    float* part = (float*)(roff + 776);
    const int tid = TIDX, lane = tid & 63, w = tid >> 6;
    const int b = u >> 3, h = u & 7; const size_t row = (size_t)TP + b;
    __syncthreads();
    if (tid < 64) sq[tid] = bf2f(p.H[row * 2560 + h * 64 + tid]);
    __syncthreads();
    if (tid < 32) { const bf16_t* km = p.KMS + ((size_t)b * 32 + tid) * 512 + h * 64; float s = 0.f;
#pragma unroll 8
        for (int d = 0; d < 64; ++d) s += sq[d] * bf2f(km[d]);
        gs[tid] = s; }
    __syncthreads();
    if (tid == 0) {
        float v0 = -INFINITY, v1 = -INFINITY, v2 = -INFINITY; int i0 = 0, i1 = 0, i2 = 0;
        for (int j = 0; j < 32; ++j) { float s = gs[j];
            if (s > v0) { v2 = v1; i2 = i1; v1 = v0; i1 = i0; v0 = s; i0 = j; }
            else if (s > v1) { v2 = v1; i2 = i1; v1 = s; i1 = j; }
            else if (s > v2) { v2 = s; i2 = j; } }
        sel[0] = i0; sel[1] = i1; sel[2] = i2;
    }
    __syncthreads();
    for (int idx = tid; idx < 769; idx += NT) {
        float s = 0.f;
        if (idx < 768) {
            const int blk = sel[idx >> 8]; const int pos = blk * 256 + (idx & 255);
            const int page = p.page_table[b * 64 + (pos >> 7)];
            const unsigned ro = ((unsigned)page * 128u + (unsigned)(pos & 127)) * 8u + (unsigned)h;
            roff[idx] = ro;
            const float* kp = p.cache_k + (size_t)ro * 64;
            f32x4 kv[16];
#pragma unroll
            for (int d4 = 0; d4 < 16; ++d4) kv[d4] = *(const f32x4*)(kp + 4 * d4);
#pragma unroll
            for (int d4 = 0; d4 < 16; ++d4) s += sq[4 * d4] * kv[d4][0] + sq[4 * d4 + 1] * kv[d4][1] + sq[4 * d4 + 2] * kv[d4][2] + sq[4 * d4 + 3] * kv[d4][3];
        } else {
            const bf16_t* kn = p.H + row * 2560 + 512 + h * 64;
            for (int d = 0; d < 64; ++d) s += sq[d] * bf2f(kn[d]);
        }
        lg[idx] = s * 0.125f;
    }
    __syncthreads();
    float mx = -INFINITY;
    for (int idx = tid; idx < 769; idx += NT) mx = fmaxf(mx, lg[idx]);
    mx = wave_max(mx); if (lane == 0) red[w] = mx;
    __syncthreads();
    mx = red[0];
#pragma unroll
    for (int i = 1; i < 8; ++i) mx = fmaxf(mx, red[i]);
    float sm = 0.f;
    for (int idx = tid; idx < 769; idx += NT) { float e = __expf(lg[idx] - mx); lg[idx] = e; sm += e; }
    sm = wave_sum(sm); if (lane == 0) red[8 + w] = sm;
    __syncthreads();
    sm = 0.f;
#pragma unroll
    for (int i = 0; i < 8; ++i) sm += red[8 + i];
    {
        const int d4 = tid & 15, kg = tid >> 4;
        f32x4 acc = {0.f, 0.f, 0.f, 0.f};
#pragma unroll
        for (int i0 = 0; i0 < 24; i0 += 8) {
            f32x4 vv[8]; float pp[8];
#pragma unroll
            for (int i = 0; i < 8; ++i) { const int idx = kg + 32 * (i0 + i); pp[i] = lg[idx]; vv[i] = *(const f32x4*)(p.cache_v + (size_t)roff[idx] * 64 + 4 * d4); }
#pragma unroll
            for (int i = 0; i < 8; ++i) acc += vv[i] * pp[i];
        }
        if (kg == 0) {
            const bf16_t* vn = p.H + row * 2560 + 1024 + h * 64 + 4 * d4; const float pn = lg[768];
            acc[0] += pn * bf2f(vn[0]); acc[1] += pn * bf2f(vn[1]); acc[2] += pn * bf2f(vn[2]); acc[3] += pn * bf2f(vn[3]);
        }
        *(f32x4*)(part + kg * 64 + 4 * d4) = acc;
    }
    __syncthreads();
    if (tid < 64) { float a = 0.f;
#pragma unroll
        for (int i = 0; i < 32; ++i) a += part[i * 64 + tid];
        p.MIX[row * DM + h * 64 + tid] = f2bf(a / sm); }
}

constexpr int MB_K = 0, MB_V = 65536, MB_VROW = 528, MB_WOR = 65536 + 2 * 64 * MB_VROW;
DI void moba_prompt_unit(const Params& p, int bh, int own, char* lds) {
    const int tid = TIDX, lane = tid & 63, w = tid >> 6, lr = lane & 15, lg = lane >> 4;
    const int b = bh >> 3, h = bh & 7;
    float* gsc = (float*)lds + w * 1024;
    unsigned* msk = (unsigned*)(lds + 32768) + w * 36;
    unsigned* worl = (unsigned*)(lds + MB_WOR);
    const int wv = __builtin_amdgcn_readfirstlane(w);
    const size_t rowq0 = (size_t)b * SEQ + own * 256 + w * 32;
    __syncthreads();
    bf16x8 qf[2][2];
#pragma unroll
    for (int qt = 0; qt < 2; ++qt)
#pragma unroll
        for (int ks = 0; ks < 2; ++ks) qf[qt][ks] = *(const bf16x8*)(p.H + (rowq0 + qt * 16 + lr) * 2560 + h * 64 + ks * 32 + lg * 8);
    unsigned mq[2]; unsigned wor;
    if (own > 3) {
        bf16_t* kml = (bf16_t*)(lds + 36864);
        {
            const int j = tid >> 4, d4 = tid & 15;
            f32x4 a = {0.f, 0.f, 0.f, 0.f};
#pragma unroll
            for (int part = 0; part < 8; ++part) a += *(const f32x4*)(p.KMPP + (((size_t)b * 32 + j) * 8 + part) * 512 + h * 64 + 4 * d4);
            store_bf4(kml + j * 64 + 4 * d4, a * (1.f / 256.f));
        }
        __syncthreads();
#pragma unroll
        for (int jt = 0; jt < 2; ++jt) {
            bf16x8 kf[2];
#pragma unroll
            for (int ks = 0; ks < 2; ++ks) kf[ks] = *(const bf16x8*)(kml + (jt * 16 + lr) * 64 + ks * 32 + lg * 8);
#pragma unroll
            for (int qt = 0; qt < 2; ++qt) {
                f32x4 a = {0.f, 0.f, 0.f, 0.f};
                a = MFMA16(kf[0], qf[qt][0], a); a = MFMA16(kf[1], qf[qt][1], a);
#pragma unroll
                for (int r = 0; r < 4; ++r) gsc[(qt * 16 + lr) * 32 + jt * 16 + 4 * lg + r] = a[r];
            }
        }
        __builtin_amdgcn_s_waitcnt(0);
        __builtin_amdgcn_wave_barrier();
        unsigned m = 0;
        if (lane < 32) {
            float v0 = -INFINITY, v1 = -INFINITY, v2 = -INFINITY; int i0 = 0, i1 = 0, i2 = 0;
            for (int j = 0; j < own; ++j) { float sc = gsc[lane * 32 + j];
                if (sc > v0) { v2 = v1; i2 = i1; v1 = v0; i1 = i0; v0 = sc; i0 = j; }
                else if (sc > v1) { v2 = v1; i2 = i1; v1 = sc; i1 = j; }
                else if (sc > v2) { v2 = sc; i2 = j; } }
            m = (1u << i0) | (1u << i1) | (1u << i2);
            msk[lane] = m;
        }
        unsigned o = m;
#pragma unroll
        for (int sft = 32; sft >= 1; sft >>= 1) o |= (unsigned)__shfl_xor((int)o, sft, 64);
        wor = o;
        __builtin_amdgcn_s_waitcnt(0);
        __builtin_amdgcn_wave_barrier();
        mq[0] = msk[lr]; mq[1] = msk[16 + lr];
    } else {
        const unsigned m = (own >= 1) ? ((1u << own) - 1u) : 0u;
        mq[0] = m; mq[1] = m; wor = m;
    }
    wor = (unsigned)__builtin_amdgcn_readfirstlane((int)wor);
    if (lane == 0) worl[w] = wor;
    __syncthreads();
    unsigned bor = 0;
#pragma unroll
    for (int i = 0; i < 8; ++i) bor |= worl[i];
    bor = (unsigned)__builtin_amdgcn_readfirstlane((int)bor);

    const bf16_t* Kbase = p.H + (size_t)b * SEQ * 2560 + 512 + h * 64;
    const bf16_t* Vbase = p.VT + (size_t)(b * 8 + h) * 64 * 8192;
    u32x4 rk[4], rv[4];
    auto gload = [&](int jb) {
#pragma unroll
        for (int i = 0; i < 4; ++i) { const int id = tid + NT * i; const int r = id >> 3, c = id & 7; rk[i] = *(const u32x4*)(Kbase + (size_t)(jb * 256 + r) * 2560 + c * 8); }
#pragma unroll
        for (int i = 0; i < 4; ++i) { const int id = tid + NT * i; const int d = id >> 5, c = id & 31; rv[i] = *(const u32x4*)(Vbase + (size_t)d * 8192 + jb * 256 + c * 8); }
    };
    auto sstore = [&](int buf) {
#pragma unroll
        for (int i = 0; i < 4; ++i) { const int id = tid + NT * i; const int r = id >> 3, c = id & 7; *(u32x4*)(lds + MB_K + buf * 32768 + r * 128 + ((c ^ (r & 7)) << 4)) = rk[i]; }
#pragma unroll
        for (int i = 0; i < 4; ++i) { const int id = tid + NT * i; const int d = id >> 5, c = id & 31; *(u32x4*)(lds + MB_V + buf * (64 * MB_VROW) + d * MB_VROW + c * 16) = rv[i]; }
    };
    const float SC = 0.125f * 1.4426950408889634f;
    float mrow[2] = {-INFINITY, -INFINITY}, lrow[2] = {0.f, 0.f};
    f32x4 oacc[2][4];
#pragma unroll
    for (int qt = 0; qt < 2; ++qt)
#pragma unroll
        for (int dt = 0; dt < 4; ++dt) oacc[qt][dt] = (f32x4){0.f, 0.f, 0.f, 0.f};
    int cur = own, buf = 0;
    gload(cur); sstore(0); __syncthreads();
    int nxt_scan = 0;
    while (cur >= 0) {
        int nxt = -1;
        while (nxt_scan < own) { const int j = nxt_scan++; if ((bor >> j) & 1u) { nxt = j; break; } }
        if (nxt >= 0) gload(nxt);
        const bool isown = (cur == own);
        if (isown || ((wor >> cur) & 1u)) {
            const char* KB = lds + MB_K + buf * 32768; const char* VB = lds + MB_V + buf * (64 * MB_VROW);
            const int nst = isown ? (wv + 1) : 8;
            const bool sel0 = isown || ((mq[0] >> cur) & 1u), sel1 = isown || ((mq[1] >> cur) & 1u);
            for (int st = 0; st < nst; ++st) {
                bf16x8 kf[2][2];
#pragma unroll
                for (int kt = 0; kt < 2; ++kt)
#pragma unroll
                    for (int ks = 0; ks < 2; ++ks) { const int r = st * 32 + kt * 16 + lr, ch = ks * 4 + lg; kf[kt][ks] = *(const bf16x8*)(KB + r * 128 + ((ch ^ (r & 7)) << 4)); }
                bf16x8 pf[2]; float alph[2];
#pragma unroll
                for (int qt = 0; qt < 2; ++qt) {
                    f32x4 sv[2];
#pragma unroll
                    for (int kt = 0; kt < 2; ++kt) { f32x4 a = {0.f, 0.f, 0.f, 0.f}; a = MFMA16(kf[kt][0], qf[qt][0], a); a = MFMA16(kf[kt][1], qf[qt][1], a); sv[kt] = a; }
                    const bool selq = qt ? sel1 : sel0;
                    if (isown) {
                        const int qin = wv * 32 + qt * 16 + lr;
#pragma unroll
                        for (int kt = 0; kt < 2; ++kt)
#pragma unroll
                            for (int r = 0; r < 4; ++r) { const int kin = st * 32 + kt * 16 + 4 * lg + r; sv[kt][r] = (kin <= qin) ? sv[kt][r] : -INFINITY; }
                    }
                    float mx = fmaxf(fmaxf(fmaxf(sv[0][0], sv[0][1]), fmaxf(sv[0][2], sv[0][3])), fmaxf(fmaxf(sv[1][0], sv[1][1]), fmaxf(sv[1][2], sv[1][3]))) * SC;
                    mx = red_max_16_32(mx);
                    mx = selq ? mx : -INFINITY;
                    const float mnew = fmaxf(mrow[qt], mx);
                    alph[qt] = __builtin_amdgcn_exp2f(mrow[qt] - mnew);
                    const float mneg = selq ? -mnew : -INFINITY;
                    float ps = 0.f;
#pragma unroll
                    for (int kt = 0; kt < 2; ++kt)
#pragma unroll
                        for (int r = 0; r < 4; ++r) { const float e = __builtin_amdgcn_exp2f(__builtin_fmaf(sv[kt][r], SC, mneg)); sv[kt][r] = e; ps += e; }
                    ps = red_sum_16_32(ps);
                    lrow[qt] = lrow[qt] * alph[qt] + ps; mrow[qt] = mnew;
                    u32x4 pk; pk[0] = pack_bf2(sv[0][0], sv[0][1]); pk[1] = pack_bf2(sv[0][2], sv[0][3]); pk[2] = pack_bf2(sv[1][0], sv[1][1]); pk[3] = pack_bf2(sv[1][2], sv[1][3]);
                    pf[qt] = __builtin_bit_cast(bf16x8, pk);
                }
                if (__any((alph[0] != 1.f) || (alph[1] != 1.f))) {
#pragma unroll
                    for (int qt = 0; qt < 2; ++qt)
#pragma unroll
                        for (int dt = 0; dt < 4; ++dt) oacc[qt][dt] = oacc[qt][dt] * alph[qt];
                }
#pragma unroll
                for (int dt = 0; dt < 4; ++dt) {
                    const char* vp = VB + (dt * 16 + lr) * MB_VROW + st * 64 + 8 * lg;
                    const u32x2 lo = *(const u32x2*)vp, hi = *(const u32x2*)(vp + 32);
                    u32x4 t4; t4[0] = lo[0]; t4[1] = lo[1]; t4[2] = hi[0]; t4[3] = hi[1];
                    const bf16x8 vf = __builtin_bit_cast(bf16x8, t4);
#pragma unroll
                    for (int qt = 0; qt < 2; ++qt) oacc[qt][dt] = MFMA16(vf, pf[qt], oacc[qt][dt]);
                }
            }
        }
        if (nxt >= 0) sstore(buf ^ 1);
        __syncthreads();
        cur = nxt; buf ^= 1;
    }
#pragma unroll
    for (int qt = 0; qt < 2; ++qt) {
        const float inv = 1.f / lrow[qt];
#pragma unroll
        for (int dt = 0; dt < 4; ++dt) store_bf4(p.MIX + (rowq0 + qt * 16 + lr) * DM + h * 64 + dt * 16 + 4 * lg, oacc[qt][dt] * inv);
    }
}

DI void ln_rows(const Params& p, const float* g, const float* bb, int bid, int nb, bool final_out) {
    const int lane = TIDX & 63, w = TIDX >> 6;
    for (int row = bid * 8 + w; row < TT; row += nb * 8) {
        f32x4 v[4]; float s = 0.f;
#pragma unroll
        for (int i = 0; i < 4; ++i) { v[i] = *(const f32x4*)(p.T + (size_t)row * DM + 4 * lane + 256 * i); s += v[i][0] + v[i][1] + v[i][2] + v[i][3]; }
        const float mu = wave_sum(s) * (1.f / 1024.f);
        float q = 0.f;
#pragma unroll
        for (int i = 0; i < 4; ++i)
#pragma unroll
            for (int k = 0; k < 4; ++k) { float d = v[i][k] - mu; q += d * d; }
        const float rs = rsqrtf(wave_sum(q) * (1.f / 1024.f) + LN_EPS);
#pragma unroll
        for (int i = 0; i < 4; ++i) {
            const int c = 4 * lane + 256 * i;
            f32x4 gg = *(const f32x4*)(g + c), be = *(const f32x4*)(bb + c), y;
#pragma unroll
            for (int k = 0; k < 4; ++k) y[k] = (v[i][k] - mu) * rs * gg[k] + be[k];
            if (final_out) { float* dst = row < TP ? p.y_prompt + (size_t)row * DM + c : p.y_sample + (size_t)(row - TP) * DM + c; *(f32x4*)dst = y; }
            else { *(f32x4*)(p.XF + (size_t)row * DM + c) = y; store_bf4(p.XB + (size_t)row * DM + c, y); }
        }
    }
}

DI unsigned ford(float f) { const unsigned u = __float_as_uint(f); return u ^ ((unsigned)((int)u >> 31) | 0x80000000u); }
DI float funord(unsigned k) { return __uint_as_float((k & 0x80000000u) ? (k ^ 0x80000000u) : ~k); }
#define KINS16(K, tk) { unsigned _v = (K); _Pragma("unroll") for (int _k = 0; _k < 16; ++_k) { const unsigned _t = tk[_k] > _v ? tk[_k] : _v; _v = tk[_k] > _v ? _v : tk[_k]; tk[_k] = _t; } }
DI void peer_topk_unit(const Params& p, int u, char* lds) {
    float* lv = (float*)lds;
    int* li = (int*)(lds + 512 * 17 * 4);
    const int tid = TIDX; const int tok = u * 32 + (tid >> 4), j = tid & 15;
    unsigned tk[16];
#pragma unroll
    for (int k = 0; k < 16; ++k) tk[k] = 0u;
    if (tok < TT) {
        const float* sp = p.S + (size_t)tok * 2048 + j * 128;
#pragma unroll 2
        for (int n4 = 0; n4 < 32; ++n4) {
            const f32x4 v = *(const f32x4*)(sp + 4 * n4);
#pragma unroll
            for (int q = 0; q < 4; ++q) KINS16((ford(v[q]) & ~127u) | (unsigned)(127 - (4 * n4 + q)), tk);
        }
    }
#pragma unroll
    for (int k = 0; k < 16; ++k) { lv[tid * 17 + k] = funord(tk[k] & ~127u); li[tid * 17 + k] = 127 - (int)(tk[k] & 127u); }
    __syncthreads();
    if ((j & 1) == 0 && tok < TT) {
        float v1[16], v2[16];
#pragma unroll
        for (int k = 0; k < 16; ++k) { v1[k] = lv[tid * 17 + k]; v2[k] = lv[(tid + 1) * 17 + k]; }
        unsigned sk[16];
#pragma unroll
        for (int k = 0; k < 16; ++k) sk[k] = 0u;
#pragma unroll
        for (int a = 0; a < 16; ++a)
#pragma unroll
            for (int bq = 0; bq < 16; ++bq)
                if ((a + 1) * (bq + 1) <= 16) KINS16((ford(v1[a] + v2[bq]) & ~255u) | (unsigned)(255 - (a * 16 + bq)), sk);
        float sc[16]; int ee[16];
#pragma unroll
        for (int k = 0; k < 16; ++k) {
            const int c = 255 - (int)(sk[k] & 255u), a = c >> 4, bq = c & 15;
            sc[k] = lv[tid * 17 + a] + lv[(tid + 1) * 17 + bq];
            ee[k] = li[tid * 17 + a] * 128 + li[(tid + 1) * 17 + bq];
        }
        float sm = 0.f; float e[16];
#pragma unroll
        for (int k = 0; k < 16; ++k) { e[k] = __expf(sc[k] - sc[0]); sm += e[k]; }
        const float inv = 1.f / sm; const int h = j >> 1;
#pragma unroll
        for (int k = 0; k < 16; ++k) { p.E[(size_t)tok * 128 + h * 16 + k] = ee[k]; p.G[(size_t)tok * 128 + h * 16 + k] = e[k] * inv; }
    }
    __syncthreads();
}

constexpr int EHS = 129;
constexpr int PEER_EH = 65536, PEER_TOK = 65536 + 64 * EHS * 8, PEER_END = PEER_TOK + 1024;
DI float gelu_exact(float z) { return 0.5f * z * (1.f + erff(z * 0.70710678118654752f)); }
#define FMA4U(ACC, O, H, W) { ACC[O] += H * (float)((W) & 0xffu); ACC[O + 1] += H * (float)(((W) >> 8) & 0xffu); ACC[O + 2] += H * (float)(((W) >> 16) & 0xffu); ACC[O + 3] += H * (float)((W) >> 24); }

DI void peer_tile(const Params& p, int layer, int tile, char* lds, bool final_out) {
    const int lane = TIDX & 63, w = TIDX >> 6, lr = lane & 15, lg = lane >> 4;
    unsigned char* X8 = (unsigned char*)lds; int2* EH = (int2*)(lds + PEER_EH); float* TOK = (float*)(lds + PEER_TOK);
    const unsigned char* U8 = p.U8 + (size_t)layer * 16384 * DM; const unsigned char* V8 = p.V8 + (size_t)layer * 16384 * DM;
    const float* SUi = p.SU + layer * 16384; const float* SVi = p.SV + layer * 16384;
    const float* lng = p.ln_g + (layer * 2 + 1) * DM; const float* lnb = p.ln_b + (layer * 2 + 1) * DM;
    const int t0 = tile * 64 + w * 8;
#pragma unroll 1
    for (int i = 0; i < 8; ++i) {
        const int t = t0 + i, tk = w * 8 + i;
        f32x4 v[4]; float am = 0.f;
#pragma unroll
        for (int k = 0; k < 4; ++k) { v[k] = *(const f32x4*)(p.XF + (size_t)t * DM + 4 * lane + 256 * k); am = fmaxf(am, fmaxf(fmaxf(fabsf(v[k][0]), fabsf(v[k][1])), fmaxf(fabsf(v[k][2]), fabsf(v[k][3])))); }
        am = wave_max(am);
        const float sc = am > 0.f ? 127.f / am : 0.f;
#pragma unroll
        for (int k = 0; k < 4; ++k) {
            unsigned pk = 0;
#pragma unroll
            for (int q = 0; q < 4; ++q) { const int qi = (int)rintf(v[k][q] * sc); pk |= ((unsigned)qi & 0xffu) << (8 * q); }
            *(unsigned*)(X8 + tk * 1024 + 4 * lane + 256 * k) = pk;
        }
        if (lane == 0) TOK[tk * 2] = am * (1.f / 127.f);
        EH[tk * EHS + lane] = make_int2(p.E[(size_t)t * 128 + lane], 0);
        EH[tk * EHS + 64 + lane] = make_int2(p.E[(size_t)t * 128 + 64 + lane], 0);
    }
    {
        const int gq = lane >> 3, li = lane & 7, tk = w * 8 + gq;
        auto uld = [&](int c, int p0, u32x4 (&uu)[4]) {
            const unsigned char* Uc = U8 + (size_t)c * (16384 * 128);
#pragma unroll
            for (int j = 0; j < 4; ++j) { const unsigned e = (unsigned)EH[tk * EHS + p0 + j].x; uu[j] = *(const u32x4*)(Uc + (e * 128u + 16u * li)); }
        };
        auto ucp = [&](int p0, u32x4 (&uu)[4], const i32x4& xq) {
#pragma unroll
            for (int j = 0; j < 4; ++j) {
                int d = __builtin_amdgcn_sdot4((int)uu[j][0], xq[0], 0, false);
                d = __builtin_amdgcn_sdot4((int)uu[j][1], xq[1], d, false);
                d = __builtin_amdgcn_sdot4((int)uu[j][2], xq[2], d, false);
                d = __builtin_amdgcn_sdot4((int)uu[j][3], xq[3], d, false);
                d += __builtin_amdgcn_update_dpp(0, d, 0x114, 0xf, 0xf, true);
                d += __builtin_amdgcn_update_dpp(0, d, 0x112, 0xf, 0xf, true);
                d += __builtin_amdgcn_update_dpp(0, d, 0x111, 0xf, 0xf, true);
                if (li == 7) __hip_atomic_fetch_add(&EH[tk * EHS + p0 + j].y, d, __ATOMIC_RELAXED, __HIP_MEMORY_SCOPE_WORKGROUP);
            }
        };
        u32x4 uA[4], uB[4];
        uld(0, 0, uA);
#pragma unroll 1
        for (int c = 0; c < 8; ++c) {
            const i32x4 xq = *(const i32x4*)(X8 + tk * 1024 + c * 128 + 16 * li);
#pragma unroll 1
            for (int p0 = 0; p0 < 128; p0 += 8) {
                uld(c, p0 + 4, uB);
                ucp(p0, uA, xq);
                if (p0 + 8 < 128) uld(c, p0 + 8, uA); else if (c < 7) uld(c + 1, 0, uA);
                ucp(p0 + 4, uB, xq);
            }
        }
    }
#pragma unroll 1
    for (int i = 0; i < 8; ++i) {
        const int t = t0 + i, tk = w * 8 + i;
        const float sxi = TOK[tk * 2];
#pragma unroll
        for (int hf = 0; hf < 2; ++hf) {
            const int pi = hf * 64 + lane;
            const int2 eh = EH[tk * EHS + pi];
            const float z = (float)eh.y * SUi[eh.x] * sxi;
            const float hp = p.G[(size_t)t * 128 + pi] * gelu_exact(z) * SVi[eh.x];
            EH[tk * EHS + pi].y = __float_as_int(hp);
        }
    }
    const int gq = lane >> 3, li = lane & 7, tk = w * 8 + gq, t = t0 + gq;
    float s1 = 0.f, s2 = 0.f;
    auto vload = [&](int c, int p0, float (&hh)[4], u32x4 (&vv)[4]) {
        const unsigned char* Vc = V8 + (size_t)c * (16384 * 128);
#pragma unroll
        for (int j = 0; j < 4; ++j) { const int2 eh = EH[tk * EHS + p0 + j]; hh[j] = __int_as_float(eh.y); vv[j] = *(const u32x4*)(Vc + ((unsigned)eh.x * 128u + 16u * li)); }
    };
    auto vcomp = [&](float (&hh)[4], u32x4 (&vv)[4], f32x2 (&acc)[8]) {
#pragma unroll
        for (int j = 0; j < 4; ++j) {
            const f32x2 h2 = {hh[j], hh[j]};
#pragma unroll
            for (int q = 0; q < 4; ++q) {
                const f32x2 a = __builtin_amdgcn_cvt_pk_f32_fp8((int)vv[j][q], false), b = __builtin_amdgcn_cvt_pk_f32_fp8((int)vv[j][q], true);
                acc[2 * q] = h2 * a + acc[2 * q]; acc[2 * q + 1] = h2 * b + acc[2 * q + 1];
            }
        }
    };
    float ehA[4], ehB[4]; u32x4 vvA[4], vvB[4];
    vload(0, 0, ehA, vvA);
#pragma unroll 1
    for (int c = 0; c < 8; ++c) {
        f32x2 acc[8];
#pragma unroll
        for (int k = 0; k < 8; ++k) acc[k] = (f32x2){0.f, 0.f};
#pragma unroll 1
        for (int p0 = 0; p0 < 128; p0 += 8) {
            vload(c, p0 + 4, ehB, vvB);
            vcomp(ehA, vvA, acc);
            if (p0 + 8 < 128) vload(c, p0 + 8, ehA, vvA); else if (c < 7) vload(c + 1, 0, ehA, vvA);
            vcomp(ehB, vvB, acc);
        }
        const int col = c * 128 + li * 16;
#pragma unroll
        for (int k4 = 0; k4 < 4; ++k4) {
            const f32x4 x = *(const f32x4*)(p.XF + (size_t)t * DM + col + 4 * k4);
            f32x4 y;
#pragma unroll
            for (int k = 0; k < 4; ++k) { y[k] = DN_ALPHA * x[k] + acc[2 * k4 + (k >> 1)][k & 1]; s1 += y[k]; s2 += y[k] * y[k]; }
            *(f32x4*)(p.T + (size_t)t * DM + col + 4 * k4) = y;
        }
    }
#pragma unroll
    for (int o = 1; o <= 4; o <<= 1) { s1 += __shfl_xor(s1, o, 64); s2 += __shfl_xor(s2, o, 64); }
    const float mu = s1 * (1.f / 1024.f);
    const float rs = rsqrtf(fmaxf(s2 * (1.f / 1024.f) - mu * mu, 0.f) + LN_EPS);
#pragma unroll 1
    for (int c = 0; c < 8; ++c) {
        const int col = c * 128 + li * 16;
#pragma unroll
        for (int k4 = 0; k4 < 4; ++k4) {
            const f32x4 y = *(const f32x4*)(p.T + (size_t)t * DM + col + 4 * k4);
            const f32x4 gg = *(const f32x4*)(lng + col + 4 * k4), be = *(const f32x4*)(lnb + col + 4 * k4);
            f32x4 o;
#pragma unroll
            for (int k = 0; k < 4; ++k) o[k] = (y[k] - mu) * rs * gg[k] + be[k];
            if (final_out) *(f32x4*)(p.y_prompt + (size_t)t * DM + col + 4 * k4) = o;
            else { *(f32x4*)(p.XF + (size_t)t * DM + col + 4 * k4) = o; store_bf4(p.XB + (size_t)t * DM + col + 4 * k4, o); }
        }
    }
}

DI void peer_sample(const Params& p, int layer, int sidx, char* lds, bool final_out) {
    const int tid = TIDX, lane = tid & 63, w = tid >> 6, lr = lane & 15, lg = lane >> 4;
    unsigned char* X8 = (unsigned char*)lds; int2* EH = (int2*)(lds + 1024); float* Z = (float*)(lds + 1024 + 1024); float* Y = Z + 128; float* PART = Y + 1024;
    const unsigned char* U8 = p.U8 + (size_t)layer * 16384 * DM; const unsigned char* V8 = p.V8 + (size_t)layer * 16384 * DM;
    const float* SUi = p.SU + layer * 16384; const float* SVi = p.SV + layer * 16384;
    const float* lng = p.ln_g + (layer * 2 + 1) * DM; const float* lnb = p.ln_b + (layer * 2 + 1) * DM;
    const int t = TP + sidx;
    __syncthreads();
    if (w == 0) {
        f32x4 v[4]; float am = 0.f;
#pragma unroll
        for (int k = 0; k < 4; ++k) { v[k] = *(const f32x4*)(p.XF + (size_t)t * DM + 4 * lane + 256 * k); am = fmaxf(am, fmaxf(fmaxf(fabsf(v[k][0]), fabsf(v[k][1])), fmaxf(fabsf(v[k][2]), fabsf(v[k][3])))); }
        am = wave_max(am);
        const float sc = am > 0.f ? 127.f / am : 0.f;
#pragma unroll
        for (int k = 0; k < 4; ++k) {
            unsigned pk = 0;
#pragma unroll
            for (int q = 0; q < 4; ++q) { const int qi = (int)rintf(v[k][q] * sc); pk |= ((unsigned)qi & 0xffu) << (8 * q); }
            *(unsigned*)(X8 + 4 * lane + 256 * k) = pk;
        }
        if (lane == 0) PART[24] = am * (1.f / 127.f);
    }
    __syncthreads();
    {
        const int e = p.E[(size_t)t * 128 + w * 16 + lr];
        i32x4 acc = {0, 0, 0, 0};
#pragma unroll
        for (int ch = 0; ch < 16; ++ch) {
            const i32x4 a = *(const i32x4*)(U8 + (size_t)(ch >> 1) * (16384 * 128) + (size_t)e * 128 + (ch & 1) * 64 + 16 * lg);
            const i32x4 xb = *(const i32x4*)(X8 + ch * 64 + 16 * lg);
            acc = __builtin_amdgcn_mfma_i32_16x16x64_i8(a, xb, acc, 0, 0, 0);
        }
        if (lr == 0) {
#pragma unroll
            for (int r = 0; r < 4; ++r) Z[w * 16 + 4 * lg + r] = (float)acc[r];
        }
        __builtin_amdgcn_s_waitcnt(0);
        __builtin_amdgcn_wave_barrier();
        float hp = 0.f;
        if (lane < 16) {
            const int pi = w * 16 + lane;
            const float z = Z[pi] * SUi[e] * PART[24];
            hp = p.G[(size_t)t * 128 + pi] * gelu_exact(z) * SVi[e];
            EH[pi] = make_int2(e, __float_as_int(hp));
        }
        hp = wave_sum(hp);
        if (lane == 0) PART[w] = hp;
    }
    __syncthreads();
    float sumh = 0.f;
#pragma unroll
    for (int i = 0; i < 8; ++i) sumh += PART[i];
    {
        const int c = w, pg = lane >> 3, li = lane & 7;
        float acc[16];
#pragma unroll
        for (int k = 0; k < 16; ++k) acc[k] = 0.f;
        const unsigned char* vb = V8 + (size_t)c * (16384 * 128) + li * 16;
        for (int p0 = 0; p0 < 16; p0 += 8) {
            int2 eh[8]; u32x4 vv[8];
#pragma unroll
            for (int j = 0; j < 8; ++j) eh[j] = EH[pg * 16 + p0 + j];
#pragma unroll
            for (int j = 0; j < 8; ++j) vv[j] = *(const u32x4*)(vb + (size_t)eh[j].x * 128);
#pragma unroll
            for (int j = 0; j < 8; ++j) { const float h = __int_as_float(eh[j].y);
#pragma unroll
                for (int q = 0; q < 4; ++q) { const f32x2 a = __builtin_amdgcn_cvt_pk_f32_fp8((int)vv[j][q], false), bq = __builtin_amdgcn_cvt_pk_f32_fp8((int)vv[j][q], true);
                    acc[4 * q] += h * a[0]; acc[4 * q + 1] += h * a[1]; acc[4 * q + 2] += h * bq[0]; acc[4 * q + 3] += h * bq[1]; } }
        }
#pragma unroll
        for (int k = 0; k < 16; ++k) { float a = acc[k]; a += __shfl_xor(a, 8, 64); a += __shfl_xor(a, 16, 64); a += __shfl_xor(a, 32, 64); acc[k] = a; }
        float s1 = 0.f, s2 = 0.f;
        if (pg == 0) {
            const int col = c * 128 + li * 16;
#pragma unroll
            for (int k = 0; k < 16; ++k) { const float y = DN_ALPHA * p.XF[(size_t)t * DM + col + k] + acc[k]; Y[col + k] = y; s1 += y; s2 += y * y; }
        }
        s1 = wave_sum(s1); s2 = wave_sum(s2);
        if (lane == 0) { PART[8 + w] = s1; PART[16 + w] = s2; }
    }
    __syncthreads();
    float s1 = 0.f, s2 = 0.f;
#pragma unroll
    for (int i = 0; i < 8; ++i) { s1 += PART[8 + i]; s2 += PART[16 + i]; }
    const float mu = s1 * (1.f / 1024.f);
    const float rs = rsqrtf(fmaxf(s2 * (1.f / 1024.f) - mu * mu, 0.f) + LN_EPS);
#pragma unroll
    for (int k = 0; k < 2; ++k) {
        const int col = tid + NT * k;
        const float o = (Y[col] - mu) * rs * lng[col] + lnb[col];
        if (final_out) p.y_sample[(size_t)sidx * DM + col] = o;
        else { p.XF[(size_t)t * DM + col] = o; p.XB[(size_t)t * DM + col] = f2bf(o); }
    }
    __syncthreads();
}

DI void peer_expert_phase(const Params& p, int layer, char* lds, int bid, int nb, bool final_out) {
    for (int tile = bid; tile < 256; tile += nb) peer_tile(p, layer, tile, lds, final_out);
    for (int sidx = bid; sidx < TS; sidx += nb) peer_sample(p, layer, sidx, lds, final_out);
}

DI void hgrn_cumsum(const Params& p, size_t row0, int h, float* bs, float* tot) {
    const int tid = TIDX;
#pragma unroll
    for (int i = 0; i < 4; ++i) { int id = tid + NT * i; int s = id >> 5, c4 = id & 31; *(f32x4*)(bs + s * 128 + 4 * c4) = *(const f32x4*)(p.LF + (row0 + s) * DM + h * 128 + 4 * c4); }
    __syncthreads();
    const int k = tid & 127, seg = tid >> 7;
    float run = 0.f;
#pragma unroll
    for (int i = 0; i < 16; ++i) { run += bs[(seg * 16 + i) * 128 + k]; bs[(seg * 16 + i) * 128 + k] = run; }
    tot[seg * 128 + k] = run;
    __syncthreads();
    float off = 0.f;
#pragma unroll
    for (int s2 = 0; s2 < 3; ++s2) if (s2 < seg) off += tot[s2 * 128 + k];
    if (seg > 0) {
#pragma unroll
        for (int i = 0; i < 16; ++i) bs[(seg * 16 + i) * 128 + k] += off;
    }
    __syncthreads();
}
constexpr int HG_TS = 72;
constexpr int HG_FS = 136;
DI void hgrn_b1_unit(const Params& p, int u, char* lds) {
    float* bs = (float*)lds;
    float* tot = (float*)(lds + 32768);
    bf16_t* KT = (bf16_t*)(lds + 36864);
    bf16_t* IT = (bf16_t*)(lds + 36864 + 18432);
    const int tid = TIDX, lane = tid & 63, w = tid >> 6, lr = lane & 15, lg = lane >> 4;
    const int bh = u >> 7, c = u & 127, b = bh >> 3, h = bh & 7;
    const size_t row0 = (size_t)b * SEQ + c * 64;
    hgrn_cumsum(p, row0, h, bs, tot);
    const bf16_t* KK = p.H + (size_t)MP * DM; const bf16_t* I1 = p.H + (size_t)2 * MP * DM;
    {
        const int s = tid >> 3, kc = (tid & 7) * 16;
        const bf16_t* kr = KK + (row0 + s) * DM + h * 128 + kc; const bf16_t* ir = I1 + (row0 + s) * DM + h * 128 + kc;
        u32x4 ka = *(const u32x4*)kr, kb = *(const u32x4*)(kr + 8), ia = *(const u32x4*)ir, ib = *(const u32x4*)(ir + 8);
#pragma unroll
        for (int i = 0; i < 16; ++i) {
            const unsigned kw = (i < 8) ? ka[(i & 7) >> 1] : kb[(i & 7) >> 1]; const unsigned iw = (i < 8) ? ia[(i & 7) >> 1] : ib[(i & 7) >> 1];
            const float kv = (i & 1) ? bfhi(kw) : bflo(kw);
            const float e = __expf(fminf(-bs[s * 128 + kc + i], 80.f));
            KT[(kc + i) * HG_TS + s] = f2bf(kv * e);
            IT[(kc + i) * HG_TS + s] = (bf16_t)((i & 1) ? (iw >> 16) : (iw & 0xffffu));
        }
    }
    __syncthreads();
    f32x4 acc[8];
#pragma unroll
    for (int j = 0; j < 8; ++j) acc[j] = (f32x4){0.f, 0.f, 0.f, 0.f};
#pragma unroll
    for (int ks = 0; ks < 2; ++ks) {
        const bf16x8 af = *(const bf16x8*)(KT + (w * 16 + lr) * HG_TS + ks * 32 + lg * 8);
#pragma unroll
        for (int j = 0; j < 8; ++j) { const bf16x8 bfr = *(const bf16x8*)(IT + (j * 16 + lr) * HG_TS + ks * 32 + lg * 8); acc[j] = MFMA16(af, bfr, acc[j]); }
    }
    f32x4 dl;
#pragma unroll
    for (int r = 0; r < 4; ++r) dl[r] = __expf(bs[63 * 128 + w * 16 + 4 * lg + r]);
#pragma unroll
    for (int j = 0; j < 8; ++j) *(f32x4*)(p.UT + ((size_t)u * 128 + j * 16 + lr) * 128 + w * 16 + 4 * lg) = acc[j] * dl;
    if (tid < 128) p.DEC[(size_t)u * 128 + tid] = __expf(bs[63 * 128 + tid]);
    __syncthreads();
}
DI void hgrn_b2(const Params& p, int bid, int nb) {
    for (int e = bid * NT + TIDX; e < 16 * 16384; e += nb * NT) {
        const int bh = e >> 14, vk = e & 16383, k = vk & 127, v = vk >> 7;
        float S = 0.f;
        for (int c0 = 0; c0 < 128; c0 += 8) {
            float uu[8], dd[8];
#pragma unroll
            for (int i = 0; i < 8; ++i) { const size_t un = (size_t)bh * 128 + c0 + i; uu[i] = p.UT[un * 16384 + vk]; dd[i] = p.DEC[un * 128 + k]; }
#pragma unroll
            for (int i = 0; i < 8; ++i) { const size_t un = (size_t)bh * 128 + c0 + i; p.ST[un * 16384 + vk] = f2bf(S); S = dd[i] * S + uu[i]; }
        }
        p.hgrn_prompt[((size_t)bh * 128 + k) * 128 + v] = S;
    }
}
DI void hgrn_b3_unit(const Params& p, int u, char* lds) {
    float* bs = (float*)lds;
    float* tot = (float*)(lds + 32768);
    bf16_t* QH = (bf16_t*)(lds + 36864);
    bf16_t* KH = (bf16_t*)(lds + 36864 + 17408);
    bf16_t* IT = (bf16_t*)(lds + 36864 + 34816);
    bf16_t* AT = (bf16_t*)(lds + 36864 + 34816 + 18432);
    const int tid = TIDX, lane = tid & 63, w = tid >> 6, lr = lane & 15, lg = lane >> 4;
    const int bh = u >> 7, c = u & 127, b = bh >> 3, h = bh & 7;
    const size_t row0 = (size_t)b * SEQ + c * 64;
    hgrn_cumsum(p, row0, h, bs, tot);
    const bf16_t* Q1 = p.H; const bf16_t* KK = p.H + (size_t)MP * DM; const bf16_t* I1 = p.H + (size_t)2 * MP * DM; const bf16_t* G1 = p.H + (size_t)3 * MP * DM;
    {
        const int s = tid >> 3, kc = (tid & 7) * 16;
        const bf16_t* qr = Q1 + (row0 + s) * DM + h * 128 + kc; const bf16_t* kr = KK + (row0 + s) * DM + h * 128 + kc; const bf16_t* ir = I1 + (row0 + s) * DM + h * 128 + kc;
        u32x4 qa = *(const u32x4*)qr, qb = *(const u32x4*)(qr + 8), ka = *(const u32x4*)kr, kb = *(const u32x4*)(kr + 8), ia = *(const u32x4*)ir, ib = *(const u32x4*)(ir + 8);
#pragma unroll
        for (int i = 0; i < 16; ++i) {
            const unsigned qw = (i < 8) ? qa[(i & 7) >> 1] : qb[(i & 7) >> 1]; const unsigned kw = (i < 8) ? ka[(i & 7) >> 1] : kb[(i & 7) >> 1]; const unsigned iw = (i < 8) ? ia[(i & 7) >> 1] : ib[(i & 7) >> 1];
            const float qv = (i & 1) ? bfhi(qw) : bflo(qw); const float kv = (i & 1) ? bfhi(kw) : bflo(kw);
            const float bb = bs[s * 128 + kc + i];
            QH[s * HG_FS + kc + i] = f2bf(qv * __expf(bb));
            KH[s * HG_FS + kc + i] = f2bf(kv * __expf(fminf(-bb, 80.f)));
            IT[(kc + i) * HG_TS + s] = (bf16_t)((i & 1) ? (iw >> 16) : (iw & 0xffffu));
        }
    }
    __syncthreads();
    {
        const int tt = w & 3;
#pragma unroll
        for (int si = 0; si < 2; ++si) {
            const int stile = (w >> 2) * 2 + si;
            f32x4 a = {0.f, 0.f, 0.f, 0.f};
            if (stile <= tt) {
#pragma unroll
                for (int ks = 0; ks < 4; ++ks) {
                    const bf16x8 af = *(const bf16x8*)(KH + (stile * 16 + lr) * HG_FS + ks * 32 + lg * 8);
                    const bf16x8 bfr = *(const bf16x8*)(QH + (tt * 16 + lr) * HG_FS + ks * 32 + lg * 8);
                    a = MFMA16(af, bfr, a);
                }
            }
            const int t = tt * 16 + lr;
#pragma unroll
            for (int r = 0; r < 4; ++r) { const int s = stile * 16 + 4 * lg + r; if (s > t) a[r] = 0.f; }
            store_bf4(AT + t * HG_TS + stile * 16 + 4 * lg, a);
        }
    }
    __syncthreads();
    const int tt = w & 3;
    f32x4 acc[4];
#pragma unroll
    for (int j = 0; j < 4; ++j) acc[j] = (f32x4){0.f, 0.f, 0.f, 0.f};
#pragma unroll
    for (int ks = 0; ks < 2; ++ks) {
        const bf16x8 bfr = *(const bf16x8*)(AT + (tt * 16 + lr) * HG_TS + ks * 32 + lg * 8);
#pragma unroll
        for (int j = 0; j < 4; ++j) { const int vt = (w >> 2) * 4 + j; const bf16x8 af = *(const bf16x8*)(IT + (vt * 16 + lr) * HG_TS + ks * 32 + lg * 8); acc[j] = MFMA16(af, bfr, acc[j]); }
    }
    const bf16_t* STu = p.ST + (size_t)u * 16384;
#pragma unroll
    for (int ks = 0; ks < 4; ++ks) {
        const bf16x8 bfr = *(const bf16x8*)(QH + (tt * 16 + lr) * HG_FS + ks * 32 + lg * 8);
#pragma unroll
        for (int j = 0; j < 4; ++j) { const int vt = (w >> 2) * 4 + j; const bf16x8 af = *(const bf16x8*)(STu + (vt * 16 + lr) * 128 + ks * 32 + lg * 8); acc[j] = MFMA16(af, bfr, acc[j]); }
    }
    float ss = 0.f;
#pragma unroll
    for (int j = 0; j < 4; ++j)
#pragma unroll
        for (int r = 0; r < 4; ++r) ss += acc[j][r] * acc[j][r];
    ss += __shfl_xor(ss, 16, 64); ss += __shfl_xor(ss, 32, 64);
    float* red = tot;
    if (lg == 0) red[(w >> 2) * 64 + tt * 16 + lr] = ss;
    __syncthreads();
    const float rs = rsqrtf((red[tt * 16 + lr] + red[64 + tt * 16 + lr]) * (1.f / 128.f) + RMS_EPS);
    const size_t row = row0 + tt * 16 + lr;
#pragma unroll
    for (int j = 0; j < 4; ++j) {
        const int col = h * 128 + ((w >> 2) * 4 + j) * 16 + 4 * lg;
        const u32x2 gw = *(const u32x2*)(G1 + row * DM + col);
        const f32x4 ng = *(const f32x4*)(p.hgrn_norm_g + col);
        f32x4 o;
        const float gg[4] = {bflo(gw[0]), bfhi(gw[0]), bflo(gw[1]), bfhi(gw[1])};
#pragma unroll
        for (int r = 0; r < 4; ++r) o[r] = acc[j][r] * rs * ng[r] * (gg[r] * sigmoidf_(gg[r]));
        store_bf4(p.MIX + row * DM + col, o);
    }
    __syncthreads();
}
DI void hgrn_sample_unit(const Params& p, int u, char* lds) {
    float* part = (float*)lds;
    float* red = part + 512;
    const int tid = TIDX, lane = tid & 63, w = tid >> 6;
    const int b = u >> 3, h = u & 7; const size_t row = (size_t)TP + b;
    const bf16_t* Q1 = p.H; const bf16_t* KK = p.H + (size_t)MP * DM; const bf16_t* I1 = p.H + (size_t)2 * MP * DM; const bf16_t* G1 = p.H + (size_t)3 * MP * DM;
    const int v = tid & 127, kq = tid >> 7;
    const float iv = bf2f(I1[row * DM + h * 128 + v]);
    float acc = 0.f;
    const float* S0 = p.state_hgrn + (size_t)u * 16384; float* S1 = p.hgrn_sample + (size_t)u * 16384;
#pragma unroll 8
    for (int kk = 0; kk < 32; ++kk) {
        const int k = kq * 32 + kk;
        const float f = __expf(p.LF[row * DM + h * 128 + k]);
        const float kv = bf2f(KK[row * DM + h * 128 + k]);
        const float q = bf2f(Q1[row * DM + h * 128 + k]);
        const float st = f * S0[k * 128 + v] + kv * iv;
        S1[k * 128 + v] = st; acc += q * st;
    }
    part[kq * 128 + v] = acc;
    __syncthreads();
    float o = 0.f, sq = 0.f;
    if (tid < 128) { o = part[tid] + part[128 + tid] + part[256 + tid] + part[384 + tid]; sq = o * o; }
    sq = wave_sum(sq); if (lane == 0) red[w] = sq;
    __syncthreads();
    if (tid < 128) {
        const float rs = rsqrtf((red[0] + red[1]) * (1.f / 128.f) + RMS_EPS);
        const float g = bf2f(G1[row * DM + h * 128 + tid]);
        p.MIX[row * DM + h * 128 + tid] = f2bf(o * rs * p.hgrn_norm_g[h * 128 + tid] * (g * sigmoidf_(g)));
    }
    __syncthreads();
}

constexpr int LDS_BAR = 135168;
constexpr int LDS_BYTES = LDS_BAR + 256;

template <int LAYER> DI void peer_phases(const Params& p, char* lds, int bid, int nb, const XcdBarrier& bar) {
    REPEAT(REP_GEMM) {
        EpiBf16 epi{p.QH, 2048};
        gemm_big(p.XB, p.WT_WQ + (size_t)LAYER * 2048 * 1024, 2048, epi, lds, bid, nb);
    }
    xcd_barrier(bar);
    REPEAT(REP_GEMM) {
        GemmArgs g{p.QH, 2048, p.KB + (size_t)LAYER * 2048 * 128, 128, 128, 1};
        EpiF32 epi{p.S, 2048};
        gemm_phase(g, MP, 2048, epi, lds, bid, nb);
    }
    xcd_barrier(bar);
    REPEAT(REP_TOPK) for (int u = bid; u < (TT + 31) / 32; u += nb) peer_topk_unit(p, u, lds);
    xcd_barrier(bar);
    REPEAT(LAYER == 1 ? REP_PEER1 : 1) peer_expert_phase(p, LAYER, lds, bid, nb, LAYER == 1);
}

__global__ void __launch_bounds__(NT, 2) mega(Params p) {
    extern __shared__ __attribute__((aligned(16))) char lds[];
    const int bid = blockIdx.x, nb = gridDim.x;
    if (TIDX == 0) *(uint4*)(lds + LDS_BAR) = make_uint4(0u, 0u, 0u, 0u);
    __syncthreads();
    XcdBarrier bar = xcd_barrier_post(p.bar, (volatile LAS unsigned*)(lds + LDS_BAR));
    REPEAT(REP_PRO) {
    for (int u = bid; u < 16 * 40; u += nb) transpose_unit(p.w_in_even, 1024, 2560, p.WT_IN_EVEN, u, lds);
    for (int u = bid; u < 16 * 16; u += nb) transpose_unit(p.w_out_even, 1024, 1024, p.WT_OUT_EVEN, u, lds);
    for (int u = bid; u < 16 * 64; u += nb) transpose_unit(p.w_in_odd, 1024, 4096, p.WT_IN_ODD, u, lds);
    for (int u = bid; u < 16 * 16; u += nb) transpose_unit(p.w_out_odd, 1024, 1024, p.WT_OUT_ODD, u, lds);
    for (int u = bid; u < 16 * 32; u += nb) transpose_unit(p.peer_wq, 1024, 2048, p.WT_WQ, u, lds);
    for (int u = bid; u < 16 * 32; u += nb) transpose_unit(p.peer_wq + (size_t)1024 * 2048, 1024, 2048, p.WT_WQ + (size_t)2048 * 1024, u, lds);
    convert_x(p, bid, nb);
    convert_keys(p, bid, nb);
    quant_rows<0>(p.peer_u, p.U8, p.SU, 2 * 16384, bid, nb);
    quant_rows_fp8(p.peer_v, p.V8, p.SV, 2 * 16384, bid, nb);
    for (int u = bid; u < 1024; u += nb) kmean_sample_unit(p, u);
    }
    xcd_barrier(bar);
    REPEAT(REP_GEMM) {
        EpiInEven epi{p.H, p.y_prompt, p.VT};
        gemm_big(p.XB, p.WT_IN_EVEN, 2560, epi, lds, bid, nb);
    }
    xcd_barrier(bar);
    REPEAT(REP_CONV) {
    for (int u = bid; u < 512; u += nb) kmean_prompt_unit(p, u);
    for (int u = bid; u < 544; u += nb) conv_unit(p, u, lds);
    }
    xcd_barrier(bar);
    REPEAT(REP_MOBAP) for (int u = bid; u < 512; u += nb) { const int bh = (u & 255) >> 4, i = u & 15; const int blk = (u < 256) ? i : 31 - i; moba_prompt_unit(p, bh, blk, lds); }
    REPEAT(REP_MOBAS) for (int u = bid; u < 256; u += nb) moba_sample_unit(p, u, lds);
    xcd_barrier(bar);
    REPEAT(REP_GEMM) {
        EpiResid epi{p.T, p.XF};
        gemm_big(p.MIX, p.WT_OUT_EVEN, 1024, epi, lds, bid, nb);
    }
    xcd_barrier(bar);
    ln_rows(p, p.ln_g, p.ln_b, bid, nb, false);
    xcd_barrier(bar);
    peer_phases<0>(p, lds, bid, nb, bar);
    xcd_barrier(bar);
    REPEAT(REP_GEMM) {
        EpiInOdd epi{p.H, p.LF, p.LB};
        gemm_big(p.XB, p.WT_IN_ODD, 4096, epi, lds, bid, nb);
    }
    xcd_barrier(bar);
    REPEAT(REP_HGRN) for (int u = bid; u < 2048 + 256; u += nb) { if (u < 2048) hgrn_b1_unit(p, u, lds); else hgrn_sample_unit(p, u - 2048, lds); }
    xcd_barrier(bar);
    REPEAT(REP_HGRN) hgrn_b2(p, bid, nb);
    xcd_barrier(bar);
    REPEAT(REP_HGRN) for (int u = bid; u < 2048; u += nb) hgrn_b3_unit(p, u, lds);
    xcd_barrier(bar);
    REPEAT(REP_GEMM) {
        EpiResid epi{p.T, p.XF};
        gemm_big(p.MIX, p.WT_OUT_ODD, 1024, epi, lds, bid, nb);
    }
    xcd_barrier(bar);
    ln_rows(p, p.ln_g + 2 * DM, p.ln_b + 2 * DM, bid, nb, false);
    xcd_barrier(bar);
    peer_phases<1>(p, lds, bid, nb, bar);
}

extern "C" void kernel_launch(void* const* d_in, const int* in_sizes, int n_in, void* d_out, int out_size, void* d_ws, size_t ws_size, hipStream_t stream) {
    Params p{};
    p.x_prompt = (const float*)d_in[0]; p.x_sample = (const float*)d_in[1]; p.cache_k = (const float*)d_in[2]; p.cache_v = (const float*)d_in[3];
    p.state_conv = (const float*)d_in[4]; p.state_hgrn = (const float*)d_in[5]; p.page_table = (const int*)d_in[6];
    p.w_in_even = (const float*)d_in[7]; p.conv_w = (const float*)d_in[8]; p.conv_b = (const float*)d_in[9]; p.conv_ln_g = (const float*)d_in[10]; p.conv_ln_b = (const float*)d_in[11];
    p.w_out_even = (const float*)d_in[12]; p.w_in_odd = (const float*)d_in[13]; p.lb_logits = (const float*)d_in[14]; p.hgrn_norm_g = (const float*)d_in[15]; p.w_out_odd = (const float*)d_in[16];
    p.ln_g = (const float*)d_in[17]; p.ln_b = (const float*)d_in[18]; p.peer_wq = (const float*)d_in[19]; p.peer_keys = (const float*)d_in[20]; p.peer_u = (const float*)d_in[21]; p.peer_v = (const float*)d_in[22];
    float* o = (float*)d_out;
    p.y_prompt = o; o += (size_t)TP * DM; p.y_sample = o; o += (size_t)TS * DM;
    p.k_prompt = o; o += (size_t)TP * 512; p.v_prompt = o; o += (size_t)TP * 512; p.k_sample = o; o += (size_t)TS * 512; p.v_sample = o; o += (size_t)TS * 512;
    p.conv_prompt = o; o += 2 * 30 * 512; p.conv_sample = o; o += 32 * 30 * 512; p.hgrn_prompt = o; o += 2 * 8 * 128 * 128; p.hgrn_sample = o;
    char* ws = (char*)d_ws; size_t off = 0;
    auto take = [&](size_t bytes) { char* r = ws + off; off += (bytes + 255) & ~(size_t)255; return r; };
    p.bar = (unsigned*)take(16384); p.LB = (float*)take(4096);
    p.WT_IN_EVEN = (bf16_t*)take((size_t)2560 * 1024 * 2); p.WT_OUT_EVEN = (bf16_t*)take((size_t)1024 * 1024 * 2);
    p.WT_IN_ODD = (bf16_t*)take((size_t)4096 * 1024 * 2); p.WT_OUT_ODD = (bf16_t*)take((size_t)1024 * 1024 * 2);
    p.WT_WQ = (bf16_t*)take((size_t)2 * 2048 * 1024 * 2); p.KB = (bf16_t*)take((size_t)2 * 2048 * 128 * 2);
    p.U8 = (unsigned char*)take((size_t)2 * 16384 * DM); p.V8 = (unsigned char*)take((size_t)2 * 16384 * DM); p.SU = (float*)take(2 * 16384 * 4); p.SV = (float*)take(2 * 16384 * 4);
    p.XB = (bf16_t*)take((size_t)MP * DM * 2); p.XF = (float*)take((size_t)MP * DM * 4);
    p.H = (bf16_t*)take((size_t)MP * 4096 * 2); p.LF = (float*)take((size_t)MP * DM * 4);
    p.VT = (bf16_t*)take((size_t)16 * 64 * 8192 * 2); p.KMPP = (float*)take((size_t)512 * 512 * 4); p.KMS = (bf16_t*)take((size_t)1024 * 512 * 2);
    p.MIX = (bf16_t*)take((size_t)MP * DM * 2); p.T = (float*)take((size_t)MP * DM * 4);
    p.QH = (bf16_t*)take((size_t)MP * 2048 * 2); p.S = (float*)take((size_t)MP * 2048 * 4);
    p.E = (int*)take((size_t)MP * 128 * 4); p.G = (float*)take((size_t)MP * 128 * 4);
    p.UT = (float*)take((size_t)2048 * 16384 * 4); p.DEC = (float*)take((size_t)2048 * 128 * 4); p.ST = (bf16_t*)take((size_t)2048 * 16384 * 2);
    if (off > ws_size) { fprintf(stderr, "workspace too small: need %zu have %zu\n", off, ws_size); return; }

    static int grid = 0;
    if (!grid) {
        int dev = 0, cus = 0, per_cu = 0;
        (void)hipGetDevice(&dev);
        (void)hipDeviceGetAttribute(&cus, hipDeviceAttributeMultiprocessorCount, dev);
        (void)hipFuncSetAttribute((const void*)mega, hipFuncAttributeMaxDynamicSharedMemorySize, LDS_BYTES);
        (void)hipOccupancyMaxActiveBlocksPerMultiprocessor(&per_cu, (const void*)mega, NT, LDS_BYTES);
        grid = cus * (per_cu < 1 ? per_cu : 1);
        if (grid <= 0) { fprintf(stderr, "mega kernel not resident: cus %d per_cu %d\n", cus, per_cu); grid = 0; return; }
    }
    (void)hipMemsetAsync(p.bar, 0, XCD_BAR_WORDS * sizeof(unsigned), stream);
    hipLaunchKernelGGL(mega, dim3(grid), dim3(NT), LDS_BYTES, stream, p);
}
```

```cpp
#include <hip/hip_runtime.h>
#include <stdint.h>
#include <stdio.h>

#define DI __device__ __forceinline__
__device__ __forceinline__ int tid_opaque() { int t = threadIdx.x; asm volatile("" : "+v"(t)); return t; }
#define TIDX tid_opaque()
typedef unsigned short bf16_t;
typedef short bf16x8 __attribute__((ext_vector_type(8)));
typedef float f32x4 __attribute__((ext_vector_type(4)));
typedef unsigned u32x4 __attribute__((ext_vector_type(4)));
typedef unsigned u32x2 __attribute__((ext_vector_type(2)));
typedef int i32x4 __attribute__((ext_vector_type(4)));
typedef float f32x2 __attribute__((ext_vector_type(2)));

constexpr int NT = 512;
constexpr int TP = 16384, TS = 32, TT = TP + TS, MP = 16640, DM = 1024, SEQ = 8192;
constexpr float DN_ALPHA = 1.4142135623730951f;
constexpr float LN_EPS = 1e-5f, RMS_EPS = 1e-6f;
constexpr size_t OFF_KP = (size_t)TT * DM, OFF_VP = OFF_KP + (size_t)TP * 512, OFF_KS = OFF_VP + (size_t)TP * 512, OFF_VS = OFF_KS + (size_t)TS * 512;

DI float bf2f(bf16_t h) { return __uint_as_float(((unsigned)h) << 16); }
typedef __bf16 bf16x2_t __attribute__((ext_vector_type(2)));
DI unsigned pack_bf2(float lo, float hi) { bf16x2_t v; v[0] = (__bf16)lo; v[1] = (__bf16)hi; return __builtin_bit_cast(unsigned, v); }
DI bf16_t f2bf(float x) { return (bf16_t)(pack_bf2(x, 0.f) & 0xffffu); }
DI float bflo(unsigned u) { return __uint_as_float(u << 16); }
DI float bfhi(unsigned u) { return __uint_as_float(u & 0xffff0000u); }
DI float sigmoidf_(float x) { return 1.f / (1.f + __expf(-x)); }
DI float wave_sum(float v) {
#pragma unroll
    for (int o = 32; o >= 1; o >>= 1) v += __shfl_xor(v, o, 64);
    return v;
}
DI float wave_max(float v) {
#pragma unroll
    for (int o = 32; o >= 1; o >>= 1) v = fmaxf(v, __shfl_xor(v, o, 64));
    return v;
}

DI float red_max_16_32(float x) {
    u32x2 r = __builtin_amdgcn_permlane16_swap(__float_as_uint(x), __float_as_uint(x), false, false);
    x = fmaxf(__uint_as_float(r[0]), __uint_as_float(r[1]));
    r = __builtin_amdgcn_permlane32_swap(__float_as_uint(x), __float_as_uint(x), false, false);
    return fmaxf(__uint_as_float(r[0]), __uint_as_float(r[1]));
}
DI float red_sum_16_32(float x) {
    u32x2 r = __builtin_amdgcn_permlane16_swap(__float_as_uint(x), __float_as_uint(x), false, false);
    x = __uint_as_float(r[0]) + __uint_as_float(r[1]);
    r = __builtin_amdgcn_permlane32_swap(__float_as_uint(x), __float_as_uint(x), false, false);
    return __uint_as_float(r[0]) + __uint_as_float(r[1]);
}
#define MFMA16(a, b, c) __builtin_amdgcn_mfma_f32_16x16x32_bf16((a), (b), (c), 0, 0, 0)

#ifndef REP_PRO
#define REP_PRO 1
#endif
#ifndef REP_GEMM
#define REP_GEMM 1
#endif
#ifndef REP_CONV
#define REP_CONV 1
#endif
#ifndef REP_MOBAP
#define REP_MOBAP 1
#endif
#ifndef REP_MOBAS
#define REP_MOBAS 1
#endif
#ifndef REP_TOPK
#define REP_TOPK 1
#endif
#ifndef REP_PEER1
#define REP_PEER1 1
#endif
#ifndef REP_USW
#define REP_USW 1
#endif
#ifndef REP_VSW
#define REP_VSW 1
#endif
#ifndef REP_HGRN
#define REP_HGRN 1
#endif
#define REPEAT(N) _Pragma("unroll 1") for (int rep_ = 0; rep_ < (N); ++rep_)
struct Params {
    const float* x_prompt; const float* x_sample; const float* cache_k; const float* cache_v;
    const float* state_conv; const float* state_hgrn; const int* page_table;
    const float* w_in_even; const float* conv_w; const float* conv_b; const float* conv_ln_g; const float* conv_ln_b;
    const float* w_out_even; const float* w_in_odd; const float* lb_logits; const float* hgrn_norm_g; const float* w_out_odd;
    const float* ln_g; const float* ln_b; const float* peer_wq; const float* peer_keys; const float* peer_u; const float* peer_v;
    float* y_prompt; float* y_sample; float* k_prompt; float* v_prompt; float* k_sample; float* v_sample;
    float* conv_prompt; float* conv_sample; float* hgrn_prompt; float* hgrn_sample;
    unsigned* bar; float* LB;
    bf16_t* WT_IN_EVEN; bf16_t* WT_OUT_EVEN; bf16_t* WT_IN_ODD; bf16_t* WT_OUT_ODD; bf16_t* WT_WQ; bf16_t* KB;
    unsigned char* U8; unsigned char* V8; float* SU; float* SV;
    bf16_t* XB; float* XF; bf16_t* H; float* LF; bf16_t* VT; float* KMPP; bf16_t* KMS;
    bf16_t* MIX; float* T; bf16_t* QH; float* S; int* E; float* G;
    float* UT; float* DEC; bf16_t* ST;
};


#define XB_TMO      128
#define XB_XCNT(j)  (256  + 64 * (j))
#define XB_XSUB(j)  (1280 + 64 * (j))
#define XB_XGEN(j)  (2304 + 64 * (j))
#define XB_TOP      3328
#define XB_TOPGEN   3392
#define XCD_BAR_WORDS 3456
#define XB_SPIN_CAP (1u << 18)
#define LAS __attribute__((address_space(3)))
__device__ __forceinline__ unsigned xb_ld(unsigned* p)              { return __hip_atomic_load(p, __ATOMIC_RELAXED, __HIP_MEMORY_SCOPE_AGENT); }
__device__ __forceinline__ unsigned xb_add(unsigned* p, unsigned v) { return __hip_atomic_fetch_add(p, v, __ATOMIC_RELAXED, __HIP_MEMORY_SCOPE_AGENT); }
__device__ __forceinline__ unsigned xb_xcc_id() { return (unsigned)__builtin_amdgcn_s_getreg((3 << 11) | 20) & 0xFu; }
#define XB_SPIN(cond, bar) do { unsigned _sp = 0; while (cond) { __builtin_amdgcn_s_sleep(1); \
    if ((++_sp & 255u) == 0u) { if (xb_ld(&(bar)[XB_TMO])) break; if (_sp > XB_SPIN_CAP) { atomicAdd(&(bar)[XB_TMO], 1u); break; } } } } while (0)
struct XcdBarrier { unsigned* bar; unsigned x; volatile LAS unsigned* st; };
__device__ __forceinline__ XcdBarrier xcd_barrier_post(unsigned* bar, volatile LAS unsigned* st) {
    XcdBarrier b; b.bar = bar; b.x = xb_xcc_id(); b.st = st;
    if (threadIdx.x == 0) (void)xb_add(&bar[XB_XCNT(b.x)], 1u);
    return b;
}
__device__ __forceinline__ void xcd_barrier_complete(unsigned* bar, unsigned x, unsigned& nloc, unsigned& nx) {
    const unsigned G = gridDim.x * gridDim.y * gridDim.z;
    unsigned sum, cnt, mine, sp = 0u;
    for (;;) {
        sum = 0u; cnt = 0u; mine = 0u;
#pragma unroll
        for (unsigned j = 0; j < 16; ++j) { const unsigned c = xb_ld(&bar[XB_XCNT(j)]); sum += c; cnt += (c > 0u) ? 1u : 0u; mine = (j == x) ? c : mine; }
        if (sum == G) break;
        __builtin_amdgcn_s_sleep(1);
        if ((++sp & 255u) == 0u) { if (xb_ld(&bar[XB_TMO])) break; if (sp > XB_SPIN_CAP) { atomicAdd(&bar[XB_TMO], 1u); break; } }
    }
    nloc = mine > 0u ? mine : 1u; nx = cnt > 0u ? cnt : 1u;
}
__device__ __forceinline__ void xcd_barrier(const XcdBarrier& b) {
    asm volatile("s_waitcnt vmcnt(0)" ::: "memory");
    __syncthreads();
    if (threadIdx.x == 0) {
        unsigned* bar = b.bar;
        __builtin_amdgcn_s_waitcnt(0);
        unsigned nloc = b.st[0], nx = b.st[1];
        if (nloc == 0u) { xcd_barrier_complete(bar, b.x, nloc, nx); b.st[0] = nloc; b.st[1] = nx; }
        const unsigned old = xb_add(&bar[XB_XSUB(b.x)], 1u);
        const unsigned gen = old / nloc;
        if (old + 1u == (gen + 1u) * nloc) {
            __builtin_amdgcn_fence(__ATOMIC_RELEASE, "agent");
            asm volatile("s_waitcnt vmcnt(0)" ::: "memory");
            const unsigned og = xb_add(&bar[XB_TOP], 1u);
            const unsigned tg = og / nx;
            if (og + 1u == (tg + 1u) * nx) xb_add(&bar[XB_TOPGEN], 1u);
            else XB_SPIN(xb_ld(&bar[XB_TOPGEN]) == tg, bar);
            __builtin_amdgcn_fence(__ATOMIC_ACQUIRE, "agent");
            xb_add(&bar[XB_XGEN(b.x)], 1u);
            asm volatile("s_waitcnt vmcnt(0)" ::: "memory");
        } else {
            XB_SPIN(xb_ld(&bar[XB_XGEN(b.x)]) == gen, bar);
            __builtin_amdgcn_fence(__ATOMIC_ACQUIRE, "agent");
            asm volatile("s_waitcnt vmcnt(0)" ::: "memory");
        }
    }
    __syncthreads();
}

DI void transpose_unit(const float* __restrict__ W, int K, int N, bf16_t* __restrict__ Wt, int u, char* lds) {
    float* tile = (float*)lds;
    const int tid = TIDX;
    const int ntn = N >> 6; const int kt = u / ntn, nt = u % ntn;
#pragma unroll
    for (int i = 0; i < 8; ++i) { int idx = tid + NT * i; int r = idx >> 6, c = idx & 63; tile[r * 65 + c] = W[(size_t)(kt * 64 + r) * N + nt * 64 + c]; }
    __syncthreads();
#pragma unroll
    for (int i = 0; i < 8; ++i) { int idx = tid + NT * i; int r = idx >> 6, c = idx & 63; Wt[(size_t)(nt * 64 + r) * K + kt * 64 + c] = f2bf(tile[c * 65 + r]); }
    __syncthreads();
}
DI void convert_range(const float* __restrict__ src, bf16_t* __restrict__ dst, size_t n4, int bid, int nb) {
    for (size_t i = (size_t)bid * NT + TIDX; i < n4; i += (size_t)nb * NT) {
        f32x4 v = *(const f32x4*)(src + 4 * i);
        u32x2 o; o[0] = pack_bf2(v[0], v[1]); o[1] = pack_bf2(v[2], v[3]);
        *(u32x2*)(dst + 4 * i) = o;
    }
}

template <int OFFS> DI void quant_rows(const float* __restrict__ src, unsigned char* __restrict__ dst, float* __restrict__ inv, int R, int bid, int nb) {
    const int lane = TIDX & 63, w = TIDX >> 6;
#pragma unroll 2
    for (int row = bid * 8 + w; row < R; row += nb * 8) {
        f32x4 v[4]; float am = 0.f;
#pragma unroll
        for (int i = 0; i < 4; ++i) { v[i] = *(const f32x4*)(src + (size_t)row * DM + 4 * lane + 256 * i); am = fmaxf(am, fmaxf(fmaxf(fabsf(v[i][0]), fabsf(v[i][1])), fmaxf(fabsf(v[i][2]), fabsf(v[i][3])))); }
        am = wave_max(am);
        const float sc = am > 0.f ? 127.f / am : 0.f;
#pragma unroll
        for (int i = 0; i < 4; ++i) {
            unsigned pk = 0;
#pragma unroll
            for (int k = 0; k < 4; ++k) { const int q = (int)rintf(v[i][k] * sc) + OFFS; pk |= ((unsigned)q & 0xffu) << (8 * k); }
            const int col = 4 * lane + 256 * i;
            *(unsigned*)(dst + (size_t)(row >> 14) * 16384 * DM + (size_t)(col >> 7) * (16384 * 128) + (size_t)(row & 16383) * 128 + (col & 127)) = pk;
        }
        if (lane == 0) inv[row] = am * (1.f / 127.f);
    }
}
DI void quant_rows_fp8(const float* __restrict__ src, unsigned char* __restrict__ dst, float* __restrict__ inv, int R, int bid, int nb) {
    const int lane = TIDX & 63, w = TIDX >> 6;
#pragma unroll 2
    for (int row = bid * 8 + w; row < R; row += nb * 8) {
        f32x4 v[4]; float am = 0.f;
#pragma unroll
        for (int i = 0; i < 4; ++i) { v[i] = *(const f32x4*)(src + (size_t)row * DM + 4 * lane + 256 * i); am = fmaxf(am, fmaxf(fmaxf(fabsf(v[i][0]), fabsf(v[i][1])), fmaxf(fabsf(v[i][2]), fabsf(v[i][3])))); }
        am = wave_max(am);
        const float sc = am > 0.f ? 416.f / am : 0.f;
#pragma unroll
        for (int i = 0; i < 4; ++i) {
            int pk = 0;
            pk = __builtin_amdgcn_cvt_pk_fp8_f32(v[i][0] * sc, v[i][1] * sc, pk, false);
            pk = __builtin_amdgcn_cvt_pk_fp8_f32(v[i][2] * sc, v[i][3] * sc, pk, true);
            const int col = 4 * lane + 256 * i;
            *(int*)(dst + (size_t)(row >> 14) * 16384 * DM + (size_t)(col >> 7) * (16384 * 128) + (size_t)(row & 16383) * 128 + (col & 127)) = pk;
        }
        if (lane == 0) inv[row] = am * (1.f / 416.f);
    }
}
DI void convert_x(const Params& p, int bid, int nb) {
    const size_t n4 = (size_t)MP * DM / 4;
    for (size_t i = (size_t)bid * NT + TIDX; i < n4; i += (size_t)nb * NT) {
        size_t e = 4 * i; int row = (int)(e >> 10); int col = (int)(e & 1023);
        f32x4 v = {0.f, 0.f, 0.f, 0.f};
        if (row < TP) v = *(const f32x4*)(p.x_prompt + e);
        else if (row < TT) v = *(const f32x4*)(p.x_sample + (size_t)(row - TP) * DM + col);
        *(f32x4*)(p.XF + e) = v;
        u32x2 o; o[0] = pack_bf2(v[0], v[1]); o[1] = pack_bf2(v[2], v[3]);
        *(u32x2*)(p.XB + e) = o;
    }
}
DI void convert_keys(const Params& p, int bid, int nb) {
    const int n = 2 * 2 * 8 * 128 * 128;
    for (int i = bid * NT + TIDX; i < n; i += nb * NT) {
        int d = i & 127, nn = (i >> 7) & 127, j = (i >> 14) & 15, l = i >> 18;
        int h = j >> 1, half = j & 1;
        p.KB[i] = f2bf(p.peer_keys[((((size_t)l * 2 + half) * 8 + h) * 128 + nn) * 128 + d]);
    }
    if (bid == 0) for (int c = TIDX; c < 1024; c += NT) p.LB[c] = sigmoidf_(p.lb_logits[1024 + c] - p.lb_logits[c]);
}
DI void kmean_sample_unit(const Params& p, int u, char* lds) {
    float* part = (float*)lds;
    const int tid = TIDX, c4 = tid & 127, rg = tid >> 7;
    const int b = u >> 5, blk = u & 31;
    f32x4 acc = {0.f, 0.f, 0.f, 0.f};
    const int page = p.page_table[b * 64 + blk * 2 + (rg >> 1)];
    const float* src = p.cache_k + ((size_t)page * 128 + (rg & 1) * 64) * 512 + 4 * c4;
#pragma unroll 1
    for (int r0 = 0; r0 < 64; r0 += 8) {
        f32x4 v[8];
#pragma unroll
        for (int i = 0; i < 8; ++i) v[i] = *(const f32x4*)(src + (size_t)(r0 + i) * 512);
#pragma unroll
        for (int i = 0; i < 8; ++i) acc += v[i];
    }
    __syncthreads();
    *(f32x4*)(part + rg * 512 + 4 * c4) = acc;
    __syncthreads();
    { const int c = tid; const float sum = part[c] + part[512 + c] + part[1024 + c] + part[1536 + c]; p.KMS[(size_t)u * 512 + c] = f2bf(sum * (1.f / 256.f)); }
}
DI void kmean_prompt_unit(const Params& p, int u) {
    const int c = TIDX;
    const float* src = p.k_prompt + (size_t)u * 32 * 512 + c;
    float acc = 0.f;
#pragma unroll
    for (int r = 0; r < 32; ++r) acc += src[(size_t)r * 512];
    p.KMPP[(size_t)u * 512 + c] = acc;
}

struct GemmArgs { const bf16_t* A; int lda; const bf16_t* Bt; int ldb; int K; int blockdiag; };
constexpr int GEMM_LDS = 2 * 49152;

template <class Epi>
DI void gemm_unit(const GemmArgs g, int m0, int n0, const Epi epi, char* lds) {
    const int tid = TIDX, lane = tid & 63, w = tid >> 6;
    const int wm = w & 3, wn = w >> 2, lr = lane & 15, lg = lane >> 4;
    const int acol = g.blockdiag ? n0 : 0;
    const int nk = g.K >> 6;
    f32x4 acc[4][4];
#pragma unroll
    for (int i = 0; i < 4; ++i)
#pragma unroll
        for (int j = 0; j < 4; ++j) acc[i][j] = (f32x4){0.f, 0.f, 0.f, 0.f};
    u32x4 ra[4], rb[2];
    auto gload = [&](int kt) {
#pragma unroll
        for (int i = 0; i < 4; ++i) { int id = tid + NT * i; int r = id >> 3, c = id & 7; ra[i] = *(const u32x4*)(g.A + (size_t)(m0 + r) * g.lda + acol + kt * 64 + c * 8); }
#pragma unroll
        for (int i = 0; i < 2; ++i) { int id = tid + NT * i; int r = id >> 3, c = id & 7; rb[i] = *(const u32x4*)(g.Bt + (size_t)(n0 + r) * g.ldb + kt * 64 + c * 8); }
    };
    auto sstore = [&](int st) {
        char* base = lds + st * 49152;
#pragma unroll
        for (int i = 0; i < 4; ++i) { int id = tid + NT * i; int r = id >> 3, c = id & 7; *(u32x4*)(base + r * 128 + ((c ^ (r & 7)) << 4)) = ra[i]; }
#pragma unroll
        for (int i = 0; i < 2; ++i) { int id = tid + NT * i; int r = id >> 3, c = id & 7; *(u32x4*)(base + 32768 + r * 128 + ((c ^ (r & 7)) << 4)) = rb[i]; }
    };
    gload(0); sstore(0); __syncthreads();
    for (int kt = 0; kt < nk; ++kt) {
        if (kt + 1 < nk) gload(kt + 1);
        const char* base = lds + (kt & 1) * 49152;
#pragma unroll
        for (int ks = 0; ks < 2; ++ks) {
            bf16x8 af[4], bfr[4];
#pragma unroll
            for (int i = 0; i < 4; ++i) { int r = wm * 64 + i * 16 + lr; int ch = ks * 4 + lg; af[i] = *(const bf16x8*)(base + r * 128 + ((ch ^ (r & 7)) << 4)); }
#pragma unroll
            for (int i = 0; i < 4; ++i) { int r = wn * 64 + i * 16 + lr; int ch = ks * 4 + lg; bfr[i] = *(const bf16x8*)(base + 32768 + r * 128 + ((ch ^ (r & 7)) << 4)); }
#pragma unroll
            for (int i = 0; i < 4; ++i)
#pragma unroll
                for (int j = 0; j < 4; ++j) acc[i][j] = MFMA16(bfr[j], af[i], acc[i][j]);
        }
        if (kt + 1 < nk) sstore((kt + 1) & 1);
        __syncthreads();
    }
#pragma unroll
    for (int i = 0; i < 4; ++i)
#pragma unroll
        for (int j = 0; j < 4; ++j) epi(m0 + wm * 64 + i * 16 + lr, n0 + wn * 64 + j * 16 + 4 * lg, acc[i][j]);
}

template <class Epi>
DI void gemm_phase(const GemmArgs g, int M, int N, const Epi epi, char* lds, int bid, int nb) {
    const int tn = N >> 7, tm = M >> 8;
    for (int u = bid; u < tm * tn; u += nb) { int mt = u / tn, nt = u % tn; gemm_unit(g, mt * 256, nt * 128, epi, lds); }
}

DI void store_bf4(bf16_t* dst, f32x4 v) { u32x2 o; o[0] = pack_bf2(v[0], v[1]); o[1] = pack_bf2(v[2], v[3]); *(u32x2*)dst = o; }

struct EpiInEven {
    bf16_t* H; float* out; bf16_t* VT;
    DI void operator()(int row, int col, f32x4 v) const {
        store_bf4(H + (size_t)row * 2560 + col, v);
        if (col >= 512 && col < 1536 && row < TT) {
            const bool isv = col >= 1024; const int c = col - (isv ? 1024 : 512);
            const size_t off = row < TP ? (isv ? OFF_VP : OFF_KP) + (size_t)row * 512 + c : (isv ? OFF_VS : OFF_KS) + (size_t)(row - TP) * 512 + c;
            *(f32x4*)(out + off) = v;
            if (isv && row < TP) {
                const int b = row >> 13, s = row & 8191, h = c >> 6, d = c & 63;
                bf16_t* vt = VT + ((size_t)(b * 8 + h) * 64 + d) * 8192 + s;
#pragma unroll
                for (int i = 0; i < 4; ++i) vt[(size_t)i * 8192] = f2bf(v[i]);
            }
        }
    }
};
struct EpiBf16 { bf16_t* O; int ld; DI void operator()(int row, int col, f32x4 v) const { store_bf4(O + (size_t)row * ld + col, v); } };
struct EpiF32 { float* O; int ld; DI void operator()(int row, int col, f32x4 v) const { *(f32x4*)(O + (size_t)row * ld + col) = v; } };
struct EpiResid {
    float* T; const float* XF;
    DI void operator()(int row, int col, f32x4 v) const { f32x4 x = *(const f32x4*)(XF + (size_t)row * DM + col); *(f32x4*)(T + (size_t)row * DM + col) = x * DN_ALPHA + v; }
};
struct EpiInOdd {
    bf16_t* H; float* LF; const float* LB;
    DI void operator()(int row, int col, f32x4 v) const {
        const int sec = col >> 10, c = col & 1023;
        if (sec == 1) {
            f32x4 lb = *(const f32x4*)(LB + c); f32x4 lf, kk;
#pragma unroll
            for (int i = 0; i < 4; ++i) { float f = lb[i] + (1.f - lb[i]) * sigmoidf_(v[i]); lf[i] = __logf(f); kk[i] = 1.f - f; }
            *(f32x4*)(LF + (size_t)row * DM + c) = lf;
            store_bf4(H + (size_t)MP * DM + (size_t)row * DM + c, kk);
        } else {
            store_bf4(H + (size_t)sec * MP * DM + (size_t)row * DM + c, v);
        }
    }
};

namespace pg8 {
#define PG8_LAS __attribute__((address_space(3)))
typedef unsigned short bf16_t;
typedef short bf16x8 __attribute__((ext_vector_type(8)));
typedef float f32x4 __attribute__((ext_vector_type(4)));
typedef unsigned u32x4 __attribute__((ext_vector_type(4)));
constexpr int BM = 256, BK = 64, HALF = 128, HTB = HALF * BK * 2  , STAGE_BYTES = 8 * HTB, NXCD = 8, WGM = 8;

__host__ __device__ __forceinline__ int lds_byte(int r, int c) { const int st = (r >> 4) * 2 + (c >> 5), rr = r & 15, cc = c & 31, ob = rr * 64 + cc * 2; return st * 1024 + (ob ^ (((ob >> 9) & 1) << 5)); }
__host__ __device__ __forceinline__ void stage_rc(int b, int& R, int& C) { const int st = b / 1024, sb = b % 1024, swz = sb ^ (((sb >> 9) & 1) << 5); R = (st >> 1) * 16 + swz / 64; C = (st & 1) * 32 + (swz % 64) / 2; }
__host__ __device__ __forceinline__ int perm32(int rho) { const int n = rho >> 4, i = rho & 15; return 8 * (i >> 2) + 4 * n + (i & 3); }

struct Unit { int pm, pn; };
struct Gemm { const bf16_t* A; const bf16_t* Bt; int M, N, K; };

struct StaticOrder {
    int nM, nN, nwg, G, c;
    __host__ __device__ void init(int M, int N, int G_, int c_) { nM = M / BM; nN = N / BM; nwg = nM * nN; G = G_; c = c_; }
    __host__ __device__ bool next(int i, Unit& u) const {
        const long L = (long)i * G + c; if (L >= nwg) return false;
        int wgid = (int)L; { const int q = nwg / NXCD, r = nwg % NXCD, xcd = wgid % NXCD, off = wgid / NXCD; wgid = (xcd < r ? xcd * (q + 1) : r * (q + 1) + (xcd - r) * q) + off; }
        const int nig = WGM * nN, gid = wgid / nig, fm = gid * WGM, gsz = (nM - fm) < WGM ? (nM - fm) : WGM;
        u.pm = fm + ((wgid % nig) % gsz); u.pn = (wgid % nig) / gsz; return true;
    }
    __device__ __forceinline__ void a_ready(const Unit&) const {}
    __device__ __forceinline__ void done(const Unit&) const {}
};

template <class Epi, class Sched, bool STAMP = false>
__device__ __forceinline__ void gemm_phase(PG8_LAS unsigned char* lds, const Gemm g, const Sched& S, const Epi& E, unsigned long long* stamps) {
    const int tid = TIDX, wid = __builtin_amdgcn_readfirstlane(tid >> 6), lane = tid & 63, wr = wid >> 2, wc = wid & 3, fr = lane & 15, fq = lane >> 4;
    const int K = g.K, nt = K / BK;
    int ts_lo = 0, ts_hi = 0, nts = 0; const unsigned long long rt_entry = STAMP ? (unsigned long long)wall_clock64() : 0ull;
#define PG8_STAMP() do { if (STAMP && wid == 0 && nts < 64) { const unsigned long long _c = (unsigned long long)clock64(); \
        ts_lo = (lane == nts) ? (int)(unsigned)_c : ts_lo; ts_hi = (lane == nts) ? (int)(unsigned)(_c >> 32) : ts_hi; ++nts; } } while (0)
    PG8_STAMP();
    unsigned voffA[2], voffB[2];
#pragma unroll
    for (int i = 0; i < 2; ++i) { int R, C; stage_rc(tid * 16 + i * 8192, R, C); const int Rb = Epi::PERM ? ((R & ~31) + perm32(R & 31)) : R;
        voffA[i] = (unsigned)(R * K + C) * 2u; voffB[i] = (unsigned)(Rb * K + C) * 2u; }
    const size_t kstep = (size_t)(BK * 2);
    const size_t hstep = (size_t)HALF * K * 2;
    const size_t tstep = 2 * hstep;
    const unsigned ldsw = (unsigned)wid * 1024u;
    const int aoff = lds_byte(wr * 64 + fr, fq * 8), boff = lds_byte(wc * 32 + fr, fq * 8);
#define PG8_SA(b, h) (((b) * 2 + (h)) * HTB)
#define PG8_SB(b, h) ((4 + (b) * 2 + (h)) * HTB)
#define PG8_STAGE(bufoff, gbase, voff) do { _Pragma("unroll") for (int _i = 0; _i < 2; ++_i) \
        __builtin_amdgcn_global_load_lds((const unsigned*)((const char*)(gbase) + (voff)[_i]), (PG8_LAS unsigned*)(lds + (bufoff) + ldsw + _i * 8192), 16, 0, 0); } while (0)
#define PG8_LDA(dst, b, h) do { _Pragma("unroll") for (int m = 0; m < 4; ++m) _Pragma("unroll") for (int k = 0; k < 2; ++k) dst[m][k] = *(const PG8_LAS bf16x8*)(lds + PG8_SA(b, h) + aoff + m * 2048 + k * 1024); } while (0)
#define PG8_LDB(dst, b, h) do { _Pragma("unroll") for (int n = 0; n < 2; ++n) _Pragma("unroll") for (int k = 0; k < 2; ++k) dst[n][k] = *(const PG8_LAS bf16x8*)(lds + PG8_SB(b, h) + boff + n * 2048 + k * 1024); } while (0)
#define PG8_MMA(ai, bj, At, Bt) do { __builtin_amdgcn_s_setprio(1); _Pragma("unroll") for (int m = 0; m < 4; ++m) _Pragma("unroll") for (int n = 0; n < 2; ++n) _Pragma("unroll") for (int k = 0; k < 2; ++k) \
        acc[ai][bj][m][n] = __builtin_amdgcn_mfma_f32_16x16x32_bf16(Bt[n][k], At[m][k], acc[ai][bj][m][n], 0, 0, 0); __builtin_amdgcn_s_setprio(0); } while (0)
#define PG8_WAIT_V(n) asm volatile("s_waitcnt vmcnt(" #n ")" ::: "memory")
#define PG8_WAIT_L(n) asm volatile("s_waitcnt lgkmcnt(" #n ")" ::: "memory")
#define PG8_BAR __builtin_amdgcn_s_barrier()
#define PG8_SCHED __builtin_amdgcn_sched_barrier(0)
    Unit cur, nxt; int ui = 0;
    if (!S.next(0, cur)) return;
    f32x4 acc[2][2][4][2];
#pragma unroll
    for (int a = 0; a < 2; ++a)
#pragma unroll
        for (int b = 0; b < 2; ++b)
#pragma unroll
            for (int m = 0; m < 4; ++m)
#pragma unroll
                for (int n = 0; n < 2; ++n) acc[a][b][m][n] = (f32x4){0.f, 0.f, 0.f, 0.f};
    bf16x8 At[4][2], B0[2][2], B1[2][2];
    const char* cA = (const char*)g.A + (size_t)cur.pm * tstep; const char* cB = (const char*)g.Bt + (size_t)cur.pn * tstep;
    S.a_ready(cur);
    PG8_STAGE(PG8_SB(0, 0), cB, voffB); PG8_STAGE(PG8_SA(0, 0), cA, voffA); PG8_STAGE(PG8_SB(0, 1), cB + hstep, voffB); PG8_STAGE(PG8_SA(0, 1), cA + hstep, voffA);
    if (wr == 1) PG8_BAR;
    PG8_WAIT_V(4); PG8_BAR;
    PG8_STAGE(PG8_SB(1, 0), cB + kstep, voffB); PG8_STAGE(PG8_SA(1, 0), cA + kstep, voffA); PG8_STAGE(PG8_SB(1, 1), cB + hstep + kstep, voffB);
    PG8_WAIT_V(6); PG8_BAR;
    PG8_STAMP();
    for (;;) {
        const bool has_next = S.next(ui + 1, nxt);
        const char* nA = has_next ? (const char*)g.A + (size_t)nxt.pm * tstep : cA; const char* nB = has_next ? (const char*)g.Bt + (size_t)nxt.pn * tstep : cB;
        for (int t = 0; t < nt; t += 2) {
            const bool last = (t == nt - 2);
            const char* a1 = cA + (size_t)(t + 1) * kstep;
            const char* a2 = last ? nA : cA + (size_t)(t + 2) * kstep; const char* b2 = last ? nB : cB + (size_t)(t + 2) * kstep;
            const char* a3 = a2 + kstep; const char* b3 = b2 + kstep;
            if (last && has_next) S.a_ready(nxt);
            PG8_LDB(B0, 0, 0); PG8_SCHED; PG8_LDA(At, 0, 0); PG8_STAGE(PG8_SA(1, 1), a1 + hstep, voffA);
            PG8_WAIT_L(8); PG8_BAR; PG8_WAIT_L(0); PG8_MMA(0, 0, At, B0); PG8_BAR; PG8_SCHED;
            PG8_LDB(B1, 0, 1); PG8_STAGE(PG8_SB(0, 0), b2, voffB);
            PG8_BAR; PG8_WAIT_L(0); PG8_MMA(0, 1, At, B1); PG8_BAR;
            PG8_LDA(At, 0, 1); PG8_STAGE(PG8_SA(0, 0), a2, voffA);
            PG8_BAR; PG8_WAIT_L(0); PG8_MMA(1, 0, At, B0); PG8_BAR; PG8_SCHED;
            PG8_STAGE(PG8_SB(0, 1), b2 + hstep, voffB);
            PG8_WAIT_V(6); PG8_BAR; PG8_MMA(1, 1, At, B1); PG8_BAR;
            PG8_LDB(B0, 1, 0); PG8_SCHED; PG8_LDA(At, 1, 0); PG8_STAGE(PG8_SA(0, 1), a2 + hstep, voffA);
            PG8_WAIT_L(8); PG8_BAR; PG8_WAIT_L(0); PG8_MMA(0, 0, At, B0); PG8_BAR; PG8_SCHED;
            PG8_LDB(B1, 1, 1); PG8_STAGE(PG8_SB(1, 0), b3, voffB);
            PG8_BAR; PG8_WAIT_L(0); PG8_MMA(0, 1, At, B1); PG8_BAR;
            PG8_LDA(At, 1, 1); PG8_STAGE(PG8_SA(1, 0), a3, voffA);
            PG8_BAR; PG8_WAIT_L(0); PG8_MMA(1, 0, At, B0); PG8_BAR; PG8_SCHED;
            PG8_STAGE(PG8_SB(1, 1), b3 + hstep, voffB);
            PG8_WAIT_V(6); PG8_BAR; PG8_MMA(1, 1, At, B1); PG8_BAR;
        }
        PG8_STAMP();
        if constexpr (!Epi::AFTER_DRAIN) { E(acc, cur, wr, wc, fr, fq); S.done(cur); }
        PG8_STAMP();
        if (!has_next) break;
#pragma unroll
        for (int a = 0; a < 2; ++a)
#pragma unroll
            for (int b = 0; b < 2; ++b)
#pragma unroll
                for (int m = 0; m < 4; ++m)
#pragma unroll
                    for (int n = 0; n < 2; ++n) acc[a][b][m][n] = (f32x4){0.f, 0.f, 0.f, 0.f};
        cur = nxt; cA = nA; cB = nB; ++ui;
    }
    PG8_WAIT_V(0);
    if (wr == 0) PG8_BAR;
    PG8_BAR;
    if constexpr (Epi::AFTER_DRAIN) { E.fused(acc, cur, wr, wc, fr, fq, lds, wid, lane); S.done(cur); }
    PG8_STAMP();
    if (STAMP && wid == 0) { stamps[lane] = lane < nts ? (((unsigned long long)(unsigned)ts_hi << 32) | (unsigned)ts_lo) : 0ull;
        if (lane == 62) stamps[62] = rt_entry; if (lane == 63) stamps[63] = (unsigned long long)wall_clock64(); }
#undef PG8_STAMP
#undef PG8_SA
#undef PG8_SB
#undef PG8_STAGE
#undef PG8_LDA
#undef PG8_LDB
#undef PG8_MMA
#undef PG8_WAIT_V
#undef PG8_WAIT_L
#undef PG8_BAR
#undef PG8_SCHED
}
}

template <class MyEpi> struct Pg8Epi {
    static constexpr bool PERM = false, AFTER_DRAIN = false;
    MyEpi e;
    __device__ __forceinline__ void operator()(const pg8::f32x4 (&acc)[2][2][4][2], const pg8::Unit& u, int wr, int wc, int fr, int fq) const {
#pragma unroll
        for (int ai = 0; ai < 2; ++ai)
#pragma unroll
            for (int m = 0; m < 4; ++m) {
                const int row = u.pm * 256 + ai * 128 + wr * 64 + m * 16 + fr;
#pragma unroll
                for (int bj = 0; bj < 2; ++bj)
#pragma unroll
                    for (int n = 0; n < 2; ++n) e(row, u.pn * 256 + bj * 128 + wc * 32 + n * 16 + 4 * fq, acc[ai][bj][m][n]);
            }
    }
};

template <class E> DI void gemm_small32_unit(const bf16_t* A, int lda, const bf16_t* Bt, int ldb, int K, int m0, int n0, const E epi) {
    const int tid = TIDX, lane = tid & 63, w = tid >> 6, lr = lane & 15, lg = lane >> 4;
    const bf16_t* a0 = A + (size_t)(m0 + lr) * lda + lg * 8; const bf16_t* a1 = a0 + (size_t)16 * lda;
    const bf16_t* b0 = Bt + (size_t)(n0 + w * 16 + lr) * ldb + lg * 8;
    f32x4 acc0 = {0.f, 0.f, 0.f, 0.f}, acc1 = {0.f, 0.f, 0.f, 0.f};
#pragma unroll 2
    for (int k0 = 0; k0 < K; k0 += 128) {
        bf16x8 fa0[4], fa1[4], fb[4];
#pragma unroll
        for (int i = 0; i < 4; ++i) { fa0[i] = *(const bf16x8*)(a0 + k0 + i * 32); fa1[i] = *(const bf16x8*)(a1 + k0 + i * 32); fb[i] = *(const bf16x8*)(b0 + k0 + i * 32); }
#pragma unroll
        for (int i = 0; i < 4; ++i) { acc0 = MFMA16(fb[i], fa0[i], acc0); acc1 = MFMA16(fb[i], fa1[i], acc1); }
    }
    epi(m0 + lr, n0 + w * 16 + 4 * lg, acc0);
    epi(m0 + 16 + lr, n0 + w * 16 + 4 * lg, acc1);
}
template <class E> DI void gemm_big(const bf16_t* A, const bf16_t* Bt, int N, const E epi, char* lds, int bid, int nb) {
    {
        pg8::Gemm g{A, Bt, TP, N, DM};
        pg8::StaticOrder S; S.init(TP, N, nb, bid);
        Pg8Epi<E> pe{epi};
        pg8::gemm_phase<Pg8Epi<E>, pg8::StaticOrder, false>((PG8_LAS unsigned char*)lds, g, S, pe, nullptr);
    }
    __syncthreads();
    for (int u = nb - 1 - bid; u < (N >> 7); u += nb) gemm_small32_unit(A, DM, Bt, DM, DM, TP, u * 128, epi);
}

DI void conv_unit(const Params& p, int u, char* lds) {
    float* sy = (float*)lds;
    const int c = TIDX, lane = c & 63, w = c >> 6;
    float wj[31];
#pragma unroll
    for (int j = 0; j < 31; ++j) wj[j] = p.conv_w[j * 512 + c];
    const float bias = p.conv_b[c];
    int ntok, row0;
    if (u < 512) {
        const int b = u >> 8, t0 = (u & 255) * 32; ntok = 32; row0 = b * SEQ + t0;
        float uu[62];
#pragma unroll
        for (int r = 0; r < 62; ++r) {
            const int t = t0 - 30 + r; float val = 0.f;
            if (t >= 0) { const size_t row = (size_t)b * SEQ + t; float a = bf2f(p.H[row * 2560 + 1536 + c]); float g = bf2f(p.H[row * 2560 + 2048 + c]); val = a * sigmoidf_(g); }
            uu[r] = val;
            if (t0 == SEQ - 32 && r >= 32) p.conv_prompt[((size_t)b * 30 + (r - 32)) * 512 + c] = val;
        }
#pragma unroll
        for (int tt = 0; tt < 32; ++tt) {
            float acc = bias;
#pragma unroll
            for (int j = 0; j < 31; ++j) acc += wj[j] * uu[tt + j];
            sy[tt * 512 + c] = acc;
        }
    } else {
        const int b = u - 512; ntok = 1; row0 = TP + b;
        const size_t row = (size_t)row0;
        float a = bf2f(p.H[row * 2560 + 1536 + c]); float g = bf2f(p.H[row * 2560 + 2048 + c]);
        const float un = a * sigmoidf_(g);
        float acc = bias + wj[30] * un;
#pragma unroll
        for (int j = 0; j < 30; ++j) {
            float e = p.state_conv[((size_t)b * 30 + j) * 512 + c]; acc += wj[j] * e;
            if (j >= 1) p.conv_sample[((size_t)b * 30 + (j - 1)) * 512 + c] = e;
        }
        p.conv_sample[((size_t)b * 30 + 29) * 512 + c] = un;
        sy[c] = acc;
    }
    __syncthreads();
    for (int tt = w; tt < ntok; tt += 8) {
        float v[8]; float s = 0.f;
#pragma unroll
        for (int i = 0; i < 8; ++i) { v[i] = sy[tt * 512 + lane + 64 * i]; s += v[i]; }
        const float mu = wave_sum(s) * (1.f / 512.f);
        float q = 0.f;
#pragma unroll
        for (int i = 0; i < 8; ++i) { float d = v[i] - mu; q += d * d; }
        const float rs = rsqrtf(wave_sum(q) * (1.f / 512.f) + LN_EPS);
#pragma unroll
        for (int i = 0; i < 8; ++i) {
            const int cc = lane + 64 * i;
            float y = (v[i] - mu) * rs * p.conv_ln_g[cc] + p.conv_ln_b[cc];
            y = y * sigmoidf_(y);
            p.MIX[(size_t)(row0 + tt) * DM + 512 + cc] = f2bf(y);
        }
    }
    __syncthreads();
}

constexpr int MB_K = 0, MB_V = 65536, MB_VROW = 528, MB_WOR = 65536 + 2 * 64 * MB_VROW;
constexpr int MB_BGS = MB_WOR + 128, MB_KMS = MB_BGS + 2 * 8192, MB_END = MB_KMS + 8192;
DI void moba_sample_unit(const Params& p, int u, char* lds) {
    float* sq = (float*)lds;
    float* gs = sq + 64;
    int* sel = (int*)(gs + 32);
    float* lg = (float*)(sel + 4);
    float* red = lg + 776;
    unsigned* roff = (unsigned*)(red + 16);
    float* part = (float*)(roff + 776);
    const int tid = TIDX, lane = tid & 63, w = tid >> 6;
    const int b = u >> 3, h = u & 7; const size_t row = (size_t)TP + b;
    __syncthreads();
    if (tid < 64) sq[tid] = bf2f(p.H[row * 2560 + h * 64 + tid]);
    __syncthreads();
    if (tid < 32) { const float* km = (const float*)(lds + MB_KMS) + tid * 64; float s = 0.f;
#pragma unroll 8
        for (int d = 0; d < 64; ++d) s += sq[d] * km[d];
        gs[tid] = s; }
    __syncthreads();
    if (tid == 0) {
        float v0 = -INFINITY, v1 = -INFINITY, v2 = -INFINITY; int i0 = 0, i1 = 0, i2 = 0;
        for (int j = 0; j < 32; ++j) { float s = gs[j];
            if (s > v0) { v2 = v1; i2 = i1; v1 = v0; i1 = i0; v0 = s; i0 = j; }
            else if (s > v1) { v2 = v1; i2 = i1; v1 = s; i1 = j; }
            else if (s > v2) { v2 = s; i2 = j; } }
        sel[0] = i0; sel[1] = i1; sel[2] = i2;
    }
    __syncthreads();
    for (int idx = tid; idx < 769; idx += NT) {
        float s = 0.f;
        if (idx < 768) {
            const int blk = sel[idx >> 8]; const int pos = blk * 256 + (idx & 255);
            const int page = p.page_table[b * 64 + (pos >> 7)];
            const unsigned ro = ((unsigned)page * 128u + (unsigned)(pos & 127)) * 8u + (unsigned)h;
            roff[idx] = ro;
            const float* kp = p.cache_k + (size_t)ro * 64;
            f32x4 kv[16];
#pragma unroll
            for (int d4 = 0; d4 < 16; ++d4) kv[d4] = *(const f32x4*)(kp + 4 * d4);
#pragma unroll
            for (int d4 = 0; d4 < 16; ++d4) s += sq[4 * d4] * kv[d4][0] + sq[4 * d4 + 1] * kv[d4][1] + sq[4 * d4 + 2] * kv[d4][2] + sq[4 * d4 + 3] * kv[d4][3];
        } else {
            const bf16_t* kn = p.H + row * 2560 + 512 + h * 64;
            for (int d = 0; d < 64; ++d) s += sq[d] * bf2f(kn[d]);
        }
        lg[idx] = s * 0.125f;
    }
    __syncthreads();
    float mx = -INFINITY;
    for (int idx = tid; idx < 769; idx += NT) mx = fmaxf(mx, lg[idx]);
    mx = wave_max(mx); if (lane == 0) red[w] = mx;
    __syncthreads();
    mx = red[0];
#pragma unroll
    for (int i = 1; i < 8; ++i) mx = fmaxf(mx, red[i]);
    float sm = 0.f;
    for (int idx = tid; idx < 769; idx += NT) { float e = __expf(lg[idx] - mx); lg[idx] = e; sm += e; }
    sm = wave_sum(sm); if (lane == 0) red[8 + w] = sm;
    __syncthreads();
    sm = 0.f;
#pragma unroll
    for (int i = 0; i < 8; ++i) sm += red[8 + i];
    {
        const int d4 = tid & 15, kg = tid >> 4;
        f32x4 acc = {0.f, 0.f, 0.f, 0.f};
#pragma unroll
        for (int i0 = 0; i0 < 24; i0 += 8) {
            f32x4 vv[8]; float pp[8];
#pragma unroll
            for (int i = 0; i < 8; ++i) { const int idx = kg + 32 * (i0 + i); pp[i] = lg[idx]; vv[i] = *(const f32x4*)(p.cache_v + (size_t)roff[idx] * 64 + 4 * d4); }
#pragma unroll
            for (int i = 0; i < 8; ++i) acc += vv[i] * pp[i];
        }
        if (kg == 0) {
            const bf16_t* vn = p.H + row * 2560 + 1024 + h * 64 + 4 * d4; const float pn = lg[768];
            acc[0] += pn * bf2f(vn[0]); acc[1] += pn * bf2f(vn[1]); acc[2] += pn * bf2f(vn[2]); acc[3] += pn * bf2f(vn[3]);
        }
        *(f32x4*)(part + kg * 64 + 4 * d4) = acc;
    }
    __syncthreads();
    if (tid < 64) { float a = 0.f;
#pragma unroll
        for (int i = 0; i < 32; ++i) a += part[i * 64 + tid];
        p.MIX[row * DM + h * 64 + tid] = f2bf(a / sm); }
}

DI void bg_kmean_fore(const Params& p, int bid, int k, char* lds) {
    const int tid = TIDX, rg = tid >> 4, d4 = tid & 15, bs = bid >> 3, hs = bid & 7;
    const int page = p.page_table[bs * 64 + 2 * k + (rg >> 4)];
    const float* base = p.cache_k + (((size_t)page * 128 + (rg & 15) * 8) * 8 + hs) * 64 + 4 * d4;
    f32x4 acc = {0.f, 0.f, 0.f, 0.f};
#pragma unroll
    for (int i = 0; i < 8; ++i) acc += *(const f32x4*)(base + (size_t)i * 512);
    __syncthreads();
    *(f32x4*)(lds + MB_BGS + (rg * 64 + d4 * 4) * 4) = acc;
    __syncthreads();
    if (tid < 64) { float sm = 0.f;
#pragma unroll 8
        for (int r = 0; r < 32; ++r) sm += *(const float*)(lds + MB_BGS + (r * 64 + tid) * 4);
        *(float*)(lds + MB_KMS + (k * 64 + tid) * 4) = sm * (1.f / 256.f); }
    __syncthreads();
}
DI void moba_prompt_unit(const Params& p, int bh, int own, char* lds, int bid, int& bgk) {
    const int tid = TIDX, lane = tid & 63, w = tid >> 6, lr = lane & 15, lg = lane >> 4;
    const int b = bh >> 3, h = bh & 7;
    float* gsc = (float*)lds + w * 1024;
    unsigned* msk = (unsigned*)(lds + 32768) + w * 36;
    unsigned* worl = (unsigned*)(lds + MB_WOR);
    const int wv = __builtin_amdgcn_readfirstlane(w);
    const size_t rowq0 = (size_t)b * SEQ + own * 256 + w * 32;
    __syncthreads();
    bf16x8 qf[2][2];
#pragma unroll
    for (int qt = 0; qt < 2; ++qt)
#pragma unroll
        for (int ks = 0; ks < 2; ++ks) qf[qt][ks] = *(const bf16x8*)(p.H + (rowq0 + qt * 16 + lr) * 2560 + h * 64 + ks * 32 + lg * 8);
    unsigned mq[2]; unsigned wor;
    if (own > 3) {
        bf16_t* kml = (bf16_t*)(lds + 36864);
        {
            const int j = tid >> 4, d4 = tid & 15;
            f32x4 a = {0.f, 0.f, 0.f, 0.f};
#pragma unroll
            for (int part = 0; part < 8; ++part) a += *(const f32x4*)(p.KMPP + (((size_t)b * 32 + j) * 8 + part) * 512 + h * 64 + 4 * d4);
            store_bf4(kml + j * 64 + 4 * d4, a * (1.f / 256.f));
        }
        __syncthreads();
#pragma unroll
        for (int jt = 0; jt < 2; ++jt) {
            bf16x8 kf[2];
#pragma unroll
            for (int ks = 0; ks < 2; ++ks) kf[ks] = *(const bf16x8*)(kml + (jt * 16 + lr) * 64 + ks * 32 + lg * 8);
#pragma unroll
            for (int qt = 0; qt < 2; ++qt) {
                f32x4 a = {0.f, 0.f, 0.f, 0.f};
                a = MFMA16(kf[0], qf[qt][0], a); a = MFMA16(kf[1], qf[qt][1], a);
#pragma unroll
                for (int r = 0; r < 4; ++r) gsc[(qt * 16 + lr) * 32 + jt * 16 + 4 * lg + r] = a[r];
            }
        }
        __builtin_amdgcn_s_waitcnt(0);
        __builtin_amdgcn_wave_barrier();
        unsigned m = 0;
        if (lane < 32) {
            float v0 = -INFINITY, v1 = -INFINITY, v2 = -INFINITY; int i0 = 0, i1 = 0, i2 = 0;
            for (int j = 0; j < own; ++j) { float sc = gsc[lane * 32 + j];
                if (sc > v0) { v2 = v1; i2 = i1; v1 = v0; i1 = i0; v0 = sc; i0 = j; }
                else if (sc > v1) { v2 = v1; i2 = i1; v1 = sc; i1 = j; }
                else if (sc > v2) { v2 = sc; i2 = j; } }
            m = (1u << i0) | (1u << i1) | (1u << i2);
            msk[lane] = m;
        }
        unsigned o = m;
#pragma unroll
        for (int sft = 32; sft >= 1; sft >>= 1) o |= (unsigned)__shfl_xor((int)o, sft, 64);
        wor = o;
        __builtin_amdgcn_s_waitcnt(0);
        __builtin_amdgcn_wave_barrier();
        mq[0] = msk[lr]; mq[1] = msk[16 + lr];
    } else {
        const unsigned m = (own >= 1) ? ((1u << own) - 1u) : 0u;
        mq[0] = m; mq[1] = m; wor = m;
    }
    wor = (unsigned)__builtin_amdgcn_readfirstlane((int)wor);
    if (lane == 0) worl[w] = wor;
    __syncthreads();
    unsigned bor = 0;
#pragma unroll
    for (int i = 0; i < 8; ++i) bor |= worl[i];
    bor = (unsigned)__builtin_amdgcn_readfirstlane((int)bor);

    const bf16_t* Kbase = p.H + (size_t)b * SEQ * 2560 + 512 + h * 64;
    const bf16_t* Vbase = p.VT + (size_t)(b * 8 + h) * 64 * 8192;
    u32x4 rk[4], rv[4];
    auto gload = [&](int jb) {
#pragma unroll
        for (int i = 0; i < 4; ++i) { const int id = tid + NT * i; const int r = id >> 3, c = id & 7; rk[i] = *(const u32x4*)(Kbase + (size_t)(jb * 256 + r) * 2560 + c * 8); }
#pragma unroll
        for (int i = 0; i < 4; ++i) { const int id = tid + NT * i; const int d = id >> 5, c = id & 31; rv[i] = *(const u32x4*)(Vbase + (size_t)d * 8192 + jb * 256 + c * 8); }
    };
    auto sstore = [&](int buf) {
#pragma unroll
        for (int i = 0; i < 4; ++i) { const int id = tid + NT * i; const int r = id >> 3, c = id & 7; *(u32x4*)(lds + MB_K + buf * 32768 + r * 128 + ((c ^ (r & 7)) << 4)) = rk[i]; }
#pragma unroll
        for (int i = 0; i < 4; ++i) { const int id = tid + NT * i; const int d = id >> 5, c = id & 31; *(u32x4*)(lds + MB_V + buf * (64 * MB_VROW) + d * MB_VROW + c * 16) = rv[i]; }
    };
    const float SC = 0.125f * 1.4426950408889634f;
    float mrow[2] = {-INFINITY, -INFINITY}, lrow[2] = {0.f, 0.f};
    f32x4 oacc[2][4];
#pragma unroll
    for (int qt = 0; qt < 2; ++qt)
#pragma unroll
        for (int dt = 0; dt < 4; ++dt) oacc[qt][dt] = (f32x4){0.f, 0.f, 0.f, 0.f};
    const int bg_rg = tid >> 4, bg_d4 = tid & 15, bg_bs = bid >> 3, bg_hs = bid & 7;
    int bg_page = (bgk < 32) ? p.page_table[bg_bs * 64 + 2 * bgk + (bg_rg >> 4)] : 0;
    int cur = own, buf = 0;
    gload(cur); sstore(0); __syncthreads();
    int nxt_scan = 0;
    while (cur >= 0) {
        int nxt = -1;
        while (nxt_scan < own) { const int j = nxt_scan++; if ((bor >> j) & 1u) { nxt = j; break; } }
        if (nxt >= 0) gload(nxt);
        const bool bg_on = bgk < 32;
        const float* bg_base = p.cache_k + (((size_t)bg_page * 128 + (bg_rg & 15) * 8) * 8 + bg_hs) * 64 + 4 * bg_d4;
        f32x4 bg_acc = {0.f, 0.f, 0.f, 0.f}, bg_pend = {0.f, 0.f, 0.f, 0.f}; int bg_i = 0;
        const bool isown = (cur == own);
        if (isown || ((wor >> cur) & 1u)) {
            const char* KB = lds + MB_K + buf * 32768; const char* VB = lds + MB_V + buf * (64 * MB_VROW);
            const int nst = isown ? (wv + 1) : 8;
            const bool sel0 = isown || ((mq[0] >> cur) & 1u), sel1 = isown || ((mq[1] >> cur) & 1u);
            for (int st = 0; st < nst; ++st) {
                if (bg_on && bg_i < 8) { bg_acc += bg_pend; bg_pend = *(const f32x4*)(bg_base + (size_t)bg_i * 512); ++bg_i; }
                bf16x8 kf[2][2];
#pragma unroll
                for (int kt = 0; kt < 2; ++kt)
#pragma unroll
                    for (int ks = 0; ks < 2; ++ks) { const int r = st * 32 + kt * 16 + lr, ch = ks * 4 + lg; kf[kt][ks] = *(const bf16x8*)(KB + r * 128 + ((ch ^ (r & 7)) << 4)); }
                bf16x8 pf[2]; float alph[2];
#pragma unroll
                for (int qt = 0; qt < 2; ++qt) {
                    f32x4 sv[2];
#pragma unroll
                    for (int kt = 0; kt < 2; ++kt) { f32x4 a = {0.f, 0.f, 0.f, 0.f}; a = MFMA16(kf[kt][0], qf[qt][0], a); a = MFMA16(kf[kt][1], qf[qt][1], a); sv[kt] = a; }
                    const bool selq = qt ? sel1 : sel0;
                    if (isown) {
                        const int qin = wv * 32 + qt * 16 + lr;
#pragma unroll
                        for (int kt = 0; kt < 2; ++kt)
#pragma unroll
                            for (int r = 0; r < 4; ++r) { const int kin = st * 32 + kt * 16 + 4 * lg + r; sv[kt][r] = (kin <= qin) ? sv[kt][r] : -INFINITY; }
                    }
                    float mx = fmaxf(fmaxf(fmaxf(sv[0][0], sv[0][1]), fmaxf(sv[0][2], sv[0][3])), fmaxf(fmaxf(sv[1][0], sv[1][1]), fmaxf(sv[1][2], sv[1][3]))) * SC;
                    mx = red_max_16_32(mx);
                    mx = selq ? mx : -INFINITY;
                    const float mnew = fmaxf(mrow[qt], mx);
                    alph[qt] = __builtin_amdgcn_exp2f(mrow[qt] - mnew);
                    const float mneg = selq ? -mnew : -INFINITY;
                    float ps = 0.f;
#pragma unroll
                    for (int kt = 0; kt < 2; ++kt)
#pragma unroll
                        for (int r = 0; r < 4; ++r) { const float e = __builtin_amdgcn_exp2f(__builtin_fmaf(sv[kt][r], SC, mneg)); sv[kt][r] = e; ps += e; }
                    ps = red_sum_16_32(ps);
                    lrow[qt] = lrow[qt] * alph[qt] + ps; mrow[qt] = mnew;
                    u32x4 pk; pk[0] = pack_bf2(sv[0][0], sv[0][1]); pk[1] = pack_bf2(sv[0][2], sv[0][3]); pk[2] = pack_bf2(sv[1][0], sv[1][1]); pk[3] = pack_bf2(sv[1][2], sv[1][3]);
                    pf[qt] = __builtin_bit_cast(bf16x8, pk);
                }
                if (__any((alph[0] != 1.f) || (alph[1] != 1.f))) {
#pragma unroll
                    for (int qt = 0; qt < 2; ++qt)
#pragma unroll
                        for (int dt = 0; dt < 4; ++dt) oacc[qt][dt] = oacc[qt][dt] * alph[qt];
                }
#pragma unroll
                for (int dt = 0; dt < 4; ++dt) {
                    const char* vp = VB + (dt * 16 + lr) * MB_VROW + st * 64 + 8 * lg;
                    const u32x2 lo = *(const u32x2*)vp, hi = *(const u32x2*)(vp + 32);
                    u32x4 t4; t4[0] = lo[0]; t4[1] = lo[1]; t4[2] = hi[0]; t4[3] = hi[1];
                    const bf16x8 vf = __builtin_bit_cast(bf16x8, t4);
#pragma unroll
                    for (int qt = 0; qt < 2; ++qt) oacc[qt][dt] = MFMA16(vf, pf[qt], oacc[qt][dt]);
                }
            }
        }
        if (bg_on) {
            while (bg_i < 8) { bg_acc += bg_pend; bg_pend = *(const f32x4*)(bg_base + (size_t)bg_i * 512); ++bg_i; }
            bg_acc += bg_pend;
            *(f32x4*)(lds + MB_BGS + (bgk & 1) * 8192 + (bg_rg * 64 + bg_d4 * 4) * 4) = bg_acc;
        }
        if (nxt >= 0) sstore(buf ^ 1);
        __syncthreads();
        if (bg_on) {
            if (tid < 64) { float sm = 0.f;
#pragma unroll 8
                for (int r = 0; r < 32; ++r) sm += *(const float*)(lds + MB_BGS + (bgk & 1) * 8192 + (r * 64 + tid) * 4);
                *(float*)(lds + MB_KMS + (bgk * 64 + tid) * 4) = sm * (1.f / 256.f); }
            ++bgk;
            if (bgk < 32) bg_page = p.page_table[bg_bs * 64 + 2 * bgk + (bg_rg >> 4)];
        }
        cur = nxt; buf ^= 1;
    }
#pragma unroll
    for (int qt = 0; qt < 2; ++qt) {
        const float inv = 1.f / lrow[qt];
#pragma unroll
        for (int dt = 0; dt < 4; ++dt) store_bf4(p.MIX + (rowq0 + qt * 16 + lr) * DM + h * 64 + dt * 16 + 4 * lg, oacc[qt][dt] * inv);
    }
}

DI void ln_rows(const Params& p, const float* g, const float* bb, int bid, int nb, bool final_out) {
    const int lane = TIDX & 63, w = TIDX >> 6;
    for (int row = bid * 8 + w; row < TT; row += nb * 8) {
        f32x4 v[4]; float s = 0.f;
#pragma unroll
        for (int i = 0; i < 4; ++i) { v[i] = *(const f32x4*)(p.T + (size_t)row * DM + 4 * lane + 256 * i); s += v[i][0] + v[i][1] + v[i][2] + v[i][3]; }
        const float mu = wave_sum(s) * (1.f / 1024.f);
        float q = 0.f;
#pragma unroll
        for (int i = 0; i < 4; ++i)
#pragma unroll
            for (int k = 0; k < 4; ++k) { float d = v[i][k] - mu; q += d * d; }
        const float rs = rsqrtf(wave_sum(q) * (1.f / 1024.f) + LN_EPS);
#pragma unroll
        for (int i = 0; i < 4; ++i) {
            const int c = 4 * lane + 256 * i;
            f32x4 gg = *(const f32x4*)(g + c), be = *(const f32x4*)(bb + c), y;
#pragma unroll
            for (int k = 0; k < 4; ++k) y[k] = (v[i][k] - mu) * rs * gg[k] + be[k];
            if (final_out) { float* dst = row < TP ? p.y_prompt + (size_t)row * DM + c : p.y_sample + (size_t)(row - TP) * DM + c; *(f32x4*)dst = y; }
            else { *(f32x4*)(p.XF + (size_t)row * DM + c) = y; store_bf4(p.XB + (size_t)row * DM + c, y); }
        }
    }
}

DI unsigned ford(float f) { const unsigned u = __float_as_uint(f); return u ^ ((unsigned)((int)u >> 31) | 0x80000000u); }
DI float funord(unsigned k) { return __uint_as_float((k & 0x80000000u) ? (k ^ 0x80000000u) : ~k); }
#define KINS16(K, tk) { unsigned _v = (K); _Pragma("unroll") for (int _k = 0; _k < 16; ++_k) { const unsigned _t = tk[_k] > _v ? tk[_k] : _v; _v = tk[_k] > _v ? _v : tk[_k]; tk[_k] = _t; } }
typedef _Float16 f16x4 __attribute__((ext_vector_type(4)));
typedef _Float16 f16x8 __attribute__((ext_vector_type(8)));
DI void peer_topk_unit(const Params& p, int layer, int u, char* lds) {
    const int tid = TIDX, lane = tid & 63, w = tid >> 6, lr = lane & 15, lg = lane >> 4;
    const int t0 = u * 32;
    __syncthreads();
    {
        const bf16_t* KBl = p.KB + (size_t)layer * 2048 * 128;
#pragma unroll 1
        for (int jj = 0; jj < 2; ++jj) {
            const int j = 2 * w + jj;
            bf16x8 qf[2][4];
#pragma unroll
            for (int tt = 0; tt < 2; ++tt)
#pragma unroll
                for (int ks = 0; ks < 4; ++ks) qf[tt][ks] = *(const bf16x8*)(p.QH + (size_t)(t0 + tt * 16 + lr) * 2048 + j * 128 + ks * 32 + lg * 8);
#pragma unroll
            for (int nt = 0; nt < 8; ++nt) {
                bf16x8 kf[4];
#pragma unroll
                for (int ks = 0; ks < 4; ++ks) kf[ks] = *(const bf16x8*)(KBl + (size_t)(j * 128 + nt * 16 + lr) * 128 + ks * 32 + lg * 8);
#pragma unroll
                for (int tt = 0; tt < 2; ++tt) {
                    f32x4 a = {0.f, 0.f, 0.f, 0.f};
#pragma unroll
                    for (int ks = 0; ks < 4; ++ks) a = MFMA16(kf[ks], qf[tt][ks], a);
                    f16x4 hv; hv[0] = (_Float16)a[0]; hv[1] = (_Float16)a[1]; hv[2] = (_Float16)a[2]; hv[3] = (_Float16)a[3];
                    const int chunk = nt * 2 + (lg >> 1);
                    *(f16x4*)(lds + ((tt * 16 + lr) * 16 + j) * 256 + ((chunk ^ j) << 4) + (lg & 1) * 8) = hv;
                }
            }
        }
    }
    __syncthreads();
    const int tok = t0 + (tid >> 4), j = tid & 15;
    unsigned tk[16];
#pragma unroll
    for (int k = 0; k < 16; ++k) tk[k] = 0u;
    {
        const char* sp = lds + tid * 256;
#pragma unroll 2
        for (int c = 0; c < 16; ++c) {
            const f16x8 v = *(const f16x8*)(sp + ((c ^ j) << 4));
#pragma unroll
            for (int q = 0; q < 8; ++q) KINS16((ford((float)v[q]) & ~127u) | (unsigned)(127 - (8 * c + q)), tk);
        }
    }
    __syncthreads();
    float* lv = (float*)lds;
    int* li = (int*)(lds + 512 * 17 * 4);
#pragma unroll
    for (int k = 0; k < 16; ++k) { lv[tid * 17 + k] = funord(tk[k] & ~127u); li[tid * 17 + k] = 127 - (int)(tk[k] & 127u); }
    __syncthreads();
    if ((j & 1) == 0) {
        float v1[16], v2[16];
#pragma unroll
        for (int k = 0; k < 16; ++k) { v1[k] = lv[tid * 17 + k]; v2[k] = lv[(tid + 1) * 17 + k]; }
        unsigned sk[16];
#pragma unroll
        for (int k = 0; k < 16; ++k) sk[k] = 0u;
#pragma unroll
        for (int a = 0; a < 16; ++a)
#pragma unroll
            for (int bq = 0; bq < 16; ++bq)
                if ((a + 1) * (bq + 1) <= 16) KINS16((ford(v1[a] + v2[bq]) & ~255u) | (unsigned)(255 - (a * 16 + bq)), sk);
        float sc[16]; int ee[16];
#pragma unroll
        for (int k = 0; k < 16; ++k) {
            const int c = 255 - (int)(sk[k] & 255u), a = c >> 4, bq = c & 15;
            sc[k] = lv[tid * 17 + a] + lv[(tid + 1) * 17 + bq];
            ee[k] = li[tid * 17 + a] * 128 + li[(tid + 1) * 17 + bq];
        }
        float sm = 0.f; float e[16];
#pragma unroll
        for (int k = 0; k < 16; ++k) { e[k] = __expf(sc[k] - sc[0]); sm += e[k]; }
        const float inv = 1.f / sm; const int h = j >> 1;
#pragma unroll
        for (int k = 0; k < 16; ++k) { p.E[(size_t)tok * 128 + h * 16 + k] = ee[k]; p.G[(size_t)tok * 128 + h * 16 + k] = e[k] * inv; }
    }
}

constexpr int EHS = 129;
constexpr int PEER_EH = 65536, PEER_TOK = 65536 + 64 * EHS * 8, PEER_END = PEER_TOK + 1024;
DI float gelu_exact(float z) { return 0.5f * z * (1.f + erff(z * 0.70710678118654752f)); }
#define FMA4U(ACC, O, H, W) { ACC[O] += H * (float)((W) & 0xffu); ACC[O + 1] += H * (float)(((W) >> 8) & 0xffu); ACC[O + 2] += H * (float)(((W) >> 16) & 0xffu); ACC[O + 3] += H * (float)((W) >> 24); }

DI void peer_tile(const Params& p, int layer, int tile, char* lds, bool final_out) {
    const int lane = TIDX & 63, w = TIDX >> 6, lr = lane & 15, lg = lane >> 4;
    unsigned char* X8 = (unsigned char*)lds; int2* EH = (int2*)(lds + PEER_EH); float* TOK = (float*)(lds + PEER_TOK);
    const unsigned char* U8 = p.U8 + (size_t)layer * 16384 * DM; const unsigned char* V8 = p.V8 + (size_t)layer * 16384 * DM;
    const float* SUi = p.SU + layer * 16384; const float* SVi = p.SV + layer * 16384;
    const float* lng = p.ln_g + (layer * 2 + 1) * DM; const float* lnb = p.ln_b + (layer * 2 + 1) * DM;
    const int t0 = tile * 64 + w * 8;
#pragma unroll 4
    for (int i = 0; i < 8; ++i) {
        const int t = t0 + i, tk = w * 8 + i;
        f32x4 v[4]; float am = 0.f;
#pragma unroll
        for (int k = 0; k < 4; ++k) { v[k] = *(const f32x4*)(p.XF + (size_t)t * DM + 4 * lane + 256 * k); am = fmaxf(am, fmaxf(fmaxf(fabsf(v[k][0]), fabsf(v[k][1])), fmaxf(fabsf(v[k][2]), fabsf(v[k][3])))); }
        am = wave_max(am);
        const float sc = am > 0.f ? 127.f / am : 0.f;
#pragma unroll
        for (int k = 0; k < 4; ++k) {
            unsigned pk = 0;
#pragma unroll
            for (int q = 0; q < 4; ++q) { const int qi = (int)rintf(v[k][q] * sc); pk |= ((unsigned)qi & 0xffu) << (8 * q); }
            *(unsigned*)(X8 + tk * 1024 + 4 * lane + 256 * k) = pk;
        }
        if (lane == 0) TOK[tk * 2] = am * (1.f / 127.f);
        EH[tk * EHS + lane] = make_int2(p.E[(size_t)t * 128 + lane], 0);
        EH[tk * EHS + 64 + lane] = make_int2(p.E[(size_t)t * 128 + 64 + lane], 0);
    }
    {
        const int gq = lane >> 3, li = lane & 7, tk = w * 8 + gq;
        auto uld = [&](int c, int p0, u32x4 (&uu)[4]) {
            const unsigned char* Uc = U8 + (size_t)c * (16384 * 128);
#pragma unroll
            for (int j = 0; j < 4; ++j) { const unsigned e = (unsigned)EH[tk * EHS + p0 + j].x; uu[j] = *(const u32x4*)(Uc + (e * 128u + 16u * li)); }
        };
        auto ucp = [&](int p0, u32x4 (&uu)[4], const i32x4& xq) {
#pragma unroll
            for (int j = 0; j < 4; ++j) {
                int d = __builtin_amdgcn_sdot4((int)uu[j][0], xq[0], 0, false);
                d = __builtin_amdgcn_sdot4((int)uu[j][1], xq[1], d, false);
                d = __builtin_amdgcn_sdot4((int)uu[j][2], xq[2], d, false);
                d = __builtin_amdgcn_sdot4((int)uu[j][3], xq[3], d, false);
                d += __builtin_amdgcn_update_dpp(0, d, 0x114, 0xf, 0xf, true);
                d += __builtin_amdgcn_update_dpp(0, d, 0x112, 0xf, 0xf, true);
                d += __builtin_amdgcn_update_dpp(0, d, 0x111, 0xf, 0xf, true);
                if (li == 7) __hip_atomic_fetch_add(&EH[tk * EHS + p0 + j].y, d, __ATOMIC_RELAXED, __HIP_MEMORY_SCOPE_WORKGROUP);
            }
        };
        u32x4 uA[4], uB[4];
        uld(0, 0, uA);
#pragma unroll 1
        for (int c = 0; c < 8; ++c) {
            const i32x4 xq = *(const i32x4*)(X8 + tk * 1024 + c * 128 + 16 * li);
#pragma unroll 1
            for (int p0 = 0; p0 < 128; p0 += 8) {
                uld(c, p0 + 4, uB);
                ucp(p0, uA, xq);
                if (p0 + 8 < 128) uld(c, p0 + 8, uA); else if (c < 7) uld(c + 1, 0, uA);
                ucp(p0 + 4, uB, xq);
            }
        }
    }
#pragma unroll 4
    for (int i = 0; i < 8; ++i) {
        const int t = t0 + i, tk = w * 8 + i;
        const float sxi = TOK[tk * 2];
#pragma unroll
        for (int hf = 0; hf < 2; ++hf) {
            const int pi = hf * 64 + lane;
            const int2 eh = EH[tk * EHS + pi];
            const float z = (float)eh.y * SUi[eh.x] * sxi;
            const float hp = p.G[(size_t)t * 128 + pi] * gelu_exact(z) * SVi[eh.x];
            EH[tk * EHS + pi].y = __float_as_int(hp);
        }
    }
    const int gq = lane >> 3, li = lane & 7, tk = w * 8 + gq, t = t0 + gq;
    float s1 = 0.f, s2 = 0.f;
    auto vload = [&](int c, int p0, float (&hh)[4], u32x4 (&vv)[4]) {
        const unsigned char* Vc = V8 + (size_t)c * (16384 * 128);
#pragma unroll
        for (int j = 0; j < 4; ++j) { const int2 eh = EH[tk * EHS + p0 + j]; hh[j] = __int_as_float(eh.y); vv[j] = *(const u32x4*)(Vc + ((unsigned)eh.x * 128u + 16u * li)); }
    };
    auto vcomp = [&](float (&hh)[4], u32x4 (&vv)[4], f32x2 (&acc)[8]) {
#pragma unroll
        for (int j = 0; j < 4; ++j) {
            const f32x2 h2 = {hh[j], hh[j]};
#pragma unroll
            for (int q = 0; q < 4; ++q) {
                const f32x2 a = __builtin_amdgcn_cvt_pk_f32_fp8((int)vv[j][q], false), b = __builtin_amdgcn_cvt_pk_f32_fp8((int)vv[j][q], true);
                acc[2 * q] = h2 * a + acc[2 * q]; acc[2 * q + 1] = h2 * b + acc[2 * q + 1];
            }
        }
    };
    float ehA[4], ehB[4]; u32x4 vvA[4], vvB[4];
    vload(0, 0, ehA, vvA);
#pragma unroll 1
    for (int c = 0; c < 8; ++c) {
        f32x2 acc[8];
#pragma unroll
        for (int k = 0; k < 8; ++k) acc[k] = (f32x2){0.f, 0.f};
        f32x4 xs[4];
#pragma unroll
        for (int k4 = 0; k4 < 4; ++k4) xs[k4] = *(const f32x4*)(p.XF + (size_t)t * DM + c * 128 + li * 16 + 4 * k4);
#pragma unroll 1
        for (int p0 = 0; p0 < 128; p0 += 8) {
            vload(c, p0 + 4, ehB, vvB);
            vcomp(ehA, vvA, acc);
            if (p0 + 8 < 128) vload(c, p0 + 8, ehA, vvA); else if (c < 7) vload(c + 1, 0, ehA, vvA);
            vcomp(ehB, vvB, acc);
        }
        const int col = c * 128 + li * 16;
#pragma unroll
        for (int k4 = 0; k4 < 4; ++k4) {
            const f32x4 x = xs[k4];
            f32x4 y;
#pragma unroll
            for (int k = 0; k < 4; ++k) { y[k] = DN_ALPHA * x[k] + acc[2 * k4 + (k >> 1)][k & 1]; s1 += y[k]; s2 += y[k] * y[k]; }
            *(f32x4*)(p.T + (size_t)t * DM + col + 4 * k4) = y;
        }
    }
#pragma unroll
    for (int o = 1; o <= 4; o <<= 1) { s1 += __shfl_xor(s1, o, 64); s2 += __shfl_xor(s2, o, 64); }
    const float mu = s1 * (1.f / 1024.f);
    const float rs = rsqrtf(fmaxf(s2 * (1.f / 1024.f) - mu * mu, 0.f) + LN_EPS);
#pragma unroll 4
    for (int c = 0; c < 8; ++c) {
        const int col = c * 128 + li * 16;
#pragma unroll
        for (int k4 = 0; k4 < 4; ++k4) {
            const f32x4 y = *(const f32x4*)(p.T + (size_t)t * DM + col + 4 * k4);
            const f32x4 gg = *(const f32x4*)(lng + col + 4 * k4), be = *(const f32x4*)(lnb + col + 4 * k4);
            f32x4 o;
#pragma unroll
            for (int k = 0; k < 4; ++k) o[k] = (y[k] - mu) * rs * gg[k] + be[k];
            if (final_out) *(f32x4*)(p.y_prompt + (size_t)t * DM + col + 4 * k4) = o;
            else { *(f32x4*)(p.XF + (size_t)t * DM + col + 4 * k4) = o; store_bf4(p.XB + (size_t)t * DM + col + 4 * k4, o); }
        }
    }
}


DI unsigned wave_top16(unsigned x0, unsigned x1, int lane) {
    unsigned res = 0u;
#pragma unroll 1
    for (int r = 0; r < 16; ++r) {
        unsigned m = x0 > x1 ? x0 : x1;
#pragma unroll
        for (int o = 32; o >= 1; o >>= 1) { const unsigned y = (unsigned)__shfl_xor((int)m, o, 64); m = y > m ? y : m; }
        if (x0 == m) x0 = 0u; else if (x1 == m) x1 = 0u;
        if (lane == r) res = m;
    }
    return res;
}
DI void peer_sample(const Params& p, int layer, int sidx, char* lds, bool final_out) {
    const int tid = TIDX, lane = tid & 63, w = tid >> 6, lr = lane & 15, lg = lane >> 4;
    unsigned char* X8 = (unsigned char*)lds; int2* EH = (int2*)(lds + 1024); float* Z = (float*)(lds + 1024 + 1024); float* Y = Z + 128; float* PART = Y + 1024;
    int* Es = (int*)(PART + 32); float* Gs = (float*)(Es + 128);
    const unsigned char* U8 = p.U8 + (size_t)layer * 16384 * DM; const unsigned char* V8 = p.V8 + (size_t)layer * 16384 * DM;
    const float* SUi = p.SU + layer * 16384; const float* SVi = p.SV + layer * 16384;
    const float* lng = p.ln_g + (layer * 2 + 1) * DM; const float* lnb = p.ln_b + (layer * 2 + 1) * DM;
    const int t = TP + sidx;
    __syncthreads();
    if (w == 0) {
        f32x4 v[4]; float am = 0.f;
#pragma unroll
        for (int k = 0; k < 4; ++k) { v[k] = *(const f32x4*)(p.XF + (size_t)t * DM + 4 * lane + 256 * k); am = fmaxf(am, fmaxf(fmaxf(fabsf(v[k][0]), fabsf(v[k][1])), fmaxf(fabsf(v[k][2]), fabsf(v[k][3])))); }
        am = wave_max(am);
        const float sc = am > 0.f ? 127.f / am : 0.f;
#pragma unroll
        for (int k = 0; k < 4; ++k) {
            unsigned pk = 0;
#pragma unroll
            for (int q = 0; q < 4; ++q) { const int qi = (int)rintf(v[k][q] * sc); pk |= ((unsigned)qi & 0xffu) << (8 * q); }
            *(unsigned*)(X8 + 4 * lane + 256 * k) = pk;
        }
        if (lane == 0) PART[24] = am * (1.f / 127.f);
    }
    {
        const float* sp = p.S + (size_t)t * 2048 + w * 256;
        const unsigned k1 = wave_top16((ford(sp[lane]) & ~127u) | (unsigned)(127 - lane), (ford(sp[64 + lane]) & ~127u) | (unsigned)(63 - lane), lane);
        const unsigned k2 = wave_top16((ford(sp[128 + lane]) & ~127u) | (unsigned)(127 - lane), (ford(sp[192 + lane]) & ~127u) | (unsigned)(63 - lane), lane);
        const float v1 = funord(k1 & ~127u), v2 = funord(k2 & ~127u); const int i1 = 127 - (int)(k1 & 127u), i2 = 127 - (int)(k2 & 127u);
        int a = 0, b = 0;
        { int base = 0;
#pragma unroll
          for (int aa = 0; aa < 16; ++aa) { const int cnt = 16 / (aa + 1); if (lane >= base && lane < base + cnt) { a = aa; b = lane - base; } base += cnt; } }
        const float sv = __shfl(v1, a, 64) + __shfl(v2, b, 64);
        const unsigned ck = lane < 50 ? ((ford(sv) & ~255u) | (unsigned)(255 - (a * 16 + b))) : 0u;
        const unsigned rk = wave_top16(ck, 0u, lane);
        const int c2 = 255 - (int)(rk & 255u), a2 = (c2 >> 4) & 15, b2 = c2 & 15;
        const float sc = __shfl(v1, a2, 64) + __shfl(v2, b2, 64);
        const int ex = __shfl(i1, a2, 64) * 128 + __shfl(i2, b2, 64);
        const float mx = __shfl(sc, 0, 64);
        const float ee = lane < 16 ? __expf(sc - mx) : 0.f;
        const float sm = wave_sum(ee);
        if (lane < 16) { Es[w * 16 + lane] = ex; Gs[w * 16 + lane] = ee / sm; }
    }
    __syncthreads();
    {
        const int e = Es[w * 16 + lr];
        i32x4 acc = {0, 0, 0, 0};
#pragma unroll
        for (int ch = 0; ch < 16; ++ch) {
            const i32x4 a = *(const i32x4*)(U8 + (size_t)(ch >> 1) * (16384 * 128) + (size_t)e * 128 + (ch & 1) * 64 + 16 * lg);
            const i32x4 xb = *(const i32x4*)(X8 + ch * 64 + 16 * lg);
            acc = __builtin_amdgcn_mfma_i32_16x16x64_i8(a, xb, acc, 0, 0, 0);
        }
        if (lr == 0) {
#pragma unroll
            for (int r = 0; r < 4; ++r) Z[w * 16 + 4 * lg + r] = (float)acc[r];
        }
        __builtin_amdgcn_s_waitcnt(0);
        __builtin_amdgcn_wave_barrier();
        float hp = 0.f;
        if (lane < 16) {
            const int pi = w * 16 + lane;
            const float z = Z[pi] * SUi[e] * PART[24];
            hp = Gs[pi] * gelu_exact(z) * SVi[e];
            EH[pi] = make_int2(e, __float_as_int(hp));
        }
        hp = wave_sum(hp);
        if (lane == 0) PART[w] = hp;
    }
    __syncthreads();
    float sumh = 0.f;
#pragma unroll
    for (int i = 0; i < 8; ++i) sumh += PART[i];
    {
        const int c = w, pg = lane >> 3, li = lane & 7;
        float acc[16];
#pragma unroll
        for (int k = 0; k < 16; ++k) acc[k] = 0.f;
        const unsigned char* vb = V8 + (size_t)c * (16384 * 128) + li * 16;
        for (int p0 = 0; p0 < 16; p0 += 8) {
            int2 eh[8]; u32x4 vv[8];
#pragma unroll
            for (int j = 0; j < 8; ++j) eh[j] = EH[pg * 16 + p0 + j];
#pragma unroll
            for (int j = 0; j < 8; ++j) vv[j] = *(const u32x4*)(vb + (size_t)eh[j].x * 128);
#pragma unroll
            for (int j = 0; j < 8; ++j) { const float h = __int_as_float(eh[j].y);
#pragma unroll
                for (int q = 0; q < 4; ++q) { const f32x2 a = __builtin_amdgcn_cvt_pk_f32_fp8((int)vv[j][q], false), bq = __builtin_amdgcn_cvt_pk_f32_fp8((int)vv[j][q], true);
                    acc[4 * q] += h * a[0]; acc[4 * q + 1] += h * a[1]; acc[4 * q + 2] += h * bq[0]; acc[4 * q + 3] += h * bq[1]; } }
        }
#pragma unroll
        for (int k = 0; k < 16; ++k) { float a = acc[k]; a += __shfl_xor(a, 8, 64); a += __shfl_xor(a, 16, 64); a += __shfl_xor(a, 32, 64); acc[k] = a; }
        float s1 = 0.f, s2 = 0.f;
        if (pg == 0) {
            const int col = c * 128 + li * 16;
#pragma unroll
            for (int k = 0; k < 16; ++k) { const float y = DN_ALPHA * p.XF[(size_t)t * DM + col + k] + acc[k]; Y[col + k] = y; s1 += y; s2 += y * y; }
        }
        s1 = wave_sum(s1); s2 = wave_sum(s2);
        if (lane == 0) { PART[8 + w] = s1; PART[16 + w] = s2; }
    }
    __syncthreads();
    float s1 = 0.f, s2 = 0.f;
#pragma unroll
    for (int i = 0; i < 8; ++i) { s1 += PART[8 + i]; s2 += PART[16 + i]; }
    const float mu = s1 * (1.f / 1024.f);
    const float rs = rsqrtf(fmaxf(s2 * (1.f / 1024.f) - mu * mu, 0.f) + LN_EPS);
#pragma unroll
    for (int k = 0; k < 2; ++k) {
        const int col = tid + NT * k;
        const float o = (Y[col] - mu) * rs * lng[col] + lnb[col];
        if (final_out) p.y_sample[(size_t)sidx * DM + col] = o;
        else { p.XF[(size_t)t * DM + col] = o; p.XB[(size_t)t * DM + col] = f2bf(o); }
    }
    __syncthreads();
}

DI void peer_expert_phase(const Params& p, int layer, char* lds, int bid, int nb, bool final_out) {
    for (int tile = bid; tile < 256; tile += nb) peer_tile(p, layer, tile, lds, final_out);
    for (int sidx = bid; sidx < TS; sidx += nb) peer_sample(p, layer, sidx, lds, final_out);
}

DI void hgrn_cumsum(const Params& p, size_t row0, int h, float* bs, float* tot) {
    const int tid = TIDX;
#pragma unroll
    for (int i = 0; i < 4; ++i) { int id = tid + NT * i; int s = id >> 5, c4 = id & 31; *(f32x4*)(bs + s * 128 + 4 * c4) = *(const f32x4*)(p.LF + (row0 + s) * DM + h * 128 + 4 * c4); }
    __syncthreads();
    const int k = tid & 127, seg = tid >> 7;
    float run = 0.f;
#pragma unroll
    for (int i = 0; i < 16; ++i) { run += bs[(seg * 16 + i) * 128 + k]; bs[(seg * 16 + i) * 128 + k] = run; }
    tot[seg * 128 + k] = run;
    __syncthreads();
    float off = 0.f;
#pragma unroll
    for (int s2 = 0; s2 < 3; ++s2) if (s2 < seg) off += tot[s2 * 128 + k];
    if (seg > 0) {
#pragma unroll
        for (int i = 0; i < 16; ++i) bs[(seg * 16 + i) * 128 + k] += off;
    }
    __syncthreads();
}
constexpr int HG_TS = 72;
constexpr int HG_FS = 136;
DI void hgrn_b1_unit(const Params& p, int u, char* lds) {
    float* bs = (float*)lds;
    float* tot = (float*)(lds + 32768);
    bf16_t* KT = (bf16_t*)(lds + 36864);
    bf16_t* IT = (bf16_t*)(lds + 36864 + 18432);
    const int tid = TIDX, lane = tid & 63, w = tid >> 6, lr = lane & 15, lg = lane >> 4;
    const int bh = u >> 7, c = u & 127, b = bh >> 3, h = bh & 7;
    const size_t row0 = (size_t)b * SEQ + c * 64;
    hgrn_cumsum(p, row0, h, bs, tot);
    const bf16_t* KK = p.H + (size_t)MP * DM; const bf16_t* I1 = p.H + (size_t)2 * MP * DM;
    {
        const int s = tid >> 3, kc = (tid & 7) * 16;
        const bf16_t* kr = KK + (row0 + s) * DM + h * 128 + kc; const bf16_t* ir = I1 + (row0 + s) * DM + h * 128 + kc;
        u32x4 ka = *(const u32x4*)kr, kb = *(const u32x4*)(kr + 8), ia = *(const u32x4*)ir, ib = *(const u32x4*)(ir + 8);
#pragma unroll
        for (int i = 0; i < 16; ++i) {
            const unsigned kw = (i < 8) ? ka[(i & 7) >> 1] : kb[(i & 7) >> 1]; const unsigned iw = (i < 8) ? ia[(i & 7) >> 1] : ib[(i & 7) >> 1];
            const float kv = (i & 1) ? bfhi(kw) : bflo(kw);
            const float e = __expf(fminf(-bs[s * 128 + kc + i], 80.f));
            KT[(kc + i) * HG_TS + s] = f2bf(kv * e);
            IT[(kc + i) * HG_TS + s] = (bf16_t)((i & 1) ? (iw >> 16) : (iw & 0xffffu));
        }
    }
    __syncthreads();
    f32x4 acc[8];
#pragma unroll
    for (int j = 0; j < 8; ++j) acc[j] = (f32x4){0.f, 0.f, 0.f, 0.f};
#pragma unroll
    for (int ks = 0; ks < 2; ++ks) {
        const bf16x8 af = *(const bf16x8*)(KT + (w * 16 + lr) * HG_TS + ks * 32 + lg * 8);
#pragma unroll
        for (int j = 0; j < 8; ++j) { const bf16x8 bfr = *(const bf16x8*)(IT + (j * 16 + lr) * HG_TS + ks * 32 + lg * 8); acc[j] = MFMA16(af, bfr, acc[j]); }
    }
    f32x4 dl;
#pragma unroll
    for (int r = 0; r < 4; ++r) dl[r] = __expf(bs[63 * 128 + w * 16 + 4 * lg + r]);
#pragma unroll
    for (int j = 0; j < 8; ++j) *(f32x4*)(p.UT + ((size_t)u * 128 + j * 16 + lr) * 128 + w * 16 + 4 * lg) = acc[j] * dl;
    if (tid < 128) p.DEC[(size_t)u * 128 + tid] = __expf(bs[63 * 128 + tid]);
    __syncthreads();
}
DI void hgrn_b2(const Params& p, int bid, int nb) {
    for (int e = bid * NT + TIDX; e < 16 * 16384; e += nb * NT) {
        const int bh = e >> 14, vk = e & 16383, k = vk & 127, v = vk >> 7;
        float S = 0.f;
        for (int c0 = 0; c0 < 128; c0 += 8) {
            float uu[8], dd[8];
#pragma unroll
            for (int i = 0; i < 8; ++i) { const size_t un = (size_t)bh * 128 + c0 + i; uu[i] = p.UT[un * 16384 + vk]; dd[i] = p.DEC[un * 128 + k]; }
#pragma unroll
            for (int i = 0; i < 8; ++i) { const size_t un = (size_t)bh * 128 + c0 + i; p.ST[un * 16384 + vk] = f2bf(S); S = dd[i] * S + uu[i]; }
        }
        p.hgrn_prompt[((size_t)bh * 128 + k) * 128 + v] = S;
    }
}
DI void hgrn_b3_unit(const Params& p, int u, char* lds) {
    float* bs = (float*)lds;
    float* tot = (float*)(lds + 32768);
    bf16_t* QH = (bf16_t*)(lds + 36864);
    bf16_t* KH = (bf16_t*)(lds + 36864 + 17408);
    bf16_t* IT = (bf16_t*)(lds + 36864 + 34816);
    bf16_t* AT = (bf16_t*)(lds + 36864 + 34816 + 18432);
    const int tid = TIDX, lane = tid & 63, w = tid >> 6, lr = lane & 15, lg = lane >> 4;
    const int bh = u >> 7, c = u & 127, b = bh >> 3, h = bh & 7;
    const size_t row0 = (size_t)b * SEQ + c * 64;
    hgrn_cumsum(p, row0, h, bs, tot);
    const bf16_t* Q1 = p.H; const bf16_t* KK = p.H + (size_t)MP * DM; const bf16_t* I1 = p.H + (size_t)2 * MP * DM; const bf16_t* G1 = p.H + (size_t)3 * MP * DM;
    {
        const int s = tid >> 3, kc = (tid & 7) * 16;
        const bf16_t* qr = Q1 + (row0 + s) * DM + h * 128 + kc; const bf16_t* kr = KK + (row0 + s) * DM + h * 128 + kc; const bf16_t* ir = I1 + (row0 + s) * DM + h * 128 + kc;
        u32x4 qa = *(const u32x4*)qr, qb = *(const u32x4*)(qr + 8), ka = *(const u32x4*)kr, kb = *(const u32x4*)(kr + 8), ia = *(const u32x4*)ir, ib = *(const u32x4*)(ir + 8);
#pragma unroll
        for (int i = 0; i < 16; ++i) {
            const unsigned qw = (i < 8) ? qa[(i & 7) >> 1] : qb[(i & 7) >> 1]; const unsigned kw = (i < 8) ? ka[(i & 7) >> 1] : kb[(i & 7) >> 1]; const unsigned iw = (i < 8) ? ia[(i & 7) >> 1] : ib[(i & 7) >> 1];
            const float qv = (i & 1) ? bfhi(qw) : bflo(qw); const float kv = (i & 1) ? bfhi(kw) : bflo(kw);
            const float bb = bs[s * 128 + kc + i];
            QH[s * HG_FS + kc + i] = f2bf(qv * __expf(bb));
            KH[s * HG_FS + kc + i] = f2bf(kv * __expf(fminf(-bb, 80.f)));
            IT[(kc + i) * HG_TS + s] = (bf16_t)((i & 1) ? (iw >> 16) : (iw & 0xffffu));
        }
    }
    __syncthreads();
    {
        const int tt = w & 3;
#pragma unroll
        for (int si = 0; si < 2; ++si) {
            const int stile = (w >> 2) * 2 + si;
            f32x4 a = {0.f, 0.f, 0.f, 0.f};
            if (stile <= tt) {
#pragma unroll
                for (int ks = 0; ks < 4; ++ks) {
                    const bf16x8 af = *(const bf16x8*)(KH + (stile * 16 + lr) * HG_FS + ks * 32 + lg * 8);
                    const bf16x8 bfr = *(const bf16x8*)(QH + (tt * 16 + lr) * HG_FS + ks * 32 + lg * 8);
                    a = MFMA16(af, bfr, a);
                }
            }
            const int t = tt * 16 + lr;
#pragma unroll
            for (int r = 0; r < 4; ++r) { const int s = stile * 16 + 4 * lg + r; if (s > t) a[r] = 0.f; }
            store_bf4(AT + t * HG_TS + stile * 16 + 4 * lg, a);
        }
    }
    __syncthreads();
    const int tt = w & 3;
    f32x4 acc[4];
#pragma unroll
    for (int j = 0; j < 4; ++j) acc[j] = (f32x4){0.f, 0.f, 0.f, 0.f};
#pragma unroll
    for (int ks = 0; ks < 2; ++ks) {
        const bf16x8 bfr = *(const bf16x8*)(AT + (tt * 16 + lr) * HG_TS + ks * 32 + lg * 8);
#pragma unroll
        for (int j = 0; j < 4; ++j) { const int vt = (w >> 2) * 4 + j; const bf16x8 af = *(const bf16x8*)(IT + (vt * 16 + lr) * HG_TS + ks * 32 + lg * 8); acc[j] = MFMA16(af, bfr, acc[j]); }
    }
    const bf16_t* STu = p.ST + (size_t)u * 16384;
#pragma unroll
    for (int ks = 0; ks < 4; ++ks) {
        const bf16x8 bfr = *(const bf16x8*)(QH + (tt * 16 + lr) * HG_FS + ks * 32 + lg * 8);
#pragma unroll
        for (int j = 0; j < 4; ++j) { const int vt = (w >> 2) * 4 + j; const bf16x8 af = *(const bf16x8*)(STu + (vt * 16 + lr) * 128 + ks * 32 + lg * 8); acc[j] = MFMA16(af, bfr, acc[j]); }
    }
    float ss = 0.f;
#pragma unroll
    for (int j = 0; j < 4; ++j)
#pragma unroll
        for (int r = 0; r < 4; ++r) ss += acc[j][r] * acc[j][r];
    ss += __shfl_xor(ss, 16, 64); ss += __shfl_xor(ss, 32, 64);
    float* red = tot;
    if (lg == 0) red[(w >> 2) * 64 + tt * 16 + lr] = ss;
    __syncthreads();
    const float rs = rsqrtf((red[tt * 16 + lr] + red[64 + tt * 16 + lr]) * (1.f / 128.f) + RMS_EPS);
    const size_t row = row0 + tt * 16 + lr;
#pragma unroll
    for (int j = 0; j < 4; ++j) {
        const int col = h * 128 + ((w >> 2) * 4 + j) * 16 + 4 * lg;
        const u32x2 gw = *(const u32x2*)(G1 + row * DM + col);
        const f32x4 ng = *(const f32x4*)(p.hgrn_norm_g + col);
        f32x4 o;
        const float gg[4] = {bflo(gw[0]), bfhi(gw[0]), bflo(gw[1]), bfhi(gw[1])};
#pragma unroll
        for (int r = 0; r < 4; ++r) o[r] = acc[j][r] * rs * ng[r] * (gg[r] * sigmoidf_(gg[r]));
        store_bf4(p.MIX + row * DM + col, o);
    }
    __syncthreads();
}
DI void hgrn_sample_unit(const Params& p, int u, char* lds) {
    float* part = (float*)lds;
    float* red = part + 512;
    const int tid = TIDX, lane = tid & 63, w = tid >> 6;
    const int b = u >> 3, h = u & 7; const size_t row = (size_t)TP + b;
    const bf16_t* Q1 = p.H; const bf16_t* KK = p.H + (size_t)MP * DM; const bf16_t* I1 = p.H + (size_t)2 * MP * DM; const bf16_t* G1 = p.H + (size_t)3 * MP * DM;
    const int v = tid & 127, kq = tid >> 7;
    const float iv = bf2f(I1[row * DM + h * 128 + v]);
    float acc = 0.f;
    const float* S0 = p.state_hgrn + (size_t)u * 16384; float* S1 = p.hgrn_sample + (size_t)u * 16384;
#pragma unroll 8
    for (int kk = 0; kk < 32; ++kk) {
        const int k = kq * 32 + kk;
        const float f = __expf(p.LF[row * DM + h * 128 + k]);
        const float kv = bf2f(KK[row * DM + h * 128 + k]);
        const float q = bf2f(Q1[row * DM + h * 128 + k]);
        const float st = f * S0[k * 128 + v] + kv * iv;
        S1[k * 128 + v] = st; acc += q * st;
    }
    part[kq * 128 + v] = acc;
    __syncthreads();
    float o = 0.f, sq = 0.f;
    if (tid < 128) { o = part[tid] + part[128 + tid] + part[256 + tid] + part[384 + tid]; sq = o * o; }
    sq = wave_sum(sq); if (lane == 0) red[w] = sq;
    __syncthreads();
    if (tid < 128) {
        const float rs = rsqrtf((red[0] + red[1]) * (1.f / 128.f) + RMS_EPS);
        const float g = bf2f(G1[row * DM + h * 128 + tid]);
        p.MIX[row * DM + h * 128 + tid] = f2bf(o * rs * p.hgrn_norm_g[h * 128 + tid] * (g * sigmoidf_(g)));
    }
    __syncthreads();
}

constexpr int LDS_BAR = 157824;
constexpr int LDS_BYTES = LDS_BAR + 256;

template <int LAYER> DI void peer_phases(const Params& p, char* lds, int bid, int nb, const XcdBarrier& bar) {
    REPEAT(REP_GEMM) {
        EpiBf16 epi{p.QH, 2048};
        gemm_big(p.XB, p.WT_WQ + (size_t)LAYER * 2048 * 1024, 2048, epi, lds, bid, nb);
    }
    xcd_barrier(bar);
    REPEAT(REP_TOPK) {
        { EpiF32 epi{p.S, 2048};
          for (int u = nb - 1 - bid; u < 16; u += nb) gemm_small32_unit(p.QH + u * 128, 2048, p.KB + (size_t)LAYER * 2048 * 128, 128, 128, TP, u * 128, epi); }
        for (int u = bid; u < TP / 32; u += nb) peer_topk_unit(p, LAYER, u, lds);
    }
    xcd_barrier(bar);
    REPEAT(LAYER == 1 ? REP_PEER1 : 1) peer_expert_phase(p, LAYER, lds, bid, nb, LAYER == 1);
}

__global__ void __launch_bounds__(NT, 2) mega(Params p) {
    extern __shared__ __attribute__((aligned(16))) char lds[];
    const int bid = blockIdx.x, nb = gridDim.x;
    if (TIDX == 0) *(uint4*)(lds + LDS_BAR) = make_uint4(0u, 0u, 0u, 0u);
    __syncthreads();
    XcdBarrier bar = xcd_barrier_post(p.bar, (volatile LAS unsigned*)(lds + LDS_BAR));
    REPEAT(REP_PRO) {
    for (int u = bid; u < 16 * 40; u += nb) transpose_unit(p.w_in_even, 1024, 2560, p.WT_IN_EVEN, u, lds);
    for (int u = bid; u < 16 * 16; u += nb) transpose_unit(p.w_out_even, 1024, 1024, p.WT_OUT_EVEN, u, lds);
    for (int u = bid; u < 16 * 64; u += nb) transpose_unit(p.w_in_odd, 1024, 4096, p.WT_IN_ODD, u, lds);
    for (int u = bid; u < 16 * 16; u += nb) transpose_unit(p.w_out_odd, 1024, 1024, p.WT_OUT_ODD, u, lds);
    for (int u = bid; u < 16 * 32; u += nb) transpose_unit(p.peer_wq, 1024, 2048, p.WT_WQ, u, lds);
    for (int u = bid; u < 16 * 32; u += nb) transpose_unit(p.peer_wq + (size_t)1024 * 2048, 1024, 2048, p.WT_WQ + (size_t)2048 * 1024, u, lds);
    convert_x(p, bid, nb);
    convert_keys(p, bid, nb);
    quant_rows<0>(p.peer_u, p.U8, p.SU, 2 * 16384, bid, nb);
    quant_rows_fp8(p.peer_v, p.V8, p.SV, 2 * 16384, bid, nb);
    }
    xcd_barrier(bar);
    REPEAT(REP_GEMM) {
        EpiInEven epi{p.H, p.y_prompt, p.VT};
        gemm_big(p.XB, p.WT_IN_EVEN, 2560, epi, lds, bid, nb);
    }
    xcd_barrier(bar);
    REPEAT(REP_CONV) {
    for (int u = bid; u < 512; u += nb) kmean_prompt_unit(p, u);
    for (int u = bid; u < 544; u += nb) conv_unit(p, u, lds);
    }
    xcd_barrier(bar);
    {
        int bgk = 0;
        if (nb == 256) {
            { const int bh = bid >> 4, i = bid & 15; moba_prompt_unit(p, bh, i, lds, bid, bgk); moba_prompt_unit(p, bh, 31 - i, lds, bid, bgk); }
            while (bgk < 32) { bg_kmean_fore(p, bid, bgk, lds); ++bgk; }
            moba_sample_unit(p, bid, lds);
        } else {
            for (int u = bid; u < 512; u += nb) { const int bh = (u & 255) >> 4, i = u & 15; const int blk = (u < 256) ? i : 31 - i; int none = 32; moba_prompt_unit(p, bh, blk, lds, 0, none); }
            for (int u = bid; u < 256; u += nb) { __syncthreads(); for (int k = 0; k < 32; ++k) bg_kmean_fore(p, u, k, lds); moba_sample_unit(p, u, lds); }
        }
    }
    xcd_barrier(bar);
    REPEAT(REP_GEMM) {
        EpiResid epi{p.T, p.XF};
        gemm_big(p.MIX, p.WT_OUT_EVEN, 1024, epi, lds, bid, nb);
    }
    xcd_barrier(bar);
    ln_rows(p, p.ln_g, p.ln_b, bid, nb, false);
    xcd_barrier(bar);
    peer_phases<0>(p, lds, bid, nb, bar);
    xcd_barrier(bar);
    REPEAT(REP_GEMM) {
        EpiInOdd epi{p.H, p.LF, p.LB};
        gemm_big(p.XB, p.WT_IN_ODD, 4096, epi, lds, bid, nb);
    }
    xcd_barrier(bar);
    REPEAT(REP_HGRN) for (int u = bid; u < 2048 + 256; u += nb) { if (u < 2048) hgrn_b1_unit(p, u, lds); else hgrn_sample_unit(p, u - 2048, lds); }
    xcd_barrier(bar);
    REPEAT(REP_HGRN) hgrn_b2(p, bid, nb);
    xcd_barrier(bar);
    REPEAT(REP_HGRN) for (int u = bid; u < 2048; u += nb) hgrn_b3_unit(p, u, lds);
    xcd_barrier(bar);
    REPEAT(REP_GEMM) {
        EpiResid epi{p.T, p.XF};
        gemm_big(p.MIX, p.WT_OUT_ODD, 1024, epi, lds, bid, nb);
    }
    xcd_barrier(bar);
    ln_rows(p, p.ln_g + 2 * DM, p.ln_b + 2 * DM, bid, nb, false);
    xcd_barrier(bar);
    peer_phases<1>(p, lds, bid, nb, bar);
}

extern "C" void kernel_launch(void* const* d_in, const int* in_sizes, int n_in, void* d_out, int out_size, void* d_ws, size_t ws_size, hipStream_t stream) {
    Params p{};
    p.x_prompt = (const float*)d_in[0]; p.x_sample = (const float*)d_in[1]; p.cache_k = (const float*)d_in[2]; p.cache_v = (const float*)d_in[3];
    p.state_conv = (const float*)d_in[4]; p.state_hgrn = (const float*)d_in[5]; p.page_table = (const int*)d_in[6];
    p.w_in_even = (const float*)d_in[7]; p.conv_w = (const float*)d_in[8]; p.conv_b = (const float*)d_in[9]; p.conv_ln_g = (const float*)d_in[10]; p.conv_ln_b = (const float*)d_in[11];
    p.w_out_even = (const float*)d_in[12]; p.w_in_odd = (const float*)d_in[13]; p.lb_logits = (const float*)d_in[14]; p.hgrn_norm_g = (const float*)d_in[15]; p.w_out_odd = (const float*)d_in[16];
    p.ln_g = (const float*)d_in[17]; p.ln_b = (const float*)d_in[18]; p.peer_wq = (const float*)d_in[19]; p.peer_keys = (const float*)d_in[20]; p.peer_u = (const float*)d_in[21]; p.peer_v = (const float*)d_in[22];
    float* o = (float*)d_out;
    p.y_prompt = o; o += (size_t)TP * DM; p.y_sample = o; o += (size_t)TS * DM;
    p.k_prompt = o; o += (size_t)TP * 512; p.v_prompt = o; o += (size_t)TP * 512; p.k_sample = o; o += (size_t)TS * 512; p.v_sample = o; o += (size_t)TS * 512;
    p.conv_prompt = o; o += 2 * 30 * 512; p.conv_sample = o; o += 32 * 30 * 512; p.hgrn_prompt = o; o += 2 * 8 * 128 * 128; p.hgrn_sample = o;
    char* ws = (char*)d_ws; size_t off = 0;
    auto take = [&](size_t bytes) { char* r = ws + off; off += (bytes + 255) & ~(size_t)255; return r; };
    p.bar = (unsigned*)take(16384); p.LB = (float*)take(4096);
    p.WT_IN_EVEN = (bf16_t*)take((size_t)2560 * 1024 * 2); p.WT_OUT_EVEN = (bf16_t*)take((size_t)1024 * 1024 * 2);
    p.WT_IN_ODD = (bf16_t*)take((size_t)4096 * 1024 * 2); p.WT_OUT_ODD = (bf16_t*)take((size_t)1024 * 1024 * 2);
    p.WT_WQ = (bf16_t*)take((size_t)2 * 2048 * 1024 * 2); p.KB = (bf16_t*)take((size_t)2 * 2048 * 128 * 2);
    p.U8 = (unsigned char*)take((size_t)2 * 16384 * DM); p.V8 = (unsigned char*)take((size_t)2 * 16384 * DM); p.SU = (float*)take(2 * 16384 * 4); p.SV = (float*)take(2 * 16384 * 4);
    p.XB = (bf16_t*)take((size_t)MP * DM * 2); p.XF = (float*)take((size_t)MP * DM * 4);
    p.H = (bf16_t*)take((size_t)MP * 4096 * 2); p.LF = (float*)take((size_t)MP * DM * 4);
    p.VT = (bf16_t*)take((size_t)16 * 64 * 8192 * 2); p.KMPP = (float*)take((size_t)512 * 512 * 4); p.KMS = (bf16_t*)take((size_t)1024 * 512 * 2);
    p.MIX = (bf16_t*)take((size_t)MP * DM * 2); p.T = (float*)take((size_t)MP * DM * 4);
    p.QH = (bf16_t*)take((size_t)MP * 2048 * 2); p.S = (float*)take((size_t)MP * 2048 * 4);
    p.E = (int*)take((size_t)MP * 128 * 4); p.G = (float*)take((size_t)MP * 128 * 4);
    p.UT = (float*)take((size_t)2048 * 16384 * 4); p.DEC = (float*)take((size_t)2048 * 128 * 4); p.ST = (bf16_t*)take((size_t)2048 * 16384 * 2);
    if (off > ws_size) { fprintf(stderr, "workspace too small: need %zu have %zu\n", off, ws_size); return; }

    static int grid = 0;
    if (!grid) {
        int dev = 0, cus = 0, per_cu = 0;
        (void)hipGetDevice(&dev);
        (void)hipDeviceGetAttribute(&cus, hipDeviceAttributeMultiprocessorCount, dev);
        (void)hipFuncSetAttribute((const void*)mega, hipFuncAttributeMaxDynamicSharedMemorySize, LDS_BYTES);
        (void)hipOccupancyMaxActiveBlocksPerMultiprocessor(&per_cu, (const void*)mega, NT, LDS_BYTES);
        grid = cus * (per_cu < 1 ? per_cu : 1);
        if (grid <= 0) { fprintf(stderr, "mega kernel not resident: cus %d per_cu %d\n", cus, per_cu); grid = 0; return; }
    }
    (void)hipMemsetAsync(p.bar, 0, XCD_BAR_WORDS * sizeof(unsigned), stream);
    hipLaunchKernelGGL(mega, dim3(grid), dim3(NT), LDS_BYTES, stream, p);
}
```

```cpp
#include <hip/hip_runtime.h>
#include <stdint.h>
#include <stdio.h>

#define DI __device__ __forceinline__
__device__ __forceinline__ int tid_opaque() { int t = threadIdx.x; asm volatile("" : "+v"(t)); return t; }
#define TIDX tid_opaque()
typedef unsigned short bf16_t;
typedef short bf16x8 __attribute__((ext_vector_type(8)));
typedef float f32x4 __attribute__((ext_vector_type(4)));
typedef unsigned u32x4 __attribute__((ext_vector_type(4)));
typedef unsigned u32x2 __attribute__((ext_vector_type(2)));
typedef int i32x4 __attribute__((ext_vector_type(4)));
typedef float f32x2 __attribute__((ext_vector_type(2)));

constexpr int NT = 512;
constexpr int TP = 16384, TS = 32, TT = TP + TS, MP = 16640, DM = 1024, SEQ = 8192;
constexpr float DN_ALPHA = 1.4142135623730951f;
constexpr float LN_EPS = 1e-5f, RMS_EPS = 1e-6f;
constexpr size_t OFF_KP = (size_t)TT * DM, OFF_VP = OFF_KP + (size_t)TP * 512, OFF_KS = OFF_VP + (size_t)TP * 512, OFF_VS = OFF_KS + (size_t)TS * 512;

DI float bf2f(bf16_t h) { return __uint_as_float(((unsigned)h) << 16); }
typedef __bf16 bf16x2_t __attribute__((ext_vector_type(2)));
DI unsigned pack_bf2(float lo, float hi) { bf16x2_t v; v[0] = (__bf16)lo; v[1] = (__bf16)hi; return __builtin_bit_cast(unsigned, v); }
DI bf16_t f2bf(float x) { return (bf16_t)(pack_bf2(x, 0.f) & 0xffffu); }
DI float bflo(unsigned u) { return __uint_as_float(u << 16); }
DI float bfhi(unsigned u) { return __uint_as_float(u & 0xffff0000u); }
DI float sigmoidf_(float x) { return 1.f / (1.f + __expf(-x)); }
DI float wave_sum(float v) {
#pragma unroll
    for (int o = 32; o >= 1; o >>= 1) v += __shfl_xor(v, o, 64);
    return v;
}
DI float wave_max(float v) {
#pragma unroll
    for (int o = 32; o >= 1; o >>= 1) v = fmaxf(v, __shfl_xor(v, o, 64));
    return v;
}

DI float red_max_16_32(float x) {
    u32x2 r = __builtin_amdgcn_permlane16_swap(__float_as_uint(x), __float_as_uint(x), false, false);
    x = fmaxf(__uint_as_float(r[0]), __uint_as_float(r[1]));
    r = __builtin_amdgcn_permlane32_swap(__float_as_uint(x), __float_as_uint(x), false, false);
    return fmaxf(__uint_as_float(r[0]), __uint_as_float(r[1]));
}
DI float red_sum_16_32(float x) {
    u32x2 r = __builtin_amdgcn_permlane16_swap(__float_as_uint(x), __float_as_uint(x), false, false);
    x = __uint_as_float(r[0]) + __uint_as_float(r[1]);
    r = __builtin_amdgcn_permlane32_swap(__float_as_uint(x), __float_as_uint(x), false, false);
    return __uint_as_float(r[0]) + __uint_as_float(r[1]);
}
#define MFMA16(a, b, c) __builtin_amdgcn_mfma_f32_16x16x32_bf16((a), (b), (c), 0, 0, 0)

#ifndef REP_PRO
#define REP_PRO 1
#endif
#ifndef REP_GEMM
#define REP_GEMM 1
#endif
#ifndef REP_CONV
#define REP_CONV 1
#endif
#ifndef REP_MOBAP
#define REP_MOBAP 1
#endif
#ifndef REP_MOBAS
#define REP_MOBAS 1
#endif
#ifndef REP_TOPK
#define REP_TOPK 1
#endif
#ifndef REP_PEER1
#define REP_PEER1 1
#endif
#ifndef REP_USW
#define REP_USW 1
#endif
#ifndef REP_VSW
#define REP_VSW 1
#endif
#ifndef REP_HGRN
#define REP_HGRN 1
#endif
#define REPEAT(N) _Pragma("unroll 1") for (int rep_ = 0; rep_ < (N); ++rep_)
struct Params {
    const float* x_prompt; const float* x_sample; const float* cache_k; const float* cache_v;
    const float* state_conv; const float* state_hgrn; const int* page_table;
    const float* w_in_even; const float* conv_w; const float* conv_b; const float* conv_ln_g; const float* conv_ln_b;
    const float* w_out_even; const float* w_in_odd; const float* lb_logits; const float* hgrn_norm_g; const float* w_out_odd;
    const float* ln_g; const float* ln_b; const float* peer_wq; const float* peer_keys; const float* peer_u; const float* peer_v;
    float* y_prompt; float* y_sample; float* k_prompt; float* v_prompt; float* k_sample; float* v_sample;
    float* conv_prompt; float* conv_sample; float* hgrn_prompt; float* hgrn_sample;
    unsigned* bar; float* LB;
    bf16_t* WT_IN_EVEN; bf16_t* WT_OUT_EVEN; bf16_t* WT_IN_ODD; bf16_t* WT_OUT_ODD; bf16_t* WT_WQ; bf16_t* KB;
    unsigned char* U8; unsigned char* V8; float* SU; float* SV;
    bf16_t* XB; float* XF; bf16_t* H; float* LF; bf16_t* VT; float* KMPP; bf16_t* KMS;
    bf16_t* MIX; float* T; bf16_t* QH; float* S; int* E; float* G;
    bf16_t* UT; float* DEC; bf16_t* ST;
};


#define XB_TMO      128
#define XB_XCNT(j)  (256  + 64 * (j))
#define XB_XSUB(j)  (1280 + 64 * (j))
#define XB_XGEN(j)  (2304 + 64 * (j))
#define XB_TOP      3328
#define XB_TOPGEN   3392
#define XCD_BAR_WORDS 3456
#define XB_SPIN_CAP (1u << 18)
#define LAS __attribute__((address_space(3)))
__device__ __forceinline__ unsigned xb_ld(unsigned* p)              { return __hip_atomic_load(p, __ATOMIC_RELAXED, __HIP_MEMORY_SCOPE_AGENT); }
__device__ __forceinline__ unsigned xb_add(unsigned* p, unsigned v) { return __hip_atomic_fetch_add(p, v, __ATOMIC_RELAXED, __HIP_MEMORY_SCOPE_AGENT); }
__device__ __forceinline__ unsigned xb_xcc_id() { return (unsigned)__builtin_amdgcn_s_getreg((3 << 11) | 20) & 0xFu; }
#define XB_SPIN(cond, bar) do { unsigned _sp = 0; while (cond) { __builtin_amdgcn_s_sleep(1); \
    if ((++_sp & 255u) == 0u) { if (xb_ld(&(bar)[XB_TMO])) break; if (_sp > XB_SPIN_CAP) { atomicAdd(&(bar)[XB_TMO], 1u); break; } } } } while (0)
struct XcdBarrier { unsigned* bar; unsigned x; volatile LAS unsigned* st; };
__device__ __forceinline__ XcdBarrier xcd_barrier_post(unsigned* bar, volatile LAS unsigned* st) {
    XcdBarrier b; b.bar = bar; b.x = xb_xcc_id(); b.st = st;
    if (threadIdx.x == 0) (void)xb_add(&bar[XB_XCNT(b.x)], 1u);
    return b;
}
__device__ __forceinline__ void xcd_barrier_complete(unsigned* bar, unsigned x, unsigned& nloc, unsigned& nx) {
    const unsigned G = gridDim.x * gridDim.y * gridDim.z;
    unsigned sum, cnt, mine, sp = 0u;
    for (;;) {
        sum = 0u; cnt = 0u; mine = 0u;
#pragma unroll
        for (unsigned j = 0; j < 16; ++j) { const unsigned c = xb_ld(&bar[XB_XCNT(j)]); sum += c; cnt += (c > 0u) ? 1u : 0u; mine = (j == x) ? c : mine; }
        if (sum == G) break;
        __builtin_amdgcn_s_sleep(1);
        if ((++sp & 255u) == 0u) { if (xb_ld(&bar[XB_TMO])) break; if (sp > XB_SPIN_CAP) { atomicAdd(&bar[XB_TMO], 1u); break; } }
    }
    nloc = mine > 0u ? mine : 1u; nx = cnt > 0u ? cnt : 1u;
}
__device__ __forceinline__ void xcd_barrier(const XcdBarrier& b) {
    asm volatile("s_waitcnt vmcnt(0)" ::: "memory");
    __syncthreads();
    if (threadIdx.x == 0) {
        unsigned* bar = b.bar;
        __builtin_amdgcn_s_waitcnt(0);
        unsigned nloc = b.st[0], nx = b.st[1];
        if (nloc == 0u) { xcd_barrier_complete(bar, b.x, nloc, nx); b.st[0] = nloc; b.st[1] = nx; }
        const unsigned old = xb_add(&bar[XB_XSUB(b.x)], 1u);
        const unsigned gen = old / nloc;
        if (old + 1u == (gen + 1u) * nloc) {
            __builtin_amdgcn_fence(__ATOMIC_RELEASE, "agent");
            asm volatile("s_waitcnt vmcnt(0)" ::: "memory");
            const unsigned og = xb_add(&bar[XB_TOP], 1u);
            const unsigned tg = og / nx;
            if (og + 1u == (tg + 1u) * nx) xb_add(&bar[XB_TOPGEN], 1u);
            else XB_SPIN(xb_ld(&bar[XB_TOPGEN]) == tg, bar);
            __builtin_amdgcn_fence(__ATOMIC_ACQUIRE, "agent");
            xb_add(&bar[XB_XGEN(b.x)], 1u);
            asm volatile("s_waitcnt vmcnt(0)" ::: "memory");
        } else {
            XB_SPIN(xb_ld(&bar[XB_XGEN(b.x)]) == gen, bar);
            __builtin_amdgcn_fence(__ATOMIC_ACQUIRE, "agent");
            asm volatile("s_waitcnt vmcnt(0)" ::: "memory");
        }
    }
    __syncthreads();
}

DI void transpose_unit(const float* __restrict__ W, int K, int N, bf16_t* __restrict__ Wt, int u, char* lds) {
    float* tile = (float*)lds;
    const int tid = TIDX;
    const int ntn = N >> 6; const int kt = u / ntn, nt = u % ntn;
#pragma unroll
    for (int i = 0; i < 8; ++i) { int idx = tid + NT * i; int r = idx >> 6, c = idx & 63; tile[r * 65 + c] = W[(size_t)(kt * 64 + r) * N + nt * 64 + c]; }
    __syncthreads();
#pragma unroll
    for (int i = 0; i < 8; ++i) { int idx = tid + NT * i; int r = idx >> 6, c = idx & 63; Wt[(size_t)(nt * 64 + r) * K + kt * 64 + c] = f2bf(tile[c * 65 + r]); }
    __syncthreads();
}
DI void convert_range(const float* __restrict__ src, bf16_t* __restrict__ dst, size_t n4, int bid, int nb) {
    for (size_t i = (size_t)bid * NT + TIDX; i < n4; i += (size_t)nb * NT) {
        f32x4 v = *(const f32x4*)(src + 4 * i);
        u32x2 o; o[0] = pack_bf2(v[0], v[1]); o[1] = pack_bf2(v[2], v[3]);
        *(u32x2*)(dst + 4 * i) = o;
    }
}

template <int OFFS> DI void quant_rows(const float* __restrict__ src, unsigned char* __restrict__ dst, float* __restrict__ inv, int R, int bid, int nb) {
    const int lane = TIDX & 63, w = TIDX >> 6;
#pragma unroll 2
    for (int row = bid * 8 + w; row < R; row += nb * 8) {
        f32x4 v[4]; float am = 0.f;
#pragma unroll
        for (int i = 0; i < 4; ++i) { v[i] = *(const f32x4*)(src + (size_t)row * DM + 4 * lane + 256 * i); am = fmaxf(am, fmaxf(fmaxf(fabsf(v[i][0]), fabsf(v[i][1])), fmaxf(fabsf(v[i][2]), fabsf(v[i][3])))); }
        am = wave_max(am);
        const float sc = am > 0.f ? 127.f / am : 0.f;
#pragma unroll
        for (int i = 0; i < 4; ++i) {
            unsigned pk = 0;
#pragma unroll
            for (int k = 0; k < 4; ++k) { const int q = (int)rintf(v[i][k] * sc) + OFFS; pk |= ((unsigned)q & 0xffu) << (8 * k); }
            const int col = 4 * lane + 256 * i;
            *(unsigned*)(dst + (size_t)(row >> 14) * 16384 * DM + (size_t)(col >> 7) * (16384 * 128) + (size_t)(row & 16383) * 128 + (col & 127)) = pk;
        }
        if (lane == 0) inv[row] = am * (1.f / 127.f);
    }
}
DI void quant_rows_fp8(const float* __restrict__ src, unsigned char* __restrict__ dst, float* __restrict__ inv, int R, int bid, int nb) {
    const int lane = TIDX & 63, w = TIDX >> 6;
#pragma unroll 2
    for (int row = bid * 8 + w; row < R; row += nb * 8) {
        f32x4 v[4]; float am = 0.f;
#pragma unroll
        for (int i = 0; i < 4; ++i) { v[i] = *(const f32x4*)(src + (size_t)row * DM + 4 * lane + 256 * i); am = fmaxf(am, fmaxf(fmaxf(fabsf(v[i][0]), fabsf(v[i][1])), fmaxf(fabsf(v[i][2]), fabsf(v[i][3])))); }
        am = wave_max(am);
        const float sc = am > 0.f ? 416.f / am : 0.f;
#pragma unroll
        for (int i = 0; i < 4; ++i) {
            int pk = 0;
            pk = __builtin_amdgcn_cvt_pk_fp8_f32(v[i][0] * sc, v[i][1] * sc, pk, false);
            pk = __builtin_amdgcn_cvt_pk_fp8_f32(v[i][2] * sc, v[i][3] * sc, pk, true);
            const int col = 4 * lane + 256 * i;
            *(int*)(dst + (size_t)(row >> 14) * 16384 * DM + (size_t)(col >> 7) * (16384 * 128) + (size_t)(row & 16383) * 128 + (col & 127)) = pk;
        }
        if (lane == 0) inv[row] = am * (1.f / 416.f);
    }
}
DI void convert_x(const Params& p, int bid, int nb) {
    const size_t n4 = (size_t)MP * DM / 4;
    for (size_t i = (size_t)bid * NT + TIDX; i < n4; i += (size_t)nb * NT) {
        size_t e = 4 * i; int row = (int)(e >> 10); int col = (int)(e & 1023);
        f32x4 v = {0.f, 0.f, 0.f, 0.f};
        if (row < TP) v = *(const f32x4*)(p.x_prompt + e);
        else if (row < TT) v = *(const f32x4*)(p.x_sample + (size_t)(row - TP) * DM + col);
        *(f32x4*)(p.XF + e) = v;
        u32x2 o; o[0] = pack_bf2(v[0], v[1]); o[1] = pack_bf2(v[2], v[3]);
        *(u32x2*)(p.XB + e) = o;
    }
}
DI void convert_keys(const Params& p, int bid, int nb) {
    const int n = 2 * 2 * 8 * 128 * 128;
    for (int i = bid * NT + TIDX; i < n; i += nb * NT) {
        int d = i & 127, nn = (i >> 7) & 127, j = (i >> 14) & 15, l = i >> 18;
        int h = j >> 1, half = j & 1;
        p.KB[i] = f2bf(p.peer_keys[((((size_t)l * 2 + half) * 8 + h) * 128 + nn) * 128 + d]);
    }
    if (bid == 0) for (int c = TIDX; c < 1024; c += NT) p.LB[c] = sigmoidf_(p.lb_logits[1024 + c] - p.lb_logits[c]);
}
DI void kmean_sample_unit(const Params& p, int u, char* lds) {
    float* part = (float*)lds;
    const int tid = TIDX, c4 = tid & 127, rg = tid >> 7;
    const int b = u >> 5, blk = u & 31;
    f32x4 acc = {0.f, 0.f, 0.f, 0.f};
    const int page = p.page_table[b * 64 + blk * 2 + (rg >> 1)];
    const float* src = p.cache_k + ((size_t)page * 128 + (rg & 1) * 64) * 512 + 4 * c4;
#pragma unroll 1
    for (int r0 = 0; r0 < 64; r0 += 8) {
        f32x4 v[8];
#pragma unroll
        for (int i = 0; i < 8; ++i) v[i] = *(const f32x4*)(src + (size_t)(r0 + i) * 512);
#pragma unroll
        for (int i = 0; i < 8; ++i) acc += v[i];
    }
    __syncthreads();
    *(f32x4*)(part + rg * 512 + 4 * c4) = acc;
    __syncthreads();
    { const int c = tid; const float sum = part[c] + part[512 + c] + part[1024 + c] + part[1536 + c]; p.KMS[(size_t)u * 512 + c] = f2bf(sum * (1.f / 256.f)); }
}
DI void kmean_prompt_unit(const Params& p, int u) {
    const int c = TIDX;
    const float* src = p.k_prompt + (size_t)u * 32 * 512 + c;
    float acc = 0.f;
#pragma unroll
    for (int r = 0; r < 32; ++r) acc += src[(size_t)r * 512];
    p.KMPP[(size_t)u * 512 + c] = acc;
}

struct GemmArgs { const bf16_t* A; int lda; const bf16_t* Bt; int ldb; int K; int blockdiag; };
constexpr int GEMM_LDS = 2 * 49152;

template <class Epi>
DI void gemm_unit(const GemmArgs g, int m0, int n0, const Epi epi, char* lds) {
    const int tid = TIDX, lane = tid & 63, w = tid >> 6;
    const int wm = w & 3, wn = w >> 2, lr = lane & 15, lg = lane >> 4;
    const int acol = g.blockdiag ? n0 : 0;
    const int nk = g.K >> 6;
    f32x4 acc[4][4];
#pragma unroll
    for (int i = 0; i < 4; ++i)
#pragma unroll
        for (int j = 0; j < 4; ++j) acc[i][j] = (f32x4){0.f, 0.f, 0.f, 0.f};
    u32x4 ra[4], rb[2];
    auto gload = [&](int kt) {
#pragma unroll
        for (int i = 0; i < 4; ++i) { int id = tid + NT * i; int r = id >> 3, c = id & 7; ra[i] = *(const u32x4*)(g.A + (size_t)(m0 + r) * g.lda + acol + kt * 64 + c * 8); }
#pragma unroll
        for (int i = 0; i < 2; ++i) { int id = tid + NT * i; int r = id >> 3, c = id & 7; rb[i] = *(const u32x4*)(g.Bt + (size_t)(n0 + r) * g.ldb + kt * 64 + c * 8); }
    };
    auto sstore = [&](int st) {
        char* base = lds + st * 49152;
#pragma unroll
        for (int i = 0; i < 4; ++i) { int id = tid + NT * i; int r = id >> 3, c = id & 7; *(u32x4*)(base + r * 128 + ((c ^ (r & 7)) << 4)) = ra[i]; }
#pragma unroll
        for (int i = 0; i < 2; ++i) { int id = tid + NT * i; int r = id >> 3, c = id & 7; *(u32x4*)(base + 32768 + r * 128 + ((c ^ (r & 7)) << 4)) = rb[i]; }
    };
    gload(0); sstore(0); __syncthreads();
    for (int kt = 0; kt < nk; ++kt) {
        if (kt + 1 < nk) gload(kt + 1);
        const char* base = lds + (kt & 1) * 49152;
#pragma unroll
        for (int ks = 0; ks < 2; ++ks) {
            bf16x8 af[4], bfr[4];
#pragma unroll
            for (int i = 0; i < 4; ++i) { int r = wm * 64 + i * 16 + lr; int ch = ks * 4 + lg; af[i] = *(const bf16x8*)(base + r * 128 + ((ch ^ (r & 7)) << 4)); }
#pragma unroll
            for (int i = 0; i < 4; ++i) { int r = wn * 64 + i * 16 + lr; int ch = ks * 4 + lg; bfr[i] = *(const bf16x8*)(base + 32768 + r * 128 + ((ch ^ (r & 7)) << 4)); }
#pragma unroll
            for (int i = 0; i < 4; ++i)
#pragma unroll
                for (int j = 0; j < 4; ++j) acc[i][j] = MFMA16(bfr[j], af[i], acc[i][j]);
        }
        if (kt + 1 < nk) sstore((kt + 1) & 1);
        __syncthreads();
    }
#pragma unroll
    for (int i = 0; i < 4; ++i)
#pragma unroll
        for (int j = 0; j < 4; ++j) epi(m0 + wm * 64 + i * 16 + lr, n0 + wn * 64 + j * 16 + 4 * lg, acc[i][j]);
}

template <class Epi>
DI void gemm_phase(const GemmArgs g, int M, int N, const Epi epi, char* lds, int bid, int nb) {
    const int tn = N >> 7, tm = M >> 8;
    for (int u = bid; u < tm * tn; u += nb) { int mt = u / tn, nt = u % tn; gemm_unit(g, mt * 256, nt * 128, epi, lds); }
}

DI void store_bf4(bf16_t* dst, f32x4 v) { u32x2 o; o[0] = pack_bf2(v[0], v[1]); o[1] = pack_bf2(v[2], v[3]); *(u32x2*)dst = o; }

struct EpiInEven {
    bf16_t* H; float* out; bf16_t* VT;
    DI void operator()(int row, int col, f32x4 v) const {
        store_bf4(H + (size_t)row * 2560 + col, v);
        if (col >= 512 && col < 1536 && row < TT) {
            const bool isv = col >= 1024; const int c = col - (isv ? 1024 : 512);
            const size_t off = row < TP ? (isv ? OFF_VP : OFF_KP) + (size_t)row * 512 + c : (isv ? OFF_VS : OFF_KS) + (size_t)(row - TP) * 512 + c;
            *(f32x4*)(out + off) = v;
            if (isv && row < TP) {
                const int b = row >> 13, s = row & 8191, h = c >> 6, d = c & 63;
                bf16_t* vt = VT + ((size_t)(b * 8 + h) * 64 + d) * 8192 + s;
#pragma unroll
                for (int i = 0; i < 4; ++i) vt[(size_t)i * 8192] = f2bf(v[i]);
            }
        }
    }
};
struct EpiBf16 { bf16_t* O; int ld; DI void operator()(int row, int col, f32x4 v) const { store_bf4(O + (size_t)row * ld + col, v); } };
struct EpiF32 { float* O; int ld; DI void operator()(int row, int col, f32x4 v) const { *(f32x4*)(O + (size_t)row * ld + col) = v; } };
struct EpiResid {
    float* T; const float* XF;
    DI void operator()(int row, int col, f32x4 v) const { f32x4 x = *(const f32x4*)(XF + (size_t)row * DM + col); *(f32x4*)(T + (size_t)row * DM + col) = x * DN_ALPHA + v; }
};
struct EpiInOdd {
    bf16_t* H; float* LF; const float* LB;
    DI void operator()(int row, int col, f32x4 v) const {
        const int sec = col >> 10, c = col & 1023;
        if (sec == 1) {
            f32x4 lb = *(const f32x4*)(LB + c); f32x4 lf, kk;
#pragma unroll
            for (int i = 0; i < 4; ++i) { float f = lb[i] + (1.f - lb[i]) * sigmoidf_(v[i]); lf[i] = __logf(f); kk[i] = 1.f - f; }
            *(f32x4*)(LF + (size_t)row * DM + c) = lf;
            store_bf4(H + (size_t)MP * DM + (size_t)row * DM + c, kk);
        } else {
            store_bf4(H + (size_t)sec * MP * DM + (size_t)row * DM + c, v);
        }
    }
};

namespace pg8 {
#define PG8_LAS __attribute__((address_space(3)))
typedef unsigned short bf16_t;
typedef short bf16x8 __attribute__((ext_vector_type(8)));
typedef float f32x4 __attribute__((ext_vector_type(4)));
typedef unsigned u32x4 __attribute__((ext_vector_type(4)));
constexpr int BM = 256, BK = 64, HALF = 128, HTB = HALF * BK * 2  , STAGE_BYTES = 8 * HTB, NXCD = 8, WGM = 8;

__host__ __device__ __forceinline__ int lds_byte(int r, int c) { const int st = (r >> 4) * 2 + (c >> 5), rr = r & 15, cc = c & 31, ob = rr * 64 + cc * 2; return st * 1024 + (ob ^ (((ob >> 9) & 1) << 5)); }
__host__ __device__ __forceinline__ void stage_rc(int b, int& R, int& C) { const int st = b / 1024, sb = b % 1024, swz = sb ^ (((sb >> 9) & 1) << 5); R = (st >> 1) * 16 + swz / 64; C = (st & 1) * 32 + (swz % 64) / 2; }
__host__ __device__ __forceinline__ int perm32(int rho) { const int n = rho >> 4, i = rho & 15; return 8 * (i >> 2) + 4 * n + (i & 3); }

struct Unit { int pm, pn; };
struct Gemm { const bf16_t* A; const bf16_t* Bt; int M, N, K; };

struct StaticOrder {
    int nM, nN, nwg, G, c;
    __host__ __device__ void init(int M, int N, int G_, int c_) { nM = M / BM; nN = N / BM; nwg = nM * nN; G = G_; c = c_; }
    __host__ __device__ bool next(int i, Unit& u) const {
        const long L = (long)i * G + c; if (L >= nwg) return false;
        int wgid = (int)L; { const int q = nwg / NXCD, r = nwg % NXCD, xcd = wgid % NXCD, off = wgid / NXCD; wgid = (xcd < r ? xcd * (q + 1) : r * (q + 1) + (xcd - r) * q) + off; }
        const int nig = WGM * nN, gid = wgid / nig, fm = gid * WGM, gsz = (nM - fm) < WGM ? (nM - fm) : WGM;
        u.pm = fm + ((wgid % nig) % gsz); u.pn = (wgid % nig) / gsz; return true;
    }
    __device__ __forceinline__ void a_ready(const Unit&) const {}
    __device__ __forceinline__ void done(const Unit&) const {}
};

template <class Epi, class Sched, bool STAMP = false>
__device__ __forceinline__ void gemm_phase(PG8_LAS unsigned char* lds, const Gemm g, const Sched& S, const Epi& E, unsigned long long* stamps) {
    const int tid = TIDX, wid = __builtin_amdgcn_readfirstlane(tid >> 6), lane = tid & 63, wr = wid >> 2, wc = wid & 3, fr = lane & 15, fq = lane >> 4;
    const int K = g.K, nt = K / BK;
    int ts_lo = 0, ts_hi = 0, nts = 0; const unsigned long long rt_entry = STAMP ? (unsigned long long)wall_clock64() : 0ull;
#define PG8_STAMP() do { if (STAMP && wid == 0 && nts < 64) { const unsigned long long _c = (unsigned long long)clock64(); \
        ts_lo = (lane == nts) ? (int)(unsigned)_c : ts_lo; ts_hi = (lane == nts) ? (int)(unsigned)(_c >> 32) : ts_hi; ++nts; } } while (0)
    PG8_STAMP();
    unsigned voffA[2], voffB[2];
#pragma unroll
    for (int i = 0; i < 2; ++i) { int R, C; stage_rc(tid * 16 + i * 8192, R, C); const int Rb = Epi::PERM ? ((R & ~31) + perm32(R & 31)) : R;
        voffA[i] = (unsigned)(R * K + C) * 2u; voffB[i] = (unsigned)(Rb * K + C) * 2u; }
    const size_t kstep = (size_t)(BK * 2);
    const size_t hstep = (size_t)HALF * K * 2;
    const size_t tstep = 2 * hstep;
    const unsigned ldsw = (unsigned)wid * 1024u;
    const int aoff = lds_byte(wr * 64 + fr, fq * 8), boff = lds_byte(wc * 32 + fr, fq * 8);
#define PG8_SA(b, h) (((b) * 2 + (h)) * HTB)
#define PG8_SB(b, h) ((4 + (b) * 2 + (h)) * HTB)
#define PG8_STAGE(bufoff, gbase, voff) do { _Pragma("unroll") for (int _i = 0; _i < 2; ++_i) \
        __builtin_amdgcn_global_load_lds((const unsigned*)((const char*)(gbase) + (voff)[_i]), (PG8_LAS unsigned*)(lds + (bufoff) + ldsw + _i * 8192), 16, 0, 0); } while (0)
#define PG8_LDA(dst, b, h) do { _Pragma("unroll") for (int m = 0; m < 4; ++m) _Pragma("unroll") for (int k = 0; k < 2; ++k) dst[m][k] = *(const PG8_LAS bf16x8*)(lds + PG8_SA(b, h) + aoff + m * 2048 + k * 1024); } while (0)
#define PG8_LDB(dst, b, h) do { _Pragma("unroll") for (int n = 0; n < 2; ++n) _Pragma("unroll") for (int k = 0; k < 2; ++k) dst[n][k] = *(const PG8_LAS bf16x8*)(lds + PG8_SB(b, h) + boff + n * 2048 + k * 1024); } while (0)
#define PG8_MMA(ai, bj, At, Bt) do { __builtin_amdgcn_s_setprio(1); _Pragma("unroll") for (int m = 0; m < 4; ++m) _Pragma("unroll") for (int n = 0; n < 2; ++n) _Pragma("unroll") for (int k = 0; k < 2; ++k) \
        acc[ai][bj][m][n] = __builtin_amdgcn_mfma_f32_16x16x32_bf16(Bt[n][k], At[m][k], acc[ai][bj][m][n], 0, 0, 0); __builtin_amdgcn_s_setprio(0); } while (0)
#define PG8_WAIT_V(n) asm volatile("s_waitcnt vmcnt(" #n ")" ::: "memory")
#define PG8_WAIT_L(n) asm volatile("s_waitcnt lgkmcnt(" #n ")" ::: "memory")
#define PG8_BAR __builtin_amdgcn_s_barrier()
#define PG8_SCHED __builtin_amdgcn_sched_barrier(0)
    Unit cur, nxt; int ui = 0;
    if (!S.next(0, cur)) return;
    f32x4 acc[2][2][4][2];
#pragma unroll
    for (int a = 0; a < 2; ++a)
#pragma unroll
        for (int b = 0; b < 2; ++b)
#pragma unroll
            for (int m = 0; m < 4; ++m)
#pragma unroll
                for (int n = 0; n < 2; ++n) acc[a][b][m][n] = (f32x4){0.f, 0.f, 0.f, 0.f};
    bf16x8 At[4][2], B0[2][2], B1[2][2];
    const char* cA = (const char*)g.A + (size_t)cur.pm * tstep; const char* cB = (const char*)g.Bt + (size_t)cur.pn * tstep;
    S.a_ready(cur);
    PG8_STAGE(PG8_SB(0, 0), cB, voffB); PG8_STAGE(PG8_SA(0, 0), cA, voffA); PG8_STAGE(PG8_SB(0, 1), cB + hstep, voffB); PG8_STAGE(PG8_SA(0, 1), cA + hstep, voffA);
    if (wr == 1) PG8_BAR;
    PG8_WAIT_V(4); PG8_BAR;
    PG8_STAGE(PG8_SB(1, 0), cB + kstep, voffB); PG8_STAGE(PG8_SA(1, 0), cA + kstep, voffA); PG8_STAGE(PG8_SB(1, 1), cB + hstep + kstep, voffB);
    PG8_WAIT_V(6); PG8_BAR;
    PG8_STAMP();
    for (;;) {
        const bool has_next = S.next(ui + 1, nxt);
        const char* nA = has_next ? (const char*)g.A + (size_t)nxt.pm * tstep : cA; const char* nB = has_next ? (const char*)g.Bt + (size_t)nxt.pn * tstep : cB;
        for (int t = 0; t < nt; t += 2) {
            const bool last = (t == nt - 2);
            const char* a1 = cA + (size_t)(t + 1) * kstep;
            const char* a2 = last ? nA : cA + (size_t)(t + 2) * kstep; const char* b2 = last ? nB : cB + (size_t)(t + 2) * kstep;
            const char* a3 = a2 + kstep; const char* b3 = b2 + kstep;
            if (last && has_next) S.a_ready(nxt);
            PG8_LDB(B0, 0, 0); PG8_SCHED; PG8_LDA(At, 0, 0); PG8_STAGE(PG8_SA(1, 1), a1 + hstep, voffA);
            PG8_WAIT_L(8); PG8_BAR; PG8_WAIT_L(0); PG8_MMA(0, 0, At, B0); PG8_BAR; PG8_SCHED;
            PG8_LDB(B1, 0, 1); PG8_STAGE(PG8_SB(0, 0), b2, voffB);
            PG8_BAR; PG8_WAIT_L(0); PG8_MMA(0, 1, At, B1); PG8_BAR;
            PG8_LDA(At, 0, 1); PG8_STAGE(PG8_SA(0, 0), a2, voffA);
            PG8_BAR; PG8_WAIT_L(0); PG8_MMA(1, 0, At, B0); PG8_BAR; PG8_SCHED;
            PG8_STAGE(PG8_SB(0, 1), b2 + hstep, voffB);
            PG8_WAIT_V(6); PG8_BAR; PG8_MMA(1, 1, At, B1); PG8_BAR;
            PG8_LDB(B0, 1, 0); PG8_SCHED; PG8_LDA(At, 1, 0); PG8_STAGE(PG8_SA(0, 1), a2 + hstep, voffA);
            PG8_WAIT_L(8); PG8_BAR; PG8_WAIT_L(0); PG8_MMA(0, 0, At, B0); PG8_BAR; PG8_SCHED;
            PG8_LDB(B1, 1, 1); PG8_STAGE(PG8_SB(1, 0), b3, voffB);
            PG8_BAR; PG8_WAIT_L(0); PG8_MMA(0, 1, At, B1); PG8_BAR;
            PG8_LDA(At, 1, 1); PG8_STAGE(PG8_SA(1, 0), a3, voffA);
            PG8_BAR; PG8_WAIT_L(0); PG8_MMA(1, 0, At, B0); PG8_BAR; PG8_SCHED;
            PG8_STAGE(PG8_SB(1, 1), b3 + hstep, voffB);
            PG8_WAIT_V(6); PG8_BAR; PG8_MMA(1, 1, At, B1); PG8_BAR;
        }
        PG8_STAMP();
        if constexpr (!Epi::AFTER_DRAIN) { E(acc, cur, wr, wc, fr, fq); S.done(cur); }
        PG8_STAMP();
        if (!has_next) break;
#pragma unroll
        for (int a = 0; a < 2; ++a)
#pragma unroll
            for (int b = 0; b < 2; ++b)
#pragma unroll
                for (int m = 0; m < 4; ++m)
#pragma unroll
                    for (int n = 0; n < 2; ++n) acc[a][b][m][n] = (f32x4){0.f, 0.f, 0.f, 0.f};
        cur = nxt; cA = nA; cB = nB; ++ui;
    }
    PG8_WAIT_V(0);
    if (wr == 0) PG8_BAR;
    PG8_BAR;
    if constexpr (Epi::AFTER_DRAIN) { E.fused(acc, cur, wr, wc, fr, fq, lds, wid, lane); S.done(cur); }
    PG8_STAMP();
    if (STAMP && wid == 0) { stamps[lane] = lane < nts ? (((unsigned long long)(unsigned)ts_hi << 32) | (unsigned)ts_lo) : 0ull;
        if (lane == 62) stamps[62] = rt_entry; if (lane == 63) stamps[63] = (unsigned long long)wall_clock64(); }
#undef PG8_STAMP
#undef PG8_SA
#undef PG8_SB
#undef PG8_STAGE
#undef PG8_LDA
#undef PG8_LDB
#undef PG8_MMA
#undef PG8_WAIT_V
#undef PG8_WAIT_L
#undef PG8_BAR
#undef PG8_SCHED
}
}

template <class MyEpi> struct Pg8Epi {
    static constexpr bool PERM = false, AFTER_DRAIN = false;
    MyEpi e;
    __device__ __forceinline__ void operator()(const pg8::f32x4 (&acc)[2][2][4][2], const pg8::Unit& u, int wr, int wc, int fr, int fq) const {
#pragma unroll
        for (int ai = 0; ai < 2; ++ai)
#pragma unroll
            for (int m = 0; m < 4; ++m) {
                const int row = u.pm * 256 + ai * 128 + wr * 64 + m * 16 + fr;
#pragma unroll
                for (int bj = 0; bj < 2; ++bj)
#pragma unroll
                    for (int n = 0; n < 2; ++n) e(row, u.pn * 256 + bj * 128 + wc * 32 + n * 16 + 4 * fq, acc[ai][bj][m][n]);
            }
    }
};

template <class E> DI void gemm_small32_unit(const bf16_t* A, int lda, const bf16_t* Bt, int ldb, int K, int m0, int n0, const E epi) {
    const int tid = TIDX, lane = tid & 63, w = tid >> 6, lr = lane & 15, lg = lane >> 4;
    const bf16_t* a0 = A + (size_t)(m0 + lr) * lda + lg * 8; const bf16_t* a1 = a0 + (size_t)16 * lda;
    const bf16_t* b0 = Bt + (size_t)(n0 + w * 16 + lr) * ldb + lg * 8;
    f32x4 acc0 = {0.f, 0.f, 0.f, 0.f}, acc1 = {0.f, 0.f, 0.f, 0.f};
#pragma unroll 2
    for (int k0 = 0; k0 < K; k0 += 128) {
        bf16x8 fa0[4], fa1[4], fb[4];
#pragma unroll
        for (int i = 0; i < 4; ++i) { fa0[i] = *(const bf16x8*)(a0 + k0 + i * 32); fa1[i] = *(const bf16x8*)(a1 + k0 + i * 32); fb[i] = *(const bf16x8*)(b0 + k0 + i * 32); }
#pragma unroll
        for (int i = 0; i < 4; ++i) { acc0 = MFMA16(fb[i], fa0[i], acc0); acc1 = MFMA16(fb[i], fa1[i], acc1); }
    }
    epi(m0 + lr, n0 + w * 16 + 4 * lg, acc0);
    epi(m0 + 16 + lr, n0 + w * 16 + 4 * lg, acc1);
}
template <class E> DI void gemm_big(const bf16_t* A, const bf16_t* Bt, int N, const E epi, char* lds, int bid, int nb) {
    {
        pg8::Gemm g{A, Bt, TP, N, DM};
        pg8::StaticOrder S; S.init(TP, N, nb, bid);
        Pg8Epi<E> pe{epi};
        pg8::gemm_phase<Pg8Epi<E>, pg8::StaticOrder, false>((PG8_LAS unsigned char*)lds, g, S, pe, nullptr);
    }
    __syncthreads();
    for (int u = nb - 1 - bid; u < (N >> 7); u += nb) gemm_small32_unit(A, DM, Bt, DM, DM, TP, u * 128, epi);
}

DI void conv_unit(const Params& p, int u, char* lds) {
    float* sy = (float*)lds;
    const int c = TIDX, lane = c & 63, w = c >> 6;
    float wj[31];
#pragma unroll
    for (int j = 0; j < 31; ++j) wj[j] = p.conv_w[j * 512 + c];
    const float bias = p.conv_b[c];
    int ntok, row0;
    if (u < 512) {
        const int b = u >> 8, t0 = (u & 255) * 32; ntok = 32; row0 = b * SEQ + t0;
        float uu[62];
#pragma unroll
        for (int r = 0; r < 62; ++r) {
            const int t = t0 - 30 + r; float val = 0.f;
            if (t >= 0) { const size_t row = (size_t)b * SEQ + t; float a = bf2f(p.H[row * 2560 + 1536 + c]); float g = bf2f(p.H[row * 2560 + 2048 + c]); val = a * sigmoidf_(g); }
            uu[r] = val;
            if (t0 == SEQ - 32 && r >= 32) p.conv_prompt[((size_t)b * 30 + (r - 32)) * 512 + c] = val;
        }
#pragma unroll
        for (int tt = 0; tt < 32; ++tt) {
            float acc = bias;
#pragma unroll
            for (int j = 0; j < 31; ++j) acc += wj[j] * uu[tt + j];
            sy[tt * 512 + c] = acc;
        }
    } else {
        const int b = u - 512; ntok = 1; row0 = TP + b;
        const size_t row = (size_t)row0;
        float a = bf2f(p.H[row * 2560 + 1536 + c]); float g = bf2f(p.H[row * 2560 + 2048 + c]);
        const float un = a * sigmoidf_(g);
        float acc = bias + wj[30] * un;
#pragma unroll
        for (int j = 0; j < 30; ++j) {
            float e = p.state_conv[((size_t)b * 30 + j) * 512 + c]; acc += wj[j] * e;
            if (j >= 1) p.conv_sample[((size_t)b * 30 + (j - 1)) * 512 + c] = e;
        }
        p.conv_sample[((size_t)b * 30 + 29) * 512 + c] = un;
        sy[c] = acc;
    }
    __syncthreads();
    for (int tt = w; tt < ntok; tt += 8) {
        float v[8]; float s = 0.f;
#pragma unroll
        for (int i = 0; i < 8; ++i) { v[i] = sy[tt * 512 + lane + 64 * i]; s += v[i]; }
        const float mu = wave_sum(s) * (1.f / 512.f);
        float q = 0.f;
#pragma unroll
        for (int i = 0; i < 8; ++i) { float d = v[i] - mu; q += d * d; }
        const float rs = rsqrtf(wave_sum(q) * (1.f / 512.f) + LN_EPS);
#pragma unroll
        for (int i = 0; i < 8; ++i) {
            const int cc = lane + 64 * i;
            float y = (v[i] - mu) * rs * p.conv_ln_g[cc] + p.conv_ln_b[cc];
            y = y * sigmoidf_(y);
            p.MIX[(size_t)(row0 + tt) * DM + 512 + cc] = f2bf(y);
        }
    }
    __syncthreads();
}

constexpr int MB_K = 0, MB_V = 65536, MB_VROW = 528, MB_WOR = 65536 + 2 * 64 * MB_VROW;
constexpr int MB_BGS = MB_WOR + 128, MB_KMS = MB_BGS + 2 * 8192, MB_END = MB_KMS + 8192;
DI void moba_sample_unit(const Params& p, int u, char* lds) {
    float* sq = (float*)lds;
    float* gs = sq + 64;
    int* sel = (int*)(gs + 32);
    float* lg = (float*)(sel + 4);
    float* red = lg + 776;
    unsigned* roff = (unsigned*)(red + 16);
    float* part = (float*)(roff + 776);
    const int tid = TIDX, lane = tid & 63, w = tid >> 6;
    const int b = u >> 3, h = u & 7; const size_t row = (size_t)TP + b;
    __syncthreads();
    if (tid < 64) sq[tid] = bf2f(p.H[row * 2560 + h * 64 + tid]);
    __syncthreads();
    if (tid < 32) { const float* km = (const float*)(lds + MB_KMS) + tid * 64; float s = 0.f;
#pragma unroll 8
        for (int d = 0; d < 64; ++d) s += sq[d] * km[d];
        gs[tid] = s; }
    __syncthreads();
    if (tid == 0) {
        float v0 = -INFINITY, v1 = -INFINITY, v2 = -INFINITY; int i0 = 0, i1 = 0, i2 = 0;
        for (int j = 0; j < 32; ++j) { float s = gs[j];
            if (s > v0) { v2 = v1; i2 = i1; v1 = v0; i1 = i0; v0 = s; i0 = j; }
            else if (s > v1) { v2 = v1; i2 = i1; v1 = s; i1 = j; }
            else if (s > v2) { v2 = s; i2 = j; } }
        sel[0] = i0; sel[1] = i1; sel[2] = i2;
    }
    __syncthreads();
    for (int idx = tid; idx < 769; idx += NT) {
        float s = 0.f;
        if (idx < 768) {
            const int blk = sel[idx >> 8]; const int pos = blk * 256 + (idx & 255);
            const int page = p.page_table[b * 64 + (pos >> 7)];
            const unsigned ro = ((unsigned)page * 128u + (unsigned)(pos & 127)) * 8u + (unsigned)h;
            roff[idx] = ro;
            const float* kp = p.cache_k + (size_t)ro * 64;
            f32x4 kv[16];
#pragma unroll
            for (int d4 = 0; d4 < 16; ++d4) kv[d4] = *(const f32x4*)(kp + 4 * d4);
#pragma unroll
            for (int d4 = 0; d4 < 16; ++d4) s += sq[4 * d4] * kv[d4][0] + sq[4 * d4 + 1] * kv[d4][1] + sq[4 * d4 + 2] * kv[d4][2] + sq[4 * d4 + 3] * kv[d4][3];
        } else {
            const bf16_t* kn = p.H + row * 2560 + 512 + h * 64;
            for (int d = 0; d < 64; ++d) s += sq[d] * bf2f(kn[d]);
        }
        lg[idx] = s * 0.125f;
    }
    __syncthreads();
    float mx = -INFINITY;
    for (int idx = tid; idx < 769; idx += NT) mx = fmaxf(mx, lg[idx]);
    mx = wave_max(mx); if (lane == 0) red[w] = mx;
    __syncthreads();
    mx = red[0];
#pragma unroll
    for (int i = 1; i < 8; ++i) mx = fmaxf(mx, red[i]);
    float sm = 0.f;
    for (int idx = tid; idx < 769; idx += NT) { float e = __expf(lg[idx] - mx); lg[idx] = e; sm += e; }
    sm = wave_sum(sm); if (lane == 0) red[8 + w] = sm;
    __syncthreads();
    sm = 0.f;
#pragma unroll
    for (int i = 0; i < 8; ++i) sm += red[8 + i];
    {
        const int d4 = tid & 15, kg = tid >> 4;
        f32x4 acc = {0.f, 0.f, 0.f, 0.f};
#pragma unroll
        for (int i0 = 0; i0 < 24; i0 += 8) {
            f32x4 vv[8]; float pp[8];
#pragma unroll
            for (int i = 0; i < 8; ++i) { const int idx = kg + 32 * (i0 + i); pp[i] = lg[idx]; vv[i] = *(const f32x4*)(p.cache_v + (size_t)roff[idx] * 64 + 4 * d4); }
#pragma unroll
            for (int i = 0; i < 8; ++i) acc += vv[i] * pp[i];
        }
        if (kg == 0) {
            const bf16_t* vn = p.H + row * 2560 + 1024 + h * 64 + 4 * d4; const float pn = lg[768];
            acc[0] += pn * bf2f(vn[0]); acc[1] += pn * bf2f(vn[1]); acc[2] += pn * bf2f(vn[2]); acc[3] += pn * bf2f(vn[3]);
        }
        *(f32x4*)(part + kg * 64 + 4 * d4) = acc;
    }
    __syncthreads();
    if (tid < 64) { float a = 0.f;
#pragma unroll
        for (int i = 0; i < 32; ++i) a += part[i * 64 + tid];
        p.MIX[row * DM + h * 64 + tid] = f2bf(a / sm); }
}

DI void bg_kmean_fore(const Params& p, int bid, int k, char* lds) {
    const int tid = TIDX, rg = tid >> 4, d4 = tid & 15, bs = bid >> 3, hs = bid & 7;
    const int page = p.page_table[bs * 64 + 2 * k + (rg >> 4)];
    const float* base = p.cache_k + (((size_t)page * 128 + (rg & 15) * 8) * 8 + hs) * 64 + 4 * d4;
    f32x4 acc = {0.f, 0.f, 0.f, 0.f};
#pragma unroll
    for (int i = 0; i < 8; ++i) acc += *(const f32x4*)(base + (size_t)i * 512);
    __syncthreads();
    *(f32x4*)(lds + MB_BGS + (rg * 64 + d4 * 4) * 4) = acc;
    __syncthreads();
    if (tid < 64) { float sm = 0.f;
#pragma unroll 8
        for (int r = 0; r < 32; ++r) sm += *(const float*)(lds + MB_BGS + (r * 64 + tid) * 4);
        *(float*)(lds + MB_KMS + (k * 64 + tid) * 4) = sm * (1.f / 256.f); }
    __syncthreads();
}
DI void moba_prompt_unit(const Params& p, int bh, int own, char* lds, int bid, int& bgk) {
    const int tid = TIDX, lane = tid & 63, w = tid >> 6, lr = lane & 15, lg = lane >> 4;
    const int b = bh >> 3, h = bh & 7;
    float* gsc = (float*)lds + w * 1024;
    unsigned* msk = (unsigned*)(lds + 32768) + w * 36;
    unsigned* worl = (unsigned*)(lds + MB_WOR);
    const int wv = __builtin_amdgcn_readfirstlane(w);
    const size_t rowq0 = (size_t)b * SEQ + own * 256 + w * 32;
    __syncthreads();
    bf16x8 qf[2][2];
#pragma unroll
    for (int qt = 0; qt < 2; ++qt)
#pragma unroll
        for (int ks = 0; ks < 2; ++ks) qf[qt][ks] = *(const bf16x8*)(p.H + (rowq0 + qt * 16 + lr) * 2560 + h * 64 + ks * 32 + lg * 8);
    unsigned mq[2]; unsigned wor;
    if (own > 3) {
        bf16_t* kml = (bf16_t*)(lds + 36864);
        {
            const int j = tid >> 4, d4 = tid & 15;
            f32x4 a = {0.f, 0.f, 0.f, 0.f};
#pragma unroll
            for (int part = 0; part < 8; ++part) a += *(const f32x4*)(p.KMPP + (((size_t)b * 32 + j) * 8 + part) * 512 + h * 64 + 4 * d4);
            store_bf4(kml + j * 64 + 4 * d4, a * (1.f / 256.f));
        }
        __syncthreads();
#pragma unroll
        for (int jt = 0; jt < 2; ++jt) {
            bf16x8 kf[2];
#pragma unroll
            for (int ks = 0; ks < 2; ++ks) kf[ks] = *(const bf16x8*)(kml + (jt * 16 + lr) * 64 + ks * 32 + lg * 8);
#pragma unroll
            for (int qt = 0; qt < 2; ++qt) {
                f32x4 a = {0.f, 0.f, 0.f, 0.f};
                a = MFMA16(kf[0], qf[qt][0], a); a = MFMA16(kf[1], qf[qt][1], a);
#pragma unroll
                for (int r = 0; r < 4; ++r) gsc[(qt * 16 + lr) * 32 + jt * 16 + 4 * lg + r] = a[r];
            }
        }
        __builtin_amdgcn_s_waitcnt(0);
        __builtin_amdgcn_wave_barrier();
        unsigned m = 0;
        if (lane < 32) {
            float v0 = -INFINITY, v1 = -INFINITY, v2 = -INFINITY; int i0 = 0, i1 = 0, i2 = 0;
            for (int j = 0; j < own; ++j) { float sc = gsc[lane * 32 + j];
                if (sc > v0) { v2 = v1; i2 = i1; v1 = v0; i1 = i0; v0 = sc; i0 = j; }
                else if (sc > v1) { v2 = v1; i2 = i1; v1 = sc; i1 = j; }
                else if (sc > v2) { v2 = sc; i2 = j; } }
            m = (1u << i0) | (1u << i1) | (1u << i2);
            msk[lane] = m;
        }
        unsigned o = m;
#pragma unroll
        for (int sft = 32; sft >= 1; sft >>= 1) o |= (unsigned)__shfl_xor((int)o, sft, 64);
        wor = o;
        __builtin_amdgcn_s_waitcnt(0);
        __builtin_amdgcn_wave_barrier();
        mq[0] = msk[lr]; mq[1] = msk[16 + lr];
    } else {
        const unsigned m = (own >= 1) ? ((1u << own) - 1u) : 0u;
        mq[0] = m; mq[1] = m; wor = m;
    }
    wor = (unsigned)__builtin_amdgcn_readfirstlane((int)wor);
    if (lane == 0) worl[w] = wor;
    __syncthreads();
    unsigned bor = 0;
#pragma unroll
    for (int i = 0; i < 8; ++i) bor |= worl[i];
    bor = (unsigned)__builtin_amdgcn_readfirstlane((int)bor);

    const bf16_t* Kbase = p.H + (size_t)b * SEQ * 2560 + 512 + h * 64;
    const bf16_t* Vbase = p.VT + (size_t)(b * 8 + h) * 64 * 8192;
    u32x4 rk[4], rv[4];
    auto gload = [&](int jb) {
#pragma unroll
        for (int i = 0; i < 4; ++i) { const int id = tid + NT * i; const int r = id >> 3, c = id & 7; rk[i] = *(const u32x4*)(Kbase + (size_t)(jb * 256 + r) * 2560 + c * 8); }
#pragma unroll
        for (int i = 0; i < 4; ++i) { const int id = tid + NT * i; const int d = id >> 5, c = id & 31; rv[i] = *(const u32x4*)(Vbase + (size_t)d * 8192 + jb * 256 + c * 8); }
    };
    auto sstore = [&](int buf) {
#pragma unroll
        for (int i = 0; i < 4; ++i) { const int id = tid + NT * i; const int r = id >> 3, c = id & 7; *(u32x4*)(lds + MB_K + buf * 32768 + r * 128 + ((c ^ (r & 7)) << 4)) = rk[i]; }
#pragma unroll
        for (int i = 0; i < 4; ++i) { const int id = tid + NT * i; const int d = id >> 5, c = id & 31; *(u32x4*)(lds + MB_V + buf * (64 * MB_VROW) + d * MB_VROW + c * 16) = rv[i]; }
    };
    const float SC = 0.125f * 1.4426950408889634f;
    float mrow[2] = {-INFINITY, -INFINITY}, lrow[2] = {0.f, 0.f};
    f32x4 oacc[2][4];
#pragma unroll
    for (int qt = 0; qt < 2; ++qt)
#pragma unroll
        for (int dt = 0; dt < 4; ++dt) oacc[qt][dt] = (f32x4){0.f, 0.f, 0.f, 0.f};
    const int bg_rg = tid >> 4, bg_d4 = tid & 15, bg_bs = bid >> 3, bg_hs = bid & 7;
    int bg_page = (bgk < 32) ? p.page_table[bg_bs * 64 + 2 * bgk + (bg_rg >> 4)] : 0;
    int cur = own, buf = 0;
    gload(cur); sstore(0); __syncthreads();
    int nxt_scan = 0;
    while (cur >= 0) {
        int nxt = -1;
        while (nxt_scan < own) { const int j = nxt_scan++; if ((bor >> j) & 1u) { nxt = j; break; } }
        if (nxt >= 0) gload(nxt);
        const bool bg_on = bgk < 32;
        const float* bg_base = p.cache_k + (((size_t)bg_page * 128 + (bg_rg & 15) * 8) * 8 + bg_hs) * 64 + 4 * bg_d4;
        f32x4 bg_acc = {0.f, 0.f, 0.f, 0.f}, bg_pend = {0.f, 0.f, 0.f, 0.f}; int bg_i = 0;
        const bool isown = (cur == own);
        if (isown || ((wor >> cur) & 1u)) {
            const char* KB = lds + MB_K + buf * 32768; const char* VB = lds + MB_V + buf * (64 * MB_VROW);
            const int nst = isown ? (wv + 1) : 8;
            const bool sel0 = isown || ((mq[0] >> cur) & 1u), sel1 = isown || ((mq[1] >> cur) & 1u);
            for (int st = 0; st < nst; ++st) {
                if (bg_on && bg_i < 8) { bg_acc += bg_pend; bg_pend = *(const f32x4*)(bg_base + (size_t)bg_i * 512); ++bg_i; }
                bf16x8 kf[2][2];
#pragma unroll
                for (int kt = 0; kt < 2; ++kt)
#pragma unroll
                    for (int ks = 0; ks < 2; ++ks) { const int r = st * 32 + kt * 16 + lr, ch = ks * 4 + lg; kf[kt][ks] = *(const bf16x8*)(KB + r * 128 + ((ch ^ (r & 7)) << 4)); }
                bf16x8 pf[2]; float alph[2];
#pragma unroll
                for (int qt = 0; qt < 2; ++qt) {
                    f32x4 sv[2];
#pragma unroll
                    for (int kt = 0; kt < 2; ++kt) { f32x4 a = {0.f, 0.f, 0.f, 0.f}; a = MFMA16(kf[kt][0], qf[qt][0], a); a = MFMA16(kf[kt][1], qf[qt][1], a); sv[kt] = a; }
                    const bool selq = qt ? sel1 : sel0;
                    if (isown) {
                        const int qin = wv * 32 + qt * 16 + lr;
#pragma unroll
                        for (int kt = 0; kt < 2; ++kt)
#pragma unroll
                            for (int r = 0; r < 4; ++r) { const int kin = st * 32 + kt * 16 + 4 * lg + r; sv[kt][r] = (kin <= qin) ? sv[kt][r] : -INFINITY; }
                    }
                    float mx = fmaxf(fmaxf(fmaxf(sv[0][0], sv[0][1]), fmaxf(sv[0][2], sv[0][3])), fmaxf(fmaxf(sv[1][0], sv[1][1]), fmaxf(sv[1][2], sv[1][3]))) * SC;
                    mx = red_max_16_32(mx);
                    mx = selq ? mx : -INFINITY;
                    const float mnew = fmaxf(mrow[qt], mx);
                    alph[qt] = __builtin_amdgcn_exp2f(mrow[qt] - mnew);
                    const float mneg = selq ? -mnew : -INFINITY;
                    float ps = 0.f;
#pragma unroll
                    for (int kt = 0; kt < 2; ++kt)
#pragma unroll
                        for (int r = 0; r < 4; ++r) { const float e = __builtin_amdgcn_exp2f(__builtin_fmaf(sv[kt][r], SC, mneg)); sv[kt][r] = e; ps += e; }
                    ps = red_sum_16_32(ps);
                    lrow[qt] = lrow[qt] * alph[qt] + ps; mrow[qt] = mnew;
                    u32x4 pk; pk[0] = pack_bf2(sv[0][0], sv[0][1]); pk[1] = pack_bf2(sv[0][2], sv[0][3]); pk[2] = pack_bf2(sv[1][0], sv[1][1]); pk[3] = pack_bf2(sv[1][2], sv[1][3]);
                    pf[qt] = __builtin_bit_cast(bf16x8, pk);
                }
                if (__any((alph[0] != 1.f) || (alph[1] != 1.f))) {
#pragma unroll
                    for (int qt = 0; qt < 2; ++qt)
#pragma unroll
                        for (int dt = 0; dt < 4; ++dt) oacc[qt][dt] = oacc[qt][dt] * alph[qt];
                }
#pragma unroll
                for (int dt = 0; dt < 4; ++dt) {
                    const char* vp = VB + (dt * 16 + lr) * MB_VROW + st * 64 + 8 * lg;
                    const u32x2 lo = *(const u32x2*)vp, hi = *(const u32x2*)(vp + 32);
                    u32x4 t4; t4[0] = lo[0]; t4[1] = lo[1]; t4[2] = hi[0]; t4[3] = hi[1];
                    const bf16x8 vf = __builtin_bit_cast(bf16x8, t4);
#pragma unroll
                    for (int qt = 0; qt < 2; ++qt) oacc[qt][dt] = MFMA16(vf, pf[qt], oacc[qt][dt]);
                }
            }
        }
        if (bg_on) {
            while (bg_i < 8) { bg_acc += bg_pend; bg_pend = *(const f32x4*)(bg_base + (size_t)bg_i * 512); ++bg_i; }
            bg_acc += bg_pend;
            *(f32x4*)(lds + MB_BGS + (bgk & 1) * 8192 + (bg_rg * 64 + bg_d4 * 4) * 4) = bg_acc;
        }
        if (nxt >= 0) sstore(buf ^ 1);
        __syncthreads();
        if (bg_on) {
            if (tid < 64) { float sm = 0.f;
#pragma unroll 8
                for (int r = 0; r < 32; ++r) sm += *(const float*)(lds + MB_BGS + (bgk & 1) * 8192 + (r * 64 + tid) * 4);
                *(float*)(lds + MB_KMS + (bgk * 64 + tid) * 4) = sm * (1.f / 256.f); }
            ++bgk;
            if (bgk < 32) bg_page = p.page_table[bg_bs * 64 + 2 * bgk + (bg_rg >> 4)];
        }
        cur = nxt; buf ^= 1;
    }
#pragma unroll
    for (int qt = 0; qt < 2; ++qt) {
        const float inv = 1.f / lrow[qt];
#pragma unroll
        for (int dt = 0; dt < 4; ++dt) store_bf4(p.MIX + (rowq0 + qt * 16 + lr) * DM + h * 64 + dt * 16 + 4 * lg, oacc[qt][dt] * inv);
    }
}

DI void ln_rows(const Params& p, const float* g, const float* bb, int bid, int nb, bool final_out) {
    const int lane = TIDX & 63, w = TIDX >> 6;
    for (int row = bid * 8 + w; row < TT; row += nb * 8) {
        f32x4 v[4]; float s = 0.f;
#pragma unroll
        for (int i = 0; i < 4; ++i) { v[i] = *(const f32x4*)(p.T + (size_t)row * DM + 4 * lane + 256 * i); s += v[i][0] + v[i][1] + v[i][2] + v[i][3]; }
        const float mu = wave_sum(s) * (1.f / 1024.f);
        float q = 0.f;
#pragma unroll
        for (int i = 0; i < 4; ++i)
#pragma unroll
            for (int k = 0; k < 4; ++k) { float d = v[i][k] - mu; q += d * d; }
        const float rs = rsqrtf(wave_sum(q) * (1.f / 1024.f) + LN_EPS);
#pragma unroll
        for (int i = 0; i < 4; ++i) {
            const int c = 4 * lane + 256 * i;
            f32x4 gg = *(const f32x4*)(g + c), be = *(const f32x4*)(bb + c), y;
#pragma unroll
            for (int k = 0; k < 4; ++k) y[k] = (v[i][k] - mu) * rs * gg[k] + be[k];
            if (final_out) { float* dst = row < TP ? p.y_prompt + (size_t)row * DM + c : p.y_sample + (size_t)(row - TP) * DM + c; *(f32x4*)dst = y; }
            else { *(f32x4*)(p.XF + (size_t)row * DM + c) = y; store_bf4(p.XB + (size_t)row * DM + c, y); }
        }
    }
}

DI unsigned ford(float f) { const unsigned u = __float_as_uint(f); return u ^ ((unsigned)((int)u >> 31) | 0x80000000u); }
DI float funord(unsigned k) { return __uint_as_float((k & 0x80000000u) ? (k ^ 0x80000000u) : ~k); }
#define KINS16(K, tk) { unsigned _v = (K); _Pragma("unroll") for (int _k = 0; _k < 16; ++_k) { const unsigned _t = tk[_k] > _v ? tk[_k] : _v; _v = tk[_k] > _v ? _v : tk[_k]; tk[_k] = _t; } }

DI void qrow_issue(const Params& p, int layer, int rid, int lane, f32x4 (&v)[4]) {
    const float* src = (rid < 16384 ? p.peer_u + ((size_t)layer * 16384 + rid) * DM : p.peer_v + ((size_t)layer * 16384 + (rid - 16384)) * DM);
#pragma unroll
    for (int i = 0; i < 4; ++i) v[i] = *(const f32x4*)(src + 4 * lane + 256 * i);
}
DI void qrow_finish(const Params& p, int layer, int rid, int lane, const f32x4 (&v)[4]) {
    float am = 0.f;
#pragma unroll
    for (int i = 0; i < 4; ++i) am = fmaxf(am, fmaxf(fmaxf(fabsf(v[i][0]), fabsf(v[i][1])), fmaxf(fabsf(v[i][2]), fabsf(v[i][3]))));
    am = wave_max(am);
    const bool isu = rid < 16384; const int e = isu ? rid : rid - 16384;
    unsigned char* dst = (isu ? p.U8 : p.V8) + (size_t)layer * 16384 * DM + (size_t)e * 128;
    const float top = isu ? 127.f : 416.f;
    const float sc = am > 0.f ? top / am : 0.f;
#pragma unroll
    for (int i = 0; i < 4; ++i) {
        int pk = 0;
        if (isu) {
#pragma unroll
            for (int k = 0; k < 4; ++k) { const int q = (int)rintf(v[i][k] * sc); pk |= (int)(((unsigned)q & 0xffu) << (8 * k)); }
        } else {
            pk = __builtin_amdgcn_cvt_pk_fp8_f32(v[i][0] * sc, v[i][1] * sc, pk, false);
            pk = __builtin_amdgcn_cvt_pk_fp8_f32(v[i][2] * sc, v[i][3] * sc, pk, true);
        }
        const int col = 4 * lane + 256 * i;
        *(int*)(dst + (size_t)(col >> 7) * (16384 * 128) + (col & 127)) = pk;
    }
    if (lane == 0) (isu ? p.SU : p.SV)[layer * 16384 + e] = am / top;
}
typedef _Float16 f16x4 __attribute__((ext_vector_type(4)));
typedef _Float16 f16x8 __attribute__((ext_vector_type(8)));
DI void peer_topk_unit(const Params& p, int layer, int u, char* lds) {
    const int tid = TIDX, lane = tid & 63, w = tid >> 6, lr = lane & 15, lg = lane >> 4;
    const int t0 = u * 32;
    __syncthreads();
    {
        const bf16_t* KBl = p.KB + (size_t)layer * 2048 * 128;
#pragma unroll 1
        for (int jj = 0; jj < 2; ++jj) {
            const int j = 2 * w + jj;
            bf16x8 qf[2][4];
#pragma unroll
            for (int tt = 0; tt < 2; ++tt)
#pragma unroll
                for (int ks = 0; ks < 4; ++ks) qf[tt][ks] = *(const bf16x8*)(p.QH + (size_t)(t0 + tt * 16 + lr) * 2048 + j * 128 + ks * 32 + lg * 8);
#pragma unroll
            for (int nt = 0; nt < 8; ++nt) {
                bf16x8 kf[4];
#pragma unroll
                for (int ks = 0; ks < 4; ++ks) kf[ks] = *(const bf16x8*)(KBl + (size_t)(j * 128 + nt * 16 + lr) * 128 + ks * 32 + lg * 8);
#pragma unroll
                for (int tt = 0; tt < 2; ++tt) {
                    f32x4 a = {0.f, 0.f, 0.f, 0.f};
#pragma unroll
                    for (int ks = 0; ks < 4; ++ks) a = MFMA16(kf[ks], qf[tt][ks], a);
                    f16x4 hv; hv[0] = (_Float16)a[0]; hv[1] = (_Float16)a[1]; hv[2] = (_Float16)a[2]; hv[3] = (_Float16)a[3];
                    const int chunk = nt * 2 + (lg >> 1);
                    *(f16x4*)(lds + ((tt * 16 + lr) * 16 + j) * 256 + ((chunk ^ j) << 4) + (lg & 1) * 8) = hv;
                }
            }
        }
    }
    __syncthreads();
    const int tok = t0 + (tid >> 4), j = tid & 15;
    const int qbase = u * 64 + w * 8;
    f32x4 qv[4][4];
#pragma unroll
    for (int i = 0; i < 4; ++i) qrow_issue(p, layer, qbase + i, lane, qv[i]);
    unsigned tk[16];
#pragma unroll
    for (int k = 0; k < 16; ++k) tk[k] = 0u;
    {
        const char* sp = lds + tid * 256;
#pragma unroll 2
        for (int c = 0; c < 16; ++c) {
            const f16x8 v = *(const f16x8*)(sp + ((c ^ j) << 4));
#pragma unroll
            for (int q = 0; q < 8; ++q) KINS16((ford((float)v[q]) & ~127u) | (unsigned)(127 - (8 * c + q)), tk);
        }
    }
#pragma unroll
    for (int i = 0; i < 4; ++i) qrow_finish(p, layer, qbase + i, lane, qv[i]);
#pragma unroll
    for (int i = 0; i < 4; ++i) qrow_issue(p, layer, qbase + 4 + i, lane, qv[i]);
    __syncthreads();
    float* lv = (float*)lds;
    int* li = (int*)(lds + 512 * 17 * 4);
#pragma unroll
    for (int k = 0; k < 16; ++k) { lv[tid * 17 + k] = funord(tk[k] & ~127u); li[tid * 17 + k] = 127 - (int)(tk[k] & 127u); }
    __syncthreads();
    if ((j & 1) == 0) {
        float v1[16], v2[16];
#pragma unroll
        for (int k = 0; k < 16; ++k) { v1[k] = lv[tid * 17 + k]; v2[k] = lv[(tid + 1) * 17 + k]; }
        unsigned sk[16];
#pragma unroll
        for (int k = 0; k < 16; ++k) sk[k] = 0u;
#pragma unroll
        for (int a = 0; a < 16; ++a)
#pragma unroll
            for (int bq = 0; bq < 16; ++bq)
                if ((a + 1) * (bq + 1) <= 16) KINS16((ford(v1[a] + v2[bq]) & ~255u) | (unsigned)(255 - (a * 16 + bq)), sk);
        float sc[16]; int ee[16];
#pragma unroll
        for (int k = 0; k < 16; ++k) {
            const int c = 255 - (int)(sk[k] & 255u), a = c >> 4, bq = c & 15;
            sc[k] = lv[tid * 17 + a] + lv[(tid + 1) * 17 + bq];
            ee[k] = li[tid * 17 + a] * 128 + li[(tid + 1) * 17 + bq];
        }
        float sm = 0.f; float e[16];
#pragma unroll
        for (int k = 0; k < 16; ++k) { e[k] = __expf(sc[k] - sc[0]); sm += e[k]; }
        const float inv = 1.f / sm; const int h = j >> 1;
#pragma unroll
        for (int k = 0; k < 16; ++k) { p.E[(size_t)tok * 128 + h * 16 + k] = ee[k]; p.G[(size_t)tok * 128 + h * 16 + k] = e[k] * inv; }
    }
#pragma unroll
    for (int i = 0; i < 4; ++i) qrow_finish(p, layer, qbase + 4 + i, lane, qv[i]);
}

constexpr int EHS = 129;
constexpr int PEER_EH = 65536, PEER_TOK = 65536 + 64 * EHS * 8, PEER_END = PEER_TOK + 1024;
DI float gelu_exact(float z) { return 0.5f * z * (1.f + erff(z * 0.70710678118654752f)); }
#define FMA4U(ACC, O, H, W) { ACC[O] += H * (float)((W) & 0xffu); ACC[O + 1] += H * (float)(((W) >> 8) & 0xffu); ACC[O + 2] += H * (float)(((W) >> 16) & 0xffu); ACC[O + 3] += H * (float)((W) >> 24); }

DI void peer_tile(const Params& p, int layer, int tile, char* lds, bool final_out) {
    const int lane = TIDX & 63, w = TIDX >> 6, lr = lane & 15, lg = lane >> 4;
    unsigned char* X8 = (unsigned char*)lds; int2* EH = (int2*)(lds + PEER_EH); float* TOK = (float*)(lds + PEER_TOK);
    const unsigned char* U8 = p.U8 + (size_t)layer * 16384 * DM; const unsigned char* V8 = p.V8 + (size_t)layer * 16384 * DM;
    const float* SUi = p.SU + layer * 16384; const float* SVi = p.SV + layer * 16384;
    const float* lng = p.ln_g + (layer * 2 + 1) * DM; const float* lnb = p.ln_b + (layer * 2 + 1) * DM;
    const int t0 = tile * 64 + w * 8;
#pragma unroll 4
    for (int i = 0; i < 8; ++i) {
        const int t = t0 + i, tk = w * 8 + i;
        f32x4 v[4]; float am = 0.f;
#pragma unroll
        for (int k = 0; k < 4; ++k) { v[k] = *(const f32x4*)(p.XF + (size_t)t * DM + 4 * lane + 256 * k); am = fmaxf(am, fmaxf(fmaxf(fabsf(v[k][0]), fabsf(v[k][1])), fmaxf(fabsf(v[k][2]), fabsf(v[k][3])))); }
        am = wave_max(am);
        const float sc = am > 0.f ? 127.f / am : 0.f;
#pragma unroll
        for (int k = 0; k < 4; ++k) {
            unsigned pk = 0;
#pragma unroll
            for (int q = 0; q < 4; ++q) { const int qi = (int)rintf(v[k][q] * sc); pk |= ((unsigned)qi & 0xffu) << (8 * q); }
            *(unsigned*)(X8 + tk * 1024 + 4 * lane + 256 * k) = pk;
        }
        if (lane == 0) TOK[tk * 2] = am * (1.f / 127.f);
        EH[tk * EHS + lane] = make_int2(p.E[(size_t)t * 128 + lane], 0);
        EH[tk * EHS + 64 + lane] = make_int2(p.E[(size_t)t * 128 + 64 + lane], 0);
    }
    {
        const int gq = lane >> 3, li = lane & 7, tk = w * 8 + gq;
        auto uld = [&](int c, int p0, u32x4 (&uu)[4]) {
            const unsigned char* Uc = U8 + (size_t)c * (16384 * 128);
#pragma unroll
            for (int j = 0; j < 4; ++j) { const unsigned e = (unsigned)EH[tk * EHS + p0 + j].x; uu[j] = *(const u32x4*)(Uc + (e * 128u + 16u * li)); }
        };
        auto ucp = [&](int p0, u32x4 (&uu)[4], const i32x4& xq) {
#pragma unroll
            for (int j = 0; j < 4; ++j) {
                int d = __builtin_amdgcn_sdot4((int)uu[j][0], xq[0], 0, false);
                d = __builtin_amdgcn_sdot4((int)uu[j][1], xq[1], d, false);
                d = __builtin_amdgcn_sdot4((int)uu[j][2], xq[2], d, false);
                d = __builtin_amdgcn_sdot4((int)uu[j][3], xq[3], d, false);
                d += __builtin_amdgcn_update_dpp(0, d, 0x114, 0xf, 0xf, true);
                d += __builtin_amdgcn_update_dpp(0, d, 0x112, 0xf, 0xf, true);
                d += __builtin_amdgcn_update_dpp(0, d, 0x111, 0xf, 0xf, true);
                if (li == 7) __hip_atomic_fetch_add(&EH[tk * EHS + p0 + j].y, d, __ATOMIC_RELAXED, __HIP_MEMORY_SCOPE_WORKGROUP);
            }
        };
        u32x4 uA[4], uB[4];
        uld(0, 0, uA);
#pragma unroll 1
        for (int c = 0; c < 8; ++c) {
            const i32x4 xq = *(const i32x4*)(X8 + tk * 1024 + c * 128 + 16 * li);
#pragma unroll 1
            for (int p0 = 0; p0 < 128; p0 += 8) {
                uld(c, p0 + 4, uB);
                ucp(p0, uA, xq);
                if (p0 + 8 < 128) uld(c, p0 + 8, uA); else if (c < 7) uld(c + 1, 0, uA);
                ucp(p0 + 4, uB, xq);
            }
        }
    }
#pragma unroll 4
    for (int i = 0; i < 8; ++i) {
        const int t = t0 + i, tk = w * 8 + i;
        const float sxi = TOK[tk * 2];
#pragma unroll
        for (int hf = 0; hf < 2; ++hf) {
            const int pi = hf * 64 + lane;
            const int2 eh = EH[tk * EHS + pi];
            const float z = (float)eh.y * SUi[eh.x] * sxi;
            const float hp = p.G[(size_t)t * 128 + pi] * gelu_exact(z) * SVi[eh.x];
            EH[tk * EHS + pi].y = __float_as_int(hp);
        }
    }
    const int gq = lane >> 3, li = lane & 7, tk = w * 8 + gq, t = t0 + gq;
    float s1 = 0.f, s2 = 0.f;
    auto vload = [&](int c, int p0, float (&hh)[4], u32x4 (&vv)[4]) {
        const unsigned char* Vc = V8 + (size_t)c * (16384 * 128);
#pragma unroll
        for (int j = 0; j < 4; ++j) { const int2 eh = EH[tk * EHS + p0 + j]; hh[j] = __int_as_float(eh.y); vv[j] = *(const u32x4*)(Vc + ((unsigned)eh.x * 128u + 16u * li)); }
    };
    auto vcomp = [&](float (&hh)[4], u32x4 (&vv)[4], f32x2 (&acc)[8]) {
#pragma unroll
        for (int j = 0; j < 4; ++j) {
            const f32x2 h2 = {hh[j], hh[j]};
#pragma unroll
            for (int q = 0; q < 4; ++q) {
                const f32x2 a = __builtin_amdgcn_cvt_pk_f32_fp8((int)vv[j][q], false), b = __builtin_amdgcn_cvt_pk_f32_fp8((int)vv[j][q], true);
                acc[2 * q] = h2 * a + acc[2 * q]; acc[2 * q + 1] = h2 * b + acc[2 * q + 1];
            }
        }
    };
    float ehA[4], ehB[4]; u32x4 vvA[4], vvB[4];
    vload(0, 0, ehA, vvA);
#pragma unroll 1
    for (int c = 0; c < 8; ++c) {
        f32x2 acc[8];
#pragma unroll
        for (int k = 0; k < 8; ++k) acc[k] = (f32x2){0.f, 0.f};
        f32x4 xs[4];
#pragma unroll
        for (int k4 = 0; k4 < 4; ++k4) xs[k4] = *(const f32x4*)(p.XF + (size_t)t * DM + c * 128 + li * 16 + 4 * k4);
#pragma unroll 1
        for (int p0 = 0; p0 < 128; p0 += 8) {
            vload(c, p0 + 4, ehB, vvB);
            vcomp(ehA, vvA, acc);
            if (p0 + 8 < 128) vload(c, p0 + 8, ehA, vvA); else if (c < 7) vload(c + 1, 0, ehA, vvA);
            vcomp(ehB, vvB, acc);
        }
        const int col = c * 128 + li * 16;
#pragma unroll
        for (int k4 = 0; k4 < 4; ++k4) {
            const f32x4 x = xs[k4];
            f32x4 y;
#pragma unroll
            for (int k = 0; k < 4; ++k) { y[k] = DN_ALPHA * x[k] + acc[2 * k4 + (k >> 1)][k & 1]; s1 += y[k]; s2 += y[k] * y[k]; }
            *(f32x4*)(p.T + (size_t)t * DM + col + 4 * k4) = y;
        }
    }
#pragma unroll
    for (int o = 1; o <= 4; o <<= 1) { s1 += __shfl_xor(s1, o, 64); s2 += __shfl_xor(s2, o, 64); }
    const float mu = s1 * (1.f / 1024.f);
    const float rs = rsqrtf(fmaxf(s2 * (1.f / 1024.f) - mu * mu, 0.f) + LN_EPS);
#pragma unroll 4
    for (int c = 0; c < 8; ++c) {
        const int col = c * 128 + li * 16;
#pragma unroll
        for (int k4 = 0; k4 < 4; ++k4) {
            const f32x4 y = *(const f32x4*)(p.T + (size_t)t * DM + col + 4 * k4);
            const f32x4 gg = *(const f32x4*)(lng + col + 4 * k4), be = *(const f32x4*)(lnb + col + 4 * k4);
            f32x4 o;
#pragma unroll
            for (int k = 0; k < 4; ++k) o[k] = (y[k] - mu) * rs * gg[k] + be[k];
            if (final_out) *(f32x4*)(p.y_prompt + (size_t)t * DM + col + 4 * k4) = o;
            else { *(f32x4*)(p.XF + (size_t)t * DM + col + 4 * k4) = o; store_bf4(p.XB + (size_t)t * DM + col + 4 * k4, o); }
        }
    }
}


DI unsigned wave_top16(unsigned x0, unsigned x1, int lane) {
    unsigned res = 0u;
#pragma unroll 1
    for (int r = 0; r < 16; ++r) {
        unsigned m = x0 > x1 ? x0 : x1;
#pragma unroll
        for (int o = 32; o >= 1; o >>= 1) { const unsigned y = (unsigned)__shfl_xor((int)m, o, 64); m = y > m ? y : m; }
        if (x0 == m) x0 = 0u; else if (x1 == m) x1 = 0u;
        if (lane == r) res = m;
    }
    return res;
}
DI void peer_sample(const Params& p, int layer, int sidx, char* lds, bool final_out) {
    const int tid = TIDX, lane = tid & 63, w = tid >> 6, lr = lane & 15, lg = lane >> 4;
    unsigned char* X8 = (unsigned char*)lds; int2* EH = (int2*)(lds + 1024); float* Z = (float*)(lds + 1024 + 1024); float* Y = Z + 128; float* PART = Y + 1024;
    int* Es = (int*)(PART + 32); float* Gs = (float*)(Es + 128);
    const unsigned char* U8 = p.U8 + (size_t)layer * 16384 * DM; const unsigned char* V8 = p.V8 + (size_t)layer * 16384 * DM;
    const float* SUi = p.SU + layer * 16384; const float* SVi = p.SV + layer * 16384;
    const float* lng = p.ln_g + (layer * 2 + 1) * DM; const float* lnb = p.ln_b + (layer * 2 + 1) * DM;
    const int t = TP + sidx;
    __syncthreads();
    if (w == 0) {
        f32x4 v[4]; float am = 0.f;
#pragma unroll
        for (int k = 0; k < 4; ++k) { v[k] = *(const f32x4*)(p.XF + (size_t)t * DM + 4 * lane + 256 * k); am = fmaxf(am, fmaxf(fmaxf(fabsf(v[k][0]), fabsf(v[k][1])), fmaxf(fabsf(v[k][2]), fabsf(v[k][3])))); }
        am = wave_max(am);
        const float sc = am > 0.f ? 127.f / am : 0.f;
#pragma unroll
        for (int k = 0; k < 4; ++k) {
            unsigned pk = 0;
#pragma unroll
            for (int q = 0; q < 4; ++q) { const int qi = (int)rintf(v[k][q] * sc); pk |= ((unsigned)qi & 0xffu) << (8 * q); }
            *(unsigned*)(X8 + 4 * lane + 256 * k) = pk;
        }
        if (lane == 0) PART[24] = am * (1.f / 127.f);
    }
    {
        const float* sp = p.S + (size_t)t * 2048 + w * 256;
        const unsigned k1 = wave_top16((ford(sp[lane]) & ~127u) | (unsigned)(127 - lane), (ford(sp[64 + lane]) & ~127u) | (unsigned)(63 - lane), lane);
        const unsigned k2 = wave_top16((ford(sp[128 + lane]) & ~127u) | (unsigned)(127 - lane), (ford(sp[192 + lane]) & ~127u) | (unsigned)(63 - lane), lane);
        const float v1 = funord(k1 & ~127u), v2 = funord(k2 & ~127u); const int i1 = 127 - (int)(k1 & 127u), i2 = 127 - (int)(k2 & 127u);
        int a = 0, b = 0;
        { int base = 0;
#pragma unroll
          for (int aa = 0; aa < 16; ++aa) { const int cnt = 16 / (aa + 1); if (lane >= base && lane < base + cnt) { a = aa; b = lane - base; } base += cnt; } }
        const float sv = __shfl(v1, a, 64) + __shfl(v2, b, 64);
        const unsigned ck = lane < 50 ? ((ford(sv) & ~255u) | (unsigned)(255 - (a * 16 + b))) : 0u;
        const unsigned rk = wave_top16(ck, 0u, lane);
        const int c2 = 255 - (int)(rk & 255u), a2 = (c2 >> 4) & 15, b2 = c2 & 15;
        const float sc = __shfl(v1, a2, 64) + __shfl(v2, b2, 64);
        const int ex = __shfl(i1, a2, 64) * 128 + __shfl(i2, b2, 64);
        const float mx = __shfl(sc, 0, 64);
        const float ee = lane < 16 ? __expf(sc - mx) : 0.f;
        const float sm = wave_sum(ee);
        if (lane < 16) { Es[w * 16 + lane] = ex; Gs[w * 16 + lane] = ee / sm; }
    }
    __syncthreads();
    {
        const int e = Es[w * 16 + lr];
        i32x4 acc = {0, 0, 0, 0};
#pragma unroll
        for (int ch = 0; ch < 16; ++ch) {
            const i32x4 a = *(const i32x4*)(U8 + (size_t)(ch >> 1) * (16384 * 128) + (size_t)e * 128 + (ch & 1) * 64 + 16 * lg);
            const i32x4 xb = *(const i32x4*)(X8 + ch * 64 + 16 * lg);
            acc = __builtin_amdgcn_mfma_i32_16x16x64_i8(a, xb, acc, 0, 0, 0);
        }
        if (lr == 0) {
#pragma unroll
            for (int r = 0; r < 4; ++r) Z[w * 16 + 4 * lg + r] = (float)acc[r];
        }
        __builtin_amdgcn_s_waitcnt(0);
        __builtin_amdgcn_wave_barrier();
        float hp = 0.f;
        if (lane < 16) {
            const int pi = w * 16 + lane;
            const float z = Z[pi] * SUi[e] * PART[24];
            hp = Gs[pi] * gelu_exact(z) * SVi[e];
            EH[pi] = make_int2(e, __float_as_int(hp));
        }
        hp = wave_sum(hp);
        if (lane == 0) PART[w] = hp;
    }
    __syncthreads();
    float sumh = 0.f;
#pragma unroll
    for (int i = 0; i < 8; ++i) sumh += PART[i];
    {
        const int c = w, pg = lane >> 3, li = lane & 7;
        float acc[16];
#pragma unroll
        for (int k = 0; k < 16; ++k) acc[k] = 0.f;
        const unsigned char* vb = V8 + (size_t)c * (16384 * 128) + li * 16;
        for (int p0 = 0; p0 < 16; p0 += 8) {
            int2 eh[8]; u32x4 vv[8];
#pragma unroll
            for (int j = 0; j < 8; ++j) eh[j] = EH[pg * 16 + p0 + j];
#pragma unroll
            for (int j = 0; j < 8; ++j) vv[j] = *(const u32x4*)(vb + (size_t)eh[j].x * 128);
#pragma unroll
            for (int j = 0; j < 8; ++j) { const float h = __int_as_float(eh[j].y);
#pragma unroll
                for (int q = 0; q < 4; ++q) { const f32x2 a = __builtin_amdgcn_cvt_pk_f32_fp8((int)vv[j][q], false), bq = __builtin_amdgcn_cvt_pk_f32_fp8((int)vv[j][q], true);
                    acc[4 * q] += h * a[0]; acc[4 * q + 1] += h * a[1]; acc[4 * q + 2] += h * bq[0]; acc[4 * q + 3] += h * bq[1]; } }
        }
#pragma unroll
        for (int k = 0; k < 16; ++k) { float a = acc[k]; a += __shfl_xor(a, 8, 64); a += __shfl_xor(a, 16, 64); a += __shfl_xor(a, 32, 64); acc[k] = a; }
        float s1 = 0.f, s2 = 0.f;
        if (pg == 0) {
            const int col = c * 128 + li * 16;
#pragma unroll
            for (int k = 0; k < 16; ++k) { const float y = DN_ALPHA * p.XF[(size_t)t * DM + col + k] + acc[k]; Y[col + k] = y; s1 += y; s2 += y * y; }
        }
        s1 = wave_sum(s1); s2 = wave_sum(s2);
        if (lane == 0) { PART[8 + w] = s1; PART[16 + w] = s2; }
    }
    __syncthreads();
    float s1 = 0.f, s2 = 0.f;
#pragma unroll
    for (int i = 0; i < 8; ++i) { s1 += PART[8 + i]; s2 += PART[16 + i]; }
    const float mu = s1 * (1.f / 1024.f);
    const float rs = rsqrtf(fmaxf(s2 * (1.f / 1024.f) - mu * mu, 0.f) + LN_EPS);
#pragma unroll
    for (int k = 0; k < 2; ++k) {
        const int col = tid + NT * k;
        const float o = (Y[col] - mu) * rs * lng[col] + lnb[col];
        if (final_out) p.y_sample[(size_t)sidx * DM + col] = o;
        else { p.XF[(size_t)t * DM + col] = o; p.XB[(size_t)t * DM + col] = f2bf(o); }
    }
    __syncthreads();
}

DI void peer_expert_phase(const Params& p, int layer, char* lds, int bid, int nb, bool final_out) {
    for (int tile = bid; tile < 256; tile += nb) peer_tile(p, layer, tile, lds, final_out);
    for (int sidx = bid; sidx < TS; sidx += nb) peer_sample(p, layer, sidx, lds, final_out);
}

DI void hgrn_cumsum(const Params& p, size_t row0, int h, float* bs, float* tot) {
    const int tid = TIDX;
#pragma unroll
    for (int i = 0; i < 4; ++i) { int id = tid + NT * i; int s = id >> 5, c4 = id & 31; *(f32x4*)(bs + s * 128 + 4 * c4) = *(const f32x4*)(p.LF + (row0 + s) * DM + h * 128 + 4 * c4); }
    __syncthreads();
    const int k = tid & 127, seg = tid >> 7;
    float run = 0.f;
#pragma unroll
    for (int i = 0; i < 16; ++i) { run += bs[(seg * 16 + i) * 128 + k]; bs[(seg * 16 + i) * 128 + k] = run; }
    tot[seg * 128 + k] = run;
    __syncthreads();
    float off = 0.f;
#pragma unroll
    for (int s2 = 0; s2 < 3; ++s2) if (s2 < seg) off += tot[s2 * 128 + k];
    if (seg > 0) {
#pragma unroll
        for (int i = 0; i < 16; ++i) bs[(seg * 16 + i) * 128 + k] += off;
    }
    __syncthreads();
}
constexpr int HG_TS = 72;
constexpr int HG_FS = 136;
DI void hgrn_b1_unit(const Params& p, int u, char* lds) {
    float* bs = (float*)lds;
    float* tot = (float*)(lds + 32768);
    bf16_t* KT = (bf16_t*)(lds + 36864);
    bf16_t* IT = (bf16_t*)(lds + 36864 + 18432);
    const int tid = TIDX, lane = tid & 63, w = tid >> 6, lr = lane & 15, lg = lane >> 4;
    const int bh = u >> 7, c = u & 127, b = bh >> 3, h = bh & 7;
    const size_t row0 = (size_t)b * SEQ + c * 64;
    hgrn_cumsum(p, row0, h, bs, tot);
    const bf16_t* KK = p.H + (size_t)MP * DM; const bf16_t* I1 = p.H + (size_t)2 * MP * DM;
    {
        const int s = tid >> 3, kc = (tid & 7) * 16;
        const bf16_t* kr = KK + (row0 + s) * DM + h * 128 + kc; const bf16_t* ir = I1 + (row0 + s) * DM + h * 128 + kc;
        u32x4 ka = *(const u32x4*)kr, kb = *(const u32x4*)(kr + 8), ia = *(const u32x4*)ir, ib = *(const u32x4*)(ir + 8);
#pragma unroll
        for (int i = 0; i < 16; ++i) {
            const unsigned kw = (i < 8) ? ka[(i & 7) >> 1] : kb[(i & 7) >> 1]; const unsigned iw = (i < 8) ? ia[(i & 7) >> 1] : ib[(i & 7) >> 1];
            const float kv = (i & 1) ? bfhi(kw) : bflo(kw);
            const float e = __expf(fminf(-bs[s * 128 + kc + i], 80.f));
            KT[(kc + i) * HG_TS + s] = f2bf(kv * e);
            IT[(kc + i) * HG_TS + s] = (bf16_t)((i & 1) ? (iw >> 16) : (iw & 0xffffu));
        }
    }
    __syncthreads();
    f32x4 acc[8];
#pragma unroll
    for (int j = 0; j < 8; ++j) acc[j] = (f32x4){0.f, 0.f, 0.f, 0.f};
#pragma unroll
    for (int ks = 0; ks < 2; ++ks) {
        const bf16x8 af = *(const bf16x8*)(KT + (w * 16 + lr) * HG_TS + ks * 32 + lg * 8);
#pragma unroll
        for (int j = 0; j < 8; ++j) { const bf16x8 bfr = *(const bf16x8*)(IT + (j * 16 + lr) * HG_TS + ks * 32 + lg * 8); acc[j] = MFMA16(af, bfr, acc[j]); }
    }
    f32x4 dl;
#pragma unroll
    for (int r = 0; r < 4; ++r) dl[r] = __expf(bs[63 * 128 + w * 16 + 4 * lg + r]);
#pragma unroll
    for (int j = 0; j < 8; ++j) store_bf4(p.UT + ((size_t)u * 128 + j * 16 + lr) * 128 + w * 16 + 4 * lg, acc[j] * dl);
    if (tid < 128) p.DEC[(size_t)u * 128 + tid] = __expf(bs[63 * 128 + tid]);
    __syncthreads();
}
DI void hgrn_b2(const Params& p, int bid, int nb) {
    for (int e = bid * NT + TIDX; e < 16 * 8192; e += nb * NT) {
        const int bh = e >> 13, vk = (e & 8191) * 2, k = vk & 127, v = vk >> 7;
        float S0 = 0.f, S1 = 0.f;
        for (int c0 = 0; c0 < 128; c0 += 8) {
            unsigned uu[8]; float d0[8], d1[8];
#pragma unroll
            for (int i = 0; i < 8; ++i) { const size_t un = (size_t)bh * 128 + c0 + i; uu[i] = *(const unsigned*)(p.UT + un * 16384 + vk); d0[i] = p.DEC[un * 128 + k]; d1[i] = p.DEC[un * 128 + k + 1]; }
#pragma unroll
            for (int i = 0; i < 8; ++i) { const size_t un = (size_t)bh * 128 + c0 + i; *(unsigned*)(p.ST + un * 16384 + vk) = pack_bf2(S0, S1); S0 = d0[i] * S0 + bflo(uu[i]); S1 = d1[i] * S1 + bfhi(uu[i]); }
        }
        p.hgrn_prompt[((size_t)bh * 128 + k) * 128 + v] = S0;
        p.hgrn_prompt[((size_t)bh * 128 + k + 1) * 128 + v] = S1;
    }
}
DI void hgrn_b3_unit(const Params& p, int u, char* lds) {
    float* bs = (float*)lds;
    float* tot = (float*)(lds + 32768);
    bf16_t* QH = (bf16_t*)(lds + 36864);
    bf16_t* KH = (bf16_t*)(lds + 36864 + 17408);
    bf16_t* IT = (bf16_t*)(lds + 36864 + 34816);
    bf16_t* AT = (bf16_t*)(lds + 36864 + 34816 + 18432);
    const int tid = TIDX, lane = tid & 63, w = tid >> 6, lr = lane & 15, lg = lane >> 4;
    const int bh = u >> 7, c = u & 127, b = bh >> 3, h = bh & 7;
    const size_t row0 = (size_t)b * SEQ + c * 64;
    hgrn_cumsum(p, row0, h, bs, tot);
    const bf16_t* Q1 = p.H; const bf16_t* KK = p.H + (size_t)MP * DM; const bf16_t* I1 = p.H + (size_t)2 * MP * DM; const bf16_t* G1 = p.H + (size_t)3 * MP * DM;
    {
        const int s = tid >> 3, kc = (tid & 7) * 16;
        const bf16_t* qr = Q1 + (row0 + s) * DM + h * 128 + kc; const bf16_t* kr = KK + (row0 + s) * DM + h * 128 + kc; const bf16_t* ir = I1 + (row0 + s) * DM + h * 128 + kc;
        u32x4 qa = *(const u32x4*)qr, qb = *(const u32x4*)(qr + 8), ka = *(const u32x4*)kr, kb = *(const u32x4*)(kr + 8), ia = *(const u32x4*)ir, ib = *(const u32x4*)(ir + 8);
#pragma unroll
        for (int i = 0; i < 16; ++i) {
            const unsigned qw = (i < 8) ? qa[(i & 7) >> 1] : qb[(i & 7) >> 1]; const unsigned kw = (i < 8) ? ka[(i & 7) >> 1] : kb[(i & 7) >> 1]; const unsigned iw = (i < 8) ? ia[(i & 7) >> 1] : ib[(i & 7) >> 1];
            const float qv = (i & 1) ? bfhi(qw) : bflo(qw); const float kv = (i & 1) ? bfhi(kw) : bflo(kw);
            const float bb = bs[s * 128 + kc + i];
            QH[s * HG_FS + kc + i] = f2bf(qv * __expf(bb));
            KH[s * HG_FS + kc + i] = f2bf(kv * __expf(fminf(-bb, 80.f)));
            IT[(kc + i) * HG_TS + s] = (bf16_t)((i & 1) ? (iw >> 16) : (iw & 0xffffu));
        }
    }
    __syncthreads();
    {
        const int tt = w & 3;
#pragma unroll
        for (int si = 0; si < 2; ++si) {
            const int stile = (w >> 2) * 2 + si;
            f32x4 a = {0.f, 0.f, 0.f, 0.f};
            if (stile <= tt) {
#pragma unroll
                for (int ks = 0; ks < 4; ++ks) {
                    const bf16x8 af = *(const bf16x8*)(KH + (stile * 16 + lr) * HG_FS + ks * 32 + lg * 8);
                    const bf16x8 bfr = *(const bf16x8*)(QH + (tt * 16 + lr) * HG_FS + ks * 32 + lg * 8);
                    a = MFMA16(af, bfr, a);
                }
            }
            const int t = tt * 16 + lr;
#pragma unroll
            for (int r = 0; r < 4; ++r) { const int s = stile * 16 + 4 * lg + r; if (s > t) a[r] = 0.f; }
            store_bf4(AT + t * HG_TS + stile * 16 + 4 * lg, a);
        }
    }
    __syncthreads();
    const int tt = w & 3;
    f32x4 acc[4];
#pragma unroll
    for (int j = 0; j < 4; ++j) acc[j] = (f32x4){0.f, 0.f, 0.f, 0.f};
#pragma unroll
    for (int ks = 0; ks < 2; ++ks) {
        const bf16x8 bfr = *(const bf16x8*)(AT + (tt * 16 + lr) * HG_TS + ks * 32 + lg * 8);
#pragma unroll
        for (int j = 0; j < 4; ++j) { const int vt = (w >> 2) * 4 + j; const bf16x8 af = *(const bf16x8*)(IT + (vt * 16 + lr) * HG_TS + ks * 32 + lg * 8); acc[j] = MFMA16(af, bfr, acc[j]); }
    }
    const bf16_t* STu = p.ST + (size_t)u * 16384;
#pragma unroll
    for (int ks = 0; ks < 4; ++ks) {
        const bf16x8 bfr = *(const bf16x8*)(QH + (tt * 16 + lr) * HG_FS + ks * 32 + lg * 8);
#pragma unroll
        for (int j = 0; j < 4; ++j) { const int vt = (w >> 2) * 4 + j; const bf16x8 af = *(const bf16x8*)(STu + (vt * 16 + lr) * 128 + ks * 32 + lg * 8); acc[j] = MFMA16(af, bfr, acc[j]); }
    }
    float ss = 0.f;
#pragma unroll
    for (int j = 0; j < 4; ++j)
#pragma unroll
        for (int r = 0; r < 4; ++r) ss += acc[j][r] * acc[j][r];
    ss += __shfl_xor(ss, 16, 64); ss += __shfl_xor(ss, 32, 64);
    float* red = tot;
    if (lg == 0) red[(w >> 2) * 64 + tt * 16 + lr] = ss;
    __syncthreads();
    const float rs = rsqrtf((red[tt * 16 + lr] + red[64 + tt * 16 + lr]) * (1.f / 128.f) + RMS_EPS);
    const size_t row = row0 + tt * 16 + lr;
#pragma unroll
    for (int j = 0; j < 4; ++j) {
        const int col = h * 128 + ((w >> 2) * 4 + j) * 16 + 4 * lg;
        const u32x2 gw = *(const u32x2*)(G1 + row * DM + col);
        const f32x4 ng = *(const f32x4*)(p.hgrn_norm_g + col);
        f32x4 o;
        const float gg[4] = {bflo(gw[0]), bfhi(gw[0]), bflo(gw[1]), bfhi(gw[1])};
#pragma unroll
        for (int r = 0; r < 4; ++r) o[r] = acc[j][r] * rs * ng[r] * (gg[r] * sigmoidf_(gg[r]));
        store_bf4(p.MIX + row * DM + col, o);
    }
    __syncthreads();
}
DI void hgrn_sample_unit(const Params& p, int u, char* lds) {
    float* part = (float*)lds;
    float* red = part + 512;
    const int tid = TIDX, lane = tid & 63, w = tid >> 6;
    const int b = u >> 3, h = u & 7; const size_t row = (size_t)TP + b;
    const bf16_t* Q1 = p.H; const bf16_t* KK = p.H + (size_t)MP * DM; const bf16_t* I1 = p.H + (size_t)2 * MP * DM; const bf16_t* G1 = p.H + (size_t)3 * MP * DM;
    const int v = tid & 127, kq = tid >> 7;
    const float iv = bf2f(I1[row * DM + h * 128 + v]);
    float acc = 0.f;
    const float* S0 = p.state_hgrn + (size_t)u * 16384; float* S1 = p.hgrn_sample + (size_t)u * 16384;
#pragma unroll 8
    for (int kk = 0; kk < 32; ++kk) {
        const int k = kq * 32 + kk;
        const float f = __expf(p.LF[row * DM + h * 128 + k]);
        const float kv = bf2f(KK[row * DM + h * 128 + k]);
        const float q = bf2f(Q1[row * DM + h * 128 + k]);
        const float st = f * S0[k * 128 + v] + kv * iv;
        S1[k * 128 + v] = st; acc += q * st;
    }
    part[kq * 128 + v] = acc;
    __syncthreads();
    float o = 0.f, sq = 0.f;
    if (tid < 128) { o = part[tid] + part[128 + tid] + part[256 + tid] + part[384 + tid]; sq = o * o; }
    sq = wave_sum(sq); if (lane == 0) red[w] = sq;
    __syncthreads();
    if (tid < 128) {
        const float rs = rsqrtf((red[0] + red[1]) * (1.f / 128.f) + RMS_EPS);
        const float g = bf2f(G1[row * DM + h * 128 + tid]);
        p.MIX[row * DM + h * 128 + tid] = f2bf(o * rs * p.hgrn_norm_g[h * 128 + tid] * (g * sigmoidf_(g)));
    }
    __syncthreads();
}

constexpr int LDS_BAR = 157824;
constexpr int LDS_BYTES = LDS_BAR + 256;

template <int LAYER> DI void peer_phases(const Params& p, char* lds, int bid, int nb, const XcdBarrier& bar) {
    REPEAT(REP_GEMM) {
        EpiBf16 epi{p.QH, 2048};
        gemm_big(p.XB, p.WT_WQ + (size_t)LAYER * 2048 * 1024, 2048, epi, lds, bid, nb);
    }
    xcd_barrier(bar);
    REPEAT(REP_TOPK) {
        { EpiF32 epi{p.S, 2048};
          for (int u = nb - 1 - bid; u < 16; u += nb) gemm_small32_unit(p.QH + u * 128, 2048, p.KB + (size_t)LAYER * 2048 * 128, 128, 128, TP, u * 128, epi); }
        for (int u = bid; u < TP / 32; u += nb) peer_topk_unit(p, LAYER, u, lds);
    }
    xcd_barrier(bar);
    REPEAT(LAYER == 1 ? REP_PEER1 : 1) peer_expert_phase(p, LAYER, lds, bid, nb, LAYER == 1);
}

__global__ void __launch_bounds__(NT, 2) mega(Params p) {
    extern __shared__ __attribute__((aligned(16))) char lds[];
    const int bid = blockIdx.x, nb = gridDim.x;
    if (TIDX == 0) *(uint4*)(lds + LDS_BAR) = make_uint4(0u, 0u, 0u, 0u);
    __syncthreads();
    XcdBarrier bar = xcd_barrier_post(p.bar, (volatile LAS unsigned*)(lds + LDS_BAR));
    REPEAT(REP_PRO) {
    for (int u = bid; u < 16 * 40; u += nb) transpose_unit(p.w_in_even, 1024, 2560, p.WT_IN_EVEN, u, lds);
    for (int u = bid; u < 16 * 16; u += nb) transpose_unit(p.w_out_even, 1024, 1024, p.WT_OUT_EVEN, u, lds);
    for (int u = bid; u < 16 * 64; u += nb) transpose_unit(p.w_in_odd, 1024, 4096, p.WT_IN_ODD, u, lds);
    for (int u = bid; u < 16 * 16; u += nb) transpose_unit(p.w_out_odd, 1024, 1024, p.WT_OUT_ODD, u, lds);
    for (int u = bid; u < 16 * 32; u += nb) transpose_unit(p.peer_wq, 1024, 2048, p.WT_WQ, u, lds);
    for (int u = bid; u < 16 * 32; u += nb) transpose_unit(p.peer_wq + (size_t)1024 * 2048, 1024, 2048, p.WT_WQ + (size_t)2048 * 1024, u, lds);
    convert_x(p, bid, nb);
    convert_keys(p, bid, nb);
    }
    xcd_barrier(bar);
    REPEAT(REP_GEMM) {
        EpiInEven epi{p.H, p.y_prompt, p.VT};
        gemm_big(p.XB, p.WT_IN_EVEN, 2560, epi, lds, bid, nb);
    }
    xcd_barrier(bar);
    REPEAT(REP_CONV) {
    for (int u = bid; u < 512; u += nb) kmean_prompt_unit(p, u);
    for (int u = bid; u < 544; u += nb) conv_unit(p, u, lds);
    }
    xcd_barrier(bar);
    {
        int bgk = 0;
        if (nb == 256) {
            { const int bh = bid >> 4, i = bid & 15; moba_prompt_unit(p, bh, i, lds, bid, bgk); moba_prompt_unit(p, bh, 31 - i, lds, bid, bgk); }
            while (bgk < 32) { bg_kmean_fore(p, bid, bgk, lds); ++bgk; }
            moba_sample_unit(p, bid, lds);
        } else {
            for (int u = bid; u < 512; u += nb) { const int bh = (u & 255) >> 4, i = u & 15; const int blk = (u < 256) ? i : 31 - i; int none = 32; moba_prompt_unit(p, bh, blk, lds, 0, none); }
            for (int u = bid; u < 256; u += nb) { __syncthreads(); for (int k = 0; k < 32; ++k) bg_kmean_fore(p, u, k, lds); moba_sample_unit(p, u, lds); }
        }
    }
    xcd_barrier(bar);
    REPEAT(REP_GEMM) {
        EpiResid epi{p.T, p.XF};
        gemm_big(p.MIX, p.WT_OUT_EVEN, 1024, epi, lds, bid, nb);
    }
    xcd_barrier(bar);
    ln_rows(p, p.ln_g, p.ln_b, bid, nb, false);
    xcd_barrier(bar);
    peer_phases<0>(p, lds, bid, nb, bar);
    xcd_barrier(bar);
    REPEAT(REP_GEMM) {
        EpiInOdd epi{p.H, p.LF, p.LB};
        gemm_big(p.XB, p.WT_IN_ODD, 4096, epi, lds, bid, nb);
    }
    xcd_barrier(bar);
    REPEAT(REP_HGRN) for (int u = bid; u < 2048 + 256; u += nb) { if (u < 2048) hgrn_b1_unit(p, u, lds); else hgrn_sample_unit(p, u - 2048, lds); }
    xcd_barrier(bar);
    REPEAT(REP_HGRN) hgrn_b2(p, bid, nb);
    xcd_barrier(bar);
    REPEAT(REP_HGRN) for (int u = bid; u < 2048; u += nb) hgrn_b3_unit(p, u, lds);
    xcd_barrier(bar);
    REPEAT(REP_GEMM) {
        EpiResid epi{p.T, p.XF};
        gemm_big(p.MIX, p.WT_OUT_ODD, 1024, epi, lds, bid, nb);
    }
    xcd_barrier(bar);
    ln_rows(p, p.ln_g + 2 * DM, p.ln_b + 2 * DM, bid, nb, false);
    xcd_barrier(bar);
    peer_phases<1>(p, lds, bid, nb, bar);
}

extern "C" void kernel_launch(void* const* d_in, const int* in_sizes, int n_in, void* d_out, int out_size, void* d_ws, size_t ws_size, hipStream_t stream) {
    Params p{};
    p.x_prompt = (const float*)d_in[0]; p.x_sample = (const float*)d_in[1]; p.cache_k = (const float*)d_in[2]; p.cache_v = (const float*)d_in[3];
    p.state_conv = (const float*)d_in[4]; p.state_hgrn = (const float*)d_in[5]; p.page_table = (const int*)d_in[6];
    p.w_in_even = (const float*)d_in[7]; p.conv_w = (const float*)d_in[8]; p.conv_b = (const float*)d_in[9]; p.conv_ln_g = (const float*)d_in[10]; p.conv_ln_b = (const float*)d_in[11];
    p.w_out_even = (const float*)d_in[12]; p.w_in_odd = (const float*)d_in[13]; p.lb_logits = (const float*)d_in[14]; p.hgrn_norm_g = (const float*)d_in[15]; p.w_out_odd = (const float*)d_in[16];
    p.ln_g = (const float*)d_in[17]; p.ln_b = (const float*)d_in[18]; p.peer_wq = (const float*)d_in[19]; p.peer_keys = (const float*)d_in[20]; p.peer_u = (const float*)d_in[21]; p.peer_v = (const float*)d_in[22];
    float* o = (float*)d_out;
    p.y_prompt = o; o += (size_t)TP * DM; p.y_sample = o; o += (size_t)TS * DM;
    p.k_prompt = o; o += (size_t)TP * 512; p.v_prompt = o; o += (size_t)TP * 512; p.k_sample = o; o += (size_t)TS * 512; p.v_sample = o; o += (size_t)TS * 512;
    p.conv_prompt = o; o += 2 * 30 * 512; p.conv_sample = o; o += 32 * 30 * 512; p.hgrn_prompt = o; o += 2 * 8 * 128 * 128; p.hgrn_sample = o;
    char* ws = (char*)d_ws; size_t off = 0;
    auto take = [&](size_t bytes) { char* r = ws + off; off += (bytes + 255) & ~(size_t)255; return r; };
    p.bar = (unsigned*)take(16384); p.LB = (float*)take(4096);
    p.WT_IN_EVEN = (bf16_t*)take((size_t)2560 * 1024 * 2); p.WT_OUT_EVEN = (bf16_t*)take((size_t)1024 * 1024 * 2);
    p.WT_IN_ODD = (bf16_t*)take((size_t)4096 * 1024 * 2); p.WT_OUT_ODD = (bf16_t*)take((size_t)1024 * 1024 * 2);
    p.WT_WQ = (bf16_t*)take((size_t)2 * 2048 * 1024 * 2); p.KB = (bf16_t*)take((size_t)2 * 2048 * 128 * 2);
    p.U8 = (unsigned char*)take((size_t)2 * 16384 * DM); p.V8 = (unsigned char*)take((size_t)2 * 16384 * DM); p.SU = (float*)take(2 * 16384 * 4); p.SV = (float*)take(2 * 16384 * 4);
    p.XB = (bf16_t*)take((size_t)MP * DM * 2); p.XF = (float*)take((size_t)MP * DM * 4);
    p.H = (bf16_t*)take((size_t)MP * 4096 * 2); p.LF = (float*)take((size_t)MP * DM * 4);
    p.VT = (bf16_t*)take((size_t)16 * 64 * 8192 * 2); p.KMPP = (float*)take((size_t)512 * 512 * 4); p.KMS = (bf16_t*)take((size_t)1024 * 512 * 2);
    p.MIX = (bf16_t*)take((size_t)MP * DM * 2); p.T = (float*)take((size_t)MP * DM * 4);
    p.QH = (bf16_t*)take((size_t)MP * 2048 * 2); p.S = (float*)take((size_t)MP * 2048 * 4);
    p.E = (int*)take((size_t)MP * 128 * 4); p.G = (float*)take((size_t)MP * 128 * 4);
    p.UT = (bf16_t*)take((size_t)2048 * 16384 * 2); p.DEC = (float*)take((size_t)2048 * 128 * 4); p.ST = (bf16_t*)take((size_t)2048 * 16384 * 2);
    if (off > ws_size) { fprintf(stderr, "workspace too small: need %zu have %zu\n", off, ws_size); return; }

    static int grid = 0;
    if (!grid) {
        int dev = 0, cus = 0, per_cu = 0;
        (void)hipGetDevice(&dev);
        (void)hipDeviceGetAttribute(&cus, hipDeviceAttributeMultiprocessorCount, dev);
        (void)hipFuncSetAttribute((const void*)mega, hipFuncAttributeMaxDynamicSharedMemorySize, LDS_BYTES);
        (void)hipOccupancyMaxActiveBlocksPerMultiprocessor(&per_cu, (const void*)mega, NT, LDS_BYTES);
        grid = cus * (per_cu < 1 ? per_cu : 1);
        if (grid <= 0) { fprintf(stderr, "mega kernel not resident: cus %d per_cu %d\n", cus, per_cu); grid = 0; return; }
    }
    (void)hipMemsetAsync(p.bar, 0, XCD_BAR_WORDS * sizeof(unsigned), stream);
    hipLaunchKernelGGL(mega, dim3(grid), dim3(NT), LDS_BYTES, stream, p);
}
```

```cpp
#include <hip/hip_runtime.h>
#include <stdint.h>
#include <stdio.h>

#define DI __device__ __forceinline__
__device__ __forceinline__ int tid_opaque() { int t = threadIdx.x; asm volatile("" : "+v"(t)); return t; }
#define TIDX tid_opaque()
typedef unsigned short bf16_t;
typedef short bf16x8 __attribute__((ext_vector_type(8)));
typedef float f32x4 __attribute__((ext_vector_type(4)));
typedef unsigned u32x4 __attribute__((ext_vector_type(4)));
typedef unsigned u32x2 __attribute__((ext_vector_type(2)));
typedef int i32x4 __attribute__((ext_vector_type(4)));
typedef float f32x2 __attribute__((ext_vector_type(2)));

constexpr int NT = 512;
constexpr int TP = 16384, TS = 32, TT = TP + TS, MP = 16640, DM = 1024, SEQ = 8192;
constexpr float DN_ALPHA = 1.4142135623730951f;
constexpr float LN_EPS = 1e-5f, RMS_EPS = 1e-6f;
constexpr size_t OFF_KP = (size_t)TT * DM, OFF_VP = OFF_KP + (size_t)TP * 512, OFF_KS = OFF_VP + (size_t)TP * 512, OFF_VS = OFF_KS + (size_t)TS * 512;

DI float bf2f(bf16_t h) { return __uint_as_float(((unsigned)h) << 16); }
typedef __bf16 bf16x2_t __attribute__((ext_vector_type(2)));
DI unsigned pack_bf2(float lo, float hi) { bf16x2_t v; v[0] = (__bf16)lo; v[1] = (__bf16)hi; return __builtin_bit_cast(unsigned, v); }
DI bf16_t f2bf(float x) { return (bf16_t)(pack_bf2(x, 0.f) & 0xffffu); }
DI float bflo(unsigned u) { return __uint_as_float(u << 16); }
DI float bfhi(unsigned u) { return __uint_as_float(u & 0xffff0000u); }
DI float sigmoidf_(float x) { return 1.f / (1.f + __expf(-x)); }
DI float wave_sum(float v) {
#pragma unroll
    for (int o = 32; o >= 1; o >>= 1) v += __shfl_xor(v, o, 64);
    return v;
}
DI float wave_max(float v) {
#pragma unroll
    for (int o = 32; o >= 1; o >>= 1) v = fmaxf(v, __shfl_xor(v, o, 64));
    return v;
}

DI float red_max_16_32(float x) {
    u32x2 r = __builtin_amdgcn_permlane16_swap(__float_as_uint(x), __float_as_uint(x), false, false);
    x = fmaxf(__uint_as_float(r[0]), __uint_as_float(r[1]));
    r = __builtin_amdgcn_permlane32_swap(__float_as_uint(x), __float_as_uint(x), false, false);
    return fmaxf(__uint_as_float(r[0]), __uint_as_float(r[1]));
}
DI float red_sum_16_32(float x) {
    u32x2 r = __builtin_amdgcn_permlane16_swap(__float_as_uint(x), __float_as_uint(x), false, false);
    x = __uint_as_float(r[0]) + __uint_as_float(r[1]);
    r = __builtin_amdgcn_permlane32_swap(__float_as_uint(x), __float_as_uint(x), false, false);
    return __uint_as_float(r[0]) + __uint_as_float(r[1]);
}
#define MFMA16(a, b, c) __builtin_amdgcn_mfma_f32_16x16x32_bf16((a), (b), (c), 0, 0, 0)

#ifndef REP_PRO
#define REP_PRO 1
#endif
#ifndef REP_GEMM
#define REP_GEMM 1
#endif
#ifndef REP_CONV
#define REP_CONV 1
#endif
#ifndef REP_MOBAP
#define REP_MOBAP 1
#endif
#ifndef REP_MOBAS
#define REP_MOBAS 1
#endif
#ifndef REP_TOPK
#define REP_TOPK 1
#endif
#ifndef REP_PEER1
#define REP_PEER1 1
#endif
#ifndef REP_USW
#define REP_USW 1
#endif
#ifndef REP_VSW
#define REP_VSW 1
#endif
#ifndef REP_HGRN
#define REP_HGRN 1
#endif
#define REPEAT(N) _Pragma("unroll 1") for (int rep_ = 0; rep_ < (N); ++rep_)
struct Params {
    const float* x_prompt; const float* x_sample; const float* cache_k; const float* cache_v;
    const float* state_conv; const float* state_hgrn; const int* page_table;
    const float* w_in_even; const float* conv_w; const float* conv_b; const float* conv_ln_g; const float* conv_ln_b;
    const float* w_out_even; const float* w_in_odd; const float* lb_logits; const float* hgrn_norm_g; const float* w_out_odd;
    const float* ln_g; const float* ln_b; const float* peer_wq; const float* peer_keys; const float* peer_u; const float* peer_v;
    float* y_prompt; float* y_sample; float* k_prompt; float* v_prompt; float* k_sample; float* v_sample;
    float* conv_prompt; float* conv_sample; float* hgrn_prompt; float* hgrn_sample;
    unsigned* bar; float* LB;
    bf16_t* WT_IN_EVEN; bf16_t* WT_OUT_EVEN; bf16_t* WT_IN_ODD; bf16_t* WT_OUT_ODD; bf16_t* WT_WQ; bf16_t* KB;
    unsigned char* U8; unsigned char* V8; float* SU; float* SV;
    bf16_t* XB; bf16_t* H; float* LF; bf16_t* VT; float* KMPP; bf16_t* KMS;
    bf16_t* MIX; bf16_t* T; bf16_t* QH; float* S; int* E; float* G;
    bf16_t* UT; float* DEC; bf16_t* ST;
};


#define XB_TMO      128
#define XB_XCNT(j)  (256  + 64 * (j))
#define XB_XSUB(j)  (1280 + 64 * (j))
#define XB_XGEN(j)  (2304 + 64 * (j))
#define XB_TOP      3328
#define XB_TOPGEN   3392
#define XCD_BAR_WORDS 3456
#define XB_SPIN_CAP (1u << 18)
#define LAS __attribute__((address_space(3)))
__device__ __forceinline__ unsigned xb_ld(unsigned* p)              { return __hip_atomic_load(p, __ATOMIC_RELAXED, __HIP_MEMORY_SCOPE_AGENT); }
__device__ __forceinline__ unsigned xb_add(unsigned* p, unsigned v) { return __hip_atomic_fetch_add(p, v, __ATOMIC_RELAXED, __HIP_MEMORY_SCOPE_AGENT); }
__device__ __forceinline__ unsigned xb_xcc_id() { return (unsigned)__builtin_amdgcn_s_getreg((3 << 11) | 20) & 0xFu; }
#define XB_SPIN(cond, bar) do { unsigned _sp = 0; while (cond) { __builtin_amdgcn_s_sleep(1); \
    if ((++_sp & 255u) == 0u) { if (xb_ld(&(bar)[XB_TMO])) break; if (_sp > XB_SPIN_CAP) { atomicAdd(&(bar)[XB_TMO], 1u); break; } } } } while (0)
struct XcdBarrier { unsigned* bar; unsigned x; volatile LAS unsigned* st; };
__device__ __forceinline__ XcdBarrier xcd_barrier_post(unsigned* bar, volatile LAS unsigned* st) {
    XcdBarrier b; b.bar = bar; b.x = xb_xcc_id(); b.st = st;
    if (threadIdx.x == 0) (void)xb_add(&bar[XB_XCNT(b.x)], 1u);
    return b;
}
__device__ __forceinline__ void xcd_barrier_complete(unsigned* bar, unsigned x, unsigned& nloc, unsigned& nx) {
    const unsigned G = gridDim.x * gridDim.y * gridDim.z;
    unsigned sum, cnt, mine, sp = 0u;
    for (;;) {
        sum = 0u; cnt = 0u; mine = 0u;
#pragma unroll
        for (unsigned j = 0; j < 16; ++j) { const unsigned c = xb_ld(&bar[XB_XCNT(j)]); sum += c; cnt += (c > 0u) ? 1u : 0u; mine = (j == x) ? c : mine; }
        if (sum == G) break;
        __builtin_amdgcn_s_sleep(1);
        if ((++sp & 255u) == 0u) { if (xb_ld(&bar[XB_TMO])) break; if (sp > XB_SPIN_CAP) { atomicAdd(&bar[XB_TMO], 1u); break; } }
    }
    nloc = mine > 0u ? mine : 1u; nx = cnt > 0u ? cnt : 1u;
}
__device__ __forceinline__ void xcd_barrier(const XcdBarrier& b) {
    asm volatile("s_waitcnt vmcnt(0)" ::: "memory");
    __syncthreads();
    if (threadIdx.x == 0) {
        unsigned* bar = b.bar;
        __builtin_amdgcn_s_waitcnt(0);
        unsigned nloc = b.st[0], nx = b.st[1];
        if (nloc == 0u) { xcd_barrier_complete(bar, b.x, nloc, nx); b.st[0] = nloc; b.st[1] = nx; }
        const unsigned old = xb_add(&bar[XB_XSUB(b.x)], 1u);
        const unsigned gen = old / nloc;
        if (old + 1u == (gen + 1u) * nloc) {
            __builtin_amdgcn_fence(__ATOMIC_RELEASE, "agent");
            asm volatile("s_waitcnt vmcnt(0)" ::: "memory");
            const unsigned og = xb_add(&bar[XB_TOP], 1u);
            const unsigned tg = og / nx;
            if (og + 1u == (tg + 1u) * nx) xb_add(&bar[XB_TOPGEN], 1u);
            else XB_SPIN(xb_ld(&bar[XB_TOPGEN]) == tg, bar);
            __builtin_amdgcn_fence(__ATOMIC_ACQUIRE, "agent");
            xb_add(&bar[XB_XGEN(b.x)], 1u);
            asm volatile("s_waitcnt vmcnt(0)" ::: "memory");
        } else {
            XB_SPIN(xb_ld(&bar[XB_XGEN(b.x)]) == gen, bar);
            __builtin_amdgcn_fence(__ATOMIC_ACQUIRE, "agent");
            asm volatile("s_waitcnt vmcnt(0)" ::: "memory");
        }
    }
    __syncthreads();
}

DI void transpose_unit(const float* __restrict__ W, int K, int N, bf16_t* __restrict__ Wt, int u, char* lds) {
    float* tile = (float*)lds;
    const int tid = TIDX;
    const int ntn = N >> 6; const int kt = u / ntn, nt = u % ntn;
#pragma unroll
    for (int i = 0; i < 8; ++i) { int idx = tid + NT * i; int r = idx >> 6, c = idx & 63; tile[r * 65 + c] = W[(size_t)(kt * 64 + r) * N + nt * 64 + c]; }
    __syncthreads();
#pragma unroll
    for (int i = 0; i < 8; ++i) { int idx = tid + NT * i; int r = idx >> 6, c = idx & 63; Wt[(size_t)(nt * 64 + r) * K + kt * 64 + c] = f2bf(tile[c * 65 + r]); }
    __syncthreads();
}
DI void convert_range(const float* __restrict__ src, bf16_t* __restrict__ dst, size_t n4, int bid, int nb) {
    for (size_t i = (size_t)bid * NT + TIDX; i < n4; i += (size_t)nb * NT) {
        f32x4 v = *(const f32x4*)(src + 4 * i);
        u32x2 o; o[0] = pack_bf2(v[0], v[1]); o[1] = pack_bf2(v[2], v[3]);
        *(u32x2*)(dst + 4 * i) = o;
    }
}

template <int OFFS> DI void quant_rows(const float* __restrict__ src, unsigned char* __restrict__ dst, float* __restrict__ inv, int R, int bid, int nb) {
    const int lane = TIDX & 63, w = TIDX >> 6;
#pragma unroll 2
    for (int row = bid * 8 + w; row < R; row += nb * 8) {
        f32x4 v[4]; float am = 0.f;
#pragma unroll
        for (int i = 0; i < 4; ++i) { v[i] = *(const f32x4*)(src + (size_t)row * DM + 4 * lane + 256 * i); am = fmaxf(am, fmaxf(fmaxf(fabsf(v[i][0]), fabsf(v[i][1])), fmaxf(fabsf(v[i][2]), fabsf(v[i][3])))); }
        am = wave_max(am);
        const float sc = am > 0.f ? 127.f / am : 0.f;
#pragma unroll
        for (int i = 0; i < 4; ++i) {
            unsigned pk = 0;
#pragma unroll
            for (int k = 0; k < 4; ++k) { const int q = (int)rintf(v[i][k] * sc) + OFFS; pk |= ((unsigned)q & 0xffu) << (8 * k); }
            const int col = 4 * lane + 256 * i;
            *(unsigned*)(dst + (size_t)(row >> 14) * 16384 * DM + (size_t)(col >> 7) * (16384 * 128) + (size_t)(row & 16383) * 128 + (col & 127)) = pk;
        }
        if (lane == 0) inv[row] = am * (1.f / 127.f);
    }
}
DI void quant_rows_fp8(const float* __restrict__ src, unsigned char* __restrict__ dst, float* __restrict__ inv, int R, int bid, int nb) {
    const int lane = TIDX & 63, w = TIDX >> 6;
#pragma unroll 2
    for (int row = bid * 8 + w; row < R; row += nb * 8) {
        f32x4 v[4]; float am = 0.f;
#pragma unroll
        for (int i = 0; i < 4; ++i) { v[i] = *(const f32x4*)(src + (size_t)row * DM + 4 * lane + 256 * i); am = fmaxf(am, fmaxf(fmaxf(fabsf(v[i][0]), fabsf(v[i][1])), fmaxf(fabsf(v[i][2]), fabsf(v[i][3])))); }
        am = wave_max(am);
        const float sc = am > 0.f ? 416.f / am : 0.f;
#pragma unroll
        for (int i = 0; i < 4; ++i) {
            int pk = 0;
            pk = __builtin_amdgcn_cvt_pk_fp8_f32(v[i][0] * sc, v[i][1] * sc, pk, false);
            pk = __builtin_amdgcn_cvt_pk_fp8_f32(v[i][2] * sc, v[i][3] * sc, pk, true);
            const int col = 4 * lane + 256 * i;
            *(int*)(dst + (size_t)(row >> 14) * 16384 * DM + (size_t)(col >> 7) * (16384 * 128) + (size_t)(row & 16383) * 128 + (col & 127)) = pk;
        }
        if (lane == 0) inv[row] = am * (1.f / 416.f);
    }
}
DI void convert_x(const Params& p, int bid, int nb) {
    const size_t n4 = (size_t)MP * DM / 4;
    for (size_t i = (size_t)bid * NT + TIDX; i < n4; i += (size_t)nb * NT) {
        size_t e = 4 * i; int row = (int)(e >> 10); int col = (int)(e & 1023);
        f32x4 v = {0.f, 0.f, 0.f, 0.f};
        if (row < TP) v = *(const f32x4*)(p.x_prompt + e);
        else if (row < TT) v = *(const f32x4*)(p.x_sample + (size_t)(row - TP) * DM + col);
        u32x2 o; o[0] = pack_bf2(v[0], v[1]); o[1] = pack_bf2(v[2], v[3]);
        *(u32x2*)(p.XB + e) = o;
    }
}
DI void convert_keys(const Params& p, int bid, int nb) {
    const int n = 2 * 2 * 8 * 128 * 128;
    for (int i = bid * NT + TIDX; i < n; i += nb * NT) {
        int d = i & 127, nn = (i >> 7) & 127, j = (i >> 14) & 15, l = i >> 18;
        int h = j >> 1, half = j & 1;
        p.KB[i] = f2bf(p.peer_keys[((((size_t)l * 2 + half) * 8 + h) * 128 + nn) * 128 + d]);
    }
    if (bid == 0) for (int c = TIDX; c < 1024; c += NT) p.LB[c] = sigmoidf_(p.lb_logits[1024 + c] - p.lb_logits[c]);
}
DI void kmean_sample_unit(const Params& p, int u, char* lds) {
    float* part = (float*)lds;
    const int tid = TIDX, c4 = tid & 127, rg = tid >> 7;
    const int b = u >> 5, blk = u & 31;
    f32x4 acc = {0.f, 0.f, 0.f, 0.f};
    const int page = p.page_table[b * 64 + blk * 2 + (rg >> 1)];
    const float* src = p.cache_k + ((size_t)page * 128 + (rg & 1) * 64) * 512 + 4 * c4;
#pragma unroll 1
    for (int r0 = 0; r0 < 64; r0 += 8) {
        f32x4 v[8];
#pragma unroll
        for (int i = 0; i < 8; ++i) v[i] = *(const f32x4*)(src + (size_t)(r0 + i) * 512);
#pragma unroll
        for (int i = 0; i < 8; ++i) acc += v[i];
    }
    __syncthreads();
    *(f32x4*)(part + rg * 512 + 4 * c4) = acc;
    __syncthreads();
    { const int c = tid; const float sum = part[c] + part[512 + c] + part[1024 + c] + part[1536 + c]; p.KMS[(size_t)u * 512 + c] = f2bf(sum * (1.f / 256.f)); }
}
DI void kmean_prompt_unit(const Params& p, int u) {
    const int c = TIDX;
    const float* src = p.k_prompt + (size_t)u * 32 * 512 + c;
    float acc = 0.f;
#pragma unroll
    for (int r = 0; r < 32; ++r) acc += src[(size_t)r * 512];
    p.KMPP[(size_t)u * 512 + c] = acc;
}

struct GemmArgs { const bf16_t* A; int lda; const bf16_t* Bt; int ldb; int K; int blockdiag; };
constexpr int GEMM_LDS = 2 * 49152;

template <class Epi>
DI void gemm_unit(const GemmArgs g, int m0, int n0, const Epi epi, char* lds) {
    const int tid = TIDX, lane = tid & 63, w = tid >> 6;
    const int wm = w & 3, wn = w >> 2, lr = lane & 15, lg = lane >> 4;
    const int acol = g.blockdiag ? n0 : 0;
    const int nk = g.K >> 6;
    f32x4 acc[4][4];
#pragma unroll
    for (int i = 0; i < 4; ++i)
#pragma unroll
        for (int j = 0; j < 4; ++j) acc[i][j] = (f32x4){0.f, 0.f, 0.f, 0.f};
    u32x4 ra[4], rb[2];
    auto gload = [&](int kt) {
#pragma unroll
        for (int i = 0; i < 4; ++i) { int id = tid + NT * i; int r = id >> 3, c = id & 7; ra[i] = *(const u32x4*)(g.A + (size_t)(m0 + r) * g.lda + acol + kt * 64 + c * 8); }
#pragma unroll
        for (int i = 0; i < 2; ++i) { int id = tid + NT * i; int r = id >> 3, c = id & 7; rb[i] = *(const u32x4*)(g.Bt + (size_t)(n0 + r) * g.ldb + kt * 64 + c * 8); }
    };
    auto sstore = [&](int st) {
        char* base = lds + st * 49152;
#pragma unroll
        for (int i = 0; i < 4; ++i) { int id = tid + NT * i; int r = id >> 3, c = id & 7; *(u32x4*)(base + r * 128 + ((c ^ (r & 7)) << 4)) = ra[i]; }
#pragma unroll
        for (int i = 0; i < 2; ++i) { int id = tid + NT * i; int r = id >> 3, c = id & 7; *(u32x4*)(base + 32768 + r * 128 + ((c ^ (r & 7)) << 4)) = rb[i]; }
    };
    gload(0); sstore(0); __syncthreads();
    for (int kt = 0; kt < nk; ++kt) {
        if (kt + 1 < nk) gload(kt + 1);
        const char* base = lds + (kt & 1) * 49152;
#pragma unroll
        for (int ks = 0; ks < 2; ++ks) {
            bf16x8 af[4], bfr[4];
#pragma unroll
            for (int i = 0; i < 4; ++i) { int r = wm * 64 + i * 16 + lr; int ch = ks * 4 + lg; af[i] = *(const bf16x8*)(base + r * 128 + ((ch ^ (r & 7)) << 4)); }
#pragma unroll
            for (int i = 0; i < 4; ++i) { int r = wn * 64 + i * 16 + lr; int ch = ks * 4 + lg; bfr[i] = *(const bf16x8*)(base + 32768 + r * 128 + ((ch ^ (r & 7)) << 4)); }
#pragma unroll
            for (int i = 0; i < 4; ++i)
#pragma unroll
                for (int j = 0; j < 4; ++j) acc[i][j] = MFMA16(bfr[j], af[i], acc[i][j]);
        }
        if (kt + 1 < nk) sstore((kt + 1) & 1);
        __syncthreads();
    }
#pragma unroll
    for (int i = 0; i < 4; ++i)
#pragma unroll
        for (int j = 0; j < 4; ++j) epi(m0 + wm * 64 + i * 16 + lr, n0 + wn * 64 + j * 16 + 4 * lg, acc[i][j]);
}

template <class Epi>
DI void gemm_phase(const GemmArgs g, int M, int N, const Epi epi, char* lds, int bid, int nb) {
    const int tn = N >> 7, tm = M >> 8;
    for (int u = bid; u < tm * tn; u += nb) { int mt = u / tn, nt = u % tn; gemm_unit(g, mt * 256, nt * 128, epi, lds); }
}

DI f32x4 ld_bf4(const bf16_t* src) { const u32x2 w = *(const u32x2*)src; return (f32x4){bflo(w[0]), bfhi(w[0]), bflo(w[1]), bfhi(w[1])}; }
DI void store_bf4(bf16_t* dst, f32x4 v) { u32x2 o; o[0] = pack_bf2(v[0], v[1]); o[1] = pack_bf2(v[2], v[3]); *(u32x2*)dst = o; }

struct EpiInEven {
    bf16_t* H; float* out; bf16_t* VT;
    DI void operator()(int row, int col, f32x4 v) const {
        store_bf4(H + (size_t)row * 2560 + col, v);
        if (col >= 512 && col < 1536 && row < TT) {
            const bool isv = col >= 1024; const int c = col - (isv ? 1024 : 512);
            const size_t off = row < TP ? (isv ? OFF_VP : OFF_KP) + (size_t)row * 512 + c : (isv ? OFF_VS : OFF_KS) + (size_t)(row - TP) * 512 + c;
            *(f32x4*)(out + off) = v;
            if (isv && row < TP) {
                const int b = row >> 13, s = row & 8191, h = c >> 6, d = c & 63;
                bf16_t* vt = VT + ((size_t)(b * 8 + h) * 64 + d) * 8192 + s;
#pragma unroll
                for (int i = 0; i < 4; ++i) vt[(size_t)i * 8192] = f2bf(v[i]);
            }
        }
    }
};
struct EpiBf16 { bf16_t* O; int ld; DI void operator()(int row, int col, f32x4 v) const { store_bf4(O + (size_t)row * ld + col, v); } };
struct EpiF32 { float* O; int ld; DI void operator()(int row, int col, f32x4 v) const { *(f32x4*)(O + (size_t)row * ld + col) = v; } };
struct EpiResid {
    bf16_t* T; const bf16_t* XB;
    DI void operator()(int row, int col, f32x4 v) const { const f32x4 x = ld_bf4(XB + (size_t)row * DM + col); store_bf4(T + (size_t)row * DM + col, x * DN_ALPHA + v); }
};
struct EpiInOdd {
    bf16_t* H; float* LF; const float* LB;
    DI void operator()(int row, int col, f32x4 v) const {
        const int sec = col >> 10, c = col & 1023;
        if (sec == 1) {
            f32x4 lb = *(const f32x4*)(LB + c); f32x4 lf, kk;
#pragma unroll
            for (int i = 0; i < 4; ++i) { float f = lb[i] + (1.f - lb[i]) * sigmoidf_(v[i]); lf[i] = __logf(f); kk[i] = 1.f - f; }
            *(f32x4*)(LF + (size_t)row * DM + c) = lf;
            store_bf4(H + (size_t)MP * DM + (size_t)row * DM + c, kk);
        } else {
            store_bf4(H + (size_t)sec * MP * DM + (size_t)row * DM + c, v);
        }
    }
};

namespace pg8 {
#define PG8_LAS __attribute__((address_space(3)))
typedef unsigned short bf16_t;
typedef short bf16x8 __attribute__((ext_vector_type(8)));
typedef float f32x4 __attribute__((ext_vector_type(4)));
typedef unsigned u32x4 __attribute__((ext_vector_type(4)));
constexpr int BM = 256, BK = 64, HALF = 128, HTB = HALF * BK * 2  , STAGE_BYTES = 8 * HTB, NXCD = 8, WGM = 8;

__host__ __device__ __forceinline__ int lds_byte(int r, int c) { const int st = (r >> 4) * 2 + (c >> 5), rr = r & 15, cc = c & 31, ob = rr * 64 + cc * 2; return st * 1024 + (ob ^ (((ob >> 9) & 1) << 5)); }
__host__ __device__ __forceinline__ void stage_rc(int b, int& R, int& C) { const int st = b / 1024, sb = b % 1024, swz = sb ^ (((sb >> 9) & 1) << 5); R = (st >> 1) * 16 + swz / 64; C = (st & 1) * 32 + (swz % 64) / 2; }
__host__ __device__ __forceinline__ int perm32(int rho) { const int n = rho >> 4, i = rho & 15; return 8 * (i >> 2) + 4 * n + (i & 3); }

struct Unit { int pm, pn; };
struct Gemm { const bf16_t* A; const bf16_t* Bt; int M, N, K; };

struct StaticOrder {
    int nM, nN, nwg, G, c;
    __host__ __device__ void init(int M, int N, int G_, int c_) { nM = M / BM; nN = N / BM; nwg = nM * nN; G = G_; c = c_; }
    __host__ __device__ bool next(int i, Unit& u) const {
        const long L = (long)i * G + c; if (L >= nwg) return false;
        int wgid = (int)L; { const int q = nwg / NXCD, r = nwg % NXCD, xcd = wgid % NXCD, off = wgid / NXCD; wgid = (xcd < r ? xcd * (q + 1) : r * (q + 1) + (xcd - r) * q) + off; }
        const int nig = WGM * nN, gid = wgid / nig, fm = gid * WGM, gsz = (nM - fm) < WGM ? (nM - fm) : WGM;
        u.pm = fm + ((wgid % nig) % gsz); u.pn = (wgid % nig) / gsz; return true;
    }
    __device__ __forceinline__ void a_ready(const Unit&) const {}
    __device__ __forceinline__ void done(const Unit&) const {}
};

template <class Epi, class Sched, bool STAMP = false>
__device__ __forceinline__ void gemm_phase(PG8_LAS unsigned char* lds, const Gemm g, const Sched& S, const Epi& E, unsigned long long* stamps) {
    const int tid = TIDX, wid = __builtin_amdgcn_readfirstlane(tid >> 6), lane = tid & 63, wr = wid >> 2, wc = wid & 3, fr = lane & 15, fq = lane >> 4;
    const int K = g.K, nt = K / BK;
    int ts_lo = 0, ts_hi = 0, nts = 0; const unsigned long long rt_entry = STAMP ? (unsigned long long)wall_clock64() : 0ull;
#define PG8_STAMP() do { if (STAMP && wid == 0 && nts < 64) { const unsigned long long _c = (unsigned long long)clock64(); \
        ts_lo = (lane == nts) ? (int)(unsigned)_c : ts_lo; ts_hi = (lane == nts) ? (int)(unsigned)(_c >> 32) : ts_hi; ++nts; } } while (0)
    PG8_STAMP();
    unsigned voffA[2], voffB[2];
#pragma unroll
    for (int i = 0; i < 2; ++i) { int R, C; stage_rc(tid * 16 + i * 8192, R, C); const int Rb = Epi::PERM ? ((R & ~31) + perm32(R & 31)) : R;
        voffA[i] = (unsigned)(R * K + C) * 2u; voffB[i] = (unsigned)(Rb * K + C) * 2u; }
    const size_t kstep = (size_t)(BK * 2);
    const size_t hstep = (size_t)HALF * K * 2;
    const size_t tstep = 2 * hstep;
    const unsigned ldsw = (unsigned)wid * 1024u;
    const int aoff = lds_byte(wr * 64 + fr, fq * 8), boff = lds_byte(wc * 32 + fr, fq * 8);
#define PG8_SA(b, h) (((b) * 2 + (h)) * HTB)
#define PG8_SB(b, h) ((4 + (b) * 2 + (h)) * HTB)
#define PG8_STAGE(bufoff, gbase, voff) do { _Pragma("unroll") for (int _i = 0; _i < 2; ++_i) \
        __builtin_amdgcn_global_load_lds((const unsigned*)((const char*)(gbase) + (voff)[_i]), (PG8_LAS unsigned*)(lds + (bufoff) + ldsw + _i * 8192), 16, 0, 0); } while (0)
#define PG8_LDA(dst, b, h) do { _Pragma("unroll") for (int m = 0; m < 4; ++m) _Pragma("unroll") for (int k = 0; k < 2; ++k) dst[m][k] = *(const PG8_LAS bf16x8*)(lds + PG8_SA(b, h) + aoff + m * 2048 + k * 1024); } while (0)
#define PG8_LDB(dst, b, h) do { _Pragma("unroll") for (int n = 0; n < 2; ++n) _Pragma("unroll") for (int k = 0; k < 2; ++k) dst[n][k] = *(const PG8_LAS bf16x8*)(lds + PG8_SB(b, h) + boff + n * 2048 + k * 1024); } while (0)
#define PG8_MMA(ai, bj, At, Bt) do { __builtin_amdgcn_s_setprio(1); _Pragma("unroll") for (int m = 0; m < 4; ++m) _Pragma("unroll") for (int n = 0; n < 2; ++n) _Pragma("unroll") for (int k = 0; k < 2; ++k) \
        acc[ai][bj][m][n] = __builtin_amdgcn_mfma_f32_16x16x32_bf16(Bt[n][k], At[m][k], acc[ai][bj][m][n], 0, 0, 0); __builtin_amdgcn_s_setprio(0); } while (0)
#define PG8_WAIT_V(n) asm volatile("s_waitcnt vmcnt(" #n ")" ::: "memory")
#define PG8_WAIT_L(n) asm volatile("s_waitcnt lgkmcnt(" #n ")" ::: "memory")
#define PG8_BAR __builtin_amdgcn_s_barrier()
#define PG8_SCHED __builtin_amdgcn_sched_barrier(0)
    Unit cur, nxt; int ui = 0;
    if (!S.next(0, cur)) return;
    f32x4 acc[2][2][4][2];
#pragma unroll
    for (int a = 0; a < 2; ++a)
#pragma unroll
        for (int b = 0; b < 2; ++b)
#pragma unroll
            for (int m = 0; m < 4; ++m)
#pragma unroll
                for (int n = 0; n < 2; ++n) acc[a][b][m][n] = (f32x4){0.f, 0.f, 0.f, 0.f};
    bf16x8 At[4][2], B0[2][2], B1[2][2];
    const char* cA = (const char*)g.A + (size_t)cur.pm * tstep; const char* cB = (const char*)g.Bt + (size_t)cur.pn * tstep;
    S.a_ready(cur);
    PG8_STAGE(PG8_SB(0, 0), cB, voffB); PG8_STAGE(PG8_SA(0, 0), cA, voffA); PG8_STAGE(PG8_SB(0, 1), cB + hstep, voffB); PG8_STAGE(PG8_SA(0, 1), cA + hstep, voffA);
    if (wr == 1) PG8_BAR;
    PG8_WAIT_V(4); PG8_BAR;
    PG8_STAGE(PG8_SB(1, 0), cB + kstep, voffB); PG8_STAGE(PG8_SA(1, 0), cA + kstep, voffA); PG8_STAGE(PG8_SB(1, 1), cB + hstep + kstep, voffB);
    PG8_WAIT_V(6); PG8_BAR;
    PG8_STAMP();
    for (;;) {
        const bool has_next = S.next(ui + 1, nxt);
        const char* nA = has_next ? (const char*)g.A + (size_t)nxt.pm * tstep : cA; const char* nB = has_next ? (const char*)g.Bt + (size_t)nxt.pn * tstep : cB;
        for (int t = 0; t < nt; t += 2) {
            const bool last = (t == nt - 2);
            const char* a1 = cA + (size_t)(t + 1) * kstep;
            const char* a2 = last ? nA : cA + (size_t)(t + 2) * kstep; const char* b2 = last ? nB : cB + (size_t)(t + 2) * kstep;
            const char* a3 = a2 + kstep; const char* b3 = b2 + kstep;
            if (last && has_next) S.a_ready(nxt);
            PG8_LDB(B0, 0, 0); PG8_SCHED; PG8_LDA(At, 0, 0); PG8_STAGE(PG8_SA(1, 1), a1 + hstep, voffA);
            PG8_WAIT_L(8); PG8_BAR; PG8_WAIT_L(0); PG8_MMA(0, 0, At, B0); PG8_BAR; PG8_SCHED;
            PG8_LDB(B1, 0, 1); PG8_STAGE(PG8_SB(0, 0), b2, voffB);
            PG8_BAR; PG8_WAIT_L(0); PG8_MMA(0, 1, At, B1); PG8_BAR;
            PG8_LDA(At, 0, 1); PG8_STAGE(PG8_SA(0, 0), a2, voffA);
            PG8_BAR; PG8_WAIT_L(0); PG8_MMA(1, 0, At, B0); PG8_BAR; PG8_SCHED;
            PG8_STAGE(PG8_SB(0, 1), b2 + hstep, voffB);
            PG8_WAIT_V(6); PG8_BAR; PG8_MMA(1, 1, At, B1); PG8_BAR;
            PG8_LDB(B0, 1, 0); PG8_SCHED; PG8_LDA(At, 1, 0); PG8_STAGE(PG8_SA(0, 1), a2 + hstep, voffA);
            PG8_WAIT_L(8); PG8_BAR; PG8_WAIT_L(0); PG8_MMA(0, 0, At, B0); PG8_BAR; PG8_SCHED;
            PG8_LDB(B1, 1, 1); PG8_STAGE(PG8_SB(1, 0), b3, voffB);
            PG8_BAR; PG8_WAIT_L(0); PG8_MMA(0, 1, At, B1); PG8_BAR;
            PG8_LDA(At, 1, 1); PG8_STAGE(PG8_SA(1, 0), a3, voffA);
            PG8_BAR; PG8_WAIT_L(0); PG8_MMA(1, 0, At, B0); PG8_BAR; PG8_SCHED;
            PG8_STAGE(PG8_SB(1, 1), b3 + hstep, voffB);
            PG8_WAIT_V(6); PG8_BAR; PG8_MMA(1, 1, At, B1); PG8_BAR;
        }
        PG8_STAMP();
        if constexpr (!Epi::AFTER_DRAIN) { E(acc, cur, wr, wc, fr, fq); S.done(cur); }
        PG8_STAMP();
        if (!has_next) break;
#pragma unroll
        for (int a = 0; a < 2; ++a)
#pragma unroll
            for (int b = 0; b < 2; ++b)
#pragma unroll
                for (int m = 0; m < 4; ++m)
#pragma unroll
                    for (int n = 0; n < 2; ++n) acc[a][b][m][n] = (f32x4){0.f, 0.f, 0.f, 0.f};
        cur = nxt; cA = nA; cB = nB; ++ui;
    }
    PG8_WAIT_V(0);
    if (wr == 0) PG8_BAR;
    PG8_BAR;
    if constexpr (Epi::AFTER_DRAIN) { E.fused(acc, cur, wr, wc, fr, fq, lds, wid, lane); S.done(cur); }
    PG8_STAMP();
    if (STAMP && wid == 0) { stamps[lane] = lane < nts ? (((unsigned long long)(unsigned)ts_hi << 32) | (unsigned)ts_lo) : 0ull;
        if (lane == 62) stamps[62] = rt_entry; if (lane == 63) stamps[63] = (unsigned long long)wall_clock64(); }
#undef PG8_STAMP
#undef PG8_SA
#undef PG8_SB
#undef PG8_STAGE
#undef PG8_LDA
#undef PG8_LDB
#undef PG8_MMA
#undef PG8_WAIT_V
#undef PG8_WAIT_L
#undef PG8_BAR
#undef PG8_SCHED
}
}

template <class MyEpi> struct Pg8Epi {
    static constexpr bool PERM = false, AFTER_DRAIN = false;
    MyEpi e;
    __device__ __forceinline__ void operator()(const pg8::f32x4 (&acc)[2][2][4][2], const pg8::Unit& u, int wr, int wc, int fr, int fq) const {
#pragma unroll
        for (int ai = 0; ai < 2; ++ai)
#pragma unroll
            for (int m = 0; m < 4; ++m) {
                const int row = u.pm * 256 + ai * 128 + wr * 64 + m * 16 + fr;
#pragma unroll
                for (int bj = 0; bj < 2; ++bj)
#pragma unroll
                    for (int n = 0; n < 2; ++n) e(row, u.pn * 256 + bj * 128 + wc * 32 + n * 16 + 4 * fq, acc[ai][bj][m][n]);
            }
    }
};

template <class E> DI void gemm_small32_unit(const bf16_t* A, int lda, const bf16_t* Bt, int ldb, int K, int m0, int n0, const E epi) {
    const int tid = TIDX, lane = tid & 63, w = tid >> 6, lr = lane & 15, lg = lane >> 4;
    const bf16_t* a0 = A + (size_t)(m0 + lr) * lda + lg * 8; const bf16_t* a1 = a0 + (size_t)16 * lda;
    const bf16_t* b0 = Bt + (size_t)(n0 + w * 16 + lr) * ldb + lg * 8;
    f32x4 acc0 = {0.f, 0.f, 0.f, 0.f}, acc1 = {0.f, 0.f, 0.f, 0.f};
#pragma unroll 2
    for (int k0 = 0; k0 < K; k0 += 128) {
        bf16x8 fa0[4], fa1[4], fb[4];
#pragma unroll
        for (int i = 0; i < 4; ++i) { fa0[i] = *(const bf16x8*)(a0 + k0 + i * 32); fa1[i] = *(const bf16x8*)(a1 + k0 + i * 32); fb[i] = *(const bf16x8*)(b0 + k0 + i * 32); }
#pragma unroll
        for (int i = 0; i < 4; ++i) { acc0 = MFMA16(fb[i], fa0[i], acc0); acc1 = MFMA16(fb[i], fa1[i], acc1); }
    }
    epi(m0 + lr, n0 + w * 16 + 4 * lg, acc0);
    epi(m0 + 16 + lr, n0 + w * 16 + 4 * lg, acc1);
}
template <class E> DI void gemm_big(const bf16_t* A, const bf16_t* Bt, int N, const E epi, char* lds, int bid, int nb) {
    {
        pg8::Gemm g{A, Bt, TP, N, DM};
        pg8::StaticOrder S; S.init(TP, N, nb, bid);
        Pg8Epi<E> pe{epi};
        pg8::gemm_phase<Pg8Epi<E>, pg8::StaticOrder, false>((PG8_LAS unsigned char*)lds, g, S, pe, nullptr);
    }
    __syncthreads();
    for (int u = nb - 1 - bid; u < (N >> 7); u += nb) gemm_small32_unit(A, DM, Bt, DM, DM, TP, u * 128, epi);
}

DI void conv_unit(const Params& p, int u, char* lds) {
    float* sy = (float*)lds;
    const int c = TIDX, lane = c & 63, w = c >> 6;
    float wj[31];
#pragma unroll
    for (int j = 0; j < 31; ++j) wj[j] = p.conv_w[j * 512 + c];
    const float bias = p.conv_b[c];
    int ntok, row0;
    if (u < 512) {
        const int b = u >> 8, t0 = (u & 255) * 32; ntok = 32; row0 = b * SEQ + t0;
        float uu[62];
#pragma unroll
        for (int r = 0; r < 62; ++r) {
            const int t = t0 - 30 + r; float val = 0.f;
            if (t >= 0) { const size_t row = (size_t)b * SEQ + t; float a = bf2f(p.H[row * 2560 + 1536 + c]); float g = bf2f(p.H[row * 2560 + 2048 + c]); val = a * sigmoidf_(g); }
            uu[r] = val;
            if (t0 == SEQ - 32 && r >= 32) p.conv_prompt[((size_t)b * 30 + (r - 32)) * 512 + c] = val;
        }
#pragma unroll
        for (int tt = 0; tt < 32; ++tt) {
            float acc = bias;
#pragma unroll
            for (int j = 0; j < 31; ++j) acc += wj[j] * uu[tt + j];
            sy[tt * 512 + c] = acc;
        }
    } else {
        const int b = u - 512; ntok = 1; row0 = TP + b;
        const size_t row = (size_t)row0;
        float a = bf2f(p.H[row * 2560 + 1536 + c]); float g = bf2f(p.H[row * 2560 + 2048 + c]);
        const float un = a * sigmoidf_(g);
        float acc = bias + wj[30] * un;
#pragma unroll
        for (int j = 0; j < 30; ++j) {
            float e = p.state_conv[((size_t)b * 30 + j) * 512 + c]; acc += wj[j] * e;
            if (j >= 1) p.conv_sample[((size_t)b * 30 + (j - 1)) * 512 + c] = e;
        }
        p.conv_sample[((size_t)b * 30 + 29) * 512 + c] = un;
        sy[c] = acc;
    }
    __syncthreads();
    for (int tt = w; tt < ntok; tt += 8) {
        float v[8]; float s = 0.f;
#pragma unroll
        for (int i = 0; i < 8; ++i) { v[i] = sy[tt * 512 + lane + 64 * i]; s += v[i]; }
        const float mu = wave_sum(s) * (1.f / 512.f);
        float q = 0.f;
#pragma unroll
        for (int i = 0; i < 8; ++i) { float d = v[i] - mu; q += d * d; }
        const float rs = rsqrtf(wave_sum(q) * (1.f / 512.f) + LN_EPS);
#pragma unroll
        for (int i = 0; i < 8; ++i) {
            const int cc = lane + 64 * i;
            float y = (v[i] - mu) * rs * p.conv_ln_g[cc] + p.conv_ln_b[cc];
            y = y * sigmoidf_(y);
            p.MIX[(size_t)(row0 + tt) * DM + 512 + cc] = f2bf(y);
        }
    }
    __syncthreads();
}

constexpr int MB_K = 0, MB_V = 65536, MB_VROW = 528, MB_WOR = 65536 + 2 * 64 * MB_VROW;
constexpr int MB_BGS = MB_WOR + 128, MB_KMS = MB_BGS + 2 * 8192, MB_END = MB_KMS + 8192;
DI void moba_sample_unit(const Params& p, int u, char* lds) {
    float* sq = (float*)lds;
    float* gs = sq + 64;
    int* sel = (int*)(gs + 32);
    float* lg = (float*)(sel + 4);
    float* red = lg + 776;
    unsigned* roff = (unsigned*)(red + 16);
    float* part = (float*)(roff + 776);
    const int tid = TIDX, lane = tid & 63, w = tid >> 6;
    const int b = u >> 3, h = u & 7; const size_t row = (size_t)TP + b;
    __syncthreads();
    if (tid < 64) sq[tid] = bf2f(p.H[row * 2560 + h * 64 + tid]);
    __syncthreads();
    if (tid < 32) { const float* km = (const float*)(lds + MB_KMS) + tid * 64; float s = 0.f;
#pragma unroll 8
        for (int d = 0; d < 64; ++d) s += sq[d] * km[d];
        gs[tid] = s; }
    __syncthreads();
    if (tid == 0) {
        float v0 = -INFINITY, v1 = -INFINITY, v2 = -INFINITY; int i0 = 0, i1 = 0, i2 = 0;
        for (int j = 0; j < 32; ++j) { float s = gs[j];
            if (s > v0) { v2 = v1; i2 = i1; v1 = v0; i1 = i0; v0 = s; i0 = j; }
            else if (s > v1) { v2 = v1; i2 = i1; v1 = s; i1 = j; }
            else if (s > v2) { v2 = s; i2 = j; } }
        sel[0] = i0; sel[1] = i1; sel[2] = i2;
    }
    __syncthreads();
    for (int idx = tid; idx < 769; idx += NT) {
        float s = 0.f;
        if (idx < 768) {
            const int blk = sel[idx >> 8]; const int pos = blk * 256 + (idx & 255);
            const int page = p.page_table[b * 64 + (pos >> 7)];
            const unsigned ro = ((unsigned)page * 128u + (unsigned)(pos & 127)) * 8u + (unsigned)h;
            roff[idx] = ro;
            const float* kp = p.cache_k + (size_t)ro * 64;
            f32x4 kv[16];
#pragma unroll
            for (int d4 = 0; d4 < 16; ++d4) kv[d4] = *(const f32x4*)(kp + 4 * d4);
#pragma unroll
            for (int d4 = 0; d4 < 16; ++d4) s += sq[4 * d4] * kv[d4][0] + sq[4 * d4 + 1] * kv[d4][1] + sq[4 * d4 + 2] * kv[d4][2] + sq[4 * d4 + 3] * kv[d4][3];
        } else {
            const bf16_t* kn = p.H + row * 2560 + 512 + h * 64;
            for (int d = 0; d < 64; ++d) s += sq[d] * bf2f(kn[d]);
        }
        lg[idx] = s * 0.125f;
    }
    __syncthreads();
    float mx = -INFINITY;
    for (int idx = tid; idx < 769; idx += NT) mx = fmaxf(mx, lg[idx]);
    mx = wave_max(mx); if (lane == 0) red[w] = mx;
    __syncthreads();
    mx = red[0];
#pragma unroll
    for (int i = 1; i < 8; ++i) mx = fmaxf(mx, red[i]);
    float sm = 0.f;
    for (int idx = tid; idx < 769; idx += NT) { float e = __expf(lg[idx] - mx); lg[idx] = e; sm += e; }
    sm = wave_sum(sm); if (lane == 0) red[8 + w] = sm;
    __syncthreads();
    sm = 0.f;
#pragma unroll
    for (int i = 0; i < 8; ++i) sm += red[8 + i];
    {
        const int d4 = tid & 15, kg = tid >> 4;
        f32x4 acc = {0.f, 0.f, 0.f, 0.f};
#pragma unroll
        for (int i0 = 0; i0 < 24; i0 += 8) {
            f32x4 vv[8]; float pp[8];
#pragma unroll
            for (int i = 0; i < 8; ++i) { const int idx = kg + 32 * (i0 + i); pp[i] = lg[idx]; vv[i] = *(const f32x4*)(p.cache_v + (size_t)roff[idx] * 64 + 4 * d4); }
#pragma unroll
            for (int i = 0; i < 8; ++i) acc += vv[i] * pp[i];
        }
        if (kg == 0) {
            const bf16_t* vn = p.H + row * 2560 + 1024 + h * 64 + 4 * d4; const float pn = lg[768];
            acc[0] += pn * bf2f(vn[0]); acc[1] += pn * bf2f(vn[1]); acc[2] += pn * bf2f(vn[2]); acc[3] += pn * bf2f(vn[3]);
        }
        *(f32x4*)(part + kg * 64 + 4 * d4) = acc;
    }
    __syncthreads();
    if (tid < 64) { float a = 0.f;
#pragma unroll
        for (int i = 0; i < 32; ++i) a += part[i * 64 + tid];
        p.MIX[row * DM + h * 64 + tid] = f2bf(a / sm); }
}

DI void bg_kmean_fore(const Params& p, int bid, int k, char* lds) {
    const int tid = TIDX, rg = tid >> 4, d4 = tid & 15, bs = bid >> 3, hs = bid & 7;
    const int page = p.page_table[bs * 64 + 2 * k + (rg >> 4)];
    const float* base = p.cache_k + (((size_t)page * 128 + (rg & 15) * 8) * 8 + hs) * 64 + 4 * d4;
    f32x4 acc = {0.f, 0.f, 0.f, 0.f};
#pragma unroll
    for (int i = 0; i < 8; ++i) acc += *(const f32x4*)(base + (size_t)i * 512);
    __syncthreads();
    *(f32x4*)(lds + MB_BGS + (rg * 64 + d4 * 4) * 4) = acc;
    __syncthreads();
    if (tid < 64) { float sm = 0.f;
#pragma unroll 8
        for (int r = 0; r < 32; ++r) sm += *(const float*)(lds + MB_BGS + (r * 64 + tid) * 4);
        *(float*)(lds + MB_KMS + (k * 64 + tid) * 4) = sm * (1.f / 256.f); }
    __syncthreads();
}
DI void moba_prompt_unit(const Params& p, int bh, int own, char* lds, int bid, int& bgk) {
    const int tid = TIDX, lane = tid & 63, w = tid >> 6, lr = lane & 15, lg = lane >> 4;
    const int b = bh >> 3, h = bh & 7;
    float* gsc = (float*)lds + w * 1024;
    unsigned* msk = (unsigned*)(lds + 32768) + w * 36;
    unsigned* worl = (unsigned*)(lds + MB_WOR);
    const int wv = __builtin_amdgcn_readfirstlane(w);
    const size_t rowq0 = (size_t)b * SEQ + own * 256 + w * 32;
    __syncthreads();
    bf16x8 qf[2][2];
#pragma unroll
    for (int qt = 0; qt < 2; ++qt)
#pragma unroll
        for (int ks = 0; ks < 2; ++ks) qf[qt][ks] = *(const bf16x8*)(p.H + (rowq0 + qt * 16 + lr) * 2560 + h * 64 + ks * 32 + lg * 8);
    unsigned mq[2]; unsigned wor;
    if (own > 3) {
        bf16_t* kml = (bf16_t*)(lds + 36864);
        {
            const int j = tid >> 4, d4 = tid & 15;
            f32x4 a = {0.f, 0.f, 0.f, 0.f};
#pragma unroll
            for (int part = 0; part < 8; ++part) a += *(const f32x4*)(p.KMPP + (((size_t)b * 32 + j) * 8 + part) * 512 + h * 64 + 4 * d4);
            store_bf4(kml + j * 64 + 4 * d4, a * (1.f / 256.f));
        }
        __syncthreads();
#pragma unroll
        for (int jt = 0; jt < 2; ++jt) {
            bf16x8 kf[2];
#pragma unroll
            for (int ks = 0; ks < 2; ++ks) kf[ks] = *(const bf16x8*)(kml + (jt * 16 + lr) * 64 + ks * 32 + lg * 8);
#pragma unroll
            for (int qt = 0; qt < 2; ++qt) {
                f32x4 a = {0.f, 0.f, 0.f, 0.f};
                a = MFMA16(kf[0], qf[qt][0], a); a = MFMA16(kf[1], qf[qt][1], a);
#pragma unroll
                for (int r = 0; r < 4; ++r) gsc[(qt * 16 + lr) * 32 + jt * 16 + 4 * lg + r] = a[r];
            }
        }
        __builtin_amdgcn_s_waitcnt(0);
        __builtin_amdgcn_wave_barrier();
        unsigned m = 0;
        if (lane < 32) {
            float v0 = -INFINITY, v1 = -INFINITY, v2 = -INFINITY; int i0 = 0, i1 = 0, i2 = 0;
            for (int j = 0; j < own; ++j) { float sc = gsc[lane * 32 + j];
                if (sc > v0) { v2 = v1; i2 = i1; v1 = v0; i1 = i0; v0 = sc; i0 = j; }
                else if (sc > v1) { v2 = v1; i2 = i1; v1 = sc; i1 = j; }
                else if (sc > v2) { v2 = sc; i2 = j; } }
            m = (1u << i0) | (1u << i1) | (1u << i2);
            msk[lane] = m;
        }
        unsigned o = m;
#pragma unroll
        for (int sft = 32; sft >= 1; sft >>= 1) o |= (unsigned)__shfl_xor((int)o, sft, 64);
        wor = o;
        __builtin_amdgcn_s_waitcnt(0);
        __builtin_amdgcn_wave_barrier();
        mq[0] = msk[lr]; mq[1] = msk[16 + lr];
    } else {
        const unsigned m = (own >= 1) ? ((1u << own) - 1u) : 0u;
        mq[0] = m; mq[1] = m; wor = m;
    }
    wor = (unsigned)__builtin_amdgcn_readfirstlane((int)wor);
    if (lane == 0) worl[w] = wor;
    __syncthreads();
    unsigned bor = 0;
#pragma unroll
    for (int i = 0; i < 8; ++i) bor |= worl[i];
    bor = (unsigned)__builtin_amdgcn_readfirstlane((int)bor);

    const bf16_t* Kbase = p.H + (size_t)b * SEQ * 2560 + 512 + h * 64;
    const bf16_t* Vbase = p.VT + (size_t)(b * 8 + h) * 64 * 8192;
    u32x4 rk[4], rv[4];
    auto gload = [&](int jb) {
#pragma unroll
        for (int i = 0; i < 4; ++i) { const int id = tid + NT * i; const int r = id >> 3, c = id & 7; rk[i] = *(const u32x4*)(Kbase + (size_t)(jb * 256 + r) * 2560 + c * 8); }
#pragma unroll
        for (int i = 0; i < 4; ++i) { const int id = tid + NT * i; const int d = id >> 5, c = id & 31; rv[i] = *(const u32x4*)(Vbase + (size_t)d * 8192 + jb * 256 + c * 8); }
    };
    auto sstore = [&](int buf) {
#pragma unroll
        for (int i = 0; i < 4; ++i) { const int id = tid + NT * i; const int r = id >> 3, c = id & 7; *(u32x4*)(lds + MB_K + buf * 32768 + r * 128 + ((c ^ (r & 7)) << 4)) = rk[i]; }
#pragma unroll
        for (int i = 0; i < 4; ++i) { const int id = tid + NT * i; const int d = id >> 5, c = id & 31; *(u32x4*)(lds + MB_V + buf * (64 * MB_VROW) + d * MB_VROW + c * 16) = rv[i]; }
    };
    const float SC = 0.125f * 1.4426950408889634f;
    float mrow[2] = {-INFINITY, -INFINITY}, lrow[2] = {0.f, 0.f};
    f32x4 oacc[2][4];
#pragma unroll
    for (int qt = 0; qt < 2; ++qt)
#pragma unroll
        for (int dt = 0; dt < 4; ++dt) oacc[qt][dt] = (f32x4){0.f, 0.f, 0.f, 0.f};
    const int bg_rg = tid >> 4, bg_d4 = tid & 15, bg_bs = bid >> 3, bg_hs = bid & 7;
    int bg_page = (bgk < 32) ? p.page_table[bg_bs * 64 + 2 * bgk + (bg_rg >> 4)] : 0;
    int cur = own, buf = 0;
    gload(cur); sstore(0); __syncthreads();
    int nxt_scan = 0;
    while (cur >= 0) {
        int nxt = -1;
        while (nxt_scan < own) { const int j = nxt_scan++; if ((bor >> j) & 1u) { nxt = j; break; } }
        if (nxt >= 0) gload(nxt);
        const bool bg_on = bgk < 32;
        const float* bg_base = p.cache_k + (((size_t)bg_page * 128 + (bg_rg & 15) * 8) * 8 + bg_hs) * 64 + 4 * bg_d4;
        f32x4 bg_acc = {0.f, 0.f, 0.f, 0.f}, bg_pend = {0.f, 0.f, 0.f, 0.f}; int bg_i = 0;
        const bool isown = (cur == own);
        if (isown || ((wor >> cur) & 1u)) {
            const char* KB = lds + MB_K + buf * 32768; const char* VB = lds + MB_V + buf * (64 * MB_VROW);
            const int nst = isown ? (wv + 1) : 8;
            const bool sel0 = isown || ((mq[0] >> cur) & 1u), sel1 = isown || ((mq[1] >> cur) & 1u);
            for (int st = 0; st < nst; ++st) {
                if (bg_on && bg_i < 8) { bg_acc += bg_pend; bg_pend = *(const f32x4*)(bg_base + (size_t)bg_i * 512); ++bg_i; }
                bf16x8 kf[2][2];
#pragma unroll
                for (int kt = 0; kt < 2; ++kt)
#pragma unroll
                    for (int ks = 0; ks < 2; ++ks) { const int r = st * 32 + kt * 16 + lr, ch = ks * 4 + lg; kf[kt][ks] = *(const bf16x8*)(KB + r * 128 + ((ch ^ (r & 7)) << 4)); }
                bf16x8 pf[2]; float alph[2];
#pragma unroll
                for (int qt = 0; qt < 2; ++qt) {
                    f32x4 sv[2];
#pragma unroll
                    for (int kt = 0; kt < 2; ++kt) { f32x4 a = {0.f, 0.f, 0.f, 0.f}; a = MFMA16(kf[kt][0], qf[qt][0], a); a = MFMA16(kf[kt][1], qf[qt][1], a); sv[kt] = a; }
                    const bool selq = qt ? sel1 : sel0;
                    if (isown) {
                        const int qin = wv * 32 + qt * 16 + lr;
#pragma unroll
                        for (int kt = 0; kt < 2; ++kt)
#pragma unroll
                            for (int r = 0; r < 4; ++r) { const int kin = st * 32 + kt * 16 + 4 * lg + r; sv[kt][r] = (kin <= qin) ? sv[kt][r] : -INFINITY; }
                    }
                    float mx = fmaxf(fmaxf(fmaxf(sv[0][0], sv[0][1]), fmaxf(sv[0][2], sv[0][3])), fmaxf(fmaxf(sv[1][0], sv[1][1]), fmaxf(sv[1][2], sv[1][3]))) * SC;
                    mx = red_max_16_32(mx);
                    mx = selq ? mx : -INFINITY;
                    const float mnew = fmaxf(mrow[qt], mx);
                    alph[qt] = __builtin_amdgcn_exp2f(mrow[qt] - mnew);
                    const float mneg = selq ? -mnew : -INFINITY;
                    float ps = 0.f;
#pragma unroll
                    for (int kt = 0; kt < 2; ++kt)
#pragma unroll
                        for (int r = 0; r < 4; ++r) { const float e = __builtin_amdgcn_exp2f(__builtin_fmaf(sv[kt][r], SC, mneg)); sv[kt][r] = e; ps += e; }
                    ps = red_sum_16_32(ps);
                    lrow[qt] = lrow[qt] * alph[qt] + ps; mrow[qt] = mnew;
                    u32x4 pk; pk[0] = pack_bf2(sv[0][0], sv[0][1]); pk[1] = pack_bf2(sv[0][2], sv[0][3]); pk[2] = pack_bf2(sv[1][0], sv[1][1]); pk[3] = pack_bf2(sv[1][2], sv[1][3]);
                    pf[qt] = __builtin_bit_cast(bf16x8, pk);
                }
                if (__any((alph[0] != 1.f) || (alph[1] != 1.f))) {
#pragma unroll
                    for (int qt = 0; qt < 2; ++qt)
#pragma unroll
                        for (int dt = 0; dt < 4; ++dt) oacc[qt][dt] = oacc[qt][dt] * alph[qt];
                }
#pragma unroll
                for (int dt = 0; dt < 4; ++dt) {
                    const char* vp = VB + (dt * 16 + lr) * MB_VROW + st * 64 + 8 * lg;
                    const u32x2 lo = *(const u32x2*)vp, hi = *(const u32x2*)(vp + 32);
                    u32x4 t4; t4[0] = lo[0]; t4[1] = lo[1]; t4[2] = hi[0]; t4[3] = hi[1];
                    const bf16x8 vf = __builtin_bit_cast(bf16x8, t4);
#pragma unroll
                    for (int qt = 0; qt < 2; ++qt) oacc[qt][dt] = MFMA16(vf, pf[qt], oacc[qt][dt]);
                }
            }
        }
        if (bg_on) {
            while (bg_i < 8) { bg_acc += bg_pend; bg_pend = *(const f32x4*)(bg_base + (size_t)bg_i * 512); ++bg_i; }
            bg_acc += bg_pend;
            *(f32x4*)(lds + MB_BGS + (bgk & 1) * 8192 + (bg_rg * 64 + bg_d4 * 4) * 4) = bg_acc;
        }
        if (nxt >= 0) sstore(buf ^ 1);
        __syncthreads();
        if (bg_on) {
            if (tid < 64) { float sm = 0.f;
#pragma unroll 8
                for (int r = 0; r < 32; ++r) sm += *(const float*)(lds + MB_BGS + (bgk & 1) * 8192 + (r * 64 + tid) * 4);
                *(float*)(lds + MB_KMS + (bgk * 64 + tid) * 4) = sm * (1.f / 256.f); }
            ++bgk;
            if (bgk < 32) bg_page = p.page_table[bg_bs * 64 + 2 * bgk + (bg_rg >> 4)];
        }
        cur = nxt; buf ^= 1;
    }
#pragma unroll
    for (int qt = 0; qt < 2; ++qt) {
        const float inv = 1.f / lrow[qt];
#pragma unroll
        for (int dt = 0; dt < 4; ++dt) store_bf4(p.MIX + (rowq0 + qt * 16 + lr) * DM + h * 64 + dt * 16 + 4 * lg, oacc[qt][dt] * inv);
    }
}

DI void ln_rows(const Params& p, const float* g, const float* bb, int bid, int nb, bool final_out) {
    const int lane = TIDX & 63, w = TIDX >> 6;
    for (int row = bid * 8 + w; row < TT; row += nb * 8) {
        f32x4 v[4]; float s = 0.f;
#pragma unroll
        for (int i = 0; i < 4; ++i) { v[i] = ld_bf4(p.T + (size_t)row * DM + 4 * lane + 256 * i); s += v[i][0] + v[i][1] + v[i][2] + v[i][3]; }
        const float mu = wave_sum(s) * (1.f / 1024.f);
        float q = 0.f;
#pragma unroll
        for (int i = 0; i < 4; ++i)
#pragma unroll
            for (int k = 0; k < 4; ++k) { float d = v[i][k] - mu; q += d * d; }
        const float rs = rsqrtf(wave_sum(q) * (1.f / 1024.f) + LN_EPS);
#pragma unroll
        for (int i = 0; i < 4; ++i) {
            const int c = 4 * lane + 256 * i;
            f32x4 gg = *(const f32x4*)(g + c), be = *(const f32x4*)(bb + c), y;
#pragma unroll
            for (int k = 0; k < 4; ++k) y[k] = (v[i][k] - mu) * rs * gg[k] + be[k];
            if (final_out) { float* dst = row < TP ? p.y_prompt + (size_t)row * DM + c : p.y_sample + (size_t)(row - TP) * DM + c; *(f32x4*)dst = y; }
            else store_bf4(p.XB + (size_t)row * DM + c, y);
        }
    }
}

DI unsigned ford(float f) { const unsigned u = __float_as_uint(f); return u ^ ((unsigned)((int)u >> 31) | 0x80000000u); }
DI float funord(unsigned k) { return __uint_as_float((k & 0x80000000u) ? (k ^ 0x80000000u) : ~k); }
#define KINS16(K, tk) { unsigned _v = (K); _Pragma("unroll") for (int _k = 0; _k < 16; ++_k) { const unsigned _t = tk[_k] > _v ? tk[_k] : _v; _v = tk[_k] > _v ? _v : tk[_k]; tk[_k] = _t; } }

DI void qrow_issue(const Params& p, int layer, int rid, int lane, f32x4 (&v)[4]) {
    const float* src = (rid < 16384 ? p.peer_u + ((size_t)layer * 16384 + rid) * DM : p.peer_v + ((size_t)layer * 16384 + (rid - 16384)) * DM);
#pragma unroll
    for (int i = 0; i < 4; ++i) v[i] = *(const f32x4*)(src + 4 * lane + 256 * i);
}
DI void qrow_finish(const Params& p, int layer, int rid, int lane, const f32x4 (&v)[4]) {
    float am = 0.f;
#pragma unroll
    for (int i = 0; i < 4; ++i) am = fmaxf(am, fmaxf(fmaxf(fabsf(v[i][0]), fabsf(v[i][1])), fmaxf(fabsf(v[i][2]), fabsf(v[i][3]))));
    am = wave_max(am);
    const bool isu = rid < 16384; const int e = isu ? rid : rid - 16384;
    unsigned char* dst = (isu ? p.U8 : p.V8) + (size_t)layer * 16384 * DM + (size_t)e * 128;
    const float top = isu ? 127.f : 416.f;
    const float sc = am > 0.f ? top / am : 0.f;
#pragma unroll
    for (int i = 0; i < 4; ++i) {
        int pk = 0;
        if (isu) {
#pragma unroll
            for (int k = 0; k < 4; ++k) { const int q = (int)rintf(v[i][k] * sc); pk |= (int)(((unsigned)q & 0xffu) << (8 * k)); }
        } else {
            pk = __builtin_amdgcn_cvt_pk_fp8_f32(v[i][0] * sc, v[i][1] * sc, pk, false);
            pk = __builtin_amdgcn_cvt_pk_fp8_f32(v[i][2] * sc, v[i][3] * sc, pk, true);
        }
        const int col = 4 * lane + 256 * i;
        *(int*)(dst + (size_t)(col >> 7) * (16384 * 128) + (col & 127)) = pk;
    }
    if (lane == 0) (isu ? p.SU : p.SV)[layer * 16384 + e] = am / top;
}
typedef _Float16 f16x4 __attribute__((ext_vector_type(4)));
typedef _Float16 f16x8 __attribute__((ext_vector_type(8)));
DI void peer_topk_unit(const Params& p, int layer, int u, char* lds) {
    const int tid = TIDX, lane = tid & 63, w = tid >> 6, lr = lane & 15, lg = lane >> 4;
    const int t0 = u * 32;
    __syncthreads();
    {
        const bf16_t* KBl = p.KB + (size_t)layer * 2048 * 128;
#pragma unroll 1
        for (int jj = 0; jj < 2; ++jj) {
            const int j = 2 * w + jj;
            bf16x8 qf[2][4];
#pragma unroll
            for (int tt = 0; tt < 2; ++tt)
#pragma unroll
                for (int ks = 0; ks < 4; ++ks) qf[tt][ks] = *(const bf16x8*)(p.QH + (size_t)(t0 + tt * 16 + lr) * 2048 + j * 128 + ks * 32 + lg * 8);
#pragma unroll
            for (int nt = 0; nt < 8; ++nt) {
                bf16x8 kf[4];
#pragma unroll
                for (int ks = 0; ks < 4; ++ks) kf[ks] = *(const bf16x8*)(KBl + (size_t)(j * 128 + nt * 16 + lr) * 128 + ks * 32 + lg * 8);
#pragma unroll
                for (int tt = 0; tt < 2; ++tt) {
                    f32x4 a = {0.f, 0.f, 0.f, 0.f};
#pragma unroll
                    for (int ks = 0; ks < 4; ++ks) a = MFMA16(kf[ks], qf[tt][ks], a);
                    f16x4 hv; hv[0] = (_Float16)a[0]; hv[1] = (_Float16)a[1]; hv[2] = (_Float16)a[2]; hv[3] = (_Float16)a[3];
                    const int chunk = nt * 2 + (lg >> 1);
                    *(f16x4*)(lds + ((tt * 16 + lr) * 16 + j) * 256 + ((chunk ^ j) << 4) + (lg & 1) * 8) = hv;
                }
            }
        }
    }
    __syncthreads();
    const int tok = t0 + (tid >> 4), j = tid & 15;
    const int qbase = u * 64 + w * 8;
    f32x4 qv[4][4];
#pragma unroll
    for (int i = 0; i < 4; ++i) qrow_issue(p, layer, qbase + i, lane, qv[i]);
    unsigned tk[16];
#pragma unroll
    for (int k = 0; k < 16; ++k) tk[k] = 0u;
    {
        const char* sp = lds + tid * 256;
#pragma unroll 2
        for (int c = 0; c < 16; ++c) {
            const f16x8 v = *(const f16x8*)(sp + ((c ^ j) << 4));
#pragma unroll
            for (int q = 0; q < 8; ++q) KINS16((ford((float)v[q]) & ~127u) | (unsigned)(127 - (8 * c + q)), tk);
        }
    }
#pragma unroll
    for (int i = 0; i < 4; ++i) qrow_finish(p, layer, qbase + i, lane, qv[i]);
#pragma unroll
    for (int i = 0; i < 4; ++i) qrow_issue(p, layer, qbase + 4 + i, lane, qv[i]);
    __syncthreads();
    float* lv = (float*)lds;
    int* li = (int*)(lds + 512 * 17 * 4);
#pragma unroll
    for (int k = 0; k < 16; ++k) { lv[tid * 17 + k] = funord(tk[k] & ~127u); li[tid * 17 + k] = 127 - (int)(tk[k] & 127u); }
    __syncthreads();
    if ((j & 1) == 0) {
        float v1[16], v2[16];
#pragma unroll
        for (int k = 0; k < 16; ++k) { v1[k] = lv[tid * 17 + k]; v2[k] = lv[(tid + 1) * 17 + k]; }
        unsigned sk[16];
#pragma unroll
        for (int k = 0; k < 16; ++k) sk[k] = 0u;
#pragma unroll
        for (int a = 0; a < 16; ++a)
#pragma unroll
            for (int bq = 0; bq < 16; ++bq)
                if ((a + 1) * (bq + 1) <= 16) KINS16((ford(v1[a] + v2[bq]) & ~255u) | (unsigned)(255 - (a * 16 + bq)), sk);
        float sc[16]; int ee[16];
#pragma unroll
        for (int k = 0; k < 16; ++k) {
            const int c = 255 - (int)(sk[k] & 255u), a = c >> 4, bq = c & 15;
            sc[k] = lv[tid * 17 + a] + lv[(tid + 1) * 17 + bq];
            ee[k] = li[tid * 17 + a] * 128 + li[(tid + 1) * 17 + bq];
        }
        float sm = 0.f; float e[16];
#pragma unroll
        for (int k = 0; k < 16; ++k) { e[k] = __expf(sc[k] - sc[0]); sm += e[k]; }
        const float inv = 1.f / sm; const int h = j >> 1;
#pragma unroll
        for (int k = 0; k < 16; ++k) { p.E[(size_t)tok * 128 + h * 16 + k] = ee[k]; p.G[(size_t)tok * 128 + h * 16 + k] = e[k] * inv; }
    }
#pragma unroll
    for (int i = 0; i < 4; ++i) qrow_finish(p, layer, qbase + 4 + i, lane, qv[i]);
}

constexpr int EHS = 129;
constexpr int PEER_EH = 65536, PEER_TOK = 65536 + 64 * EHS * 8, PEER_END = PEER_TOK + 1024;
DI float gelu_exact(float z) { return 0.5f * z * (1.f + erff(z * 0.70710678118654752f)); }
#define FMA4U(ACC, O, H, W) { ACC[O] += H * (float)((W) & 0xffu); ACC[O + 1] += H * (float)(((W) >> 8) & 0xffu); ACC[O + 2] += H * (float)(((W) >> 16) & 0xffu); ACC[O + 3] += H * (float)((W) >> 24); }

DI void peer_tile(const Params& p, int layer, int tile, char* lds, bool final_out) {
    const int lane = TIDX & 63, w = TIDX >> 6, lr = lane & 15, lg = lane >> 4;
    unsigned char* X8 = (unsigned char*)lds; int2* EH = (int2*)(lds + PEER_EH); float* TOK = (float*)(lds + PEER_TOK);
    const unsigned char* U8 = p.U8 + (size_t)layer * 16384 * DM; const unsigned char* V8 = p.V8 + (size_t)layer * 16384 * DM;
    const float* SUi = p.SU + layer * 16384; const float* SVi = p.SV + layer * 16384;
    const float* lng = p.ln_g + (layer * 2 + 1) * DM; const float* lnb = p.ln_b + (layer * 2 + 1) * DM;
    const int t0 = tile * 64 + w * 8;
#pragma unroll 4
    for (int i = 0; i < 8; ++i) {
        const int t = t0 + i, tk = w * 8 + i;
        f32x4 v[4]; float am = 0.f;
#pragma unroll
        for (int k = 0; k < 4; ++k) { v[k] = ld_bf4(p.XB + (size_t)t * DM + 4 * lane + 256 * k); am = fmaxf(am, fmaxf(fmaxf(fabsf(v[k][0]), fabsf(v[k][1])), fmaxf(fabsf(v[k][2]), fabsf(v[k][3])))); }
        am = wave_max(am);
        const float sc = am > 0.f ? 127.f / am : 0.f;
#pragma unroll
        for (int k = 0; k < 4; ++k) {
            unsigned pk = 0;
#pragma unroll
            for (int q = 0; q < 4; ++q) { const int qi = (int)rintf(v[k][q] * sc); pk |= ((unsigned)qi & 0xffu) << (8 * q); }
            *(unsigned*)(X8 + tk * 1024 + 4 * lane + 256 * k) = pk;
        }
        if (lane == 0) TOK[tk * 2] = am * (1.f / 127.f);
        EH[tk * EHS + lane] = make_int2(p.E[(size_t)t * 128 + lane], 0);
        EH[tk * EHS + 64 + lane] = make_int2(p.E[(size_t)t * 128 + 64 + lane], 0);
    }
    {
        const int gq = lane >> 3, li = lane & 7, tk = w * 8 + gq;
        auto uld = [&](int c, int p0, u32x4 (&uu)[4]) {
            const unsigned char* Uc = U8 + (size_t)c * (16384 * 128);
#pragma unroll
            for (int j = 0; j < 4; ++j) { const unsigned e = (unsigned)EH[tk * EHS + p0 + j].x; uu[j] = *(const u32x4*)(Uc + (e * 128u + 16u * li)); }
        };
        auto ucp = [&](int p0, u32x4 (&uu)[4], const i32x4& xq) {
#pragma unroll
            for (int j = 0; j < 4; ++j) {
                int d = __builtin_amdgcn_sdot4((int)uu[j][0], xq[0], 0, false);
                d = __builtin_amdgcn_sdot4((int)uu[j][1], xq[1], d, false);
                d = __builtin_amdgcn_sdot4((int)uu[j][2], xq[2], d, false);
                d = __builtin_amdgcn_sdot4((int)uu[j][3], xq[3], d, false);
                d += __builtin_amdgcn_update_dpp(0, d, 0x114, 0xf, 0xf, true);
                d += __builtin_amdgcn_update_dpp(0, d, 0x112, 0xf, 0xf, true);
                d += __builtin_amdgcn_update_dpp(0, d, 0x111, 0xf, 0xf, true);
                if (li == 7) __hip_atomic_fetch_add(&EH[tk * EHS + p0 + j].y, d, __ATOMIC_RELAXED, __HIP_MEMORY_SCOPE_WORKGROUP);
            }
        };
        u32x4 uA[4], uB[4];
        uld(0, 0, uA);
#pragma unroll 1
        for (int c = 0; c < 8; ++c) {
            const i32x4 xq = *(const i32x4*)(X8 + tk * 1024 + c * 128 + 16 * li);
#pragma unroll 1
            for (int p0 = 0; p0 < 128; p0 += 8) {
                uld(c, p0 + 4, uB);
                ucp(p0, uA, xq);
                if (p0 + 8 < 128) uld(c, p0 + 8, uA); else if (c < 7) uld(c + 1, 0, uA);
                ucp(p0 + 4, uB, xq);
            }
        }
    }
#pragma unroll 4
    for (int i = 0; i < 8; ++i) {
        const int t = t0 + i, tk = w * 8 + i;
        const float sxi = TOK[tk * 2];
#pragma unroll
        for (int hf = 0; hf < 2; ++hf) {
            const int pi = hf * 64 + lane;
            const int2 eh = EH[tk * EHS + pi];
            const float z = (float)eh.y * SUi[eh.x] * sxi;
            const float hp = p.G[(size_t)t * 128 + pi] * gelu_exact(z) * SVi[eh.x];
            EH[tk * EHS + pi].y = __float_as_int(hp);
        }
    }
    const int gq = lane >> 3, li = lane & 7, tk = w * 8 + gq, t = t0 + gq;
    float s1 = 0.f, s2 = 0.f;
    auto vload = [&](int c, int p0, float (&hh)[4], u32x4 (&vv)[4]) {
        const unsigned char* Vc = V8 + (size_t)c * (16384 * 128);
#pragma unroll
        for (int j = 0; j < 4; ++j) { const int2 eh = EH[tk * EHS + p0 + j]; hh[j] = __int_as_float(eh.y); vv[j] = *(const u32x4*)(Vc + ((unsigned)eh.x * 128u + 16u * li)); }
    };
    auto vcomp = [&](float (&hh)[4], u32x4 (&vv)[4], f32x2 (&acc)[8]) {
#pragma unroll
        for (int j = 0; j < 4; ++j) {
            const f32x2 h2 = {hh[j], hh[j]};
#pragma unroll
            for (int q = 0; q < 4; ++q) {
                const f32x2 a = __builtin_amdgcn_cvt_pk_f32_fp8((int)vv[j][q], false), b = __builtin_amdgcn_cvt_pk_f32_fp8((int)vv[j][q], true);
                acc[2 * q] = h2 * a + acc[2 * q]; acc[2 * q + 1] = h2 * b + acc[2 * q + 1];
            }
        }
    };
    float ehA[4], ehB[4]; u32x4 vvA[4], vvB[4];
    vload(0, 0, ehA, vvA);
#pragma unroll 1
    for (int c = 0; c < 8; ++c) {
        f32x2 acc[8];
#pragma unroll
        for (int k = 0; k < 8; ++k) acc[k] = (f32x2){0.f, 0.f};
        f32x4 xs[4];
#pragma unroll
        for (int k4 = 0; k4 < 4; ++k4) xs[k4] = ld_bf4(p.XB + (size_t)t * DM + c * 128 + li * 16 + 4 * k4);
#pragma unroll 1
        for (int p0 = 0; p0 < 128; p0 += 8) {
            vload(c, p0 + 4, ehB, vvB);
            vcomp(ehA, vvA, acc);
            if (p0 + 8 < 128) vload(c, p0 + 8, ehA, vvA); else if (c < 7) vload(c + 1, 0, ehA, vvA);
            vcomp(ehB, vvB, acc);
        }
        const int col = c * 128 + li * 16;
#pragma unroll
        for (int k4 = 0; k4 < 4; ++k4) {
            const f32x4 x = xs[k4];
            f32x4 y;
#pragma unroll
            for (int k = 0; k < 4; ++k) { y[k] = DN_ALPHA * x[k] + acc[2 * k4 + (k >> 1)][k & 1]; s1 += y[k]; s2 += y[k] * y[k]; }
            store_bf4(p.T + (size_t)t * DM + col + 4 * k4, y);
        }
    }
#pragma unroll
    for (int o = 1; o <= 4; o <<= 1) { s1 += __shfl_xor(s1, o, 64); s2 += __shfl_xor(s2, o, 64); }
    const float mu = s1 * (1.f / 1024.f);
    const float rs = rsqrtf(fmaxf(s2 * (1.f / 1024.f) - mu * mu, 0.f) + LN_EPS);
#pragma unroll 4
    for (int c = 0; c < 8; ++c) {
        const int col = c * 128 + li * 16;
#pragma unroll
        for (int k4 = 0; k4 < 4; ++k4) {
            const f32x4 y = ld_bf4(p.T + (size_t)t * DM + col + 4 * k4);
            const f32x4 gg = *(const f32x4*)(lng + col + 4 * k4), be = *(const f32x4*)(lnb + col + 4 * k4);
            f32x4 o;
#pragma unroll
            for (int k = 0; k < 4; ++k) o[k] = (y[k] - mu) * rs * gg[k] + be[k];
            if (final_out) *(f32x4*)(p.y_prompt + (size_t)t * DM + col + 4 * k4) = o;
            else store_bf4(p.XB + (size_t)t * DM + col + 4 * k4, o);
        }
    }
}


DI unsigned wave_top16(unsigned x0, unsigned x1, int lane) {
    unsigned res = 0u;
#pragma unroll 1
    for (int r = 0; r < 16; ++r) {
        unsigned m = x0 > x1 ? x0 : x1;
#pragma unroll
        for (int o = 32; o >= 1; o >>= 1) { const unsigned y = (unsigned)__shfl_xor((int)m, o, 64); m = y > m ? y : m; }
        if (x0 == m) x0 = 0u; else if (x1 == m) x1 = 0u;
        if (lane == r) res = m;
    }
    return res;
}
DI void peer_sample(const Params& p, int layer, int sidx, char* lds, bool final_out) {
    const int tid = TIDX, lane = tid & 63, w = tid >> 6, lr = lane & 15, lg = lane >> 4;
    unsigned char* X8 = (unsigned char*)lds; int2* EH = (int2*)(lds + 1024); float* Z = (float*)(lds + 1024 + 1024); float* Y = Z + 128; float* PART = Y + 1024;
    int* Es = (int*)(PART + 32); float* Gs = (float*)(Es + 128);
    const unsigned char* U8 = p.U8 + (size_t)layer * 16384 * DM; const unsigned char* V8 = p.V8 + (size_t)layer * 16384 * DM;
    const float* SUi = p.SU + layer * 16384; const float* SVi = p.SV + layer * 16384;
    const float* lng = p.ln_g + (layer * 2 + 1) * DM; const float* lnb = p.ln_b + (layer * 2 + 1) * DM;
    const int t = TP + sidx;
    __syncthreads();
    if (w == 0) {
        f32x4 v[4]; float am = 0.f;
#pragma unroll
        for (int k = 0; k < 4; ++k) { v[k] = ld_bf4(p.XB + (size_t)t * DM + 4 * lane + 256 * k); am = fmaxf(am, fmaxf(fmaxf(fabsf(v[k][0]), fabsf(v[k][1])), fmaxf(fabsf(v[k][2]), fabsf(v[k][3])))); }
        am = wave_max(am);
        const float sc = am > 0.f ? 127.f / am : 0.f;
#pragma unroll
        for (int k = 0; k < 4; ++k) {
            unsigned pk = 0;
#pragma unroll
            for (int q = 0; q < 4; ++q) { const int qi = (int)rintf(v[k][q] * sc); pk |= ((unsigned)qi & 0xffu) << (8 * q); }
            *(unsigned*)(X8 + 4 * lane + 256 * k) = pk;
        }
        if (lane == 0) PART[24] = am * (1.f / 127.f);
    }
    {
        const float* sp = p.S + (size_t)t * 2048 + w * 256;
        const unsigned k1 = wave_top16((ford(sp[lane]) & ~127u) | (unsigned)(127 - lane), (ford(sp[64 + lane]) & ~127u) | (unsigned)(63 - lane), lane);
        const unsigned k2 = wave_top16((ford(sp[128 + lane]) & ~127u) | (unsigned)(127 - lane), (ford(sp[192 + lane]) & ~127u) | (unsigned)(63 - lane), lane);
        const float v1 = funord(k1 & ~127u), v2 = funord(k2 & ~127u); const int i1 = 127 - (int)(k1 & 127u), i2 = 127 - (int)(k2 & 127u);
        int a = 0, b = 0;
        { int base = 0;
#pragma unroll
          for (int aa = 0; aa < 16; ++aa) { const int cnt = 16 / (aa + 1); if (lane >= base && lane < base + cnt) { a = aa; b = lane - base; } base += cnt; } }
        const float sv = __shfl(v1, a, 64) + __shfl(v2, b, 64);
        const unsigned ck = lane < 50 ? ((ford(sv) & ~255u) | (unsigned)(255 - (a * 16 + b))) : 0u;
        const unsigned rk = wave_top16(ck, 0u, lane);
        const int c2 = 255 - (int)(rk & 255u), a2 = (c2 >> 4) & 15, b2 = c2 & 15;
        const float sc = __shfl(v1, a2, 64) + __shfl(v2, b2, 64);
        const int ex = __shfl(i1, a2, 64) * 128 + __shfl(i2, b2, 64);
        const float mx = __shfl(sc, 0, 64);
        const float ee = lane < 16 ? __expf(sc - mx) : 0.f;
        const float sm = wave_sum(ee);
        if (lane < 16) { Es[w * 16 + lane] = ex; Gs[w * 16 + lane] = ee / sm; }
    }
    __syncthreads();
    {
        const int e = Es[w * 16 + lr];
        i32x4 acc = {0, 0, 0, 0};
#pragma unroll
        for (int ch = 0; ch < 16; ++ch) {
            const i32x4 a = *(const i32x4*)(U8 + (size_t)(ch >> 1) * (16384 * 128) + (size_t)e * 128 + (ch & 1) * 64 + 16 * lg);
            const i32x4 xb = *(const i32x4*)(X8 + ch * 64 + 16 * lg);
            acc = __builtin_amdgcn_mfma_i32_16x16x64_i8(a, xb, acc, 0, 0, 0);
        }
        if (lr == 0) {
#pragma unroll
            for (int r = 0; r < 4; ++r) Z[w * 16 + 4 * lg + r] = (float)acc[r];
        }
        __builtin_amdgcn_s_waitcnt(0);
        __builtin_amdgcn_wave_barrier();
        float hp = 0.f;
        if (lane < 16) {
            const int pi = w * 16 + lane;
            const float z = Z[pi] * SUi[e] * PART[24];
            hp = Gs[pi] * gelu_exact(z) * SVi[e];
            EH[pi] = make_int2(e, __float_as_int(hp));
        }
        hp = wave_sum(hp);
        if (lane == 0) PART[w] = hp;
    }
    __syncthreads();
    float sumh = 0.f;
#pragma unroll
    for (int i = 0; i < 8; ++i) sumh += PART[i];
    {
        const int c = w, pg = lane >> 3, li = lane & 7;
        float acc[16];
#pragma unroll
        for (int k = 0; k < 16; ++k) acc[k] = 0.f;
        const unsigned char* vb = V8 + (size_t)c * (16384 * 128) + li * 16;
        for (int p0 = 0; p0 < 16; p0 += 8) {
            int2 eh[8]; u32x4 vv[8];
#pragma unroll
            for (int j = 0; j < 8; ++j) eh[j] = EH[pg * 16 + p0 + j];
#pragma unroll
            for (int j = 0; j < 8; ++j) vv[j] = *(const u32x4*)(vb + (size_t)eh[j].x * 128);
#pragma unroll
            for (int j = 0; j < 8; ++j) { const float h = __int_as_float(eh[j].y);
#pragma unroll
                for (int q = 0; q < 4; ++q) { const f32x2 a = __builtin_amdgcn_cvt_pk_f32_fp8((int)vv[j][q], false), bq = __builtin_amdgcn_cvt_pk_f32_fp8((int)vv[j][q], true);
                    acc[4 * q] += h * a[0]; acc[4 * q + 1] += h * a[1]; acc[4 * q + 2] += h * bq[0]; acc[4 * q + 3] += h * bq[1]; } }
        }
#pragma unroll
        for (int k = 0; k < 16; ++k) { float a = acc[k]; a += __shfl_xor(a, 8, 64); a += __shfl_xor(a, 16, 64); a += __shfl_xor(a, 32, 64); acc[k] = a; }
        float s1 = 0.f, s2 = 0.f;
        if (pg == 0) {
            const int col = c * 128 + li * 16;
#pragma unroll
            for (int k = 0; k < 16; ++k) { const float y = DN_ALPHA * bf2f(p.XB[(size_t)t * DM + col + k]) + acc[k]; Y[col + k] = y; s1 += y; s2 += y * y; }
        }
        s1 = wave_sum(s1); s2 = wave_sum(s2);
        if (lane == 0) { PART[8 + w] = s1; PART[16 + w] = s2; }
    }
    __syncthreads();
    float s1 = 0.f, s2 = 0.f;
#pragma unroll
    for (int i = 0; i < 8; ++i) { s1 += PART[8 + i]; s2 += PART[16 + i]; }
    const float mu = s1 * (1.f / 1024.f);
    const float rs = rsqrtf(fmaxf(s2 * (1.f / 1024.f) - mu * mu, 0.f) + LN_EPS);
#pragma unroll
    for (int k = 0; k < 2; ++k) {
        const int col = tid + NT * k;
        const float o = (Y[col] - mu) * rs * lng[col] + lnb[col];
        if (final_out) p.y_sample[(size_t)sidx * DM + col] = o;
        else p.XB[(size_t)t * DM + col] = f2bf(o);
    }
    __syncthreads();
}

DI void peer_expert_phase(const Params& p, int layer, char* lds, int bid, int nb, bool final_out) {
    for (int tile = bid; tile < 256; tile += nb) peer_tile(p, layer, tile, lds, final_out);
    for (int sidx = bid; sidx < TS; sidx += nb) peer_sample(p, layer, sidx, lds, final_out);
}

DI void hgrn_cumsum(const Params& p, size_t row0, int h, float* bs, float* tot) {
    const int tid = TIDX;
#pragma unroll
    for (int i = 0; i < 4; ++i) { int id = tid + NT * i; int s = id >> 5, c4 = id & 31; *(f32x4*)(bs + s * 128 + 4 * c4) = *(const f32x4*)(p.LF + (row0 + s) * DM + h * 128 + 4 * c4); }
    __syncthreads();
    const int k = tid & 127, seg = tid >> 7;
    float run = 0.f;
#pragma unroll
    for (int i = 0; i < 16; ++i) { run += bs[(seg * 16 + i) * 128 + k]; bs[(seg * 16 + i) * 128 + k] = run; }
    tot[seg * 128 + k] = run;
    __syncthreads();
    float off = 0.f;
#pragma unroll
    for (int s2 = 0; s2 < 3; ++s2) if (s2 < seg) off += tot[s2 * 128 + k];
    if (seg > 0) {
#pragma unroll
        for (int i = 0; i < 16; ++i) bs[(seg * 16 + i) * 128 + k] += off;
    }
    __syncthreads();
}
constexpr int HG_TS = 72;
constexpr int HG_FS = 136;
DI void hgrn_b1_unit(const Params& p, int u, char* lds) {
    float* bs = (float*)lds;
    float* tot = (float*)(lds + 32768);
    bf16_t* KT = (bf16_t*)(lds + 36864);
    bf16_t* IT = (bf16_t*)(lds + 36864 + 18432);
    const int tid = TIDX, lane = tid & 63, w = tid >> 6, lr = lane & 15, lg = lane >> 4;
    const int bh = u >> 7, c = u & 127, b = bh >> 3, h = bh & 7;
    const size_t row0 = (size_t)b * SEQ + c * 64;
    hgrn_cumsum(p, row0, h, bs, tot);
    const bf16_t* KK = p.H + (size_t)MP * DM; const bf16_t* I1 = p.H + (size_t)2 * MP * DM;
    {
        const int s = tid >> 3, kc = (tid & 7) * 16;
        const bf16_t* kr = KK + (row0 + s) * DM + h * 128 + kc; const bf16_t* ir = I1 + (row0 + s) * DM + h * 128 + kc;
        u32x4 ka = *(const u32x4*)kr, kb = *(const u32x4*)(kr + 8), ia = *(const u32x4*)ir, ib = *(const u32x4*)(ir + 8);
#pragma unroll
        for (int i = 0; i < 16; ++i) {
            const unsigned kw = (i < 8) ? ka[(i & 7) >> 1] : kb[(i & 7) >> 1]; const unsigned iw = (i < 8) ? ia[(i & 7) >> 1] : ib[(i & 7) >> 1];
            const float kv = (i & 1) ? bfhi(kw) : bflo(kw);
            const float e = __expf(fminf(-bs[s * 128 + kc + i], 80.f));
            KT[(kc + i) * HG_TS + s] = f2bf(kv * e);
            IT[(kc + i) * HG_TS + s] = (bf16_t)((i & 1) ? (iw >> 16) : (iw & 0xffffu));
        }
    }
    __syncthreads();
    f32x4 acc[8];
#pragma unroll
    for (int j = 0; j < 8; ++j) acc[j] = (f32x4){0.f, 0.f, 0.f, 0.f};
#pragma unroll
    for (int ks = 0; ks < 2; ++ks) {
        const bf16x8 af = *(const bf16x8*)(KT + (w * 16 + lr) * HG_TS + ks * 32 + lg * 8);
#pragma unroll
        for (int j = 0; j < 8; ++j) { const bf16x8 bfr = *(const bf16x8*)(IT + (j * 16 + lr) * HG_TS + ks * 32 + lg * 8); acc[j] = MFMA16(af, bfr, acc[j]); }
    }
    f32x4 dl;
#pragma unroll
    for (int r = 0; r < 4; ++r) dl[r] = __expf(bs[63 * 128 + w * 16 + 4 * lg + r]);
#pragma unroll
    for (int j = 0; j < 8; ++j) store_bf4(p.UT + ((size_t)u * 128 + j * 16 + lr) * 128 + w * 16 + 4 * lg, acc[j] * dl);
    if (tid < 128) p.DEC[(size_t)u * 128 + tid] = __expf(bs[63 * 128 + tid]);
    __syncthreads();
}
DI void hgrn_b2(const Params& p, int bid, int nb) {
    for (int e = bid * NT + TIDX; e < 16 * 8192; e += nb * NT) {
        const int bh = e >> 13, vk = (e & 8191) * 2, k = vk & 127, v = vk >> 7;
        float S0 = 0.f, S1 = 0.f;
        for (int c0 = 0; c0 < 128; c0 += 8) {
            unsigned uu[8]; float d0[8], d1[8];
#pragma unroll
            for (int i = 0; i < 8; ++i) { const size_t un = (size_t)bh * 128 + c0 + i; uu[i] = *(const unsigned*)(p.UT + un * 16384 + vk); d0[i] = p.DEC[un * 128 + k]; d1[i] = p.DEC[un * 128 + k + 1]; }
#pragma unroll
            for (int i = 0; i < 8; ++i) { const size_t un = (size_t)bh * 128 + c0 + i; *(unsigned*)(p.ST + un * 16384 + vk) = pack_bf2(S0, S1); S0 = d0[i] * S0 + bflo(uu[i]); S1 = d1[i] * S1 + bfhi(uu[i]); }
        }
        p.hgrn_prompt[((size_t)bh * 128 + k) * 128 + v] = S0;
        p.hgrn_prompt[((size_t)bh * 128 + k + 1) * 128 + v] = S1;
    }
}
DI void hgrn_b3_unit(const Params& p, int u, char* lds) {
    float* bs = (float*)lds;
    float* tot = (float*)(lds + 32768);
    bf16_t* QH = (bf16_t*)(lds + 36864);
    bf16_t* KH = (bf16_t*)(lds + 36864 + 17408);
    bf16_t* IT = (bf16_t*)(lds + 36864 + 34816);
    bf16_t* AT = (bf16_t*)(lds + 36864 + 34816 + 18432);
    const int tid = TIDX, lane = tid & 63, w = tid >> 6, lr = lane & 15, lg = lane >> 4;
    const int bh = u >> 7, c = u & 127, b = bh >> 3, h = bh & 7;
    const size_t row0 = (size_t)b * SEQ + c * 64;
    hgrn_cumsum(p, row0, h, bs, tot);
    const bf16_t* Q1 = p.H; const bf16_t* KK = p.H + (size_t)MP * DM; const bf16_t* I1 = p.H + (size_t)2 * MP * DM; const bf16_t* G1 = p.H + (size_t)3 * MP * DM;
    {
        const int s = tid >> 3, kc = (tid & 7) * 16;
        const bf16_t* qr = Q1 + (row0 + s) * DM + h * 128 + kc; const bf16_t* kr = KK + (row0 + s) * DM + h * 128 + kc; const bf16_t* ir = I1 + (row0 + s) * DM + h * 128 + kc;
        u32x4 qa = *(const u32x4*)qr, qb = *(const u32x4*)(qr + 8), ka = *(const u32x4*)kr, kb = *(const u32x4*)(kr + 8), ia = *(const u32x4*)ir, ib = *(const u32x4*)(ir + 8);
#pragma unroll
        for (int i = 0; i < 16; ++i) {
            const unsigned qw = (i < 8) ? qa[(i & 7) >> 1] : qb[(i & 7) >> 1]; const unsigned kw = (i < 8) ? ka[(i & 7) >> 1] : kb[(i & 7) >> 1]; const unsigned iw = (i < 8) ? ia[(i & 7) >> 1] : ib[(i & 7) >> 1];
            const float qv = (i & 1) ? bfhi(qw) : bflo(qw); const float kv = (i & 1) ? bfhi(kw) : bflo(kw);
            const float bb = bs[s * 128 + kc + i];
            QH[s * HG_FS + kc + i] = f2bf(qv * __expf(bb));
            KH[s * HG_FS + kc + i] = f2bf(kv * __expf(fminf(-bb, 80.f)));
            IT[(kc + i) * HG_TS + s] = (bf16_t)((i & 1) ? (iw >> 16) : (iw & 0xffffu));
        }
    }
    __syncthreads();
    {
        const int tt = w & 3;
#pragma unroll
        for (int si = 0; si < 2; ++si) {
            const int stile = (w >> 2) * 2 + si;
            f32x4 a = {0.f, 0.f, 0.f, 0.f};
            if (stile <= tt) {
#pragma unroll
                for (int ks = 0; ks < 4; ++ks) {
                    const bf16x8 af = *(const bf16x8*)(KH + (stile * 16 + lr) * HG_FS + ks * 32 + lg * 8);
                    const bf16x8 bfr = *(const bf16x8*)(QH + (tt * 16 + lr) * HG_FS + ks * 32 + lg * 8);
                    a = MFMA16(af, bfr, a);
                }
            }
            const int t = tt * 16 + lr;
#pragma unroll
            for (int r = 0; r < 4; ++r) { const int s = stile * 16 + 4 * lg + r; if (s > t) a[r] = 0.f; }
            store_bf4(AT + t * HG_TS + stile * 16 + 4 * lg, a);
        }
    }
    __syncthreads();
    const int tt = w & 3;
    f32x4 acc[4];
#pragma unroll
    for (int j = 0; j < 4; ++j) acc[j] = (f32x4){0.f, 0.f, 0.f, 0.f};
#pragma unroll
    for (int ks = 0; ks < 2; ++ks) {
        const bf16x8 bfr = *(const bf16x8*)(AT + (tt * 16 + lr) * HG_TS + ks * 32 + lg * 8);
#pragma unroll
        for (int j = 0; j < 4; ++j) { const int vt = (w >> 2) * 4 + j; const bf16x8 af = *(const bf16x8*)(IT + (vt * 16 + lr) * HG_TS + ks * 32 + lg * 8); acc[j] = MFMA16(af, bfr, acc[j]); }
    }
    const bf16_t* STu = p.ST + (size_t)u * 16384;
#pragma unroll
    for (int ks = 0; ks < 4; ++ks) {
        const bf16x8 bfr = *(const bf16x8*)(QH + (tt * 16 + lr) * HG_FS + ks * 32 + lg * 8);
#pragma unroll
        for (int j = 0; j < 4; ++j) { const int vt = (w >> 2) * 4 + j; const bf16x8 af = *(const bf16x8*)(STu + (vt * 16 + lr) * 128 + ks * 32 + lg * 8); acc[j] = MFMA16(af, bfr, acc[j]); }
    }
    float ss = 0.f;
#pragma unroll
    for (int j = 0; j < 4; ++j)
#pragma unroll
        for (int r = 0; r < 4; ++r) ss += acc[j][r] * acc[j][r];
    ss += __shfl_xor(ss, 16, 64); ss += __shfl_xor(ss, 32, 64);
    float* red = tot;
    if (lg == 0) red[(w >> 2) * 64 + tt * 16 + lr] = ss;
    __syncthreads();
    const float rs = rsqrtf((red[tt * 16 + lr] + red[64 + tt * 16 + lr]) * (1.f / 128.f) + RMS_EPS);
    const size_t row = row0 + tt * 16 + lr;
#pragma unroll
    for (int j = 0; j < 4; ++j) {
        const int col = h * 128 + ((w >> 2) * 4 + j) * 16 + 4 * lg;
        const u32x2 gw = *(const u32x2*)(G1 + row * DM + col);
        const f32x4 ng = *(const f32x4*)(p.hgrn_norm_g + col);
        f32x4 o;
        const float gg[4] = {bflo(gw[0]), bfhi(gw[0]), bflo(gw[1]), bfhi(gw[1])};
#pragma unroll
        for (int r = 0; r < 4; ++r) o[r] = acc[j][r] * rs * ng[r] * (gg[r] * sigmoidf_(gg[r]));
        store_bf4(p.MIX + row * DM + col, o);
    }
    __syncthreads();
}
DI void hgrn_sample_unit(const Params& p, int u, char* lds) {
    float* part = (float*)lds;
    float* red = part + 512;
    const int tid = TIDX, lane = tid & 63, w = tid >> 6;
    const int b = u >> 3, h = u & 7; const size_t row = (size_t)TP + b;
    const bf16_t* Q1 = p.H; const bf16_t* KK = p.H + (size_t)MP * DM; const bf16_t* I1 = p.H + (size_t)2 * MP * DM; const bf16_t* G1 = p.H + (size_t)3 * MP * DM;
    const int v = tid & 127, kq = tid >> 7;
    const float iv = bf2f(I1[row * DM + h * 128 + v]);
    float acc = 0.f;
    const float* S0 = p.state_hgrn + (size_t)u * 16384; float* S1 = p.hgrn_sample + (size_t)u * 16384;
#pragma unroll 8
    for (int kk = 0; kk < 32; ++kk) {
        const int k = kq * 32 + kk;
        const float f = __expf(p.LF[row * DM + h * 128 + k]);
        const float kv = bf2f(KK[row * DM + h * 128 + k]);
        const float q = bf2f(Q1[row * DM + h * 128 + k]);
        const float st = f * S0[k * 128 + v] + kv * iv;
        S1[k * 128 + v] = st; acc += q * st;
    }
    part[kq * 128 + v] = acc;
    __syncthreads();
    float o = 0.f, sq = 0.f;
    if (tid < 128) { o = part[tid] + part[128 + tid] + part[256 + tid] + part[384 + tid]; sq = o * o; }
    sq = wave_sum(sq); if (lane == 0) red[w] = sq;
    __syncthreads();
    if (tid < 128) {
        const float rs = rsqrtf((red[0] + red[1]) * (1.f / 128.f) + RMS_EPS);
        const float g = bf2f(G1[row * DM + h * 128 + tid]);
        p.MIX[row * DM + h * 128 + tid] = f2bf(o * rs * p.hgrn_norm_g[h * 128 + tid] * (g * sigmoidf_(g)));
    }
    __syncthreads();
}

constexpr int LDS_BAR = 157824;
constexpr int LDS_BYTES = LDS_BAR + 256;

template <int LAYER> DI void peer_phases(const Params& p, char* lds, int bid, int nb, const XcdBarrier& bar) {
    REPEAT(REP_GEMM) {
        EpiBf16 epi{p.QH, 2048};
        gemm_big(p.XB, p.WT_WQ + (size_t)LAYER * 2048 * 1024, 2048, epi, lds, bid, nb);
    }
    xcd_barrier(bar);
    REPEAT(REP_TOPK) {
        { EpiF32 epi{p.S, 2048};
          for (int u = nb - 1 - bid; u < 16; u += nb) gemm_small32_unit(p.QH + u * 128, 2048, p.KB + (size_t)LAYER * 2048 * 128, 128, 128, TP, u * 128, epi); }
        for (int u = bid; u < TP / 32; u += nb) peer_topk_unit(p, LAYER, u, lds);
    }
    xcd_barrier(bar);
    REPEAT(LAYER == 1 ? REP_PEER1 : 1) peer_expert_phase(p, LAYER, lds, bid, nb, LAYER == 1);
}

__global__ void __launch_bounds__(NT, 2) mega(Params p) {
    extern __shared__ __attribute__((aligned(16))) char lds[];
    const int bid = blockIdx.x, nb = gridDim.x;
    if (TIDX == 0) *(uint4*)(lds + LDS_BAR) = make_uint4(0u, 0u, 0u, 0u);
    __syncthreads();
    XcdBarrier bar = xcd_barrier_post(p.bar, (volatile LAS unsigned*)(lds + LDS_BAR));
    REPEAT(REP_PRO) {
    for (int u = bid; u < 16 * 40; u += nb) transpose_unit(p.w_in_even, 1024, 2560, p.WT_IN_EVEN, u, lds);
    for (int u = bid; u < 16 * 16; u += nb) transpose_unit(p.w_out_even, 1024, 1024, p.WT_OUT_EVEN, u, lds);
    for (int u = bid; u < 16 * 64; u += nb) transpose_unit(p.w_in_odd, 1024, 4096, p.WT_IN_ODD, u, lds);
    for (int u = bid; u < 16 * 16; u += nb) transpose_unit(p.w_out_odd, 1024, 1024, p.WT_OUT_ODD, u, lds);
    for (int u = bid; u < 16 * 32; u += nb) transpose_unit(p.peer_wq, 1024, 2048, p.WT_WQ, u, lds);
    for (int u = bid; u < 16 * 32; u += nb) transpose_unit(p.peer_wq + (size_t)1024 * 2048, 1024, 2048, p.WT_WQ + (size_t)2048 * 1024, u, lds);
    convert_x(p, bid, nb);
    convert_keys(p, bid, nb);
    }
    xcd_barrier(bar);
    REPEAT(REP_GEMM) {
        EpiInEven epi{p.H, p.y_prompt, p.VT};
        gemm_big(p.XB, p.WT_IN_EVEN, 2560, epi, lds, bid, nb);
    }
    xcd_barrier(bar);
    REPEAT(REP_CONV) {
    for (int u = bid; u < 512; u += nb) kmean_prompt_unit(p, u);
    for (int u = bid; u < 544; u += nb) conv_unit(p, u, lds);
    }
    xcd_barrier(bar);
    {
        int bgk = 0;
        if (nb == 256) {
            { const int bh = bid >> 4, i = bid & 15; moba_prompt_unit(p, bh, i, lds, bid, bgk); moba_prompt_unit(p, bh, 31 - i, lds, bid, bgk); }
            while (bgk < 32) { bg_kmean_fore(p, bid, bgk, lds); ++bgk; }
            moba_sample_unit(p, bid, lds);
        } else {
            for (int u = bid; u < 512; u += nb) { const int bh = (u & 255) >> 4, i = u & 15; const int blk = (u < 256) ? i : 31 - i; int none = 32; moba_prompt_unit(p, bh, blk, lds, 0, none); }
            for (int u = bid; u < 256; u += nb) { __syncthreads(); for (int k = 0; k < 32; ++k) bg_kmean_fore(p, u, k, lds); moba_sample_unit(p, u, lds); }
        }
    }
    xcd_barrier(bar);
    REPEAT(REP_GEMM) {
        EpiResid epi{p.T, p.XB};
        gemm_big(p.MIX, p.WT_OUT_EVEN, 1024, epi, lds, bid, nb);
    }
    xcd_barrier(bar);
    ln_rows(p, p.ln_g, p.ln_b, bid, nb, false);
    xcd_barrier(bar);
    peer_phases<0>(p, lds, bid, nb, bar);
    xcd_barrier(bar);
    REPEAT(REP_GEMM) {
        EpiInOdd epi{p.H, p.LF, p.LB};
        gemm_big(p.XB, p.WT_IN_ODD, 4096, epi, lds, bid, nb);
    }
    xcd_barrier(bar);
    REPEAT(REP_HGRN) for (int u = bid; u < 2048 + 256; u += nb) { if (u < 2048) hgrn_b1_unit(p, u, lds); else hgrn_sample_unit(p, u - 2048, lds); }
    xcd_barrier(bar);
    REPEAT(REP_HGRN) hgrn_b2(p, bid, nb);
    xcd_barrier(bar);
    REPEAT(REP_HGRN) for (int u = bid; u < 2048; u += nb) hgrn_b3_unit(p, u, lds);
    xcd_barrier(bar);
    REPEAT(REP_GEMM) {
        EpiResid epi{p.T, p.XB};
        gemm_big(p.MIX, p.WT_OUT_ODD, 1024, epi, lds, bid, nb);
    }
    xcd_barrier(bar);
    ln_rows(p, p.ln_g + 2 * DM, p.ln_b + 2 * DM, bid, nb, false);
    xcd_barrier(bar);
    peer_phases<1>(p, lds, bid, nb, bar);
}

extern "C" void kernel_launch(void* const* d_in, const int* in_sizes, int n_in, void* d_out, int out_size, void* d_ws, size_t ws_size, hipStream_t stream) {
    Params p{};
    p.x_prompt = (const float*)d_in[0]; p.x_sample = (const float*)d_in[1]; p.cache_k = (const float*)d_in[2]; p.cache_v = (const float*)d_in[3];
    p.state_conv = (const float*)d_in[4]; p.state_hgrn = (const float*)d_in[5]; p.page_table = (const int*)d_in[6];
    p.w_in_even = (const float*)d_in[7]; p.conv_w = (const float*)d_in[8]; p.conv_b = (const float*)d_in[9]; p.conv_ln_g = (const float*)d_in[10]; p.conv_ln_b = (const float*)d_in[11];
    p.w_out_even = (const float*)d_in[12]; p.w_in_odd = (const float*)d_in[13]; p.lb_logits = (const float*)d_in[14]; p.hgrn_norm_g = (const float*)d_in[15]; p.w_out_odd = (const float*)d_in[16];
    p.ln_g = (const float*)d_in[17]; p.ln_b = (const float*)d_in[18]; p.peer_wq = (const float*)d_in[19]; p.peer_keys = (const float*)d_in[20]; p.peer_u = (const float*)d_in[21]; p.peer_v = (const float*)d_in[22];
    float* o = (float*)d_out;
    p.y_prompt = o; o += (size_t)TP * DM; p.y_sample = o; o += (size_t)TS * DM;
    p.k_prompt = o; o += (size_t)TP * 512; p.v_prompt = o; o += (size_t)TP * 512; p.k_sample = o; o += (size_t)TS * 512; p.v_sample = o; o += (size_t)TS * 512;
    p.conv_prompt = o; o += 2 * 30 * 512; p.conv_sample = o; o += 32 * 30 * 512; p.hgrn_prompt = o; o += 2 * 8 * 128 * 128; p.hgrn_sample = o;
    char* ws = (char*)d_ws; size_t off = 0;
    auto take = [&](size_t bytes) { char* r = ws + off; off += (bytes + 255) & ~(size_t)255; return r; };
    p.bar = (unsigned*)take(16384); p.LB = (float*)take(4096);
    p.WT_IN_EVEN = (bf16_t*)take((size_t)2560 * 1024 * 2); p.WT_OUT_EVEN = (bf16_t*)take((size_t)1024 * 1024 * 2);
    p.WT_IN_ODD = (bf16_t*)take((size_t)4096 * 1024 * 2); p.WT_OUT_ODD = (bf16_t*)take((size_t)1024 * 1024 * 2);
    p.WT_WQ = (bf16_t*)take((size_t)2 * 2048 * 1024 * 2); p.KB = (bf16_t*)take((size_t)2 * 2048 * 128 * 2);
    p.U8 = (unsigned char*)take((size_t)2 * 16384 * DM); p.V8 = (unsigned char*)take((size_t)2 * 16384 * DM); p.SU = (float*)take(2 * 16384 * 4); p.SV = (float*)take(2 * 16384 * 4);
    p.XB = (bf16_t*)take((size_t)MP * DM * 2);
    p.H = (bf16_t*)take((size_t)MP * 4096 * 2); p.LF = (float*)take((size_t)MP * DM * 4);
    p.VT = (bf16_t*)take((size_t)16 * 64 * 8192 * 2); p.KMPP = (float*)take((size_t)512 * 512 * 4); p.KMS = (bf16_t*)take((size_t)1024 * 512 * 2);
    p.MIX = (bf16_t*)take((size_t)MP * DM * 2); p.T = (bf16_t*)take((size_t)MP * DM * 2);
    p.QH = (bf16_t*)take((size_t)MP * 2048 * 2); p.S = (float*)take((size_t)MP * 2048 * 4);
    p.E = (int*)take((size_t)MP * 128 * 4); p.G = (float*)take((size_t)MP * 128 * 4);
    p.UT = (bf16_t*)take((size_t)2048 * 16384 * 2); p.DEC = (float*)take((size_t)2048 * 128 * 4); p.ST = (bf16_t*)take((size_t)2048 * 16384 * 2);
    if (off > ws_size) { fprintf(stderr, "workspace too small: need %zu have %zu\n", off, ws_size); return; }

    static int grid = 0;
    if (!grid) {
        int dev = 0, cus = 0, per_cu = 0;
        (void)hipGetDevice(&dev);
        (void)hipDeviceGetAttribute(&cus, hipDeviceAttributeMultiprocessorCount, dev);
        (void)hipFuncSetAttribute((const void*)mega, hipFuncAttributeMaxDynamicSharedMemorySize, LDS_BYTES);
        (void)hipOccupancyMaxActiveBlocksPerMultiprocessor(&per_cu, (const void*)mega, NT, LDS_BYTES);
        grid = cus * (per_cu < 1 ? per_cu : 1);
        if (grid <= 0) { fprintf(stderr, "mega kernel not resident: cus %d per_cu %d\n", cus, per_cu); grid = 0; return; }
    }
    (void)hipMemsetAsync(p.bar, 0, XCD_BAR_WORDS * sizeof(unsigned), stream);
    hipLaunchKernelGGL(mega, dim3(grid), dim3(NT), LDS_BYTES, stream, p);
}
```

```cpp
#include <hip/hip_runtime.h>
#include <stdint.h>
#include <stdio.h>

#define DI __device__ __forceinline__
__device__ __forceinline__ int tid_opaque() { int t = threadIdx.x; asm volatile("" : "+v"(t)); return t; }
#define TIDX tid_opaque()
typedef unsigned short bf16_t;
typedef short bf16x8 __attribute__((ext_vector_type(8)));
typedef float f32x4 __attribute__((ext_vector_type(4)));
typedef unsigned u32x4 __attribute__((ext_vector_type(4)));
typedef unsigned u32x2 __attribute__((ext_vector_type(2)));
typedef int i32x4 __attribute__((ext_vector_type(4)));
typedef float f32x2 __attribute__((ext_vector_type(2)));

constexpr int NT = 512;
constexpr int TP = 16384, TS = 32, TT = TP + TS, MP = 16640, DM = 1024, SEQ = 8192;
constexpr float DN_ALPHA = 1.4142135623730951f;
constexpr float LN_EPS = 1e-5f, RMS_EPS = 1e-6f;
constexpr size_t OFF_KP = (size_t)TT * DM, OFF_VP = OFF_KP + (size_t)TP * 512, OFF_KS = OFF_VP + (size_t)TP * 512, OFF_VS = OFF_KS + (size_t)TS * 512;

DI float bf2f(bf16_t h) { return __uint_as_float(((unsigned)h) << 16); }
typedef __bf16 bf16x2_t __attribute__((ext_vector_type(2)));
DI unsigned pack_bf2(float lo, float hi) { bf16x2_t v; v[0] = (__bf16)lo; v[1] = (__bf16)hi; return __builtin_bit_cast(unsigned, v); }
DI bf16_t f2bf(float x) { return (bf16_t)(pack_bf2(x, 0.f) & 0xffffu); }
DI float bflo(unsigned u) { return __uint_as_float(u << 16); }
DI float bfhi(unsigned u) { return __uint_as_float(u & 0xffff0000u); }
DI float sigmoidf_(float x) { return 1.f / (1.f + __expf(-x)); }
DI float wave_sum(float v) {
#pragma unroll
    for (int o = 32; o >= 1; o >>= 1) v += __shfl_xor(v, o, 64);
    return v;
}
DI float wave_max(float v) {
#pragma unroll
    for (int o = 32; o >= 1; o >>= 1) v = fmaxf(v, __shfl_xor(v, o, 64));
    return v;
}

DI float red_max_16_32(float x) {
    u32x2 r = __builtin_amdgcn_permlane16_swap(__float_as_uint(x), __float_as_uint(x), false, false);
    x = fmaxf(__uint_as_float(r[0]), __uint_as_float(r[1]));
    r = __builtin_amdgcn_permlane32_swap(__float_as_uint(x), __float_as_uint(x), false, false);
    return fmaxf(__uint_as_float(r[0]), __uint_as_float(r[1]));
}
DI float red_sum_16_32(float x) {
    u32x2 r = __builtin_amdgcn_permlane16_swap(__float_as_uint(x), __float_as_uint(x), false, false);
    x = __uint_as_float(r[0]) + __uint_as_float(r[1]);
    r = __builtin_amdgcn_permlane32_swap(__float_as_uint(x), __float_as_uint(x), false, false);
    return __uint_as_float(r[0]) + __uint_as_float(r[1]);
}
#define MFMA16(a, b, c) __builtin_amdgcn_mfma_f32_16x16x32_bf16((a), (b), (c), 0, 0, 0)

#ifndef REP_PRO
#define REP_PRO 1
#endif
#ifndef REP_GEMM
#define REP_GEMM 1
#endif
#ifndef REP_CONV
#define REP_CONV 1
#endif
#ifndef REP_MOBAP
#define REP_MOBAP 1
#endif
#ifndef REP_MOBAS
#define REP_MOBAS 1
#endif
#ifndef REP_TOPK
#define REP_TOPK 1
#endif
#ifndef REP_PEER1
#define REP_PEER1 1
#endif
#ifndef REP_USW
#define REP_USW 1
#endif
#ifndef REP_VSW
#define REP_VSW 1
#endif
#ifndef REP_HGRN
#define REP_HGRN 1
#endif
#define REPEAT(N) _Pragma("unroll 1") for (int rep_ = 0; rep_ < (N); ++rep_)
struct Params {
    const float* x_prompt; const float* x_sample; const float* cache_k; const float* cache_v;
    const float* state_conv; const float* state_hgrn; const int* page_table;
    const float* w_in_even; const float* conv_w; const float* conv_b; const float* conv_ln_g; const float* conv_ln_b;
    const float* w_out_even; const float* w_in_odd; const float* lb_logits; const float* hgrn_norm_g; const float* w_out_odd;
    const float* ln_g; const float* ln_b; const float* peer_wq; const float* peer_keys; const float* peer_u; const float* peer_v;
    float* y_prompt; float* y_sample; float* k_prompt; float* v_prompt; float* k_sample; float* v_sample;
    float* conv_prompt; float* conv_sample; float* hgrn_prompt; float* hgrn_sample;
    unsigned* bar; float* LB;
    bf16_t* WT_IN_EVEN; bf16_t* WT_OUT_EVEN; bf16_t* WT_IN_ODD; bf16_t* WT_OUT_ODD; bf16_t* WT_WQ; bf16_t* KB;
    unsigned char* U8; unsigned char* V8; float* SU; float* SV;
    bf16_t* XB; bf16_t* H; _Float16* LF; bf16_t* VT; float* KMPP; bf16_t* KMS;
    bf16_t* MIX; bf16_t* T; bf16_t* QH; float* S; int* E; float* G;
    bf16_t* UT; float* DEC; bf16_t* ST;
};


#define XB_TMO      128
#define XB_XCNT(j)  (256  + 64 * (j))
#define XB_XSUB(j)  (1280 + 64 * (j))
#define XB_XGEN(j)  (2304 + 64 * (j))
#define XB_TOP      3328
#define XB_TOPGEN   3392
#define XCD_BAR_WORDS 3456
#define XB_SPIN_CAP (1u << 18)
#define LAS __attribute__((address_space(3)))
__device__ __forceinline__ unsigned xb_ld(unsigned* p)              { return __hip_atomic_load(p, __ATOMIC_RELAXED, __HIP_MEMORY_SCOPE_AGENT); }
__device__ __forceinline__ unsigned xb_add(unsigned* p, unsigned v) { return __hip_atomic_fetch_add(p, v, __ATOMIC_RELAXED, __HIP_MEMORY_SCOPE_AGENT); }
__device__ __forceinline__ unsigned xb_xcc_id() { return (unsigned)__builtin_amdgcn_s_getreg((3 << 11) | 20) & 0xFu; }
#define XB_SPIN(cond, bar) do { unsigned _sp = 0; while (cond) { __builtin_amdgcn_s_sleep(1); \
    if ((++_sp & 255u) == 0u) { if (xb_ld(&(bar)[XB_TMO])) break; if (_sp > XB_SPIN_CAP) { atomicAdd(&(bar)[XB_TMO], 1u); break; } } } } while (0)
struct XcdBarrier { unsigned* bar; unsigned x; volatile LAS unsigned* st; };
__device__ __forceinline__ XcdBarrier xcd_barrier_post(unsigned* bar, volatile LAS unsigned* st) {
    XcdBarrier b; b.bar = bar; b.x = xb_xcc_id(); b.st = st;
    if (threadIdx.x == 0) (void)xb_add(&bar[XB_XCNT(b.x)], 1u);
    return b;
}
__device__ __forceinline__ void xcd_barrier_complete(unsigned* bar, unsigned x, unsigned& nloc, unsigned& nx) {
    const unsigned G = gridDim.x * gridDim.y * gridDim.z;
    unsigned sum, cnt, mine, sp = 0u;
    for (;;) {
        sum = 0u; cnt = 0u; mine = 0u;
#pragma unroll
        for (unsigned j = 0; j < 16; ++j) { const unsigned c = xb_ld(&bar[XB_XCNT(j)]); sum += c; cnt += (c > 0u) ? 1u : 0u; mine = (j == x) ? c : mine; }
        if (sum == G) break;
        __builtin_amdgcn_s_sleep(1);
        if ((++sp & 255u) == 0u) { if (xb_ld(&bar[XB_TMO])) break; if (sp > XB_SPIN_CAP) { atomicAdd(&bar[XB_TMO], 1u); break; } }
    }
    nloc = mine > 0u ? mine : 1u; nx = cnt > 0u ? cnt : 1u;
}
__device__ __forceinline__ void xcd_barrier(const XcdBarrier& b) {
    asm volatile("s_waitcnt vmcnt(0)" ::: "memory");
    __syncthreads();
    if (threadIdx.x == 0) {
        unsigned* bar = b.bar;
        __builtin_amdgcn_s_waitcnt(0);
        unsigned nloc = b.st[0], nx = b.st[1];
        if (nloc == 0u) { xcd_barrier_complete(bar, b.x, nloc, nx); b.st[0] = nloc; b.st[1] = nx; }
        const unsigned old = xb_add(&bar[XB_XSUB(b.x)], 1u);
        const unsigned gen = old / nloc;
        if (old + 1u == (gen + 1u) * nloc) {
            __builtin_amdgcn_fence(__ATOMIC_RELEASE, "agent");
            asm volatile("s_waitcnt vmcnt(0)" ::: "memory");
            const unsigned og = xb_add(&bar[XB_TOP], 1u);
            const unsigned tg = og / nx;
            if (og + 1u == (tg + 1u) * nx) xb_add(&bar[XB_TOPGEN], 1u);
            else XB_SPIN(xb_ld(&bar[XB_TOPGEN]) == tg, bar);
            __builtin_amdgcn_fence(__ATOMIC_ACQUIRE, "agent");
            xb_add(&bar[XB_XGEN(b.x)], 1u);
            asm volatile("s_waitcnt vmcnt(0)" ::: "memory");
        } else {
            XB_SPIN(xb_ld(&bar[XB_XGEN(b.x)]) == gen, bar);
            __builtin_amdgcn_fence(__ATOMIC_ACQUIRE, "agent");
            asm volatile("s_waitcnt vmcnt(0)" ::: "memory");
        }
    }
    __syncthreads();
}

DI void transpose_unit(const float* __restrict__ W, int K, int N, bf16_t* __restrict__ Wt, int u, char* lds) {
    float* tile = (float*)lds;
    const int tid = TIDX;
    const int ntn = N >> 6; const int kt = u / ntn, nt = u % ntn;
#pragma unroll
    for (int i = 0; i < 8; ++i) { int idx = tid + NT * i; int r = idx >> 6, c = idx & 63; tile[r * 65 + c] = W[(size_t)(kt * 64 + r) * N + nt * 64 + c]; }
    __syncthreads();
#pragma unroll
    for (int i = 0; i < 8; ++i) { int idx = tid + NT * i; int r = idx >> 6, c = idx & 63; Wt[(size_t)(nt * 64 + r) * K + kt * 64 + c] = f2bf(tile[c * 65 + r]); }
    __syncthreads();
}
DI void convert_range(const float* __restrict__ src, bf16_t* __restrict__ dst, size_t n4, int bid, int nb) {
    for (size_t i = (size_t)bid * NT + TIDX; i < n4; i += (size_t)nb * NT) {
        f32x4 v = *(const f32x4*)(src + 4 * i);
        u32x2 o; o[0] = pack_bf2(v[0], v[1]); o[1] = pack_bf2(v[2], v[3]);
        *(u32x2*)(dst + 4 * i) = o;
    }
}

template <int OFFS> DI void quant_rows(const float* __restrict__ src, unsigned char* __restrict__ dst, float* __restrict__ inv, int R, int bid, int nb) {
    const int lane = TIDX & 63, w = TIDX >> 6;
#pragma unroll 2
    for (int row = bid * 8 + w; row < R; row += nb * 8) {
        f32x4 v[4]; float am = 0.f;
#pragma unroll
        for (int i = 0; i < 4; ++i) { v[i] = *(const f32x4*)(src + (size_t)row * DM + 4 * lane + 256 * i); am = fmaxf(am, fmaxf(fmaxf(fabsf(v[i][0]), fabsf(v[i][1])), fmaxf(fabsf(v[i][2]), fabsf(v[i][3])))); }
        am = wave_max(am);
        const float sc = am > 0.f ? 127.f / am : 0.f;
#pragma unroll
        for (int i = 0; i < 4; ++i) {
            unsigned pk = 0;
#pragma unroll
            for (int k = 0; k < 4; ++k) { const int q = (int)rintf(v[i][k] * sc) + OFFS; pk |= ((unsigned)q & 0xffu) << (8 * k); }
            const int col = 4 * lane + 256 * i;
            *(unsigned*)(dst + (size_t)(row >> 14) * 16384 * DM + (size_t)(col >> 7) * (16384 * 128) + (size_t)(row & 16383) * 128 + (col & 127)) = pk;
        }
        if (lane == 0) inv[row] = am * (1.f / 127.f);
    }
}
DI void quant_rows_fp8(const float* __restrict__ src, unsigned char* __restrict__ dst, float* __restrict__ inv, int R, int bid, int nb) {
    const int lane = TIDX & 63, w = TIDX >> 6;
#pragma unroll 2
    for (int row = bid * 8 + w; row < R; row += nb * 8) {
        f32x4 v[4]; float am = 0.f;
#pragma unroll
        for (int i = 0; i < 4; ++i) { v[i] = *(const f32x4*)(src + (size_t)row * DM + 4 * lane + 256 * i); am = fmaxf(am, fmaxf(fmaxf(fabsf(v[i][0]), fabsf(v[i][1])), fmaxf(fabsf(v[i][2]), fabsf(v[i][3])))); }
        am = wave_max(am);
        const float sc = am > 0.f ? 416.f / am : 0.f;
#pragma unroll
        for (int i = 0; i < 4; ++i) {
            int pk = 0;
            pk = __builtin_amdgcn_cvt_pk_fp8_f32(v[i][0] * sc, v[i][1] * sc, pk, false);
            pk = __builtin_amdgcn_cvt_pk_fp8_f32(v[i][2] * sc, v[i][3] * sc, pk, true);
            const int col = 4 * lane + 256 * i;
            *(int*)(dst + (size_t)(row >> 14) * 16384 * DM + (size_t)(col >> 7) * (16384 * 128) + (size_t)(row & 16383) * 128 + (col & 127)) = pk;
        }
        if (lane == 0) inv[row] = am * (1.f / 416.f);
    }
}
DI void convert_x(const Params& p, int bid, int nb) {
    const size_t n4 = (size_t)MP * DM / 4;
    for (size_t i = (size_t)bid * NT + TIDX; i < n4; i += (size_t)nb * NT) {
        size_t e = 4 * i; int row = (int)(e >> 10); int col = (int)(e & 1023);
        f32x4 v = {0.f, 0.f, 0.f, 0.f};
        if (row < TP) v = *(const f32x4*)(p.x_prompt + e);
        else if (row < TT) v = *(const f32x4*)(p.x_sample + (size_t)(row - TP) * DM + col);
        u32x2 o; o[0] = pack_bf2(v[0], v[1]); o[1] = pack_bf2(v[2], v[3]);
        *(u32x2*)(p.XB + e) = o;
    }
}
DI void convert_keys(const Params& p, int bid, int nb) {
    const int n = 2 * 2 * 8 * 128 * 128;
    for (int i = bid * NT + TIDX; i < n; i += nb * NT) {
        int d = i & 127, nn = (i >> 7) & 127, j = (i >> 14) & 15, l = i >> 18;
        int h = j >> 1, half = j & 1;
        p.KB[i] = f2bf(p.peer_keys[((((size_t)l * 2 + half) * 8 + h) * 128 + nn) * 128 + d]);
    }
    if (bid == 0) for (int c = TIDX; c < 1024; c += NT) p.LB[c] = sigmoidf_(p.lb_logits[1024 + c] - p.lb_logits[c]);
}
DI void kmean_sample_unit(const Params& p, int u, char* lds) {
    float* part = (float*)lds;
    const int tid = TIDX, c4 = tid & 127, rg = tid >> 7;
    const int b = u >> 5, blk = u & 31;
    f32x4 acc = {0.f, 0.f, 0.f, 0.f};
    const int page = p.page_table[b * 64 + blk * 2 + (rg >> 1)];
    const float* src = p.cache_k + ((size_t)page * 128 + (rg & 1) * 64) * 512 + 4 * c4;
#pragma unroll 1
    for (int r0 = 0; r0 < 64; r0 += 8) {
        f32x4 v[8];
#pragma unroll
        for (int i = 0; i < 8; ++i) v[i] = *(const f32x4*)(src + (size_t)(r0 + i) * 512);
#pragma unroll
        for (int i = 0; i < 8; ++i) acc += v[i];
    }
    __syncthreads();
    *(f32x4*)(part + rg * 512 + 4 * c4) = acc;
    __syncthreads();
    { const int c = tid; const float sum = part[c] + part[512 + c] + part[1024 + c] + part[1536 + c]; p.KMS[(size_t)u * 512 + c] = f2bf(sum * (1.f / 256.f)); }
}
DI void kmean_prompt_unit(const Params& p, int u) {
    const int c = TIDX;
    const float* src = p.k_prompt + (size_t)u * 32 * 512 + c;
    float acc = 0.f;
#pragma unroll
    for (int r = 0; r < 32; ++r) acc += src[(size_t)r * 512];
    p.KMPP[(size_t)u * 512 + c] = acc;
}

struct GemmArgs { const bf16_t* A; int lda; const bf16_t* Bt; int ldb; int K; int blockdiag; };
constexpr int GEMM_LDS = 2 * 49152;

template <class Epi>
DI void gemm_unit(const GemmArgs g, int m0, int n0, const Epi epi, char* lds) {
    const int tid = TIDX, lane = tid & 63, w = tid >> 6;
    const int wm = w & 3, wn = w >> 2, lr = lane & 15, lg = lane >> 4;
    const int acol = g.blockdiag ? n0 : 0;
    const int nk = g.K >> 6;
    f32x4 acc[4][4];
#pragma unroll
    for (int i = 0; i < 4; ++i)
#pragma unroll
        for (int j = 0; j < 4; ++j) acc[i][j] = (f32x4){0.f, 0.f, 0.f, 0.f};
    u32x4 ra[4], rb[2];
    auto gload = [&](int kt) {
#pragma unroll
        for (int i = 0; i < 4; ++i) { int id = tid + NT * i; int r = id >> 3, c = id & 7; ra[i] = *(const u32x4*)(g.A + (size_t)(m0 + r) * g.lda + acol + kt * 64 + c * 8); }
#pragma unroll
        for (int i = 0; i < 2; ++i) { int id = tid + NT * i; int r = id >> 3, c = id & 7; rb[i] = *(const u32x4*)(g.Bt + (size_t)(n0 + r) * g.ldb + kt * 64 + c * 8); }
    };
    auto sstore = [&](int st) {
        char* base = lds + st * 49152;
#pragma unroll
        for (int i = 0; i < 4; ++i) { int id = tid + NT * i; int r = id >> 3, c = id & 7; *(u32x4*)(base + r * 128 + ((c ^ (r & 7)) << 4)) = ra[i]; }
#pragma unroll
        for (int i = 0; i < 2; ++i) { int id = tid + NT * i; int r = id >> 3, c = id & 7; *(u32x4*)(base + 32768 + r * 128 + ((c ^ (r & 7)) << 4)) = rb[i]; }
    };
    gload(0); sstore(0); __syncthreads();
    for (int kt = 0; kt < nk; ++kt) {
        if (kt + 1 < nk) gload(kt + 1);
        const char* base = lds + (kt & 1) * 49152;
#pragma unroll
        for (int ks = 0; ks < 2; ++ks) {
            bf16x8 af[4], bfr[4];
#pragma unroll
            for (int i = 0; i < 4; ++i) { int r = wm * 64 + i * 16 + lr; int ch = ks * 4 + lg; af[i] = *(const bf16x8*)(base + r * 128 + ((ch ^ (r & 7)) << 4)); }
#pragma unroll
            for (int i = 0; i < 4; ++i) { int r = wn * 64 + i * 16 + lr; int ch = ks * 4 + lg; bfr[i] = *(const bf16x8*)(base + 32768 + r * 128 + ((ch ^ (r & 7)) << 4)); }
#pragma unroll
            for (int i = 0; i < 4; ++i)
#pragma unroll
                for (int j = 0; j < 4; ++j) acc[i][j] = MFMA16(bfr[j], af[i], acc[i][j]);
        }
        if (kt + 1 < nk) sstore((kt + 1) & 1);
        __syncthreads();
    }
#pragma unroll
    for (int i = 0; i < 4; ++i)
#pragma unroll
        for (int j = 0; j < 4; ++j) epi(m0 + wm * 64 + i * 16 + lr, n0 + wn * 64 + j * 16 + 4 * lg, acc[i][j]);
}

template <class Epi>
DI void gemm_phase(const GemmArgs g, int M, int N, const Epi epi, char* lds, int bid, int nb) {
    const int tn = N >> 7, tm = M >> 8;
    for (int u = bid; u < tm * tn; u += nb) { int mt = u / tn, nt = u % tn; gemm_unit(g, mt * 256, nt * 128, epi, lds); }
}

DI f32x4 ld_bf4(const bf16_t* src) { const u32x2 w = *(const u32x2*)src; return (f32x4){bflo(w[0]), bfhi(w[0]), bflo(w[1]), bfhi(w[1])}; }
DI void store_bf4(bf16_t* dst, f32x4 v) { u32x2 o; o[0] = pack_bf2(v[0], v[1]); o[1] = pack_bf2(v[2], v[3]); *(u32x2*)dst = o; }

struct EpiInEven {
    bf16_t* H; float* out; bf16_t* VT;
    DI void operator()(int row, int col, f32x4 v) const {
        store_bf4(H + (size_t)row * 2560 + col, v);
        if (col >= 512 && col < 1536 && row < TT) {
            const bool isv = col >= 1024; const int c = col - (isv ? 1024 : 512);
            const size_t off = row < TP ? (isv ? OFF_VP : OFF_KP) + (size_t)row * 512 + c : (isv ? OFF_VS : OFF_KS) + (size_t)(row - TP) * 512 + c;
            *(f32x4*)(out + off) = v;
            if (isv && row < TP) {
                const int b = row >> 13, s = row & 8191, h = c >> 6, d = c & 63;
                bf16_t* vt = VT + ((size_t)(b * 8 + h) * 64 + d) * 8192 + s;
#pragma unroll
                for (int i = 0; i < 4; ++i) vt[(size_t)i * 8192] = f2bf(v[i]);
            }
        }
    }
};
struct EpiBf16 { bf16_t* O; int ld; DI void operator()(int row, int col, f32x4 v) const { store_bf4(O + (size_t)row * ld + col, v); } };
struct EpiF32 { float* O; int ld; DI void operator()(int row, int col, f32x4 v) const { *(f32x4*)(O + (size_t)row * ld + col) = v; } };
struct EpiResid {
    bf16_t* T; const bf16_t* XB;
    DI void operator()(int row, int col, f32x4 v) const { const f32x4 x = ld_bf4(XB + (size_t)row * DM + col); store_bf4(T + (size_t)row * DM + col, x * DN_ALPHA + v); }
};
struct EpiInOdd {
    bf16_t* H; _Float16* LF; const float* LB;
    DI void operator()(int row, int col, f32x4 v) const {
        const int sec = col >> 10, c = col & 1023;
        if (sec == 1) {
            f32x4 lb = *(const f32x4*)(LB + c); f32x4 lf, kk;
#pragma unroll
            for (int i = 0; i < 4; ++i) { float f = lb[i] + (1.f - lb[i]) * sigmoidf_(v[i]); lf[i] = __logf(f); kk[i] = 1.f - f; }
            { typedef _Float16 h4 __attribute__((ext_vector_type(4))); h4 hv; hv[0] = (_Float16)lf[0]; hv[1] = (_Float16)lf[1]; hv[2] = (_Float16)lf[2]; hv[3] = (_Float16)lf[3]; *(h4*)(LF + (size_t)row * DM + c) = hv; }
            store_bf4(H + (size_t)MP * DM + (size_t)row * DM + c, kk);
        } else {
            store_bf4(H + (size_t)sec * MP * DM + (size_t)row * DM + c, v);
        }
    }
};

namespace pg8 {
#define PG8_LAS __attribute__((address_space(3)))
typedef unsigned short bf16_t;
typedef short bf16x8 __attribute__((ext_vector_type(8)));
typedef float f32x4 __attribute__((ext_vector_type(4)));
typedef unsigned u32x4 __attribute__((ext_vector_type(4)));
constexpr int BM = 256, BK = 64, HALF = 128, HTB = HALF * BK * 2  , STAGE_BYTES = 8 * HTB, NXCD = 8, WGM = 8;

__host__ __device__ __forceinline__ int lds_byte(int r, int c) { const int st = (r >> 4) * 2 + (c >> 5), rr = r & 15, cc = c & 31, ob = rr * 64 + cc * 2; return st * 1024 + (ob ^ (((ob >> 9) & 1) << 5)); }
__host__ __device__ __forceinline__ void stage_rc(int b, int& R, int& C) { const int st = b / 1024, sb = b % 1024, swz = sb ^ (((sb >> 9) & 1) << 5); R = (st >> 1) * 16 + swz / 64; C = (st & 1) * 32 + (swz % 64) / 2; }
__host__ __device__ __forceinline__ int perm32(int rho) { const int n = rho >> 4, i = rho & 15; return 8 * (i >> 2) + 4 * n + (i & 3); }

struct Unit { int pm, pn; };
struct Gemm { const bf16_t* A; const bf16_t* Bt; int M, N, K; };

struct StaticOrder {
    int nM, nN, nwg, G, c;
    __host__ __device__ void init(int M, int N, int G_, int c_) { nM = M / BM; nN = N / BM; nwg = nM * nN; G = G_; c = c_; }
    __host__ __device__ bool next(int i, Unit& u) const {
        const long L = (long)i * G + c; if (L >= nwg) return false;
        int wgid = (int)L; { const int q = nwg / NXCD, r = nwg % NXCD, xcd = wgid % NXCD, off = wgid / NXCD; wgid = (xcd < r ? xcd * (q + 1) : r * (q + 1) + (xcd - r) * q) + off; }
        const int nig = WGM * nN, gid = wgid / nig, fm = gid * WGM, gsz = (nM - fm) < WGM ? (nM - fm) : WGM;
        u.pm = fm + ((wgid % nig) % gsz); u.pn = (wgid % nig) / gsz; return true;
    }
    __device__ __forceinline__ void a_ready(const Unit&) const {}
    __device__ __forceinline__ void done(const Unit&) const {}
};

template <class Epi, class Sched, bool STAMP = false>
__device__ __forceinline__ void gemm_phase(PG8_LAS unsigned char* lds, const Gemm g, const Sched& S, const Epi& E, unsigned long long* stamps) {
    const int tid = TIDX, wid = __builtin_amdgcn_readfirstlane(tid >> 6), lane = tid & 63, wr = wid >> 2, wc = wid & 3, fr = lane & 15, fq = lane >> 4;
    const int K = g.K, nt = K / BK;
    int ts_lo = 0, ts_hi = 0, nts = 0; const unsigned long long rt_entry = STAMP ? (unsigned long long)wall_clock64() : 0ull;
#define PG8_STAMP() do { if (STAMP && wid == 0 && nts < 64) { const unsigned long long _c = (unsigned long long)clock64(); \
        ts_lo = (lane == nts) ? (int)(unsigned)_c : ts_lo; ts_hi = (lane == nts) ? (int)(unsigned)(_c >> 32) : ts_hi; ++nts; } } while (0)
    PG8_STAMP();
    unsigned voffA[2], voffB[2];
#pragma unroll
    for (int i = 0; i < 2; ++i) { int R, C; stage_rc(tid * 16 + i * 8192, R, C); const int Rb = Epi::PERM ? ((R & ~31) + perm32(R & 31)) : R;
        voffA[i] = (unsigned)(R * K + C) * 2u; voffB[i] = (unsigned)(Rb * K + C) * 2u; }
    const size_t kstep = (size_t)(BK * 2);
    const size_t hstep = (size_t)HALF * K * 2;
    const size_t tstep = 2 * hstep;
    const unsigned ldsw = (unsigned)wid * 1024u;
    const int aoff = lds_byte(wr * 64 + fr, fq * 8), boff = lds_byte(wc * 32 + fr, fq * 8);
#define PG8_SA(b, h) (((b) * 2 + (h)) * HTB)
#define PG8_SB(b, h) ((4 + (b) * 2 + (h)) * HTB)
#define PG8_STAGE(bufoff, gbase, voff) do { _Pragma("unroll") for (int _i = 0; _i < 2; ++_i) \
        __builtin_amdgcn_global_load_lds((const unsigned*)((const char*)(gbase) + (voff)[_i]), (PG8_LAS unsigned*)(lds + (bufoff) + ldsw + _i * 8192), 16, 0, 0); } while (0)
#define PG8_LDA(dst, b, h) do { _Pragma("unroll") for (int m = 0; m < 4; ++m) _Pragma("unroll") for (int k = 0; k < 2; ++k) dst[m][k] = *(const PG8_LAS bf16x8*)(lds + PG8_SA(b, h) + aoff + m * 2048 + k * 1024); } while (0)
#define PG8_LDB(dst, b, h) do { _Pragma("unroll") for (int n = 0; n < 2; ++n) _Pragma("unroll") for (int k = 0; k < 2; ++k) dst[n][k] = *(const PG8_LAS bf16x8*)(lds + PG8_SB(b, h) + boff + n * 2048 + k * 1024); } while (0)
#define PG8_MMA(ai, bj, At, Bt) do { __builtin_amdgcn_s_setprio(1); _Pragma("unroll") for (int m = 0; m < 4; ++m) _Pragma("unroll") for (int n = 0; n < 2; ++n) _Pragma("unroll") for (int k = 0; k < 2; ++k) \
        acc[ai][bj][m][n] = __builtin_amdgcn_mfma_f32_16x16x32_bf16(Bt[n][k], At[m][k], acc[ai][bj][m][n], 0, 0, 0); __builtin_amdgcn_s_setprio(0); } while (0)
#define PG8_WAIT_V(n) asm volatile("s_waitcnt vmcnt(" #n ")" ::: "memory")
#define PG8_WAIT_L(n) asm volatile("s_waitcnt lgkmcnt(" #n ")" ::: "memory")
#define PG8_BAR __builtin_amdgcn_s_barrier()
#define PG8_SCHED __builtin_amdgcn_sched_barrier(0)
    Unit cur, nxt; int ui = 0;
    if (!S.next(0, cur)) return;
    f32x4 acc[2][2][4][2];
#pragma unroll
    for (int a = 0; a < 2; ++a)
#pragma unroll
        for (int b = 0; b < 2; ++b)
#pragma unroll
            for (int m = 0; m < 4; ++m)
#pragma unroll
                for (int n = 0; n < 2; ++n) acc[a][b][m][n] = (f32x4){0.f, 0.f, 0.f, 0.f};
    bf16x8 At[4][2], B0[2][2], B1[2][2];
    const char* cA = (const char*)g.A + (size_t)cur.pm * tstep; const char* cB = (const char*)g.Bt + (size_t)cur.pn * tstep;
    S.a_ready(cur);
    PG8_STAGE(PG8_SB(0, 0), cB, voffB); PG8_STAGE(PG8_SA(0, 0), cA, voffA); PG8_STAGE(PG8_SB(0, 1), cB + hstep, voffB); PG8_STAGE(PG8_SA(0, 1), cA + hstep, voffA);
    if (wr == 1) PG8_BAR;
    PG8_WAIT_V(4); PG8_BAR;
    PG8_STAGE(PG8_SB(1, 0), cB + kstep, voffB); PG8_STAGE(PG8_SA(1, 0), cA + kstep, voffA); PG8_STAGE(PG8_SB(1, 1), cB + hstep + kstep, voffB);
    PG8_WAIT_V(6); PG8_BAR;
    PG8_STAMP();
    for (;;) {
        const bool has_next = S.next(ui + 1, nxt);
        const char* nA = has_next ? (const char*)g.A + (size_t)nxt.pm * tstep : cA; const char* nB = has_next ? (const char*)g.Bt + (size_t)nxt.pn * tstep : cB;
        for (int t = 0; t < nt; t += 2) {
            const bool last = (t == nt - 2);
            const char* a1 = cA + (size_t)(t + 1) * kstep;
            const char* a2 = last ? nA : cA + (size_t)(t + 2) * kstep; const char* b2 = last ? nB : cB + (size_t)(t + 2) * kstep;
            const char* a3 = a2 + kstep; const char* b3 = b2 + kstep;
            if (last && has_next) S.a_ready(nxt);
            PG8_LDB(B0, 0, 0); PG8_SCHED; PG8_LDA(At, 0, 0); PG8_STAGE(PG8_SA(1, 1), a1 + hstep, voffA);
            PG8_WAIT_L(8); PG8_BAR; PG8_WAIT_L(0); PG8_MMA(0, 0, At, B0); PG8_BAR; PG8_SCHED;
            PG8_LDB(B1, 0, 1); PG8_STAGE(PG8_SB(0, 0), b2, voffB);
            PG8_BAR; PG8_WAIT_L(0); PG8_MMA(0, 1, At, B1); PG8_BAR;
            PG8_LDA(At, 0, 1); PG8_STAGE(PG8_SA(0, 0), a2, voffA);
            PG8_BAR; PG8_WAIT_L(0); PG8_MMA(1, 0, At, B0); PG8_BAR; PG8_SCHED;
            PG8_STAGE(PG8_SB(0, 1), b2 + hstep, voffB);
            PG8_WAIT_V(6); PG8_BAR; PG8_MMA(1, 1, At, B1); PG8_BAR;
            PG8_LDB(B0, 1, 0); PG8_SCHED; PG8_LDA(At, 1, 0); PG8_STAGE(PG8_SA(0, 1), a2 + hstep, voffA);
            PG8_WAIT_L(8); PG8_BAR; PG8_WAIT_L(0); PG8_MMA(0, 0, At, B0); PG8_BAR; PG8_SCHED;
            PG8_LDB(B1, 1, 1); PG8_STAGE(PG8_SB(1, 0), b3, voffB);
            PG8_BAR; PG8_WAIT_L(0); PG8_MMA(0, 1, At, B1); PG8_BAR;
            PG8_LDA(At, 1, 1); PG8_STAGE(PG8_SA(1, 0), a3, voffA);
            PG8_BAR; PG8_WAIT_L(0); PG8_MMA(1, 0, At, B0); PG8_BAR; PG8_SCHED;
            PG8_STAGE(PG8_SB(1, 1), b3 + hstep, voffB);
            PG8_WAIT_V(6); PG8_BAR; PG8_MMA(1, 1, At, B1); PG8_BAR;
        }
        PG8_STAMP();
        if constexpr (!Epi::AFTER_DRAIN) { E(acc, cur, wr, wc, fr, fq); S.done(cur); }
        PG8_STAMP();
        if (!has_next) break;
#pragma unroll
        for (int a = 0; a < 2; ++a)
#pragma unroll
            for (int b = 0; b < 2; ++b)
#pragma unroll
                for (int m = 0; m < 4; ++m)
#pragma unroll
                    for (int n = 0; n < 2; ++n) acc[a][b][m][n] = (f32x4){0.f, 0.f, 0.f, 0.f};
        cur = nxt; cA = nA; cB = nB; ++ui;
    }
    PG8_WAIT_V(0);
    if (wr == 0) PG8_BAR;
    PG8_BAR;
    if constexpr (Epi::AFTER_DRAIN) { E.fused(acc, cur, wr, wc, fr, fq, lds, wid, lane); S.done(cur); }
    PG8_STAMP();
    if (STAMP && wid == 0) { stamps[lane] = lane < nts ? (((unsigned long long)(unsigned)ts_hi << 32) | (unsigned)ts_lo) : 0ull;
        if (lane == 62) stamps[62] = rt_entry; if (lane == 63) stamps[63] = (unsigned long long)wall_clock64(); }
#undef PG8_STAMP
#undef PG8_SA
#undef PG8_SB
#undef PG8_STAGE
#undef PG8_LDA
#undef PG8_LDB
#undef PG8_MMA
#undef PG8_WAIT_V
#undef PG8_WAIT_L
#undef PG8_BAR
#undef PG8_SCHED
}
}

template <class MyEpi> struct Pg8Epi {
    static constexpr bool PERM = false, AFTER_DRAIN = false;
    MyEpi e;
    __device__ __forceinline__ void operator()(const pg8::f32x4 (&acc)[2][2][4][2], const pg8::Unit& u, int wr, int wc, int fr, int fq) const {
#pragma unroll
        for (int ai = 0; ai < 2; ++ai)
#pragma unroll
            for (int m = 0; m < 4; ++m) {
                const int row = u.pm * 256 + ai * 128 + wr * 64 + m * 16 + fr;
#pragma unroll
                for (int bj = 0; bj < 2; ++bj)
#pragma unroll
                    for (int n = 0; n < 2; ++n) e(row, u.pn * 256 + bj * 128 + wc * 32 + n * 16 + 4 * fq, acc[ai][bj][m][n]);
            }
    }
};

template <class E> DI void gemm_small32_unit(const bf16_t* A, int lda, const bf16_t* Bt, int ldb, int K, int m0, int n0, const E epi) {
    const int tid = TIDX, lane = tid & 63, w = tid >> 6, lr = lane & 15, lg = lane >> 4;
    const bf16_t* a0 = A + (size_t)(m0 + lr) * lda + lg * 8; const bf16_t* a1 = a0 + (size_t)16 * lda;
    const bf16_t* b0 = Bt + (size_t)(n0 + w * 16 + lr) * ldb + lg * 8;
    f32x4 acc0 = {0.f, 0.f, 0.f, 0.f}, acc1 = {0.f, 0.f, 0.f, 0.f};
#pragma unroll 2
    for (int k0 = 0; k0 < K; k0 += 128) {
        bf16x8 fa0[4], fa1[4], fb[4];
#pragma unroll
        for (int i = 0; i < 4; ++i) { fa0[i] = *(const bf16x8*)(a0 + k0 + i * 32); fa1[i] = *(const bf16x8*)(a1 + k0 + i * 32); fb[i] = *(const bf16x8*)(b0 + k0 + i * 32); }
#pragma unroll
        for (int i = 0; i < 4; ++i) { acc0 = MFMA16(fb[i], fa0[i], acc0); acc1 = MFMA16(fb[i], fa1[i], acc1); }
    }
    epi(m0 + lr, n0 + w * 16 + 4 * lg, acc0);
    epi(m0 + 16 + lr, n0 + w * 16 + 4 * lg, acc1);
}
template <class E> DI void gemm_big(const bf16_t* A, const bf16_t* Bt, int N, const E epi, char* lds, int bid, int nb) {
    {
        pg8::Gemm g{A, Bt, TP, N, DM};
        pg8::StaticOrder S; S.init(TP, N, nb, bid);
        Pg8Epi<E> pe{epi};
        pg8::gemm_phase<Pg8Epi<E>, pg8::StaticOrder, false>((PG8_LAS unsigned char*)lds, g, S, pe, nullptr);
    }
    __syncthreads();
    for (int u = nb - 1 - bid; u < (N >> 7); u += nb) gemm_small32_unit(A, DM, Bt, DM, DM, TP, u * 128, epi);
}

DI void conv_unit(const Params& p, int u, char* lds) {
    float* sy = (float*)lds;
    const int c = TIDX, lane = c & 63, w = c >> 6;
    float wj[31];
#pragma unroll
    for (int j = 0; j < 31; ++j) wj[j] = p.conv_w[j * 512 + c];
    const float bias = p.conv_b[c];
    int ntok, row0;
    if (u < 512) {
        const int b = u >> 8, t0 = (u & 255) * 32; ntok = 32; row0 = b * SEQ + t0;
        float uu[62];
#pragma unroll
        for (int r = 0; r < 62; ++r) {
            const int t = t0 - 30 + r; float val = 0.f;
            if (t >= 0) { const size_t row = (size_t)b * SEQ + t; float a = bf2f(p.H[row * 2560 + 1536 + c]); float g = bf2f(p.H[row * 2560 + 2048 + c]); val = a * sigmoidf_(g); }
            uu[r] = val;
            if (t0 == SEQ - 32 && r >= 32) p.conv_prompt[((size_t)b * 30 + (r - 32)) * 512 + c] = val;
        }
#pragma unroll
        for (int tt = 0; tt < 32; ++tt) {
            float acc = bias;
#pragma unroll
            for (int j = 0; j < 31; ++j) acc += wj[j] * uu[tt + j];
            sy[tt * 512 + c] = acc;
        }
    } else {
        const int b = u - 512; ntok = 1; row0 = TP + b;
        const size_t row = (size_t)row0;
        float a = bf2f(p.H[row * 2560 + 1536 + c]); float g = bf2f(p.H[row * 2560 + 2048 + c]);
        const float un = a * sigmoidf_(g);
        float acc = bias + wj[30] * un;
#pragma unroll
        for (int j = 0; j < 30; ++j) {
            float e = p.state_conv[((size_t)b * 30 + j) * 512 + c]; acc += wj[j] * e;
            if (j >= 1) p.conv_sample[((size_t)b * 30 + (j - 1)) * 512 + c] = e;
        }
        p.conv_sample[((size_t)b * 30 + 29) * 512 + c] = un;
        sy[c] = acc;
    }
    __syncthreads();
    for (int tt = w; tt < ntok; tt += 8) {
        float v[8]; float s = 0.f;
#pragma unroll
        for (int i = 0; i < 8; ++i) { v[i] = sy[tt * 512 + lane + 64 * i]; s += v[i]; }
        const float mu = wave_sum(s) * (1.f / 512.f);
        float q = 0.f;
#pragma unroll
        for (int i = 0; i < 8; ++i) { float d = v[i] - mu; q += d * d; }
        const float rs = rsqrtf(wave_sum(q) * (1.f / 512.f) + LN_EPS);
#pragma unroll
        for (int i = 0; i < 8; ++i) {
            const int cc = lane + 64 * i;
            float y = (v[i] - mu) * rs * p.conv_ln_g[cc] + p.conv_ln_b[cc];
            y = y * sigmoidf_(y);
            p.MIX[(size_t)(row0 + tt) * DM + 512 + cc] = f2bf(y);
        }
    }
    __syncthreads();
}

constexpr int MB_K = 0, MB_V = 65536, MB_VROW = 528, MB_WOR = 65536 + 2 * 64 * MB_VROW;
constexpr int MB_BGS = MB_WOR + 128, MB_KMS = MB_BGS + 2 * 8192, MB_END = MB_KMS + 8192;
DI void moba_sample_unit(const Params& p, int u, char* lds) {
    float* sq = (float*)lds;
    float* gs = sq + 64;
    int* sel = (int*)(gs + 32);
    float* lg = (float*)(sel + 4);
    float* red = lg + 776;
    unsigned* roff = (unsigned*)(red + 16);
    float* part = (float*)(roff + 776);
    const int tid = TIDX, lane = tid & 63, w = tid >> 6;
    const int b = u >> 3, h = u & 7; const size_t row = (size_t)TP + b;
    __syncthreads();
    if (tid < 64) sq[tid] = bf2f(p.H[row * 2560 + h * 64 + tid]);
    __syncthreads();
    if (tid < 32) { const float* km = (const float*)(lds + MB_KMS) + tid * 64; float s = 0.f;
#pragma unroll 8
        for (int d = 0; d < 64; ++d) s += sq[d] * km[d];
        gs[tid] = s; }
    __syncthreads();
    if (tid == 0) {
        float v0 = -INFINITY, v1 = -INFINITY, v2 = -INFINITY; int i0 = 0, i1 = 0, i2 = 0;
        for (int j = 0; j < 32; ++j) { float s = gs[j];
            if (s > v0) { v2 = v1; i2 = i1; v1 = v0; i1 = i0; v0 = s; i0 = j; }
            else if (s > v1) { v2 = v1; i2 = i1; v1 = s; i1 = j; }
            else if (s > v2) { v2 = s; i2 = j; } }
        sel[0] = i0; sel[1] = i1; sel[2] = i2;
    }
    __syncthreads();
    for (int idx = tid; idx < 769; idx += NT) {
        float s = 0.f;
        if (idx < 768) {
            const int blk = sel[idx >> 8]; const int pos = blk * 256 + (idx & 255);
            const int page = p.page_table[b * 64 + (pos >> 7)];
            const unsigned ro = ((unsigned)page * 128u + (unsigned)(pos & 127)) * 8u + (unsigned)h;
            roff[idx] = ro;
            const float* kp = p.cache_k + (size_t)ro * 64;
            f32x4 kv[16];
#pragma unroll
            for (int d4 = 0; d4 < 16; ++d4) kv[d4] = *(const f32x4*)(kp + 4 * d4);
#pragma unroll
            for (int d4 = 0; d4 < 16; ++d4) s += sq[4 * d4] * kv[d4][0] + sq[4 * d4 + 1] * kv[d4][1] + sq[4 * d4 + 2] * kv[d4][2] + sq[4 * d4 + 3] * kv[d4][3];
        } else {
            const bf16_t* kn = p.H + row * 2560 + 512 + h * 64;
            for (int d = 0; d < 64; ++d) s += sq[d] * bf2f(kn[d]);
        }
        lg[idx] = s * 0.125f;
    }
    __syncthreads();
    float mx = -INFINITY;
    for (int idx = tid; idx < 769; idx += NT) mx = fmaxf(mx, lg[idx]);
    mx = wave_max(mx); if (lane == 0) red[w] = mx;
    __syncthreads();
    mx = red[0];
#pragma unroll
    for (int i = 1; i < 8; ++i) mx = fmaxf(mx, red[i]);
    float sm = 0.f;
    for (int idx = tid; idx < 769; idx += NT) { float e = __expf(lg[idx] - mx); lg[idx] = e; sm += e; }
    sm = wave_sum(sm); if (lane == 0) red[8 + w] = sm;
    __syncthreads();
    sm = 0.f;
#pragma unroll
    for (int i = 0; i < 8; ++i) sm += red[8 + i];
    {
        const int d4 = tid & 15, kg = tid >> 4;
        f32x4 acc = {0.f, 0.f, 0.f, 0.f};
#pragma unroll
        for (int i0 = 0; i0 < 24; i0 += 8) {
            f32x4 vv[8]; float pp[8];
#pragma unroll
            for (int i = 0; i < 8; ++i) { const int idx = kg + 32 * (i0 + i); pp[i] = lg[idx]; vv[i] = *(const f32x4*)(p.cache_v + (size_t)roff[idx] * 64 + 4 * d4); }
#pragma unroll
            for (int i = 0; i < 8; ++i) acc += vv[i] * pp[i];
        }
        if (kg == 0) {
            const bf16_t* vn = p.H + row * 2560 + 1024 + h * 64 + 4 * d4; const float pn = lg[768];
            acc[0] += pn * bf2f(vn[0]); acc[1] += pn * bf2f(vn[1]); acc[2] += pn * bf2f(vn[2]); acc[3] += pn * bf2f(vn[3]);
        }
        *(f32x4*)(part + kg * 64 + 4 * d4) = acc;
    }
    __syncthreads();
    if (tid < 64) { float a = 0.f;
#pragma unroll
        for (int i = 0; i < 32; ++i) a += part[i * 64 + tid];
        p.MIX[row * DM + h * 64 + tid] = f2bf(a / sm); }
}

DI void bg_kmean_fore(const Params& p, int bid, int k, char* lds) {
    const int tid = TIDX, rg = tid >> 4, d4 = tid & 15, bs = bid >> 3, hs = bid & 7;
    const int page = p.page_table[bs * 64 + 2 * k + (rg >> 4)];
    const float* base = p.cache_k + (((size_t)page * 128 + (rg & 15) * 8) * 8 + hs) * 64 + 4 * d4;
    f32x4 acc = {0.f, 0.f, 0.f, 0.f};
#pragma unroll
    for (int i = 0; i < 8; ++i) acc += *(const f32x4*)(base + (size_t)i * 512);
    __syncthreads();
    *(f32x4*)(lds + MB_BGS + (rg * 64 + d4 * 4) * 4) = acc;
    __syncthreads();
    if (tid < 64) { float sm = 0.f;
#pragma unroll 8
        for (int r = 0; r < 32; ++r) sm += *(const float*)(lds + MB_BGS + (r * 64 + tid) * 4);
        *(float*)(lds + MB_KMS + (k * 64 + tid) * 4) = sm * (1.f / 256.f); }
    __syncthreads();
}
DI void moba_prompt_unit(const Params& p, int bh, int own, char* lds, int bid, int& bgk) {
    const int tid = TIDX, lane = tid & 63, w = tid >> 6, lr = lane & 15, lg = lane >> 4;
    const int b = bh >> 3, h = bh & 7;
    float* gsc = (float*)lds + w * 1024;
    unsigned* msk = (unsigned*)(lds + 32768) + w * 36;
    unsigned* worl = (unsigned*)(lds + MB_WOR);
    const int wv = __builtin_amdgcn_readfirstlane(w);
    const size_t rowq0 = (size_t)b * SEQ + own * 256 + w * 32;
    __syncthreads();
    bf16x8 qf[2][2];
#pragma unroll
    for (int qt = 0; qt < 2; ++qt)
#pragma unroll
        for (int ks = 0; ks < 2; ++ks) qf[qt][ks] = *(const bf16x8*)(p.H + (rowq0 + qt * 16 + lr) * 2560 + h * 64 + ks * 32 + lg * 8);
    unsigned mq[2]; unsigned wor;
    if (own > 3) {
        bf16_t* kml = (bf16_t*)(lds + 36864);
        {
            const int j = tid >> 4, d4 = tid & 15;
            f32x4 a = {0.f, 0.f, 0.f, 0.f};
#pragma unroll
            for (int part = 0; part < 8; ++part) a += *(const f32x4*)(p.KMPP + (((size_t)b * 32 + j) * 8 + part) * 512 + h * 64 + 4 * d4);
            store_bf4(kml + j * 64 + 4 * d4, a * (1.f / 256.f));
        }
        __syncthreads();
#pragma unroll
        for (int jt = 0; jt < 2; ++jt) {
            bf16x8 kf[2];
#pragma unroll
            for (int ks = 0; ks < 2; ++ks) kf[ks] = *(const bf16x8*)(kml + (jt * 16 + lr) * 64 + ks * 32 + lg * 8);
#pragma unroll
            for (int qt = 0; qt < 2; ++qt) {
                f32x4 a = {0.f, 0.f, 0.f, 0.f};
                a = MFMA16(kf[0], qf[qt][0], a); a = MFMA16(kf[1], qf[qt][1], a);
#pragma unroll
                for (int r = 0; r < 4; ++r) gsc[(qt * 16 + lr) * 32 + jt * 16 + 4 * lg + r] = a[r];
            }
        }
        __builtin_amdgcn_s_waitcnt(0);
        __builtin_amdgcn_wave_barrier();
        unsigned m = 0;
        if (lane < 32) {
            float v0 = -INFINITY, v1 = -INFINITY, v2 = -INFINITY; int i0 = 0, i1 = 0, i2 = 0;
            for (int j = 0; j < own; ++j) { float sc = gsc[lane * 32 + j];
                if (sc > v0) { v2 = v1; i2 = i1; v1 = v0; i1 = i0; v0 = sc; i0 = j; }
                else if (sc > v1) { v2 = v1; i2 = i1; v1 = sc; i1 = j; }
                else if (sc > v2) { v2 = sc; i2 = j; } }
            m = (1u << i0) | (1u << i1) | (1u << i2);
            msk[lane] = m;
        }
        unsigned o = m;
#pragma unroll
        for (int sft = 32; sft >= 1; sft >>= 1) o |= (unsigned)__shfl_xor((int)o, sft, 64);
        wor = o;
        __builtin_amdgcn_s_waitcnt(0);
        __builtin_amdgcn_wave_barrier();
        mq[0] = msk[lr]; mq[1] = msk[16 + lr];
    } else {
        const unsigned m = (own >= 1) ? ((1u << own) - 1u) : 0u;
        mq[0] = m; mq[1] = m; wor = m;
    }
    wor = (unsigned)__builtin_amdgcn_readfirstlane((int)wor);
    if (lane == 0) worl[w] = wor;
    __syncthreads();
    unsigned bor = 0;
#pragma unroll
    for (int i = 0; i < 8; ++i) bor |= worl[i];
    bor = (unsigned)__builtin_amdgcn_readfirstlane((int)bor);

    const bf16_t* Kbase = p.H + (size_t)b * SEQ * 2560 + 512 + h * 64;
    const bf16_t* Vbase = p.VT + (size_t)(b * 8 + h) * 64 * 8192;
    u32x4 rk[4], rv[4];
    auto gload = [&](int jb) {
#pragma unroll
        for (int i = 0; i < 4; ++i) { const int id = tid + NT * i; const int r = id >> 3, c = id & 7; rk[i] = *(const u32x4*)(Kbase + (size_t)(jb * 256 + r) * 2560 + c * 8); }
#pragma unroll
        for (int i = 0; i < 4; ++i) { const int id = tid + NT * i; const int d = id >> 5, c = id & 31; rv[i] = *(const u32x4*)(Vbase + (size_t)d * 8192 + jb * 256 + c * 8); }
    };
    auto sstore = [&](int buf) {
#pragma unroll
        for (int i = 0; i < 4; ++i) { const int id = tid + NT * i; const int r = id >> 3, c = id & 7; *(u32x4*)(lds + MB_K + buf * 32768 + r * 128 + ((c ^ (r & 7)) << 4)) = rk[i]; }
#pragma unroll
        for (int i = 0; i < 4; ++i) { const int id = tid + NT * i; const int d = id >> 5, c = id & 31; *(u32x4*)(lds + MB_V + buf * (64 * MB_VROW) + d * MB_VROW + c * 16) = rv[i]; }
    };
    const float SC = 0.125f * 1.4426950408889634f;
    float mrow[2] = {-INFINITY, -INFINITY}, lrow[2] = {0.f, 0.f};
    f32x4 oacc[2][4];
#pragma unroll
    for (int qt = 0; qt < 2; ++qt)
#pragma unroll
        for (int dt = 0; dt < 4; ++dt) oacc[qt][dt] = (f32x4){0.f, 0.f, 0.f, 0.f};
    const int bg_rg = tid >> 4, bg_d4 = tid & 15, bg_bs = bid >> 3, bg_hs = bid & 7;
    int bg_page = (bgk < 32) ? p.page_table[bg_bs * 64 + 2 * bgk + (bg_rg >> 4)] : 0;
    int cur = own, buf = 0;
    gload(cur); sstore(0); __syncthreads();
    int nxt_scan = 0;
    while (cur >= 0) {
        int nxt = -1;
        while (nxt_scan < own) { const int j = nxt_scan++; if ((bor >> j) & 1u) { nxt = j; break; } }
        if (nxt >= 0) gload(nxt);
        const bool bg_on = bgk < 32;
        const float* bg_base = p.cache_k + (((size_t)bg_page * 128 + (bg_rg & 15) * 8) * 8 + bg_hs) * 64 + 4 * bg_d4;
        f32x4 bg_acc = {0.f, 0.f, 0.f, 0.f}, bg_pend = {0.f, 0.f, 0.f, 0.f}; int bg_i = 0;
        const bool isown = (cur == own);
        if (isown || ((wor >> cur) & 1u)) {
            const char* KB = lds + MB_K + buf * 32768; const char* VB = lds + MB_V + buf * (64 * MB_VROW);
            const int nst = isown ? (wv + 1) : 8;
            const bool sel0 = isown || ((mq[0] >> cur) & 1u), sel1 = isown || ((mq[1] >> cur) & 1u);
            for (int st = 0; st < nst; ++st) {
                if (bg_on && bg_i < 8) { bg_acc += bg_pend; bg_pend = *(const f32x4*)(bg_base + (size_t)bg_i * 512); ++bg_i; }
                bf16x8 kf[2][2];
#pragma unroll
                for (int kt = 0; kt < 2; ++kt)
#pragma unroll
                    for (int ks = 0; ks < 2; ++ks) { const int r = st * 32 + kt * 16 + lr, ch = ks * 4 + lg; kf[kt][ks] = *(const bf16x8*)(KB + r * 128 + ((ch ^ (r & 7)) << 4)); }
                bf16x8 pf[2]; float alph[2];
#pragma unroll
                for (int qt = 0; qt < 2; ++qt) {
                    f32x4 sv[2];
#pragma unroll
                    for (int kt = 0; kt < 2; ++kt) { f32x4 a = {0.f, 0.f, 0.f, 0.f}; a = MFMA16(kf[kt][0], qf[qt][0], a); a = MFMA16(kf[kt][1], qf[qt][1], a); sv[kt] = a; }
                    const bool selq = qt ? sel1 : sel0;
                    if (isown) {
                        const int qin = wv * 32 + qt * 16 + lr;
#pragma unroll
                        for (int kt = 0; kt < 2; ++kt)
#pragma unroll
                            for (int r = 0; r < 4; ++r) { const int kin = st * 32 + kt * 16 + 4 * lg + r; sv[kt][r] = (kin <= qin) ? sv[kt][r] : -INFINITY; }
                    }
                    float mx = fmaxf(fmaxf(fmaxf(sv[0][0], sv[0][1]), fmaxf(sv[0][2], sv[0][3])), fmaxf(fmaxf(sv[1][0], sv[1][1]), fmaxf(sv[1][2], sv[1][3]))) * SC;
                    mx = red_max_16_32(mx);
                    mx = selq ? mx : -INFINITY;
                    const float mnew = fmaxf(mrow[qt], mx);
                    alph[qt] = __builtin_amdgcn_exp2f(mrow[qt] - mnew);
                    const float mneg = selq ? -mnew : -INFINITY;
                    float ps = 0.f;
#pragma unroll
                    for (int kt = 0; kt < 2; ++kt)
#pragma unroll
                        for (int r = 0; r < 4; ++r) { const float e = __builtin_amdgcn_exp2f(__builtin_fmaf(sv[kt][r], SC, mneg)); sv[kt][r] = e; ps += e; }
                    ps = red_sum_16_32(ps);
                    lrow[qt] = lrow[qt] * alph[qt] + ps; mrow[qt] = mnew;
                    u32x4 pk; pk[0] = pack_bf2(sv[0][0], sv[0][1]); pk[1] = pack_bf2(sv[0][2], sv[0][3]); pk[2] = pack_bf2(sv[1][0], sv[1][1]); pk[3] = pack_bf2(sv[1][2], sv[1][3]);
                    pf[qt] = __builtin_bit_cast(bf16x8, pk);
                }
                if (__any((alph[0] != 1.f) || (alph[1] != 1.f))) {
#pragma unroll
                    for (int qt = 0; qt < 2; ++qt)
#pragma unroll
                        for (int dt = 0; dt < 4; ++dt) oacc[qt][dt] = oacc[qt][dt] * alph[qt];
                }
#pragma unroll
                for (int dt = 0; dt < 4; ++dt) {
                    const char* vp = VB + (dt * 16 + lr) * MB_VROW + st * 64 + 8 * lg;
                    const u32x2 lo = *(const u32x2*)vp, hi = *(const u32x2*)(vp + 32);
                    u32x4 t4; t4[0] = lo[0]; t4[1] = lo[1]; t4[2] = hi[0]; t4[3] = hi[1];
                    const bf16x8 vf = __builtin_bit_cast(bf16x8, t4);
#pragma unroll
                    for (int qt = 0; qt < 2; ++qt) oacc[qt][dt] = MFMA16(vf, pf[qt], oacc[qt][dt]);
                }
            }
        }
        if (bg_on) {
            while (bg_i < 8) { bg_acc += bg_pend; bg_pend = *(const f32x4*)(bg_base + (size_t)bg_i * 512); ++bg_i; }
            bg_acc += bg_pend;
            *(f32x4*)(lds + MB_BGS + (bgk & 1) * 8192 + (bg_rg * 64 + bg_d4 * 4) * 4) = bg_acc;
        }
        if (nxt >= 0) sstore(buf ^ 1);
        __syncthreads();
        if (bg_on) {
            if (tid < 64) { float sm = 0.f;
#pragma unroll 8
                for (int r = 0; r < 32; ++r) sm += *(const float*)(lds + MB_BGS + (bgk & 1) * 8192 + (r * 64 + tid) * 4);
                *(float*)(lds + MB_KMS + (bgk * 64 + tid) * 4) = sm * (1.f / 256.f); }
            ++bgk;
            if (bgk < 32) bg_page = p.page_table[bg_bs * 64 + 2 * bgk + (bg_rg >> 4)];
        }
        cur = nxt; buf ^= 1;
    }
#pragma unroll
    for (int qt = 0; qt < 2; ++qt) {
        const float inv = 1.f / lrow[qt];
#pragma unroll
        for (int dt = 0; dt < 4; ++dt) store_bf4(p.MIX + (rowq0 + qt * 16 + lr) * DM + h * 64 + dt * 16 + 4 * lg, oacc[qt][dt] * inv);
    }
}

DI void ln_rows(const Params& p, const float* g, const float* bb, int bid, int nb, bool final_out) {
    const int lane = TIDX & 63, w = TIDX >> 6;
    for (int row = bid * 8 + w; row < TT; row += nb * 8) {
        f32x4 v[4]; float s = 0.f;
#pragma unroll
        for (int i = 0; i < 4; ++i) { v[i] = ld_bf4(p.T + (size_t)row * DM + 4 * lane + 256 * i); s += v[i][0] + v[i][1] + v[i][2] + v[i][3]; }
        const float mu = wave_sum(s) * (1.f / 1024.f);
        float q = 0.f;
#pragma unroll
        for (int i = 0; i < 4; ++i)
#pragma unroll
            for (int k = 0; k < 4; ++k) { float d = v[i][k] - mu; q += d * d; }
        const float rs = rsqrtf(wave_sum(q) * (1.f / 1024.f) + LN_EPS);
#pragma unroll
        for (int i = 0; i < 4; ++i) {
            const int c = 4 * lane + 256 * i;
            f32x4 gg = *(const f32x4*)(g + c), be = *(const f32x4*)(bb + c), y;
#pragma unroll
            for (int k = 0; k < 4; ++k) y[k] = (v[i][k] - mu) * rs * gg[k] + be[k];
            if (final_out) { float* dst = row < TP ? p.y_prompt + (size_t)row * DM + c : p.y_sample + (size_t)(row - TP) * DM + c; *(f32x4*)dst = y; }
            else store_bf4(p.XB + (size_t)row * DM + c, y);
        }
    }
}

DI unsigned ford(float f) { const unsigned u = __float_as_uint(f); return u ^ ((unsigned)((int)u >> 31) | 0x80000000u); }
DI float funord(unsigned k) { return __uint_as_float((k & 0x80000000u) ? (k ^ 0x80000000u) : ~k); }
#define KINS16(K, tk) { unsigned _v = (K); _Pragma("unroll") for (int _k = 0; _k < 16; ++_k) { const unsigned _t = tk[_k] > _v ? tk[_k] : _v; _v = tk[_k] > _v ? _v : tk[_k]; tk[_k] = _t; } }

DI void qrow_issue(const Params& p, int layer, int rid, int lane, f32x4 (&v)[4]) {
    const float* src = (rid < 16384 ? p.peer_u + ((size_t)layer * 16384 + rid) * DM : p.peer_v + ((size_t)layer * 16384 + (rid - 16384)) * DM);
#pragma unroll
    for (int i = 0; i < 4; ++i) v[i] = *(const f32x4*)(src + 4 * lane + 256 * i);
}
DI void qrow_finish(const Params& p, int layer, int rid, int lane, const f32x4 (&v)[4]) {
    float am = 0.f;
#pragma unroll
    for (int i = 0; i < 4; ++i) am = fmaxf(am, fmaxf(fmaxf(fabsf(v[i][0]), fabsf(v[i][1])), fmaxf(fabsf(v[i][2]), fabsf(v[i][3]))));
    am = wave_max(am);
    const bool isu = rid < 16384; const int e = isu ? rid : rid - 16384;
    unsigned char* dst = (isu ? p.U8 : p.V8) + (size_t)layer * 16384 * DM + (size_t)e * 128;
    const float top = isu ? 127.f : 416.f;
    const float sc = am > 0.f ? top / am : 0.f;
#pragma unroll
    for (int i = 0; i < 4; ++i) {
        int pk = 0;
        if (isu) {
#pragma unroll
            for (int k = 0; k < 4; ++k) { const int q = (int)rintf(v[i][k] * sc); pk |= (int)(((unsigned)q & 0xffu) << (8 * k)); }
        } else {
            pk = __builtin_amdgcn_cvt_pk_fp8_f32(v[i][0] * sc, v[i][1] * sc, pk, false);
            pk = __builtin_amdgcn_cvt_pk_fp8_f32(v[i][2] * sc, v[i][3] * sc, pk, true);
        }
        const int col = 4 * lane + 256 * i;
        *(int*)(dst + (size_t)(col >> 7) * (16384 * 128) + (col & 127)) = pk;
    }
    if (lane == 0) (isu ? p.SU : p.SV)[layer * 16384 + e] = am / top;
}
typedef _Float16 f16x4 __attribute__((ext_vector_type(4)));
typedef _Float16 f16x8 __attribute__((ext_vector_type(8)));
DI void peer_topk_unit(const Params& p, int layer, int u, char* lds) {
    const int tid = TIDX, lane = tid & 63, w = tid >> 6, lr = lane & 15, lg = lane >> 4;
    const int t0 = u * 32;
    __syncthreads();
    {
        const bf16_t* KBl = p.KB + (size_t)layer * 2048 * 128;
#pragma unroll 1
        for (int jj = 0; jj < 2; ++jj) {
            const int j = 2 * w + jj;
            bf16x8 qf[2][4];
#pragma unroll
            for (int tt = 0; tt < 2; ++tt)
#pragma unroll
                for (int ks = 0; ks < 4; ++ks) qf[tt][ks] = *(const bf16x8*)(p.QH + (size_t)(t0 + tt * 16 + lr) * 2048 + j * 128 + ks * 32 + lg * 8);
#pragma unroll
            for (int nt = 0; nt < 8; ++nt) {
                bf16x8 kf[4];
#pragma unroll
                for (int ks = 0; ks < 4; ++ks) kf[ks] = *(const bf16x8*)(KBl + (size_t)(j * 128 + nt * 16 + lr) * 128 + ks * 32 + lg * 8);
#pragma unroll
                for (int tt = 0; tt < 2; ++tt) {
                    f32x4 a = {0.f, 0.f, 0.f, 0.f};
#pragma unroll
                    for (int ks = 0; ks < 4; ++ks) a = MFMA16(kf[ks], qf[tt][ks], a);
                    f16x4 hv; hv[0] = (_Float16)a[0]; hv[1] = (_Float16)a[1]; hv[2] = (_Float16)a[2]; hv[3] = (_Float16)a[3];
                    const int chunk = nt * 2 + (lg >> 1);
                    *(f16x4*)(lds + ((tt * 16 + lr) * 16 + j) * 256 + ((chunk ^ j) << 4) + (lg & 1) * 8) = hv;
                }
            }
        }
    }
    __syncthreads();
    const int tok = t0 + (tid >> 4), j = tid & 15;
    const int qbase = u * 64 + w * 8;
    f32x4 qv[4][4];
#pragma unroll
    for (int i = 0; i < 4; ++i) qrow_issue(p, layer, qbase + i, lane, qv[i]);
    unsigned tk[16];
#pragma unroll
    for (int k = 0; k < 16; ++k) tk[k] = 0u;
    {
        const char* sp = lds + tid * 256;
#pragma unroll 2
        for (int c = 0; c < 16; ++c) {
            const f16x8 v = *(const f16x8*)(sp + ((c ^ j) << 4));
#pragma unroll
            for (int q = 0; q < 8; ++q) KINS16((ford((float)v[q]) & ~127u) | (unsigned)(127 - (8 * c + q)), tk);
        }
    }
#pragma unroll
    for (int i = 0; i < 4; ++i) qrow_finish(p, layer, qbase + i, lane, qv[i]);
#pragma unroll
    for (int i = 0; i < 4; ++i) qrow_issue(p, layer, qbase + 4 + i, lane, qv[i]);
    __syncthreads();
    float* lv = (float*)lds;
    int* li = (int*)(lds + 512 * 17 * 4);
#pragma unroll
    for (int k = 0; k < 16; ++k) { lv[tid * 17 + k] = funord(tk[k] & ~127u); li[tid * 17 + k] = 127 - (int)(tk[k] & 127u); }
    __syncthreads();
    if ((j & 1) == 0) {
        float v1[16], v2[16];
#pragma unroll
        for (int k = 0; k < 16; ++k) { v1[k] = lv[tid * 17 + k]; v2[k] = lv[(tid + 1) * 17 + k]; }
        unsigned sk[16];
#pragma unroll
        for (int k = 0; k < 16; ++k) sk[k] = 0u;
#pragma unroll
        for (int a = 0; a < 16; ++a)
#pragma unroll
            for (int bq = 0; bq < 16; ++bq)
                if ((a + 1) * (bq + 1) <= 16) KINS16((ford(v1[a] + v2[bq]) & ~255u) | (unsigned)(255 - (a * 16 + bq)), sk);
        float sc[16]; int ee[16];
#pragma unroll
        for (int k = 0; k < 16; ++k) {
            const int c = 255 - (int)(sk[k] & 255u), a = c >> 4, bq = c & 15;
            sc[k] = lv[tid * 17 + a] + lv[(tid + 1) * 17 + bq];
            ee[k] = li[tid * 17 + a] * 128 + li[(tid + 1) * 17 + bq];
        }
        float sm = 0.f; float e[16];
#pragma unroll
        for (int k = 0; k < 16; ++k) { e[k] = __expf(sc[k] - sc[0]); sm += e[k]; }
        const float inv = 1.f / sm; const int h = j >> 1;
#pragma unroll
        for (int k = 0; k < 16; ++k) { p.E[(size_t)tok * 128 + h * 16 + k] = ee[k]; p.G[(size_t)tok * 128 + h * 16 + k] = e[k] * inv; }
    }
#pragma unroll
    for (int i = 0; i < 4; ++i) qrow_finish(p, layer, qbase + 4 + i, lane, qv[i]);
}

constexpr int EHS = 129;
constexpr int PEER_EH = 65536, PEER_TOK = 65536 + 64 * EHS * 8, PEER_END = PEER_TOK + 1024;
DI float gelu_exact(float z) { return 0.5f * z * (1.f + erff(z * 0.70710678118654752f)); }
#define FMA4U(ACC, O, H, W) { ACC[O] += H * (float)((W) & 0xffu); ACC[O + 1] += H * (float)(((W) >> 8) & 0xffu); ACC[O + 2] += H * (float)(((W) >> 16) & 0xffu); ACC[O + 3] += H * (float)((W) >> 24); }

DI void peer_tile(const Params& p, int layer, int tile, char* lds, bool final_out) {
    const int lane = TIDX & 63, w = TIDX >> 6, lr = lane & 15, lg = lane >> 4;
    unsigned char* X8 = (unsigned char*)lds; int2* EH = (int2*)(lds + PEER_EH); float* TOK = (float*)(lds + PEER_TOK);
    const unsigned char* U8 = p.U8 + (size_t)layer * 16384 * DM; const unsigned char* V8 = p.V8 + (size_t)layer * 16384 * DM;
    const float* SUi = p.SU + layer * 16384; const float* SVi = p.SV + layer * 16384;
    const float* lng = p.ln_g + (layer * 2 + 1) * DM; const float* lnb = p.ln_b + (layer * 2 + 1) * DM;
    const int t0 = tile * 64 + w * 8;
#pragma unroll 4
    for (int i = 0; i < 8; ++i) {
        const int t = t0 + i, tk = w * 8 + i;
        f32x4 v[4]; float am = 0.f;
#pragma unroll
        for (int k = 0; k < 4; ++k) { v[k] = ld_bf4(p.XB + (size_t)t * DM + 4 * lane + 256 * k); am = fmaxf(am, fmaxf(fmaxf(fabsf(v[k][0]), fabsf(v[k][1])), fmaxf(fabsf(v[k][2]), fabsf(v[k][3])))); }
        am = wave_max(am);
        const float sc = am > 0.f ? 127.f / am : 0.f;
#pragma unroll
        for (int k = 0; k < 4; ++k) {
            unsigned pk = 0;
#pragma unroll
            for (int q = 0; q < 4; ++q) { const int qi = (int)rintf(v[k][q] * sc); pk |= ((unsigned)qi & 0xffu) << (8 * q); }
            *(unsigned*)(X8 + tk * 1024 + 4 * lane + 256 * k) = pk;
        }
        if (lane == 0) TOK[tk * 2] = am * (1.f / 127.f);
        EH[tk * EHS + lane] = make_int2(p.E[(size_t)t * 128 + lane], 0);
        EH[tk * EHS + 64 + lane] = make_int2(p.E[(size_t)t * 128 + 64 + lane], 0);
    }
    {
        const int gq = lane >> 3, li = lane & 7, tk = w * 8 + gq;
        auto uld = [&](int c, int p0, u32x4 (&uu)[4]) {
            const unsigned char* Uc = U8 + (size_t)c * (16384 * 128);
#pragma unroll
            for (int j = 0; j < 4; ++j) { const unsigned e = (unsigned)EH[tk * EHS + p0 + j].x; uu[j] = *(const u32x4*)(Uc + (e * 128u + 16u * li)); }
        };
        auto ucp = [&](int p0, u32x4 (&uu)[4], const i32x4& xq) {
#pragma unroll
            for (int j = 0; j < 4; ++j) {
                int d = __builtin_amdgcn_sdot4((int)uu[j][0], xq[0], 0, false);
                d = __builtin_amdgcn_sdot4((int)uu[j][1], xq[1], d, false);
                d = __builtin_amdgcn_sdot4((int)uu[j][2], xq[2], d, false);
                d = __builtin_amdgcn_sdot4((int)uu[j][3], xq[3], d, false);
                d += __builtin_amdgcn_update_dpp(0, d, 0x114, 0xf, 0xf, true);
                d += __builtin_amdgcn_update_dpp(0, d, 0x112, 0xf, 0xf, true);
                d += __builtin_amdgcn_update_dpp(0, d, 0x111, 0xf, 0xf, true);
                if (li == 7) __hip_atomic_fetch_add(&EH[tk * EHS + p0 + j].y, d, __ATOMIC_RELAXED, __HIP_MEMORY_SCOPE_WORKGROUP);
            }
        };
        u32x4 uA[4], uB[4];
        uld(0, 0, uA);
#pragma unroll 1
        for (int c = 0; c < 8; ++c) {
            const i32x4 xq = *(const i32x4*)(X8 + tk * 1024 + c * 128 + 16 * li);
#pragma unroll 1
            for (int p0 = 0; p0 < 128; p0 += 8) {
                uld(c, p0 + 4, uB);
                ucp(p0, uA, xq);
                if (p0 + 8 < 128) uld(c, p0 + 8, uA); else if (c < 7) uld(c + 1, 0, uA);
                ucp(p0 + 4, uB, xq);
            }
        }
    }
#pragma unroll 4
    for (int i = 0; i < 8; ++i) {
        const int t = t0 + i, tk = w * 8 + i;
        const float sxi = TOK[tk * 2];
#pragma unroll
        for (int hf = 0; hf < 2; ++hf) {
            const int pi = hf * 64 + lane;
            const int2 eh = EH[tk * EHS + pi];
            const float z = (float)eh.y * SUi[eh.x] * sxi;
            const float hp = p.G[(size_t)t * 128 + pi] * gelu_exact(z) * SVi[eh.x];
            EH[tk * EHS + pi].y = __float_as_int(hp);
        }
    }
    const int gq = lane >> 3, li = lane & 7, tk = w * 8 + gq, t = t0 + gq;
    float s1 = 0.f, s2 = 0.f;
    auto vload = [&](int c, int p0, float (&hh)[4], u32x4 (&vv)[4]) {
        const unsigned char* Vc = V8 + (size_t)c * (16384 * 128);
#pragma unroll
        for (int j = 0; j < 4; ++j) { const int2 eh = EH[tk * EHS + p0 + j]; hh[j] = __int_as_float(eh.y); vv[j] = *(const u32x4*)(Vc + ((unsigned)eh.x * 128u + 16u * li)); }
    };
    auto vcomp = [&](float (&hh)[4], u32x4 (&vv)[4], f32x2 (&acc)[8]) {
#pragma unroll
        for (int j = 0; j < 4; ++j) {
            const f32x2 h2 = {hh[j], hh[j]};
#pragma unroll
            for (int q = 0; q < 4; ++q) {
                const f32x2 a = __builtin_amdgcn_cvt_pk_f32_fp8((int)vv[j][q], false), b = __builtin_amdgcn_cvt_pk_f32_fp8((int)vv[j][q], true);
                acc[2 * q] = h2 * a + acc[2 * q]; acc[2 * q + 1] = h2 * b + acc[2 * q + 1];
            }
        }
    };
    float ehA[4], ehB[4]; u32x4 vvA[4], vvB[4];
    vload(0, 0, ehA, vvA);
#pragma unroll 1
    for (int c = 0; c < 8; ++c) {
        f32x2 acc[8];
#pragma unroll
        for (int k = 0; k < 8; ++k) acc[k] = (f32x2){0.f, 0.f};
        f32x4 xs[4];
#pragma unroll
        for (int k4 = 0; k4 < 4; ++k4) xs[k4] = ld_bf4(p.XB + (size_t)t * DM + c * 128 + li * 16 + 4 * k4);
#pragma unroll 1
        for (int p0 = 0; p0 < 128; p0 += 8) {
            vload(c, p0 + 4, ehB, vvB);
            vcomp(ehA, vvA, acc);
            if (p0 + 8 < 128) vload(c, p0 + 8, ehA, vvA); else if (c < 7) vload(c + 1, 0, ehA, vvA);
            vcomp(ehB, vvB, acc);
        }
        const int col = c * 128 + li * 16;
#pragma unroll
        for (int k4 = 0; k4 < 4; ++k4) {
            const f32x4 x = xs[k4];
            f32x4 y;
#pragma unroll
            for (int k = 0; k < 4; ++k) { y[k] = DN_ALPHA * x[k] + acc[2 * k4 + (k >> 1)][k & 1]; s1 += y[k]; s2 += y[k] * y[k]; }
            store_bf4(p.T + (size_t)t * DM + col + 4 * k4, y);
        }
    }
#pragma unroll
    for (int o = 1; o <= 4; o <<= 1) { s1 += __shfl_xor(s1, o, 64); s2 += __shfl_xor(s2, o, 64); }
    const float mu = s1 * (1.f / 1024.f);
    const float rs = rsqrtf(fmaxf(s2 * (1.f / 1024.f) - mu * mu, 0.f) + LN_EPS);
#pragma unroll 4
    for (int c = 0; c < 8; ++c) {
        const int col = c * 128 + li * 16;
#pragma unroll
        for (int k4 = 0; k4 < 4; ++k4) {
            const f32x4 y = ld_bf4(p.T + (size_t)t * DM + col + 4 * k4);
            const f32x4 gg = *(const f32x4*)(lng + col + 4 * k4), be = *(const f32x4*)(lnb + col + 4 * k4);
            f32x4 o;
#pragma unroll
            for (int k = 0; k < 4; ++k) o[k] = (y[k] - mu) * rs * gg[k] + be[k];
            if (final_out) *(f32x4*)(p.y_prompt + (size_t)t * DM + col + 4 * k4) = o;
            else store_bf4(p.XB + (size_t)t * DM + col + 4 * k4, o);
        }
    }
}


DI unsigned wave_top16(unsigned x0, unsigned x1, int lane) {
    unsigned res = 0u;
#pragma unroll 1
    for (int r = 0; r < 16; ++r) {
        unsigned m = x0 > x1 ? x0 : x1;
#pragma unroll
        for (int o = 32; o >= 1; o >>= 1) { const unsigned y = (unsigned)__shfl_xor((int)m, o, 64); m = y > m ? y : m; }
        if (x0 == m) x0 = 0u; else if (x1 == m) x1 = 0u;
        if (lane == r) res = m;
    }
    return res;
}
DI void peer_sample(const Params& p, int layer, int sidx, char* lds, bool final_out) {
    const int tid = TIDX, lane = tid & 63, w = tid >> 6, lr = lane & 15, lg = lane >> 4;
    unsigned char* X8 = (unsigned char*)lds; int2* EH = (int2*)(lds + 1024); float* Z = (float*)(lds + 1024 + 1024); float* Y = Z + 128; float* PART = Y + 1024;
    int* Es = (int*)(PART + 32); float* Gs = (float*)(Es + 128);
    const unsigned char* U8 = p.U8 + (size_t)layer * 16384 * DM; const unsigned char* V8 = p.V8 + (size_t)layer * 16384 * DM;
    const float* SUi = p.SU + layer * 16384; const float* SVi = p.SV + layer * 16384;
    const float* lng = p.ln_g + (layer * 2 + 1) * DM; const float* lnb = p.ln_b + (layer * 2 + 1) * DM;
    const int t = TP + sidx;
    __syncthreads();
    if (w == 0) {
        f32x4 v[4]; float am = 0.f;
#pragma unroll
        for (int k = 0; k < 4; ++k) { v[k] = ld_bf4(p.XB + (size_t)t * DM + 4 * lane + 256 * k); am = fmaxf(am, fmaxf(fmaxf(fabsf(v[k][0]), fabsf(v[k][1])), fmaxf(fabsf(v[k][2]), fabsf(v[k][3])))); }
        am = wave_max(am);
        const float sc = am > 0.f ? 127.f / am : 0.f;
#pragma unroll
        for (int k = 0; k < 4; ++k) {
            unsigned pk = 0;
#pragma unroll
            for (int q = 0; q < 4; ++q) { const int qi = (int)rintf(v[k][q] * sc); pk |= ((unsigned)qi & 0xffu) << (8 * q); }
            *(unsigned*)(X8 + 4 * lane + 256 * k) = pk;
        }
        if (lane == 0) PART[24] = am * (1.f / 127.f);
    }
    {
        const float* sp = p.S + (size_t)t * 2048 + w * 256;
        const unsigned k1 = wave_top16((ford(sp[lane]) & ~127u) | (unsigned)(127 - lane), (ford(sp[64 + lane]) & ~127u) | (unsigned)(63 - lane), lane);
        const unsigned k2 = wave_top16((ford(sp[128 + lane]) & ~127u) | (unsigned)(127 - lane), (ford(sp[192 + lane]) & ~127u) | (unsigned)(63 - lane), lane);
        const float v1 = funord(k1 & ~127u), v2 = funord(k2 & ~127u); const int i1 = 127 - (int)(k1 & 127u), i2 = 127 - (int)(k2 & 127u);
        int a = 0, b = 0;
        { int base = 0;
#pragma unroll
          for (int aa = 0; aa < 16; ++aa) { const int cnt = 16 / (aa + 1); if (lane >= base && lane < base + cnt) { a = aa; b = lane - base; } base += cnt; } }
        const float sv = __shfl(v1, a, 64) + __shfl(v2, b, 64);
        const unsigned ck = lane < 50 ? ((ford(sv) & ~255u) | (unsigned)(255 - (a * 16 + b))) : 0u;
        const unsigned rk = wave_top16(ck, 0u, lane);
        const int c2 = 255 - (int)(rk & 255u), a2 = (c2 >> 4) & 15, b2 = c2 & 15;
        const float sc = __shfl(v1, a2, 64) + __shfl(v2, b2, 64);
        const int ex = __shfl(i1, a2, 64) * 128 + __shfl(i2, b2, 64);
        const float mx = __shfl(sc, 0, 64);
        const float ee = lane < 16 ? __expf(sc - mx) : 0.f;
        const float sm = wave_sum(ee);
        if (lane < 16) { Es[w * 16 + lane] = ex; Gs[w * 16 + lane] = ee / sm; }
    }
    __syncthreads();
    {
        const int e = Es[w * 16 + lr];
        i32x4 acc = {0, 0, 0, 0};
#pragma unroll
        for (int ch = 0; ch < 16; ++ch) {
            const i32x4 a = *(const i32x4*)(U8 + (size_t)(ch >> 1) * (16384 * 128) + (size_t)e * 128 + (ch & 1) * 64 + 16 * lg);
            const i32x4 xb = *(const i32x4*)(X8 + ch * 64 + 16 * lg);
            acc = __builtin_amdgcn_mfma_i32_16x16x64_i8(a, xb, acc, 0, 0, 0);
        }
        if (lr == 0) {
#pragma unroll
            for (int r = 0; r < 4; ++r) Z[w * 16 + 4 * lg + r] = (float)acc[r];
        }
        __builtin_amdgcn_s_waitcnt(0);
        __builtin_amdgcn_wave_barrier();
        float hp = 0.f;
        if (lane < 16) {
            const int pi = w * 16 + lane;
            const float z = Z[pi] * SUi[e] * PART[24];
            hp = Gs[pi] * gelu_exact(z) * SVi[e];
            EH[pi] = make_int2(e, __float_as_int(hp));
        }
        hp = wave_sum(hp);
        if (lane == 0) PART[w] = hp;
    }
    __syncthreads();
    float sumh = 0.f;
#pragma unroll
    for (int i = 0; i < 8; ++i) sumh += PART[i];
    {
        const int c = w, pg = lane >> 3, li = lane & 7;
        float acc[16];
#pragma unroll
        for (int k = 0; k < 16; ++k) acc[k] = 0.f;
        const unsigned char* vb = V8 + (size_t)c * (16384 * 128) + li * 16;
        for (int p0 = 0; p0 < 16; p0 += 8) {
            int2 eh[8]; u32x4 vv[8];
#pragma unroll
            for (int j = 0; j < 8; ++j) eh[j] = EH[pg * 16 + p0 + j];
#pragma unroll
            for (int j = 0; j < 8; ++j) vv[j] = *(const u32x4*)(vb + (size_t)eh[j].x * 128);
#pragma unroll
            for (int j = 0; j < 8; ++j) { const float h = __int_as_float(eh[j].y);
#pragma unroll
                for (int q = 0; q < 4; ++q) { const f32x2 a = __builtin_amdgcn_cvt_pk_f32_fp8((int)vv[j][q], false), bq = __builtin_amdgcn_cvt_pk_f32_fp8((int)vv[j][q], true);
                    acc[4 * q] += h * a[0]; acc[4 * q + 1] += h * a[1]; acc[4 * q + 2] += h * bq[0]; acc[4 * q + 3] += h * bq[1]; } }
        }
#pragma unroll
        for (int k = 0; k < 16; ++k) { float a = acc[k]; a += __shfl_xor(a, 8, 64); a += __shfl_xor(a, 16, 64); a += __shfl_xor(a, 32, 64); acc[k] = a; }
        float s1 = 0.f, s2 = 0.f;
        if (pg == 0) {
            const int col = c * 128 + li * 16;
#pragma unroll
            for (int k = 0; k < 16; ++k) { const float y = DN_ALPHA * bf2f(p.XB[(size_t)t * DM + col + k]) + acc[k]; Y[col + k] = y; s1 += y; s2 += y * y; }
        }
        s1 = wave_sum(s1); s2 = wave_sum(s2);
        if (lane == 0) { PART[8 + w] = s1; PART[16 + w] = s2; }
    }
    __syncthreads();
    float s1 = 0.f, s2 = 0.f;
#pragma unroll
    for (int i = 0; i < 8; ++i) { s1 += PART[8 + i]; s2 += PART[16 + i]; }
    const float mu = s1 * (1.f / 1024.f);
    const float rs = rsqrtf(fmaxf(s2 * (1.f / 1024.f) - mu * mu, 0.f) + LN_EPS);
#pragma unroll
    for (int k = 0; k < 2; ++k) {
        const int col = tid + NT * k;
        const float o = (Y[col] - mu) * rs * lng[col] + lnb[col];
        if (final_out) p.y_sample[(size_t)sidx * DM + col] = o;
        else p.XB[(size_t)t * DM + col] = f2bf(o);
    }
    __syncthreads();
}

DI void peer_expert_phase(const Params& p, int layer, char* lds, int bid, int nb, bool final_out) {
    for (int tile = bid; tile < 256; tile += nb) peer_tile(p, layer, tile, lds, final_out);
    for (int sidx = bid; sidx < TS; sidx += nb) peer_sample(p, layer, sidx, lds, final_out);
}

DI void hgrn_cumsum(const Params& p, size_t row0, int h, float* bs, float* tot) {
    const int tid = TIDX;
#pragma unroll
    for (int i = 0; i < 4; ++i) { int id = tid + NT * i; int s = id >> 5, c4 = id & 31; typedef _Float16 h4 __attribute__((ext_vector_type(4))); const h4 hv = *(const h4*)(p.LF + (row0 + s) * DM + h * 128 + 4 * c4); *(f32x4*)(bs + s * 128 + 4 * c4) = (f32x4){(float)hv[0], (float)hv[1], (float)hv[2], (float)hv[3]}; }
    __syncthreads();
    const int k = tid & 127, seg = tid >> 7;
    float run = 0.f;
#pragma unroll
    for (int i = 0; i < 16; ++i) { run += bs[(seg * 16 + i) * 128 + k]; bs[(seg * 16 + i) * 128 + k] = run; }
    tot[seg * 128 + k] = run;
    __syncthreads();
    float off = 0.f;
#pragma unroll
    for (int s2 = 0; s2 < 3; ++s2) if (s2 < seg) off += tot[s2 * 128 + k];
    if (seg > 0) {
#pragma unroll
        for (int i = 0; i < 16; ++i) bs[(seg * 16 + i) * 128 + k] += off;
    }
    __syncthreads();
}
constexpr int HG_TS = 72;
constexpr int HG_FS = 136;
DI void hgrn_b1_unit(const Params& p, int u, char* lds) {
    float* bs = (float*)lds;
    float* tot = (float*)(lds + 32768);
    bf16_t* KT = (bf16_t*)(lds + 36864);
    bf16_t* IT = (bf16_t*)(lds + 36864 + 18432);
    const int tid = TIDX, lane = tid & 63, w = tid >> 6, lr = lane & 15, lg = lane >> 4;
    const int bh = u >> 7, c = u & 127, b = bh >> 3, h = bh & 7;
    const size_t row0 = (size_t)b * SEQ + c * 64;
    hgrn_cumsum(p, row0, h, bs, tot);
    const bf16_t* KK = p.H + (size_t)MP * DM; const bf16_t* I1 = p.H + (size_t)2 * MP * DM;
    {
        const int s = tid >> 3, kc = (tid & 7) * 16;
        const bf16_t* kr = KK + (row0 + s) * DM + h * 128 + kc; const bf16_t* ir = I1 + (row0 + s) * DM + h * 128 + kc;
        u32x4 ka = *(const u32x4*)kr, kb = *(const u32x4*)(kr + 8), ia = *(const u32x4*)ir, ib = *(const u32x4*)(ir + 8);
#pragma unroll
        for (int i = 0; i < 16; ++i) {
            const unsigned kw = (i < 8) ? ka[(i & 7) >> 1] : kb[(i & 7) >> 1]; const unsigned iw = (i < 8) ? ia[(i & 7) >> 1] : ib[(i & 7) >> 1];
            const float kv = (i & 1) ? bfhi(kw) : bflo(kw);
            const float e = __expf(fminf(-bs[s * 128 + kc + i], 80.f));
            KT[(kc + i) * HG_TS + s] = f2bf(kv * e);
            IT[(kc + i) * HG_TS + s] = (bf16_t)((i & 1) ? (iw >> 16) : (iw & 0xffffu));
        }
    }
    __syncthreads();
    f32x4 acc[8];
#pragma unroll
    for (int j = 0; j < 8; ++j) acc[j] = (f32x4){0.f, 0.f, 0.f, 0.f};
#pragma unroll
    for (int ks = 0; ks < 2; ++ks) {
        const bf16x8 af = *(const bf16x8*)(KT + (w * 16 + lr) * HG_TS + ks * 32 + lg * 8);
#pragma unroll
        for (int j = 0; j < 8; ++j) { const bf16x8 bfr = *(const bf16x8*)(IT + (j * 16 + lr) * HG_TS + ks * 32 + lg * 8); acc[j] = MFMA16(af, bfr, acc[j]); }
    }
    f32x4 dl;
#pragma unroll
    for (int r = 0; r < 4; ++r) dl[r] = __expf(bs[63 * 128 + w * 16 + 4 * lg + r]);
#pragma unroll
    for (int j = 0; j < 8; ++j) store_bf4(p.UT + ((size_t)u * 128 + j * 16 + lr) * 128 + w * 16 + 4 * lg, acc[j] * dl);
    if (tid < 128) p.DEC[(size_t)u * 128 + tid] = __expf(bs[63 * 128 + tid]);
    __syncthreads();
}
DI void hgrn_b2(const Params& p, int bid, int nb) {
    for (int e = bid * NT + TIDX; e < 16 * 8192; e += nb * NT) {
        const int bh = e >> 13, vk = (e & 8191) * 2, k = vk & 127, v = vk >> 7;
        float S0 = 0.f, S1 = 0.f;
        for (int c0 = 0; c0 < 128; c0 += 8) {
            unsigned uu[8]; float d0[8], d1[8];
#pragma unroll
            for (int i = 0; i < 8; ++i) { const size_t un = (size_t)bh * 128 + c0 + i; uu[i] = *(const unsigned*)(p.UT + un * 16384 + vk); d0[i] = p.DEC[un * 128 + k]; d1[i] = p.DEC[un * 128 + k + 1]; }
#pragma unroll
            for (int i = 0; i < 8; ++i) { const size_t un = (size_t)bh * 128 + c0 + i; *(unsigned*)(p.ST + un * 16384 + vk) = pack_bf2(S0, S1); S0 = d0[i] * S0 + bflo(uu[i]); S1 = d1[i] * S1 + bfhi(uu[i]); }
        }
        p.hgrn_prompt[((size_t)bh * 128 + k) * 128 + v] = S0;
        p.hgrn_prompt[((size_t)bh * 128 + k + 1) * 128 + v] = S1;
    }
}
DI void hgrn_b3_unit(const Params& p, int u, char* lds) {
    float* bs = (float*)lds;
    float* tot = (float*)(lds + 32768);
    bf16_t* QH = (bf16_t*)(lds + 36864);
    bf16_t* KH = (bf16_t*)(lds + 36864 + 17408);
    bf16_t* IT = (bf16_t*)(lds + 36864 + 34816);
    bf16_t* AT = (bf16_t*)(lds + 36864 + 34816 + 18432);
    const int tid = TIDX, lane = tid & 63, w = tid >> 6, lr = lane & 15, lg = lane >> 4;
    const int bh = u >> 7, c = u & 127, b = bh >> 3, h = bh & 7;
    const size_t row0 = (size_t)b * SEQ + c * 64;
    hgrn_cumsum(p, row0, h, bs, tot);
    const bf16_t* Q1 = p.H; const bf16_t* KK = p.H + (size_t)MP * DM; const bf16_t* I1 = p.H + (size_t)2 * MP * DM; const bf16_t* G1 = p.H + (size_t)3 * MP * DM;
    {
        const int s = tid >> 3, kc = (tid & 7) * 16;
        const bf16_t* qr = Q1 + (row0 + s) * DM + h * 128 + kc; const bf16_t* kr = KK + (row0 + s) * DM + h * 128 + kc; const bf16_t* ir = I1 + (row0 + s) * DM + h * 128 + kc;
        u32x4 qa = *(const u32x4*)qr, qb = *(const u32x4*)(qr + 8), ka = *(const u32x4*)kr, kb = *(const u32x4*)(kr + 8), ia = *(const u32x4*)ir, ib = *(const u32x4*)(ir + 8);
#pragma unroll
        for (int i = 0; i < 16; ++i) {
            const unsigned qw = (i < 8) ? qa[(i & 7) >> 1] : qb[(i & 7) >> 1]; const unsigned kw = (i < 8) ? ka[(i & 7) >> 1] : kb[(i & 7) >> 1]; const unsigned iw = (i < 8) ? ia[(i & 7) >> 1] : ib[(i & 7) >> 1];
            const float qv = (i & 1) ? bfhi(qw) : bflo(qw); const float kv = (i & 1) ? bfhi(kw) : bflo(kw);
            const float bb = bs[s * 128 + kc + i];
            QH[s * HG_FS + kc + i] = f2bf(qv * __expf(bb));
            KH[s * HG_FS + kc + i] = f2bf(kv * __expf(fminf(-bb, 80.f)));
            IT[(kc + i) * HG_TS + s] = (bf16_t)((i & 1) ? (iw >> 16) : (iw & 0xffffu));
        }
    }
    __syncthreads();
    {
        const int tt = w & 3;
#pragma unroll
        for (int si = 0; si < 2; ++si) {
            const int stile = (w >> 2) * 2 + si;
            f32x4 a = {0.f, 0.f, 0.f, 0.f};
            if (stile <= tt) {
#pragma unroll
                for (int ks = 0; ks < 4; ++ks) {
                    const bf16x8 af = *(const bf16x8*)(KH + (stile * 16 + lr) * HG_FS + ks * 32 + lg * 8);
                    const bf16x8 bfr = *(const bf16x8*)(QH + (tt * 16 + lr) * HG_FS + ks * 32 + lg * 8);
                    a = MFMA16(af, bfr, a);
                }
            }
            const int t = tt * 16 + lr;
#pragma unroll
            for (int r = 0; r < 4; ++r) { const int s = stile * 16 + 4 * lg + r; if (s > t) a[r] = 0.f; }
            store_bf4(AT + t * HG_TS + stile * 16 + 4 * lg, a);
        }
    }
    __syncthreads();
    const int tt = w & 3;
    f32x4 acc[4];
#pragma unroll
    for (int j = 0; j < 4; ++j) acc[j] = (f32x4){0.f, 0.f, 0.f, 0.f};
#pragma unroll
    for (int ks = 0; ks < 2; ++ks) {
        const bf16x8 bfr = *(const bf16x8*)(AT + (tt * 16 + lr) * HG_TS + ks * 32 + lg * 8);
#pragma unroll
        for (int j = 0; j < 4; ++j) { const int vt = (w >> 2) * 4 + j; const bf16x8 af = *(const bf16x8*)(IT + (vt * 16 + lr) * HG_TS + ks * 32 + lg * 8); acc[j] = MFMA16(af, bfr, acc[j]); }
    }
    const bf16_t* STu = p.ST + (size_t)u * 16384;
#pragma unroll
    for (int ks = 0; ks < 4; ++ks) {
        const bf16x8 bfr = *(const bf16x8*)(QH + (tt * 16 + lr) * HG_FS + ks * 32 + lg * 8);
#pragma unroll
        for (int j = 0; j < 4; ++j) { const int vt = (w >> 2) * 4 + j; const bf16x8 af = *(const bf16x8*)(STu + (vt * 16 + lr) * 128 + ks * 32 + lg * 8); acc[j] = MFMA16(af, bfr, acc[j]); }
    }
    float ss = 0.f;
#pragma unroll
    for (int j = 0; j < 4; ++j)
#pragma unroll
        for (int r = 0; r < 4; ++r) ss += acc[j][r] * acc[j][r];
    ss += __shfl_xor(ss, 16, 64); ss += __shfl_xor(ss, 32, 64);
    float* red = tot;
    if (lg == 0) red[(w >> 2) * 64 + tt * 16 + lr] = ss;
    __syncthreads();
    const float rs = rsqrtf((red[tt * 16 + lr] + red[64 + tt * 16 + lr]) * (1.f / 128.f) + RMS_EPS);
    const size_t row = row0 + tt * 16 + lr;
#pragma unroll
    for (int j = 0; j < 4; ++j) {
        const int col = h * 128 + ((w >> 2) * 4 + j) * 16 + 4 * lg;
        const u32x2 gw = *(const u32x2*)(G1 + row * DM + col);
        const f32x4 ng = *(const f32x4*)(p.hgrn_norm_g + col);
        f32x4 o;
        const float gg[4] = {bflo(gw[0]), bfhi(gw[0]), bflo(gw[1]), bfhi(gw[1])};
#pragma unroll
        for (int r = 0; r < 4; ++r) o[r] = acc[j][r] * rs * ng[r] * (gg[r] * sigmoidf_(gg[r]));
        store_bf4(p.MIX + row * DM + col, o);
    }
    __syncthreads();
}
DI void hgrn_sample_unit(const Params& p, int u, char* lds) {
    float* part = (float*)lds;
    float* red = part + 512;
    const int tid = TIDX, lane = tid & 63, w = tid >> 6;
    const int b = u >> 3, h = u & 7; const size_t row = (size_t)TP + b;
    const bf16_t* Q1 = p.H; const bf16_t* KK = p.H + (size_t)MP * DM; const bf16_t* I1 = p.H + (size_t)2 * MP * DM; const bf16_t* G1 = p.H + (size_t)3 * MP * DM;
    const int v = tid & 127, kq = tid >> 7;
    const float iv = bf2f(I1[row * DM + h * 128 + v]);
    float acc = 0.f;
    const float* S0 = p.state_hgrn + (size_t)u * 16384; float* S1 = p.hgrn_sample + (size_t)u * 16384;
#pragma unroll 8
    for (int kk = 0; kk < 32; ++kk) {
        const int k = kq * 32 + kk;
        const float f = __expf((float)p.LF[row * DM + h * 128 + k]);
        const float kv = bf2f(KK[row * DM + h * 128 + k]);
        const float q = bf2f(Q1[row * DM + h * 128 + k]);
        const float st = f * S0[k * 128 + v] + kv * iv;
        S1[k * 128 + v] = st; acc += q * st;
    }
    part[kq * 128 + v] = acc;
    __syncthreads();
    float o = 0.f, sq = 0.f;
    if (tid < 128) { o = part[tid] + part[128 + tid] + part[256 + tid] + part[384 + tid]; sq = o * o; }
    sq = wave_sum(sq); if (lane == 0) red[w] = sq;
    __syncthreads();
    if (tid < 128) {
        const float rs = rsqrtf((red[0] + red[1]) * (1.f / 128.f) + RMS_EPS);
        const float g = bf2f(G1[row * DM + h * 128 + tid]);
        p.MIX[row * DM + h * 128 + tid] = f2bf(o * rs * p.hgrn_norm_g[h * 128 + tid] * (g * sigmoidf_(g)));
    }
    __syncthreads();
}

constexpr int LDS_BAR = 157824;
constexpr int LDS_BYTES = LDS_BAR + 256;

template <int LAYER> DI void peer_phases(const Params& p, char* lds, int bid, int nb, const XcdBarrier& bar) {
    REPEAT(REP_GEMM) {
        EpiBf16 epi{p.QH, 2048};
        gemm_big(p.XB, p.WT_WQ + (size_t)LAYER * 2048 * 1024, 2048, epi, lds, bid, nb);
    }
    xcd_barrier(bar);
    REPEAT(REP_TOPK) {
        { EpiF32 epi{p.S, 2048};
          for (int u = nb - 1 - bid; u < 16; u += nb) gemm_small32_unit(p.QH + u * 128, 2048, p.KB + (size_t)LAYER * 2048 * 128, 128, 128, TP, u * 128, epi); }
        for (int u = bid; u < TP / 32; u += nb) peer_topk_unit(p, LAYER, u, lds);
    }
    xcd_barrier(bar);
    REPEAT(LAYER == 1 ? REP_PEER1 : 1) peer_expert_phase(p, LAYER, lds, bid, nb, LAYER == 1);
}

__global__ void __launch_bounds__(NT, 2) mega(Params p) {
    extern __shared__ __attribute__((aligned(16))) char lds[];
    const int bid = blockIdx.x, nb = gridDim.x;
    if (TIDX == 0) *(uint4*)(lds + LDS_BAR) = make_uint4(0u, 0u, 0u, 0u);
    __syncthreads();
    XcdBarrier bar = xcd_barrier_post(p.bar, (volatile LAS unsigned*)(lds + LDS_BAR));
    REPEAT(REP_PRO) {
    for (int u = bid; u < 16 * 40; u += nb) transpose_unit(p.w_in_even, 1024, 2560, p.WT_IN_EVEN, u, lds);
    for (int u = bid; u < 16 * 16; u += nb) transpose_unit(p.w_out_even, 1024, 1024, p.WT_OUT_EVEN, u, lds);
    for (int u = bid; u < 16 * 64; u += nb) transpose_unit(p.w_in_odd, 1024, 4096, p.WT_IN_ODD, u, lds);
    for (int u = bid; u < 16 * 16; u += nb) transpose_unit(p.w_out_odd, 1024, 1024, p.WT_OUT_ODD, u, lds);
    for (int u = bid; u < 16 * 32; u += nb) transpose_unit(p.peer_wq, 1024, 2048, p.WT_WQ, u, lds);
    for (int u = bid; u < 16 * 32; u += nb) transpose_unit(p.peer_wq + (size_t)1024 * 2048, 1024, 2048, p.WT_WQ + (size_t)2048 * 1024, u, lds);
    convert_x(p, bid, nb);
    convert_keys(p, bid, nb);
    }
    xcd_barrier(bar);
    REPEAT(REP_GEMM) {
        EpiInEven epi{p.H, p.y_prompt, p.VT};
        gemm_big(p.XB, p.WT_IN_EVEN, 2560, epi, lds, bid, nb);
    }
    xcd_barrier(bar);
    REPEAT(REP_CONV) {
    for (int u = bid; u < 512; u += nb) kmean_prompt_unit(p, u);
    for (int u = bid; u < 544; u += nb) conv_unit(p, u, lds);
    }
    xcd_barrier(bar);
    {
        int bgk = 0;
        if (nb == 256) {
            { const int bh = bid >> 4, i = bid & 15; moba_prompt_unit(p, bh, i, lds, bid, bgk); moba_prompt_unit(p, bh, 31 - i, lds, bid, bgk); }
            while (bgk < 32) { bg_kmean_fore(p, bid, bgk, lds); ++bgk; }
            moba_sample_unit(p, bid, lds);
        } else {
            for (int u = bid; u < 512; u += nb) { const int bh = (u & 255) >> 4, i = u & 15; const int blk = (u < 256) ? i : 31 - i; int none = 32; moba_prompt_unit(p, bh, blk, lds, 0, none); }
            for (int u = bid; u < 256; u += nb) { __syncthreads(); for (int k = 0; k < 32; ++k) bg_kmean_fore(p, u, k, lds); moba_sample_unit(p, u, lds); }
        }
    }
    xcd_barrier(bar);
    REPEAT(REP_GEMM) {
        EpiResid epi{p.T, p.XB};
        gemm_big(p.MIX, p.WT_OUT_EVEN, 1024, epi, lds, bid, nb);
    }
    xcd_barrier(bar);
    ln_rows(p, p.ln_g, p.ln_b, bid, nb, false);
    xcd_barrier(bar);
    peer_phases<0>(p, lds, bid, nb, bar);
    xcd_barrier(bar);
    REPEAT(REP_GEMM) {
        EpiInOdd epi{p.H, p.LF, p.LB};
        gemm_big(p.XB, p.WT_IN_ODD, 4096, epi, lds, bid, nb);
    }
    xcd_barrier(bar);
    REPEAT(REP_HGRN) for (int u = bid; u < 2048 + 256; u += nb) { if (u < 2048) hgrn_b1_unit(p, u, lds); else hgrn_sample_unit(p, u - 2048, lds); }
    xcd_barrier(bar);
    REPEAT(REP_HGRN) hgrn_b2(p, bid, nb);
    xcd_barrier(bar);
    REPEAT(REP_HGRN) for (int u = bid; u < 2048; u += nb) hgrn_b3_unit(p, u, lds);
    xcd_barrier(bar);
    REPEAT(REP_GEMM) {
        EpiResid epi{p.T, p.XB};
        gemm_big(p.MIX, p.WT_OUT_ODD, 1024, epi, lds, bid, nb);
    }
    xcd_barrier(bar);
    ln_rows(p, p.ln_g + 2 * DM, p.ln_b + 2 * DM, bid, nb, false);
    xcd_barrier(bar);
    peer_phases<1>(p, lds, bid, nb, bar);
}

extern "C" void kernel_launch(void* const* d_in, const int* in_sizes, int n_in, void* d_out, int out_size, void* d_ws, size_t ws_size, hipStream_t stream) {
    Params p{};
    p.x_prompt = (const float*)d_in[0]; p.x_sample = (const float*)d_in[1]; p.cache_k = (const float*)d_in[2]; p.cache_v = (const float*)d_in[3];
    p.state_conv = (const float*)d_in[4]; p.state_hgrn = (const float*)d_in[5]; p.page_table = (const int*)d_in[6];
    p.w_in_even = (const float*)d_in[7]; p.conv_w = (const float*)d_in[8]; p.conv_b = (const float*)d_in[9]; p.conv_ln_g = (const float*)d_in[10]; p.conv_ln_b = (const float*)d_in[11];
    p.w_out_even = (const float*)d_in[12]; p.w_in_odd = (const float*)d_in[13]; p.lb_logits = (const float*)d_in[14]; p.hgrn_norm_g = (const float*)d_in[15]; p.w_out_odd = (const float*)d_in[16];
    p.ln_g = (const float*)d_in[17]; p.ln_b = (const float*)d_in[18]; p.peer_wq = (const float*)d_in[19]; p.peer_keys = (const float*)d_in[20]; p.peer_u = (const float*)d_in[21]; p.peer_v = (const float*)d_in[22];
    float* o = (float*)d_out;
    p.y_prompt = o; o += (size_t)TP * DM; p.y_sample = o; o += (size_t)TS * DM;
    p.k_prompt = o; o += (size_t)TP * 512; p.v_prompt = o; o += (size_t)TP * 512; p.k_sample = o; o += (size_t)TS * 512; p.v_sample = o; o += (size_t)TS * 512;
    p.conv_prompt = o; o += 2 * 30 * 512; p.conv_sample = o; o += 32 * 30 * 512; p.hgrn_prompt = o; o += 2 * 8 * 128 * 128; p.hgrn_sample = o;
    char* ws = (char*)d_ws; size_t off = 0;
    auto take = [&](size_t bytes) { char* r = ws + off; off += (bytes + 255) & ~(size_t)255; return r; };
    p.bar = (unsigned*)take(16384); p.LB = (float*)take(4096);
    p.WT_IN_EVEN = (bf16_t*)take((size_t)2560 * 1024 * 2); p.WT_OUT_EVEN = (bf16_t*)take((size_t)1024 * 1024 * 2);
    p.WT_IN_ODD = (bf16_t*)take((size_t)4096 * 1024 * 2); p.WT_OUT_ODD = (bf16_t*)take((size_t)1024 * 1024 * 2);
    p.WT_WQ = (bf16_t*)take((size_t)2 * 2048 * 1024 * 2); p.KB = (bf16_t*)take((size_t)2 * 2048 * 128 * 2);
    p.U8 = (unsigned char*)take((size_t)2 * 16384 * DM); p.V8 = (unsigned char*)take((size_t)2 * 16384 * DM); p.SU = (float*)take(2 * 16384 * 4); p.SV = (float*)take(2 * 16384 * 4);
    p.XB = (bf16_t*)take((size_t)MP * DM * 2);
    p.H = (bf16_t*)take((size_t)MP * 4096 * 2); p.LF = (_Float16*)take((size_t)MP * DM * 2);
    p.VT = (bf16_t*)take((size_t)16 * 64 * 8192 * 2); p.KMPP = (float*)take((size_t)512 * 512 * 4); p.KMS = (bf16_t*)take((size_t)1024 * 512 * 2);
    p.MIX = (bf16_t*)take((size_t)MP * DM * 2); p.T = (bf16_t*)take((size_t)MP * DM * 2);
    p.QH = (bf16_t*)take((size_t)MP * 2048 * 2); p.S = (float*)take((size_t)MP * 2048 * 4);
    p.E = (int*)take((size_t)MP * 128 * 4); p.G = (float*)take((size_t)MP * 128 * 4);
    p.UT = (bf16_t*)take((size_t)2048 * 16384 * 2); p.DEC = (float*)take((size_t)2048 * 128 * 4); p.ST = (bf16_t*)take((size_t)2048 * 16384 * 2);
    if (off > ws_size) { fprintf(stderr, "workspace too small: need %zu have %zu\n", off, ws_size); return; }

    static int grid = 0;
    if (!grid) {
        int dev = 0, cus = 0, per_cu = 0;
        (void)hipGetDevice(&dev);
        (void)hipDeviceGetAttribute(&cus, hipDeviceAttributeMultiprocessorCount, dev);
        (void)hipFuncSetAttribute((const void*)mega, hipFuncAttributeMaxDynamicSharedMemorySize, LDS_BYTES);
        (void)hipOccupancyMaxActiveBlocksPerMultiprocessor(&per_cu, (const void*)mega, NT, LDS_BYTES);
        grid = cus * (per_cu < 1 ? per_cu : 1);
        if (grid <= 0) { fprintf(stderr, "mega kernel not resident: cus %d per_cu %d\n", cus, per_cu); grid = 0; return; }
    }
    (void)hipMemsetAsync(p.bar, 0, XCD_BAR_WORDS * sizeof(unsigned), stream);
    hipLaunchKernelGGL(mega, dim3(grid), dim3(NT), LDS_BYTES, stream, p);
}
```

```cpp
#include <hip/hip_runtime.h>
#include <stdint.h>
#include <stdio.h>

#define DI __device__ __forceinline__
__device__ __forceinline__ int tid_opaque() { int t = threadIdx.x; asm volatile("" : "+v"(t)); return t; }
#define TIDX tid_opaque()
typedef unsigned short bf16_t;
typedef short bf16x8 __attribute__((ext_vector_type(8)));
typedef float f32x4 __attribute__((ext_vector_type(4)));
typedef unsigned u32x4 __attribute__((ext_vector_type(4)));
typedef unsigned u32x2 __attribute__((ext_vector_type(2)));
typedef int i32x4 __attribute__((ext_vector_type(4)));
typedef float f32x2 __attribute__((ext_vector_type(2)));

constexpr int NT = 512;
constexpr int TP = 16384, TS = 32, TT = TP + TS, MP = 16640, DM = 1024, SEQ = 8192;
constexpr float DN_ALPHA = 1.4142135623730951f;
constexpr float LN_EPS = 1e-5f, RMS_EPS = 1e-6f;
constexpr size_t OFF_KP = (size_t)TT * DM, OFF_VP = OFF_KP + (size_t)TP * 512, OFF_KS = OFF_VP + (size_t)TP * 512, OFF_VS = OFF_KS + (size_t)TS * 512;

DI float bf2f(bf16_t h) { return __uint_as_float(((unsigned)h) << 16); }
typedef __bf16 bf16x2_t __attribute__((ext_vector_type(2)));
DI unsigned pack_bf2(float lo, float hi) { bf16x2_t v; v[0] = (__bf16)lo; v[1] = (__bf16)hi; return __builtin_bit_cast(unsigned, v); }
DI bf16_t f2bf(float x) { return (bf16_t)(pack_bf2(x, 0.f) & 0xffffu); }
DI float bflo(unsigned u) { return __uint_as_float(u << 16); }
DI float bfhi(unsigned u) { return __uint_as_float(u & 0xffff0000u); }
DI float sigmoidf_(float x) { return 1.f / (1.f + __expf(-x)); }
DI float wave_sum(float v) {
#pragma unroll
    for (int o = 32; o >= 1; o >>= 1) v += __shfl_xor(v, o, 64);
    return v;
}
DI float wave_max(float v) {
#pragma unroll
    for (int o = 32; o >= 1; o >>= 1) v = fmaxf(v, __shfl_xor(v, o, 64));
    return v;
}

DI float red_max_16_32(float x) {
    u32x2 r = __builtin_amdgcn_permlane16_swap(__float_as_uint(x), __float_as_uint(x), false, false);
    x = fmaxf(__uint_as_float(r[0]), __uint_as_float(r[1]));
    r = __builtin_amdgcn_permlane32_swap(__float_as_uint(x), __float_as_uint(x), false, false);
    return fmaxf(__uint_as_float(r[0]), __uint_as_float(r[1]));
}
DI float red_sum_16_32(float x) {
    u32x2 r = __builtin_amdgcn_permlane16_swap(__float_as_uint(x), __float_as_uint(x), false, false);
    x = __uint_as_float(r[0]) + __uint_as_float(r[1]);
    r = __builtin_amdgcn_permlane32_swap(__float_as_uint(x), __float_as_uint(x), false, false);
    return __uint_as_float(r[0]) + __uint_as_float(r[1]);
}
#define MFMA16(a, b, c) __builtin_amdgcn_mfma_f32_16x16x32_bf16((a), (b), (c), 0, 0, 0)

#ifndef REP_PRO
#define REP_PRO 1
#endif
#ifndef REP_GEMM
#define REP_GEMM 1
#endif
#ifndef REP_CONV
#define REP_CONV 1
#endif
#ifndef REP_MOBAP
#define REP_MOBAP 1
#endif
#ifndef REP_MOBAS
#define REP_MOBAS 1
#endif
#ifndef REP_TOPK
#define REP_TOPK 1
#endif
#ifndef REP_PEER1
#define REP_PEER1 1
#endif
#ifndef REP_USW
#define REP_USW 1
#endif
#ifndef REP_VSW
#define REP_VSW 1
#endif
#ifndef REP_HGRN
#define REP_HGRN 1
#endif
#define REPEAT(N) _Pragma("unroll 1") for (int rep_ = 0; rep_ < (N); ++rep_)
struct Params {
    const float* x_prompt; const float* x_sample; const float* cache_k; const float* cache_v;
    const float* state_conv; const float* state_hgrn; const int* page_table;
    const float* w_in_even; const float* conv_w; const float* conv_b; const float* conv_ln_g; const float* conv_ln_b;
    const float* w_out_even; const float* w_in_odd; const float* lb_logits; const float* hgrn_norm_g; const float* w_out_odd;
    const float* ln_g; const float* ln_b; const float* peer_wq; const float* peer_keys; const float* peer_u; const float* peer_v;
    float* y_prompt; float* y_sample; float* k_prompt; float* v_prompt; float* k_sample; float* v_sample;
    float* conv_prompt; float* conv_sample; float* hgrn_prompt; float* hgrn_sample;
    unsigned* bar; float* LB;
    bf16_t* WT_IN_EVEN; bf16_t* WT_OUT_EVEN; bf16_t* WT_IN_ODD; bf16_t* WT_OUT_ODD; bf16_t* WT_WQ; bf16_t* KB;
    unsigned char* U8; unsigned char* V8; float* SU; float* SV;
    bf16_t* XB; bf16_t* H; _Float16* LF; bf16_t* VT; float* KMPP; bf16_t* KMS;
    bf16_t* MIX; bf16_t* T; bf16_t* QH; float* S; int* E; float* G;
    bf16_t* UT; float* DEC; bf16_t* ST;
};


#define XB_TMO      128
#define XB_XCNT(j)  (256  + 64 * (j))
#define XB_XSUB(j)  (1280 + 64 * (j))
#define XB_XGEN(j)  (2304 + 64 * (j))
#define XB_TOP      3328
#define XB_TOPGEN   3392
#define XCD_BAR_WORDS 3456
#define XB_SPIN_CAP (1u << 18)
#define LAS __attribute__((address_space(3)))
__device__ __forceinline__ unsigned xb_ld(unsigned* p)              { return __hip_atomic_load(p, __ATOMIC_RELAXED, __HIP_MEMORY_SCOPE_AGENT); }
__device__ __forceinline__ unsigned xb_add(unsigned* p, unsigned v) { return __hip_atomic_fetch_add(p, v, __ATOMIC_RELAXED, __HIP_MEMORY_SCOPE_AGENT); }
__device__ __forceinline__ unsigned xb_xcc_id() { return (unsigned)__builtin_amdgcn_s_getreg((3 << 11) | 20) & 0xFu; }
#define XB_SPIN(cond, bar) do { unsigned _sp = 0; while (cond) { __builtin_amdgcn_s_sleep(1); \
    if ((++_sp & 255u) == 0u) { if (xb_ld(&(bar)[XB_TMO])) break; if (_sp > XB_SPIN_CAP) { atomicAdd(&(bar)[XB_TMO], 1u); break; } } } } while (0)
struct XcdBarrier { unsigned* bar; unsigned x; volatile LAS unsigned* st; };
__device__ __forceinline__ XcdBarrier xcd_barrier_post(unsigned* bar, volatile LAS unsigned* st) {
    XcdBarrier b; b.bar = bar; b.x = xb_xcc_id(); b.st = st;
    if (threadIdx.x == 0) (void)xb_add(&bar[XB_XCNT(b.x)], 1u);
    return b;
}
__device__ __forceinline__ void xcd_barrier_complete(unsigned* bar, unsigned x, unsigned& nloc, unsigned& nx) {
    const unsigned G = gridDim.x * gridDim.y * gridDim.z;
    unsigned sum, cnt, mine, sp = 0u;
    for (;;) {
        sum = 0u; cnt = 0u; mine = 0u;
#pragma unroll
        for (unsigned j = 0; j < 16; ++j) { const unsigned c = xb_ld(&bar[XB_XCNT(j)]); sum += c; cnt += (c > 0u) ? 1u : 0u; mine = (j == x) ? c : mine; }
        if (sum == G) break;
        __builtin_amdgcn_s_sleep(1);
        if ((++sp & 255u) == 0u) { if (xb_ld(&bar[XB_TMO])) break; if (sp > XB_SPIN_CAP) { atomicAdd(&bar[XB_TMO], 1u); break; } }
    }
    nloc = mine > 0u ? mine : 1u; nx = cnt > 0u ? cnt : 1u;
}
__device__ __forceinline__ void xcd_barrier(const XcdBarrier& b) {
    asm volatile("s_waitcnt vmcnt(0)" ::: "memory");
    __syncthreads();
    if (threadIdx.x == 0) {
        unsigned* bar = b.bar;
        __builtin_amdgcn_s_waitcnt(0);
        unsigned nloc = b.st[0], nx = b.st[1];
        if (nloc == 0u) { xcd_barrier_complete(bar, b.x, nloc, nx); b.st[0] = nloc; b.st[1] = nx; }
        const unsigned old = xb_add(&bar[XB_XSUB(b.x)], 1u);
        const unsigned gen = old / nloc;
        if (old + 1u == (gen + 1u) * nloc) {
            __builtin_amdgcn_fence(__ATOMIC_RELEASE, "agent");
            asm volatile("s_waitcnt vmcnt(0)" ::: "memory");
            const unsigned og = xb_add(&bar[XB_TOP], 1u);
            const unsigned tg = og / nx;
            if (og + 1u == (tg + 1u) * nx) xb_add(&bar[XB_TOPGEN], 1u);
            else XB_SPIN(xb_ld(&bar[XB_TOPGEN]) == tg, bar);
            __builtin_amdgcn_fence(__ATOMIC_ACQUIRE, "agent");
            xb_add(&bar[XB_XGEN(b.x)], 1u);
            asm volatile("s_waitcnt vmcnt(0)" ::: "memory");
        } else {
            XB_SPIN(xb_ld(&bar[XB_XGEN(b.x)]) == gen, bar);
            __builtin_amdgcn_fence(__ATOMIC_ACQUIRE, "agent");
            asm volatile("s_waitcnt vmcnt(0)" ::: "memory");
        }
    }
    __syncthreads();
}

DI void transpose_unit(const float* __restrict__ W, int K, int N, bf16_t* __restrict__ Wt, int u, char* lds) {
    float* tile = (float*)lds;
    const int tid = TIDX;
    const int ntn = N >> 6; const int kt = u / ntn, nt = u % ntn;
#pragma unroll
    for (int i = 0; i < 8; ++i) { int idx = tid + NT * i; int r = idx >> 6, c = idx & 63; tile[r * 65 + c] = W[(size_t)(kt * 64 + r) * N + nt * 64 + c]; }
    __syncthreads();
#pragma unroll
    for (int i = 0; i < 8; ++i) { int idx = tid + NT * i; int r = idx >> 6, c = idx & 63; Wt[(size_t)(nt * 64 + r) * K + kt * 64 + c] = f2bf(tile[c * 65 + r]); }
    __syncthreads();
}
DI void convert_range(const float* __restrict__ src, bf16_t* __restrict__ dst, size_t n4, int bid, int nb) {
    for (size_t i = (size_t)bid * NT + TIDX; i < n4; i += (size_t)nb * NT) {
        f32x4 v = *(const f32x4*)(src + 4 * i);
        u32x2 o; o[0] = pack_bf2(v[0], v[1]); o[1] = pack_bf2(v[2], v[3]);
        *(u32x2*)(dst + 4 * i) = o;
    }
}

template <int OFFS> DI void quant_rows(const float* __restrict__ src, unsigned char* __restrict__ dst, float* __restrict__ inv, int R, int bid, int nb) {
    const int lane = TIDX & 63, w = TIDX >> 6;
#pragma unroll 2
    for (int row = bid * 8 + w; row < R; row += nb * 8) {
        f32x4 v[4]; float am = 0.f;
#pragma unroll
        for (int i = 0; i < 4; ++i) { v[i] = *(const f32x4*)(src + (size_t)row * DM + 4 * lane + 256 * i); am = fmaxf(am, fmaxf(fmaxf(fabsf(v[i][0]), fabsf(v[i][1])), fmaxf(fabsf(v[i][2]), fabsf(v[i][3])))); }
        am = wave_max(am);
        const float sc = am > 0.f ? 127.f / am : 0.f;
#pragma unroll
        for (int i = 0; i < 4; ++i) {
            unsigned pk = 0;
#pragma unroll
            for (int k = 0; k < 4; ++k) { const int q = (int)rintf(v[i][k] * sc) + OFFS; pk |= ((unsigned)q & 0xffu) << (8 * k); }
            const int col = 4 * lane + 256 * i;
            *(unsigned*)(dst + (size_t)(row >> 14) * 16384 * DM + (size_t)(col >> 7) * (16384 * 128) + (size_t)(row & 16383) * 128 + (col & 127)) = pk;
        }
        if (lane == 0) inv[row] = am * (1.f / 127.f);
    }
}
DI void quant_rows_fp8(const float* __restrict__ src, unsigned char* __restrict__ dst, float* __restrict__ inv, int R, int bid, int nb) {
    const int lane = TIDX & 63, w = TIDX >> 6;
#pragma unroll 2
    for (int row = bid * 8 + w; row < R; row += nb * 8) {
        f32x4 v[4]; float am = 0.f;
#pragma unroll
        for (int i = 0; i < 4; ++i) { v[i] = *(const f32x4*)(src + (size_t)row * DM + 4 * lane + 256 * i); am = fmaxf(am, fmaxf(fmaxf(fabsf(v[i][0]), fabsf(v[i][1])), fmaxf(fabsf(v[i][2]), fabsf(v[i][3])))); }
        am = wave_max(am);
        const float sc = am > 0.f ? 416.f / am : 0.f;
#pragma unroll
        for (int i = 0; i < 4; ++i) {
            int pk = 0;
            pk = __builtin_amdgcn_cvt_pk_fp8_f32(v[i][0] * sc, v[i][1] * sc, pk, false);
            pk = __builtin_amdgcn_cvt_pk_fp8_f32(v[i][2] * sc, v[i][3] * sc, pk, true);
            const int col = 4 * lane + 256 * i;
            *(int*)(dst + (size_t)(row >> 14) * 16384 * DM + (size_t)(col >> 7) * (16384 * 128) + (size_t)(row & 16383) * 128 + (col & 127)) = pk;
        }
        if (lane == 0) inv[row] = am * (1.f / 416.f);
    }
}
DI void convert_x(const Params& p, int bid, int nb) {
    const size_t n4 = (size_t)MP * DM / 4;
    for (size_t i = (size_t)bid * NT + TIDX; i < n4; i += (size_t)nb * NT) {
        size_t e = 4 * i; int row = (int)(e >> 10); int col = (int)(e & 1023);
        f32x4 v = {0.f, 0.f, 0.f, 0.f};
        if (row < TP) v = *(const f32x4*)(p.x_prompt + e);
        else if (row < TT) v = *(const f32x4*)(p.x_sample + (size_t)(row - TP) * DM + col);
        u32x2 o; o[0] = pack_bf2(v[0], v[1]); o[1] = pack_bf2(v[2], v[3]);
        *(u32x2*)(p.XB + e) = o;
    }
}
DI void convert_keys(const Params& p, int bid, int nb) {
    const int n = 2 * 2 * 8 * 128 * 128;
    for (int i = bid * NT + TIDX; i < n; i += nb * NT) {
        int d = i & 127, nn = (i >> 7) & 127, j = (i >> 14) & 15, l = i >> 18;
        int h = j >> 1, half = j & 1;
        p.KB[i] = f2bf(p.peer_keys[((((size_t)l * 2 + half) * 8 + h) * 128 + nn) * 128 + d]);
    }
    if (bid == 0) for (int c = TIDX; c < 1024; c += NT) p.LB[c] = sigmoidf_(p.lb_logits[1024 + c] - p.lb_logits[c]);
}
DI void kmean_sample_unit(const Params& p, int u, char* lds) {
    float* part = (float*)lds;
    const int tid = TIDX, c4 = tid & 127, rg = tid >> 7;
    const int b = u >> 5, blk = u & 31;
    f32x4 acc = {0.f, 0.f, 0.f, 0.f};
    const int page = p.page_table[b * 64 + blk * 2 + (rg >> 1)];
    const float* src = p.cache_k + ((size_t)page * 128 + (rg & 1) * 64) * 512 + 4 * c4;
#pragma unroll 1
    for (int r0 = 0; r0 < 64; r0 += 8) {
        f32x4 v[8];
#pragma unroll
        for (int i = 0; i < 8; ++i) v[i] = *(const f32x4*)(src + (size_t)(r0 + i) * 512);
#pragma unroll
        for (int i = 0; i < 8; ++i) acc += v[i];
    }
    __syncthreads();
    *(f32x4*)(part + rg * 512 + 4 * c4) = acc;
    __syncthreads();
    { const int c = tid; const float sum = part[c] + part[512 + c] + part[1024 + c] + part[1536 + c]; p.KMS[(size_t)u * 512 + c] = f2bf(sum * (1.f / 256.f)); }
}
DI void kmean_prompt_unit(const Params& p, int u) {
    const int c = TIDX;
    const float* src = p.k_prompt + (size_t)u * 32 * 512 + c;
    float acc = 0.f;
#pragma unroll
    for (int r = 0; r < 32; ++r) acc += src[(size_t)r * 512];
    p.KMPP[(size_t)u * 512 + c] = acc;
}

struct GemmArgs { const bf16_t* A; int lda; const bf16_t* Bt; int ldb; int K; int blockdiag; };
constexpr int GEMM_LDS = 2 * 49152;

template <class Epi>
DI void gemm_unit(const GemmArgs g, int m0, int n0, const Epi epi, char* lds) {
    const int tid = TIDX, lane = tid & 63, w = tid >> 6;
    const int wm = w & 3, wn = w >> 2, lr = lane & 15, lg = lane >> 4;
    const int acol = g.blockdiag ? n0 : 0;
    const int nk = g.K >> 6;
    f32x4 acc[4][4];
#pragma unroll
    for (int i = 0; i < 4; ++i)
#pragma unroll
        for (int j = 0; j < 4; ++j) acc[i][j] = (f32x4){0.f, 0.f, 0.f, 0.f};
    u32x4 ra[4], rb[2];
    auto gload = [&](int kt) {
#pragma unroll
        for (int i = 0; i < 4; ++i) { int id = tid + NT * i; int r = id >> 3, c = id & 7; ra[i] = *(const u32x4*)(g.A + (size_t)(m0 + r) * g.lda + acol + kt * 64 + c * 8); }
#pragma unroll
        for (int i = 0; i < 2; ++i) { int id = tid + NT * i; int r = id >> 3, c = id & 7; rb[i] = *(const u32x4*)(g.Bt + (size_t)(n0 + r) * g.ldb + kt * 64 + c * 8); }
    };
    auto sstore = [&](int st) {
        char* base = lds + st * 49152;
#pragma unroll
        for (int i = 0; i < 4; ++i) { int id = tid + NT * i; int r = id >> 3, c = id & 7; *(u32x4*)(base + r * 128 + ((c ^ (r & 7)) << 4)) = ra[i]; }
#pragma unroll
        for (int i = 0; i < 2; ++i) { int id = tid + NT * i; int r = id >> 3, c = id & 7; *(u32x4*)(base + 32768 + r * 128 + ((c ^ (r & 7)) << 4)) = rb[i]; }
    };
    gload(0); sstore(0); __syncthreads();
    for (int kt = 0; kt < nk; ++kt) {
        if (kt + 1 < nk) gload(kt + 1);
        const char* base = lds + (kt & 1) * 49152;
#pragma unroll
        for (int ks = 0; ks < 2; ++ks) {
            bf16x8 af[4], bfr[4];
#pragma unroll
            for (int i = 0; i < 4; ++i) { int r = wm * 64 + i * 16 + lr; int ch = ks * 4 + lg; af[i] = *(const bf16x8*)(base + r * 128 + ((ch ^ (r & 7)) << 4)); }
#pragma unroll
            for (int i = 0; i < 4; ++i) { int r = wn * 64 + i * 16 + lr; int ch = ks * 4 + lg; bfr[i] = *(const bf16x8*)(base + 32768 + r * 128 + ((ch ^ (r & 7)) << 4)); }
#pragma unroll
            for (int i = 0; i < 4; ++i)
#pragma unroll
                for (int j = 0; j < 4; ++j) acc[i][j] = MFMA16(bfr[j], af[i], acc[i][j]);
        }
        if (kt + 1 < nk) sstore((kt + 1) & 1);
        __syncthreads();
    }
#pragma unroll
    for (int i = 0; i < 4; ++i)
#pragma unroll
        for (int j = 0; j < 4; ++j) epi(m0 + wm * 64 + i * 16 + lr, n0 + wn * 64 + j * 16 + 4 * lg, acc[i][j]);
}

template <class Epi>
DI void gemm_phase(const GemmArgs g, int M, int N, const Epi epi, char* lds, int bid, int nb) {
    const int tn = N >> 7, tm = M >> 8;
    for (int u = bid; u < tm * tn; u += nb) { int mt = u / tn, nt = u % tn; gemm_unit(g, mt * 256, nt * 128, epi, lds); }
}

DI f32x4 ld_bf4(const bf16_t* src) { const u32x2 w = *(const u32x2*)src; return (f32x4){bflo(w[0]), bfhi(w[0]), bflo(w[1]), bfhi(w[1])}; }
DI void store_bf4(bf16_t* dst, f32x4 v) { u32x2 o; o[0] = pack_bf2(v[0], v[1]); o[1] = pack_bf2(v[2], v[3]); *(u32x2*)dst = o; }

struct EpiInEven {
    bf16_t* H; float* out; bf16_t* VT;
    DI void operator()(int row, int col, f32x4 v) const {
        store_bf4(H + (size_t)row * 2560 + col, v);
        if (col >= 512 && col < 1536 && row < TT) {
            const bool isv = col >= 1024; const int c = col - (isv ? 1024 : 512);
            const size_t off = row < TP ? (isv ? OFF_VP : OFF_KP) + (size_t)row * 512 + c : (isv ? OFF_VS : OFF_KS) + (size_t)(row - TP) * 512 + c;
            *(f32x4*)(out + off) = v;
            if (isv && row < TP) {
                const int b = row >> 13, s = row & 8191, h = c >> 6, d = c & 63;
                bf16_t* vt = VT + ((size_t)(b * 8 + h) * 64 + d) * 8192 + s;
#pragma unroll
                for (int i = 0; i < 4; ++i) vt[(size_t)i * 8192] = f2bf(v[i]);
            }
        }
    }
};
struct EpiBf16 { bf16_t* O; int ld; DI void operator()(int row, int col, f32x4 v) const { store_bf4(O + (size_t)row * ld + col, v); } };
struct EpiF32 { float* O; int ld; DI void operator()(int row, int col, f32x4 v) const { *(f32x4*)(O + (size_t)row * ld + col) = v; } };
struct EpiResid {
    bf16_t* T; const bf16_t* XB;
    DI void operator()(int row, int col, f32x4 v) const { const f32x4 x = ld_bf4(XB + (size_t)row * DM + col); store_bf4(T + (size_t)row * DM + col, x * DN_ALPHA + v); }
};
struct EpiInOdd {
    bf16_t* H; _Float16* LF; const float* LB;
    DI void operator()(int row, int col, f32x4 v) const {
        const int sec = col >> 10, c = col & 1023;
        if (sec == 1) {
            f32x4 lb = *(const f32x4*)(LB + c); f32x4 lf, kk;
#pragma unroll
            for (int i = 0; i < 4; ++i) { float f = lb[i] + (1.f - lb[i]) * sigmoidf_(v[i]); lf[i] = __logf(f); kk[i] = 1.f - f; }
            { typedef _Float16 h4 __attribute__((ext_vector_type(4))); h4 hv; hv[0] = (_Float16)lf[0]; hv[1] = (_Float16)lf[1]; hv[2] = (_Float16)lf[2]; hv[3] = (_Float16)lf[3]; *(h4*)(LF + (size_t)row * DM + c) = hv; }
            store_bf4(H + (size_t)MP * DM + (size_t)row * DM + c, kk);
        } else {
            store_bf4(H + (size_t)sec * MP * DM + (size_t)row * DM + c, v);
        }
    }
};

namespace pg8 {
#define PG8_LAS __attribute__((address_space(3)))
typedef unsigned short bf16_t;
typedef short bf16x8 __attribute__((ext_vector_type(8)));
typedef float f32x4 __attribute__((ext_vector_type(4)));
typedef unsigned u32x4 __attribute__((ext_vector_type(4)));
constexpr int BM = 256, BK = 64, HALF = 128, HTB = HALF * BK * 2  , STAGE_BYTES = 8 * HTB, NXCD = 8, WGM = 8;

__host__ __device__ __forceinline__ int lds_byte(int r, int c) { const int st = (r >> 4) * 2 + (c >> 5), rr = r & 15, cc = c & 31, ob = rr * 64 + cc * 2; return st * 1024 + (ob ^ (((ob >> 9) & 1) << 5)); }
__host__ __device__ __forceinline__ void stage_rc(int b, int& R, int& C) { const int st = b / 1024, sb = b % 1024, swz = sb ^ (((sb >> 9) & 1) << 5); R = (st >> 1) * 16 + swz / 64; C = (st & 1) * 32 + (swz % 64) / 2; }
__host__ __device__ __forceinline__ int perm32(int rho) { const int n = rho >> 4, i = rho & 15; return 8 * (i >> 2) + 4 * n + (i & 3); }

struct Unit { int pm, pn; };
struct Gemm { const bf16_t* A; const bf16_t* Bt; int M, N, K; };

struct StaticOrder {
    int nM, nN, nwg, G, c;
    __host__ __device__ void init(int M, int N, int G_, int c_) { nM = M / BM; nN = N / BM; nwg = nM * nN; G = G_; c = c_; }
    __host__ __device__ bool next(int i, Unit& u) const {
        const long L = (long)i * G + c; if (L >= nwg) return false;
        int wgid = (int)L; { const int q = nwg / NXCD, r = nwg % NXCD, xcd = wgid % NXCD, off = wgid / NXCD; wgid = (xcd < r ? xcd * (q + 1) : r * (q + 1) + (xcd - r) * q) + off; }
        const int nig = WGM * nN, gid = wgid / nig, fm = gid * WGM, gsz = (nM - fm) < WGM ? (nM - fm) : WGM;
        u.pm = fm + ((wgid % nig) % gsz); u.pn = (wgid % nig) / gsz; return true;
    }
    __device__ __forceinline__ void a_ready(const Unit&) const {}
    __device__ __forceinline__ void done(const Unit&) const {}
};

template <class Epi, class Sched, bool STAMP = false>
__device__ __forceinline__ void gemm_phase(PG8_LAS unsigned char* lds, const Gemm g, const Sched& S, const Epi& E, unsigned long long* stamps) {
    const int tid = TIDX, wid = __builtin_amdgcn_readfirstlane(tid >> 6), lane = tid & 63, wr = wid >> 2, wc = wid & 3, fr = lane & 15, fq = lane >> 4;
    const int K = g.K, nt = K / BK;
    int ts_lo = 0, ts_hi = 0, nts = 0; const unsigned long long rt_entry = STAMP ? (unsigned long long)wall_clock64() : 0ull;
#define PG8_STAMP() do { if (STAMP && wid == 0 && nts < 64) { const unsigned long long _c = (unsigned long long)clock64(); \
        ts_lo = (lane == nts) ? (int)(unsigned)_c : ts_lo; ts_hi = (lane == nts) ? (int)(unsigned)(_c >> 32) : ts_hi; ++nts; } } while (0)
    PG8_STAMP();
    unsigned voffA[2], voffB[2];
#pragma unroll
    for (int i = 0; i < 2; ++i) { int R, C; stage_rc(tid * 16 + i * 8192, R, C); const int Rb = Epi::PERM ? ((R & ~31) + perm32(R & 31)) : R;
        voffA[i] = (unsigned)(R * K + C) * 2u; voffB[i] = (unsigned)(Rb * K + C) * 2u; }
    const size_t kstep = (size_t)(BK * 2);
    const size_t hstep = (size_t)HALF * K * 2;
    const size_t tstep = 2 * hstep;
    const unsigned ldsw = (unsigned)wid * 1024u;
    const int aoff = lds_byte(wr * 64 + fr, fq * 8), boff = lds_byte(wc * 32 + fr, fq * 8);
#define PG8_SA(b, h) (((b) * 2 + (h)) * HTB)
#define PG8_SB(b, h) ((4 + (b) * 2 + (h)) * HTB)
#define PG8_STAGE(bufoff, gbase, voff) do { _Pragma("unroll") for (int _i = 0; _i < 2; ++_i) \
        __builtin_amdgcn_global_load_lds((const unsigned*)((const char*)(gbase) + (voff)[_i]), (PG8_LAS unsigned*)(lds + (bufoff) + ldsw + _i * 8192), 16, 0, 0); } while (0)
#define PG8_LDA(dst, b, h) do { _Pragma("unroll") for (int m = 0; m < 4; ++m) _Pragma("unroll") for (int k = 0; k < 2; ++k) dst[m][k] = *(const PG8_LAS bf16x8*)(lds + PG8_SA(b, h) + aoff + m * 2048 + k * 1024); } while (0)
#define PG8_LDB(dst, b, h) do { _Pragma("unroll") for (int n = 0; n < 2; ++n) _Pragma("unroll") for (int k = 0; k < 2; ++k) dst[n][k] = *(const PG8_LAS bf16x8*)(lds + PG8_SB(b, h) + boff + n * 2048 + k * 1024); } while (0)
#define PG8_MMA(ai, bj, At, Bt) do { __builtin_amdgcn_s_setprio(1); _Pragma("unroll") for (int m = 0; m < 4; ++m) _Pragma("unroll") for (int n = 0; n < 2; ++n) _Pragma("unroll") for (int k = 0; k < 2; ++k) \
        acc[ai][bj][m][n] = __builtin_amdgcn_mfma_f32_16x16x32_bf16(Bt[n][k], At[m][k], acc[ai][bj][m][n], 0, 0, 0); __builtin_amdgcn_s_setprio(0); } while (0)
#define PG8_WAIT_V(n) asm volatile("s_waitcnt vmcnt(" #n ")" ::: "memory")
#define PG8_WAIT_L(n) asm volatile("s_waitcnt lgkmcnt(" #n ")" ::: "memory")
#define PG8_BAR __builtin_amdgcn_s_barrier()
#define PG8_SCHED __builtin_amdgcn_sched_barrier(0)
    Unit cur, nxt; int ui = 0;
    if (!S.next(0, cur)) return;
    f32x4 acc[2][2][4][2];
#pragma unroll
    for (int a = 0; a < 2; ++a)
#pragma unroll
        for (int b = 0; b < 2; ++b)
#pragma unroll
            for (int m = 0; m < 4; ++m)
#pragma unroll
                for (int n = 0; n < 2; ++n) acc[a][b][m][n] = (f32x4){0.f, 0.f, 0.f, 0.f};
    bf16x8 At[4][2], B0[2][2], B1[2][2];
    const char* cA = (const char*)g.A + (size_t)cur.pm * tstep; const char* cB = (const char*)g.Bt + (size_t)cur.pn * tstep;
    S.a_ready(cur);
    PG8_STAGE(PG8_SB(0, 0), cB, voffB); PG8_STAGE(PG8_SA(0, 0), cA, voffA); PG8_STAGE(PG8_SB(0, 1), cB + hstep, voffB); PG8_STAGE(PG8_SA(0, 1), cA + hstep, voffA);
    if (wr == 1) PG8_BAR;
    PG8_WAIT_V(4); PG8_BAR;
    PG8_STAGE(PG8_SB(1, 0), cB + kstep, voffB); PG8_STAGE(PG8_SA(1, 0), cA + kstep, voffA); PG8_STAGE(PG8_SB(1, 1), cB + hstep + kstep, voffB);
    PG8_WAIT_V(6); PG8_BAR;
    PG8_STAMP();
    for (;;) {
        const bool has_next = S.next(ui + 1, nxt);
        const char* nA = has_next ? (const char*)g.A + (size_t)nxt.pm * tstep : cA; const char* nB = has_next ? (const char*)g.Bt + (size_t)nxt.pn * tstep : cB;
        for (int t = 0; t < nt; t += 2) {
            const bool last = (t == nt - 2);
            const char* a1 = cA + (size_t)(t + 1) * kstep;
            const char* a2 = last ? nA : cA + (size_t)(t + 2) * kstep; const char* b2 = last ? nB : cB + (size_t)(t + 2) * kstep;
            const char* a3 = a2 + kstep; const char* b3 = b2 + kstep;
            if (last && has_next) S.a_ready(nxt);
            PG8_LDB(B0, 0, 0); PG8_SCHED; PG8_LDA(At, 0, 0); PG8_STAGE(PG8_SA(1, 1), a1 + hstep, voffA);
            PG8_WAIT_L(8); PG8_BAR; PG8_WAIT_L(0); PG8_MMA(0, 0, At, B0); PG8_BAR; PG8_SCHED;
            PG8_LDB(B1, 0, 1); PG8_STAGE(PG8_SB(0, 0), b2, voffB);
            PG8_BAR; PG8_WAIT_L(0); PG8_MMA(0, 1, At, B1); PG8_BAR;
            PG8_LDA(At, 0, 1); PG8_STAGE(PG8_SA(0, 0), a2, voffA);
            PG8_BAR; PG8_WAIT_L(0); PG8_MMA(1, 0, At, B0); PG8_BAR; PG8_SCHED;
            PG8_STAGE(PG8_SB(0, 1), b2 + hstep, voffB);
            PG8_WAIT_V(6); PG8_BAR; PG8_MMA(1, 1, At, B1); PG8_BAR;
            PG8_LDB(B0, 1, 0); PG8_SCHED; PG8_LDA(At, 1, 0); PG8_STAGE(PG8_SA(0, 1), a2 + hstep, voffA);
            PG8_WAIT_L(8); PG8_BAR; PG8_WAIT_L(0); PG8_MMA(0, 0, At, B0); PG8_BAR; PG8_SCHED;
            PG8_LDB(B1, 1, 1); PG8_STAGE(PG8_SB(1, 0), b3, voffB);
            PG8_BAR; PG8_WAIT_L(0); PG8_MMA(0, 1, At, B1); PG8_BAR;
            PG8_LDA(At, 1, 1); PG8_STAGE(PG8_SA(1, 0), a3, voffA);
            PG8_BAR; PG8_WAIT_L(0); PG8_MMA(1, 0, At, B0); PG8_BAR; PG8_SCHED;
            PG8_STAGE(PG8_SB(1, 1), b3 + hstep, voffB);
            PG8_WAIT_V(6); PG8_BAR; PG8_MMA(1, 1, At, B1); PG8_BAR;
        }
        PG8_STAMP();
        if constexpr (!Epi::AFTER_DRAIN) { E(acc, cur, wr, wc, fr, fq); S.done(cur); }
        PG8_STAMP();
        if (!has_next) break;
#pragma unroll
        for (int a = 0; a < 2; ++a)
#pragma unroll
            for (int b = 0; b < 2; ++b)
#pragma unroll
                for (int m = 0; m < 4; ++m)
#pragma unroll
                    for (int n = 0; n < 2; ++n) acc[a][b][m][n] = (f32x4){0.f, 0.f, 0.f, 0.f};
        cur = nxt; cA = nA; cB = nB; ++ui;
    }
    PG8_WAIT_V(0);
    if (wr == 0) PG8_BAR;
    PG8_BAR;
    if constexpr (Epi::AFTER_DRAIN) { E.fused(acc, cur, wr, wc, fr, fq, lds, wid, lane); S.done(cur); }
    PG8_STAMP();
    if (STAMP && wid == 0) { stamps[lane] = lane < nts ? (((unsigned long long)(unsigned)ts_hi << 32) | (unsigned)ts_lo) : 0ull;
        if (lane == 62) stamps[62] = rt_entry; if (lane == 63) stamps[63] = (unsigned long long)wall_clock64(); }
#undef PG8_STAMP
#undef PG8_SA
#undef PG8_SB
#undef PG8_STAGE
#undef PG8_LDA
#undef PG8_LDB
#undef PG8_MMA
#undef PG8_WAIT_V
#undef PG8_WAIT_L
#undef PG8_BAR
#undef PG8_SCHED
}
}

template <class MyEpi> struct Pg8Epi {
    static constexpr bool PERM = false, AFTER_DRAIN = false;
    MyEpi e;
    __device__ __forceinline__ void operator()(const pg8::f32x4 (&acc)[2][2][4][2], const pg8::Unit& u, int wr, int wc, int fr, int fq) const {
#pragma unroll
        for (int ai = 0; ai < 2; ++ai)
#pragma unroll
            for (int m = 0; m < 4; ++m) {
                const int row = u.pm * 256 + ai * 128 + wr * 64 + m * 16 + fr;
#pragma unroll
                for (int bj = 0; bj < 2; ++bj)
#pragma unroll
                    for (int n = 0; n < 2; ++n) e(row, u.pn * 256 + bj * 128 + wc * 32 + n * 16 + 4 * fq, acc[ai][bj][m][n]);
            }
    }
};

template <class E> DI void gemm_small32_unit(const bf16_t* A, int lda, const bf16_t* Bt, int ldb, int K, int m0, int n0, const E epi) {
    const int tid = TIDX, lane = tid & 63, w = tid >> 6, lr = lane & 15, lg = lane >> 4;
    const bf16_t* a0 = A + (size_t)(m0 + lr) * lda + lg * 8; const bf16_t* a1 = a0 + (size_t)16 * lda;
    const bf16_t* b0 = Bt + (size_t)(n0 + w * 16 + lr) * ldb + lg * 8;
    f32x4 acc0 = {0.f, 0.f, 0.f, 0.f}, acc1 = {0.f, 0.f, 0.f, 0.f};
#pragma unroll 2
    for (int k0 = 0; k0 < K; k0 += 128) {
        bf16x8 fa0[4], fa1[4], fb[4];
#pragma unroll
        for (int i = 0; i < 4; ++i) { fa0[i] = *(const bf16x8*)(a0 + k0 + i * 32); fa1[i] = *(const bf16x8*)(a1 + k0 + i * 32); fb[i] = *(const bf16x8*)(b0 + k0 + i * 32); }
#pragma unroll
        for (int i = 0; i < 4; ++i) { acc0 = MFMA16(fb[i], fa0[i], acc0); acc1 = MFMA16(fb[i], fa1[i], acc1); }
    }
    epi(m0 + lr, n0 + w * 16 + 4 * lg, acc0);
    epi(m0 + 16 + lr, n0 + w * 16 + 4 * lg, acc1);
}
template <class E> DI void gemm_big(const bf16_t* A, const bf16_t* Bt, int N, const E epi, char* lds, int bid, int nb) {
    {
        pg8::Gemm g{A, Bt, TP, N, DM};
        pg8::StaticOrder S; S.init(TP, N, nb, bid);
        Pg8Epi<E> pe{epi};
        pg8::gemm_phase<Pg8Epi<E>, pg8::StaticOrder, false>((PG8_LAS unsigned char*)lds, g, S, pe, nullptr);
    }
    __syncthreads();
    for (int u = nb - 1 - bid; u < (N >> 7); u += nb) gemm_small32_unit(A, DM, Bt, DM, DM, TP, u * 128, epi);
}

DI void conv_unit(const Params& p, int u, char* lds) {
    float* sy = (float*)lds;
    const int c = TIDX, lane = c & 63, w = c >> 6;
    float wj[31];
#pragma unroll
    for (int j = 0; j < 31; ++j) wj[j] = p.conv_w[j * 512 + c];
    const float bias = p.conv_b[c];
    int ntok, row0;
    if (u < 512) {
        const int b = u >> 8, t0 = (u & 255) * 32; ntok = 32; row0 = b * SEQ + t0;
        float uu[62];
#pragma unroll
        for (int r = 0; r < 62; ++r) {
            const int t = t0 - 30 + r; float val = 0.f;
            if (t >= 0) { const size_t row = (size_t)b * SEQ + t; float a = bf2f(p.H[row * 2560 + 1536 + c]); float g = bf2f(p.H[row * 2560 + 2048 + c]); val = a * sigmoidf_(g); }
            uu[r] = val;
            if (t0 == SEQ - 32 && r >= 32) p.conv_prompt[((size_t)b * 30 + (r - 32)) * 512 + c] = val;
        }
#pragma unroll
        for (int tt = 0; tt < 32; ++tt) {
            float acc = bias;
#pragma unroll
            for (int j = 0; j < 31; ++j) acc += wj[j] * uu[tt + j];
            sy[tt * 512 + c] = acc;
        }
    } else {
        const int b = u - 512; ntok = 1; row0 = TP + b;
        const size_t row = (size_t)row0;
        float a = bf2f(p.H[row * 2560 + 1536 + c]); float g = bf2f(p.H[row * 2560 + 2048 + c]);
        const float un = a * sigmoidf_(g);
        float acc = bias + wj[30] * un;
#pragma unroll
        for (int j = 0; j < 30; ++j) {
            float e = p.state_conv[((size_t)b * 30 + j) * 512 + c]; acc += wj[j] * e;
            if (j >= 1) p.conv_sample[((size_t)b * 30 + (j - 1)) * 512 + c] = e;
        }
        p.conv_sample[((size_t)b * 30 + 29) * 512 + c] = un;
        sy[c] = acc;
    }
    __syncthreads();
    for (int tt = w; tt < ntok; tt += 8) {
        float v[8]; float s = 0.f;
#pragma unroll
        for (int i = 0; i < 8; ++i) { v[i] = sy[tt * 512 + lane + 64 * i]; s += v[i]; }
        const float mu = wave_sum(s) * (1.f / 512.f);
        float q = 0.f;
#pragma unroll
        for (int i = 0; i < 8; ++i) { float d = v[i] - mu; q += d * d; }
        const float rs = rsqrtf(wave_sum(q) * (1.f / 512.f) + LN_EPS);
#pragma unroll
        for (int i = 0; i < 8; ++i) {
            const int cc = lane + 64 * i;
            float y = (v[i] - mu) * rs * p.conv_ln_g[cc] + p.conv_ln_b[cc];
            y = y * sigmoidf_(y);
            p.MIX[(size_t)(row0 + tt) * DM + 512 + cc] = f2bf(y);
        }
    }
    __syncthreads();
}

constexpr int MB_K = 0, MB_V = 65536, MB_VROW = 528, MB_WOR = 65536 + 2 * 64 * MB_VROW;
constexpr int MB_BGS = MB_WOR + 128, MB_KMS = MB_BGS + 2 * 8192, MB_END = MB_KMS + 8192;
DI void moba_sample_unit(const Params& p, int u, char* lds) {
    float* sq = (float*)lds;
    float* gs = sq + 64;
    int* sel = (int*)(gs + 32);
    float* lg = (float*)(sel + 4);
    float* red = lg + 776;
    unsigned* roff = (unsigned*)(red + 16);
    float* part = (float*)(roff + 776);
    const int tid = TIDX, lane = tid & 63, w = tid >> 6;
    const int b = u >> 3, h = u & 7; const size_t row = (size_t)TP + b;
    __syncthreads();
    if (tid < 64) sq[tid] = bf2f(p.H[row * 2560 + h * 64 + tid]);
    __syncthreads();
    if (tid < 32) { const float* km = (const float*)(lds + MB_KMS) + tid * 64; float s = 0.f;
#pragma unroll 8
        for (int d = 0; d < 64; ++d) s += sq[d] * km[d];
        gs[tid] = s; }
    __syncthreads();
    if (tid == 0) {
        float v0 = -INFINITY, v1 = -INFINITY, v2 = -INFINITY; int i0 = 0, i1 = 0, i2 = 0;
        for (int j = 0; j < 32; ++j) { float s = gs[j];
            if (s > v0) { v2 = v1; i2 = i1; v1 = v0; i1 = i0; v0 = s; i0 = j; }
            else if (s > v1) { v2 = v1; i2 = i1; v1 = s; i1 = j; }
            else if (s > v2) { v2 = s; i2 = j; } }
        sel[0] = i0; sel[1] = i1; sel[2] = i2;
    }
    __syncthreads();
    for (int idx = tid; idx < 769; idx += NT) {
        float s = 0.f;
        if (idx < 768) {
            const int blk = sel[idx >> 8]; const int pos = blk * 256 + (idx & 255);
            const int page = p.page_table[b * 64 + (pos >> 7)];
            const unsigned ro = ((unsigned)page * 128u + (unsigned)(pos & 127)) * 8u + (unsigned)h;
            roff[idx] = ro;
            const float* kp = p.cache_k + (size_t)ro * 64;
            f32x4 kv[16];
#pragma unroll
            for (int d4 = 0; d4 < 16; ++d4) kv[d4] = *(const f32x4*)(kp + 4 * d4);
#pragma unroll
            for (int d4 = 0; d4 < 16; ++d4) s += sq[4 * d4] * kv[d4][0] + sq[4 * d4 + 1] * kv[d4][1] + sq[4 * d4 + 2] * kv[d4][2] + sq[4 * d4 + 3] * kv[d4][3];
        } else {
            const bf16_t* kn = p.H + row * 2560 + 512 + h * 64;
            for (int d = 0; d < 64; ++d) s += sq[d] * bf2f(kn[d]);
        }
        lg[idx] = s * 0.125f;
    }
    __syncthreads();
    float mx = -INFINITY;
    for (int idx = tid; idx < 769; idx += NT) mx = fmaxf(mx, lg[idx]);
    mx = wave_max(mx); if (lane == 0) red[w] = mx;
    __syncthreads();
    mx = red[0];
#pragma unroll
    for (int i = 1; i < 8; ++i) mx = fmaxf(mx, red[i]);
    float sm = 0.f;
    for (int idx = tid; idx < 769; idx += NT) { float e = __expf(lg[idx] - mx); lg[idx] = e; sm += e; }
    sm = wave_sum(sm); if (lane == 0) red[8 + w] = sm;
    __syncthreads();
    sm = 0.f;
#pragma unroll
    for (int i = 0; i < 8; ++i) sm += red[8 + i];
    {
        const int d4 = tid & 15, kg = tid >> 4;
        f32x4 acc = {0.f, 0.f, 0.f, 0.f};
#pragma unroll
        for (int i0 = 0; i0 < 24; i0 += 8) {
            f32x4 vv[8]; float pp[8];
#pragma unroll
            for (int i = 0; i < 8; ++i) { const int idx = kg + 32 * (i0 + i); pp[i] = lg[idx]; vv[i] = *(const f32x4*)(p.cache_v + (size_t)roff[idx] * 64 + 4 * d4); }
#pragma unroll
            for (int i = 0; i < 8; ++i) acc += vv[i] * pp[i];
        }
        if (kg == 0) {
            const bf16_t* vn = p.H + row * 2560 + 1024 + h * 64 + 4 * d4; const float pn = lg[768];
            acc[0] += pn * bf2f(vn[0]); acc[1] += pn * bf2f(vn[1]); acc[2] += pn * bf2f(vn[2]); acc[3] += pn * bf2f(vn[3]);
        }
        *(f32x4*)(part + kg * 64 + 4 * d4) = acc;
    }
    __syncthreads();
    if (tid < 64) { float a = 0.f;
#pragma unroll
        for (int i = 0; i < 32; ++i) a += part[i * 64 + tid];
        p.MIX[row * DM + h * 64 + tid] = f2bf(a / sm); }
}

DI void bg_kmean_fore(const Params& p, int bid, int k, char* lds) {
    const int tid = TIDX, rg = tid >> 4, d4 = tid & 15, bs = bid >> 3, hs = bid & 7;
    const int page = p.page_table[bs * 64 + 2 * k + (rg >> 4)];
    const float* base = p.cache_k + (((size_t)page * 128 + (rg & 15) * 8) * 8 + hs) * 64 + 4 * d4;
    f32x4 acc = {0.f, 0.f, 0.f, 0.f};
#pragma unroll
    for (int i = 0; i < 8; ++i) acc += *(const f32x4*)(base + (size_t)i * 512);
    __syncthreads();
    *(f32x4*)(lds + MB_BGS + (rg * 64 + d4 * 4) * 4) = acc;
    __syncthreads();
    if (tid < 64) { float sm = 0.f;
#pragma unroll 8
        for (int r = 0; r < 32; ++r) sm += *(const float*)(lds + MB_BGS + (r * 64 + tid) * 4);
        *(float*)(lds + MB_KMS + (k * 64 + tid) * 4) = sm * (1.f / 256.f); }
    __syncthreads();
}
DI void moba_prompt_unit(const Params& p, int bh, int own, char* lds, int bid, int& bgk) {
    const int tid = TIDX, lane = tid & 63, w = tid >> 6, lr = lane & 15, lg = lane >> 4;
    const int b = bh >> 3, h = bh & 7;
    float* gsc = (float*)lds + w * 1024;
    unsigned* msk = (unsigned*)(lds + 32768) + w * 36;
    unsigned* worl = (unsigned*)(lds + MB_WOR);
    const int wv = __builtin_amdgcn_readfirstlane(w);
    const size_t rowq0 = (size_t)b * SEQ + own * 256 + w * 32;
    __syncthreads();
    bf16x8 qf[2][2];
#pragma unroll
    for (int qt = 0; qt < 2; ++qt)
#pragma unroll
        for (int ks = 0; ks < 2; ++ks) qf[qt][ks] = *(const bf16x8*)(p.H + (rowq0 + qt * 16 + lr) * 2560 + h * 64 + ks * 32 + lg * 8);
    unsigned mq[2]; unsigned wor;
    if (own > 3) {
        bf16_t* kml = (bf16_t*)(lds + 36864);
        {
            const int j = tid >> 4, d4 = tid & 15;
            f32x4 a = {0.f, 0.f, 0.f, 0.f};
#pragma unroll
            for (int part = 0; part < 8; ++part) a += *(const f32x4*)(p.KMPP + (((size_t)b * 32 + j) * 8 + part) * 512 + h * 64 + 4 * d4);
            store_bf4(kml + j * 64 + 4 * d4, a * (1.f / 256.f));
        }
        __syncthreads();
#pragma unroll
        for (int jt = 0; jt < 2; ++jt) {
            bf16x8 kf[2];
#pragma unroll
            for (int ks = 0; ks < 2; ++ks) kf[ks] = *(const bf16x8*)(kml + (jt * 16 + lr) * 64 + ks * 32 + lg * 8);
#pragma unroll
            for (int qt = 0; qt < 2; ++qt) {
                f32x4 a = {0.f, 0.f, 0.f, 0.f};
                a = MFMA16(kf[0], qf[qt][0], a); a = MFMA16(kf[1], qf[qt][1], a);
#pragma unroll
                for (int r = 0; r < 4; ++r) gsc[(qt * 16 + lr) * 32 + jt * 16 + 4 * lg + r] = a[r];
            }
        }
        __builtin_amdgcn_s_waitcnt(0);
        __builtin_amdgcn_wave_barrier();
        unsigned m = 0;
        if (lane < 32) {
            float v0 = -INFINITY, v1 = -INFINITY, v2 = -INFINITY; int i0 = 0, i1 = 0, i2 = 0;
            for (int j = 0; j < own; ++j) { float sc = gsc[lane * 32 + j];
                if (sc > v0) { v2 = v1; i2 = i1; v1 = v0; i1 = i0; v0 = sc; i0 = j; }
                else if (sc > v1) { v2 = v1; i2 = i1; v1 = sc; i1 = j; }
                else if (sc > v2) { v2 = sc; i2 = j; } }
            m = (1u << i0) | (1u << i1) | (1u << i2);
            msk[lane] = m;
        }
        unsigned o = m;
#pragma unroll
        for (int sft = 32; sft >= 1; sft >>= 1) o |= (unsigned)__shfl_xor((int)o, sft, 64);
        wor = o;
        __builtin_amdgcn_s_waitcnt(0);
        __builtin_amdgcn_wave_barrier();
        mq[0] = msk[lr]; mq[1] = msk[16 + lr];
    } else {
        const unsigned m = (own >= 1) ? ((1u << own) - 1u) : 0u;
        mq[0] = m; mq[1] = m; wor = m;
    }
    wor = (unsigned)__builtin_amdgcn_readfirstlane((int)wor);
    if (lane == 0) worl[w] = wor;
    __syncthreads();
    unsigned bor = 0;
#pragma unroll
    for (int i = 0; i < 8; ++i) bor |= worl[i];
    bor = (unsigned)__builtin_amdgcn_readfirstlane((int)bor);

    const bf16_t* Kbase = p.H + (size_t)b * SEQ * 2560 + 512 + h * 64;
    const bf16_t* Vbase = p.VT + (size_t)(b * 8 + h) * 64 * 8192;
    u32x4 rk[4], rv[4];
    auto gload = [&](int jb) {
#pragma unroll
        for (int i = 0; i < 4; ++i) { const int id = tid + NT * i; const int r = id >> 3, c = id & 7; rk[i] = *(const u32x4*)(Kbase + (size_t)(jb * 256 + r) * 2560 + c * 8); }
#pragma unroll
        for (int i = 0; i < 4; ++i) { const int id = tid + NT * i; const int d = id >> 5, c = id & 31; rv[i] = *(const u32x4*)(Vbase + (size_t)d * 8192 + jb * 256 + c * 8); }
    };
    auto sstore = [&](int buf) {
#pragma unroll
        for (int i = 0; i < 4; ++i) { const int id = tid + NT * i; const int r = id >> 3, c = id & 7; *(u32x4*)(lds + MB_K + buf * 32768 + r * 128 + ((c ^ (r & 7)) << 4)) = rk[i]; }
#pragma unroll
        for (int i = 0; i < 4; ++i) { const int id = tid + NT * i; const int d = id >> 5, c = id & 31; *(u32x4*)(lds + MB_V + buf * (64 * MB_VROW) + d * MB_VROW + c * 16) = rv[i]; }
    };
    const float SC = 0.125f * 1.4426950408889634f;
    float mrow[2] = {-INFINITY, -INFINITY}, lrow[2] = {0.f, 0.f};
    f32x4 oacc[2][4];
#pragma unroll
    for (int qt = 0; qt < 2; ++qt)
#pragma unroll
        for (int dt = 0; dt < 4; ++dt) oacc[qt][dt] = (f32x4){0.f, 0.f, 0.f, 0.f};
    const int bg_rg = tid >> 4, bg_d4 = tid & 15, bg_bs = bid >> 3, bg_hs = bid & 7;
    int bg_page = (bgk < 32) ? p.page_table[bg_bs * 64 + 2 * bgk + (bg_rg >> 4)] : 0;
    int cur = own, buf = 0;
    gload(cur); sstore(0); __syncthreads();
    int nxt_scan = 0;
    while (cur >= 0) {
        int nxt = -1;
        while (nxt_scan < own) { const int j = nxt_scan++; if ((bor >> j) & 1u) { nxt = j; break; } }
        if (nxt >= 0) gload(nxt);
        const bool bg_on = bgk < 32;
        const float* bg_base = p.cache_k + (((size_t)bg_page * 128 + (bg_rg & 15) * 8) * 8 + bg_hs) * 64 + 4 * bg_d4;
        f32x4 bg_acc = {0.f, 0.f, 0.f, 0.f}, bg_pend = {0.f, 0.f, 0.f, 0.f}; int bg_i = 0;
        const bool isown = (cur == own);
        if (isown || ((wor >> cur) & 1u)) {
            const char* KB = lds + MB_K + buf * 32768; const char* VB = lds + MB_V + buf * (64 * MB_VROW);
            const int nst = isown ? (wv + 1) : 8;
            const bool sel0 = isown || ((mq[0] >> cur) & 1u), sel1 = isown || ((mq[1] >> cur) & 1u);
            for (int st = 0; st < nst; ++st) {
                if (bg_on && bg_i < 8) { bg_acc += bg_pend; bg_pend = *(const f32x4*)(bg_base + (size_t)bg_i * 512); ++bg_i; }
                bf16x8 kf[2][2];
#pragma unroll
                for (int kt = 0; kt < 2; ++kt)
#pragma unroll
                    for (int ks = 0; ks < 2; ++ks) { const int r = st * 32 + kt * 16 + lr, ch = ks * 4 + lg; kf[kt][ks] = *(const bf16x8*)(KB + r * 128 + ((ch ^ (r & 7)) << 4)); }
                bf16x8 pf[2]; float alph[2];
#pragma unroll
                for (int qt = 0; qt < 2; ++qt) {
                    f32x4 sv[2];
#pragma unroll
                    for (int kt = 0; kt < 2; ++kt) { f32x4 a = {0.f, 0.f, 0.f, 0.f}; a = MFMA16(kf[kt][0], qf[qt][0], a); a = MFMA16(kf[kt][1], qf[qt][1], a); sv[kt] = a; }
                    const bool selq = qt ? sel1 : sel0;
                    if (isown) {
                        const int qin = wv * 32 + qt * 16 + lr;
#pragma unroll
                        for (int kt = 0; kt < 2; ++kt)
#pragma unroll
                            for (int r = 0; r < 4; ++r) { const int kin = st * 32 + kt * 16 + 4 * lg + r; sv[kt][r] = (kin <= qin) ? sv[kt][r] : -INFINITY; }
                    }
                    float mx = fmaxf(fmaxf(fmaxf(sv[0][0], sv[0][1]), fmaxf(sv[0][2], sv[0][3])), fmaxf(fmaxf(sv[1][0], sv[1][1]), fmaxf(sv[1][2], sv[1][3]))) * SC;
                    mx = red_max_16_32(mx);
                    mx = selq ? mx : -INFINITY;
                    const float mnew = fmaxf(mrow[qt], mx);
                    alph[qt] = __builtin_amdgcn_exp2f(mrow[qt] - mnew);
                    const float mneg = selq ? -mnew : -INFINITY;
                    float ps = 0.f;
#pragma unroll
                    for (int kt = 0; kt < 2; ++kt)
#pragma unroll
                        for (int r = 0; r < 4; ++r) { const float e = __builtin_amdgcn_exp2f(__builtin_fmaf(sv[kt][r], SC, mneg)); sv[kt][r] = e; ps += e; }
                    ps = red_sum_16_32(ps);
                    lrow[qt] = lrow[qt] * alph[qt] + ps; mrow[qt] = mnew;
                    u32x4 pk; pk[0] = pack_bf2(sv[0][0], sv[0][1]); pk[1] = pack_bf2(sv[0][2], sv[0][3]); pk[2] = pack_bf2(sv[1][0], sv[1][1]); pk[3] = pack_bf2(sv[1][2], sv[1][3]);
                    pf[qt] = __builtin_bit_cast(bf16x8, pk);
                }
                if (__any((alph[0] != 1.f) || (alph[1] != 1.f))) {
#pragma unroll
                    for (int qt = 0; qt < 2; ++qt)
#pragma unroll
                        for (int dt = 0; dt < 4; ++dt) oacc[qt][dt] = oacc[qt][dt] * alph[qt];
                }
#pragma unroll
                for (int dt = 0; dt < 4; ++dt) {
                    const char* vp = VB + (dt * 16 + lr) * MB_VROW + st * 64 + 8 * lg;
                    const u32x2 lo = *(const u32x2*)vp, hi = *(const u32x2*)(vp + 32);
                    u32x4 t4; t4[0] = lo[0]; t4[1] = lo[1]; t4[2] = hi[0]; t4[3] = hi[1];
                    const bf16x8 vf = __builtin_bit_cast(bf16x8, t4);
#pragma unroll
                    for (int qt = 0; qt < 2; ++qt) oacc[qt][dt] = MFMA16(vf, pf[qt], oacc[qt][dt]);
                }
            }
        }
        if (bg_on) {
            while (bg_i < 8) { bg_acc += bg_pend; bg_pend = *(const f32x4*)(bg_base + (size_t)bg_i * 512); ++bg_i; }
            bg_acc += bg_pend;
            *(f32x4*)(lds + MB_BGS + (bgk & 1) * 8192 + (bg_rg * 64 + bg_d4 * 4) * 4) = bg_acc;
        }
        if (nxt >= 0) sstore(buf ^ 1);
        __syncthreads();
        if (bg_on) {
            if (tid < 64) { float sm = 0.f;
#pragma unroll 8
                for (int r = 0; r < 32; ++r) sm += *(const float*)(lds + MB_BGS + (bgk & 1) * 8192 + (r * 64 + tid) * 4);
                *(float*)(lds + MB_KMS + (bgk * 64 + tid) * 4) = sm * (1.f / 256.f); }
            ++bgk;
            if (bgk < 32) bg_page = p.page_table[bg_bs * 64 + 2 * bgk + (bg_rg >> 4)];
        }
        cur = nxt; buf ^= 1;
    }
#pragma unroll
    for (int qt = 0; qt < 2; ++qt) {
        const float inv = 1.f / lrow[qt];
#pragma unroll
        for (int dt = 0; dt < 4; ++dt) store_bf4(p.MIX + (rowq0 + qt * 16 + lr) * DM + h * 64 + dt * 16 + 4 * lg, oacc[qt][dt] * inv);
    }
}

DI void ln_rows(const Params& p, const float* g, const float* bb, int bid, int nb, bool final_out) {
    const int lane = TIDX & 63, w = TIDX >> 6;
    for (int row = bid * 8 + w; row < TT; row += nb * 8) {
        f32x4 v[4]; float s = 0.f;
#pragma unroll
        for (int i = 0; i < 4; ++i) { v[i] = ld_bf4(p.T + (size_t)row * DM + 4 * lane + 256 * i); s += v[i][0] + v[i][1] + v[i][2] + v[i][3]; }
        const float mu = wave_sum(s) * (1.f / 1024.f);
        float q = 0.f;
#pragma unroll
        for (int i = 0; i < 4; ++i)
#pragma unroll
            for (int k = 0; k < 4; ++k) { float d = v[i][k] - mu; q += d * d; }
        const float rs = rsqrtf(wave_sum(q) * (1.f / 1024.f) + LN_EPS);
#pragma unroll
        for (int i = 0; i < 4; ++i) {
            const int c = 4 * lane + 256 * i;
            f32x4 gg = *(const f32x4*)(g + c), be = *(const f32x4*)(bb + c), y;
#pragma unroll
            for (int k = 0; k < 4; ++k) y[k] = (v[i][k] - mu) * rs * gg[k] + be[k];
            if (final_out) { float* dst = row < TP ? p.y_prompt + (size_t)row * DM + c : p.y_sample + (size_t)(row - TP) * DM + c; *(f32x4*)dst = y; }
            else store_bf4(p.XB + (size_t)row * DM + c, y);
        }
    }
}

DI unsigned ford(float f) { const unsigned u = __float_as_uint(f); return u ^ ((unsigned)((int)u >> 31) | 0x80000000u); }
DI float funord(unsigned k) { return __uint_as_float((k & 0x80000000u) ? (k ^ 0x80000000u) : ~k); }
#define KINS16(K, tk) { unsigned _v = (K); _Pragma("unroll") for (int _k = 0; _k < 16; ++_k) { const unsigned _t = tk[_k] > _v ? tk[_k] : _v; _v = tk[_k] > _v ? _v : tk[_k]; tk[_k] = _t; } }

DI void qrow_issue(const Params& p, int layer, int rid, int lane, f32x4 (&v)[4]) {
    const float* src = (rid < 16384 ? p.peer_u + ((size_t)layer * 16384 + rid) * DM : p.peer_v + ((size_t)layer * 16384 + (rid - 16384)) * DM);
#pragma unroll
    for (int i = 0; i < 4; ++i) v[i] = *(const f32x4*)(src + 4 * lane + 256 * i);
}
DI void qrow_finish(const Params& p, int layer, int rid, int lane, const f32x4 (&v)[4]) {
    float am = 0.f;
#pragma unroll
    for (int i = 0; i < 4; ++i) am = fmaxf(am, fmaxf(fmaxf(fabsf(v[i][0]), fabsf(v[i][1])), fmaxf(fabsf(v[i][2]), fabsf(v[i][3]))));
    am = wave_max(am);
    const bool isu = rid < 16384; const int e = isu ? rid : rid - 16384;
    unsigned char* dst = (isu ? p.U8 : p.V8) + (size_t)layer * 16384 * DM + (size_t)e * 128;
    const float top = isu ? 127.f : 416.f;
    const float sc = am > 0.f ? top / am : 0.f;
#pragma unroll
    for (int i = 0; i < 4; ++i) {
        int pk = 0;
        if (isu) {
#pragma unroll
            for (int k = 0; k < 4; ++k) { const int q = (int)rintf(v[i][k] * sc); pk |= (int)(((unsigned)q & 0xffu) << (8 * k)); }
        } else {
            pk = __builtin_amdgcn_cvt_pk_fp8_f32(v[i][0] * sc, v[i][1] * sc, pk, false);
            pk = __builtin_amdgcn_cvt_pk_fp8_f32(v[i][2] * sc, v[i][3] * sc, pk, true);
        }
        const int col = 4 * lane + 256 * i;
        *(int*)(dst + (size_t)(col >> 7) * (16384 * 128) + (col & 127)) = pk;
    }
    if (lane == 0) (isu ? p.SU : p.SV)[layer * 16384 + e] = am / top;
}
#define CEX(a, b) { const unsigned _t = (a) > (b) ? (a) : (b); (b) = (a) > (b) ? (b) : (a); (a) = _t; }
#define SORT16_DESC(X) { CEX(X[0], X[1]); CEX(X[2], X[3]); CEX(X[0], X[2]); CEX(X[1], X[3]); CEX(X[1], X[2]); CEX(X[4], X[5]); CEX(X[6], X[7]); CEX(X[4], X[6]); CEX(X[5], X[7]); CEX(X[5], X[6]); CEX(X[0], X[4]); CEX(X[2], X[6]); CEX(X[2], X[4]); CEX(X[1], X[5]); CEX(X[3], X[7]); CEX(X[3], X[5]); CEX(X[1], X[2]); CEX(X[3], X[4]); CEX(X[5], X[6]); CEX(X[8], X[9]); CEX(X[10], X[11]); CEX(X[8], X[10]); CEX(X[9], X[11]); CEX(X[9], X[10]); CEX(X[12], X[13]); CEX(X[14], X[15]); CEX(X[12], X[14]); CEX(X[13], X[15]); CEX(X[13], X[14]); CEX(X[8], X[12]); CEX(X[10], X[14]); CEX(X[10], X[12]); CEX(X[9], X[13]); CEX(X[11], X[15]); CEX(X[11], X[13]); CEX(X[9], X[10]); CEX(X[11], X[12]); CEX(X[13], X[14]); CEX(X[0], X[8]); CEX(X[4], X[12]); CEX(X[4], X[8]); CEX(X[2], X[10]); CEX(X[6], X[14]); CEX(X[6], X[10]); CEX(X[2], X[4]); CEX(X[6], X[8]); CEX(X[10], X[12]); CEX(X[1], X[9]); CEX(X[5], X[13]); CEX(X[5], X[9]); CEX(X[3], X[11]); CEX(X[7], X[15]); CEX(X[7], X[11]); CEX(X[3], X[5]); CEX(X[7], X[9]); CEX(X[11], X[13]); CEX(X[1], X[2]); CEX(X[3], X[4]); CEX(X[5], X[6]); CEX(X[7], X[8]); CEX(X[9], X[10]); CEX(X[11], X[12]); CEX(X[13], X[14]); }
#define BITONIC16_DESC(X) { CEX(X[0], X[8]); CEX(X[1], X[9]); CEX(X[2], X[10]); CEX(X[3], X[11]); CEX(X[4], X[12]); CEX(X[5], X[13]); CEX(X[6], X[14]); CEX(X[7], X[15]); CEX(X[0], X[4]); CEX(X[1], X[5]); CEX(X[2], X[6]); CEX(X[3], X[7]); CEX(X[8], X[12]); CEX(X[9], X[13]); CEX(X[10], X[14]); CEX(X[11], X[15]); CEX(X[0], X[2]); CEX(X[1], X[3]); CEX(X[4], X[6]); CEX(X[5], X[7]); CEX(X[8], X[10]); CEX(X[9], X[11]); CEX(X[12], X[14]); CEX(X[13], X[15]); CEX(X[0], X[1]); CEX(X[2], X[3]); CEX(X[4], X[5]); CEX(X[6], X[7]); CEX(X[8], X[9]); CEX(X[10], X[11]); CEX(X[12], X[13]); CEX(X[14], X[15]); }
#define CAND_BATCH0(X) { X[0] = CKEY(0, 0); X[1] = CKEY(0, 1); X[2] = CKEY(0, 2); X[3] = CKEY(0, 3); X[4] = CKEY(0, 4); X[5] = CKEY(0, 5); X[6] = CKEY(0, 6); X[7] = CKEY(0, 7); X[8] = CKEY(0, 8); X[9] = CKEY(0, 9); X[10] = CKEY(0, 10); X[11] = CKEY(0, 11); X[12] = CKEY(0, 12); X[13] = CKEY(0, 13); X[14] = CKEY(0, 14); X[15] = CKEY(0, 15); }
#define CAND_BATCH1(X) { X[0] = CKEY(1, 0); X[1] = CKEY(1, 1); X[2] = CKEY(1, 2); X[3] = CKEY(1, 3); X[4] = CKEY(1, 4); X[5] = CKEY(1, 5); X[6] = CKEY(1, 6); X[7] = CKEY(1, 7); X[8] = CKEY(2, 0); X[9] = CKEY(2, 1); X[10] = CKEY(2, 2); X[11] = CKEY(2, 3); X[12] = CKEY(2, 4); X[13] = CKEY(3, 0); X[14] = CKEY(3, 1); X[15] = CKEY(3, 2); }
#define CAND_BATCH2(X) { X[0] = CKEY(3, 3); X[1] = CKEY(4, 0); X[2] = CKEY(4, 1); X[3] = CKEY(4, 2); X[4] = CKEY(5, 0); X[5] = CKEY(5, 1); X[6] = CKEY(6, 0); X[7] = CKEY(6, 1); X[8] = CKEY(7, 0); X[9] = CKEY(7, 1); X[10] = CKEY(8, 0); X[11] = CKEY(9, 0); X[12] = CKEY(10, 0); X[13] = CKEY(11, 0); X[14] = CKEY(12, 0); X[15] = CKEY(13, 0); }
#define CAND_BATCH3(X) { X[0] = CKEY(14, 0); X[1] = CKEY(15, 0); X[2] = 0u; X[3] = 0u; X[4] = 0u; X[5] = 0u; X[6] = 0u; X[7] = 0u; X[8] = 0u; X[9] = 0u; X[10] = 0u; X[11] = 0u; X[12] = 0u; X[13] = 0u; X[14] = 0u; X[15] = 0u; }
#define MERGE16(R, X) { _Pragma("unroll") for (int _i = 0; _i < 16; ++_i) R[_i] = R[_i] > X[15 - _i] ? R[_i] : X[15 - _i]; BITONIC16_DESC(R); }
typedef _Float16 f16x4 __attribute__((ext_vector_type(4)));
typedef _Float16 f16x8 __attribute__((ext_vector_type(8)));
DI void peer_topk_unit(const Params& p, int layer, int u, char* lds) {
    const int tid = TIDX, lane = tid & 63, w = tid >> 6, lr = lane & 15, lg = lane >> 4;
    const int t0 = u * 32;
    __syncthreads();
    {
        const bf16_t* KBl = p.KB + (size_t)layer * 2048 * 128;
#pragma unroll 1
        for (int jj = 0; jj < 2; ++jj) {
            const int j = 2 * w + jj;
            bf16x8 qf[2][4];
#pragma unroll
            for (int tt = 0; tt < 2; ++tt)
#pragma unroll
                for (int ks = 0; ks < 4; ++ks) qf[tt][ks] = *(const bf16x8*)(p.QH + (size_t)(t0 + tt * 16 + lr) * 2048 + j * 128 + ks * 32 + lg * 8);
#pragma unroll
            for (int nt = 0; nt < 8; ++nt) {
                bf16x8 kf[4];
#pragma unroll
                for (int ks = 0; ks < 4; ++ks) kf[ks] = *(const bf16x8*)(KBl + (size_t)(j * 128 + nt * 16 + lr) * 128 + ks * 32 + lg * 8);
#pragma unroll
                for (int tt = 0; tt < 2; ++tt) {
                    f32x4 a = {0.f, 0.f, 0.f, 0.f};
#pragma unroll
                    for (int ks = 0; ks < 4; ++ks) a = MFMA16(kf[ks], qf[tt][ks], a);
                    f16x4 hv; hv[0] = (_Float16)a[0]; hv[1] = (_Float16)a[1]; hv[2] = (_Float16)a[2]; hv[3] = (_Float16)a[3];
                    const int chunk = nt * 2 + (lg >> 1);
                    *(f16x4*)(lds + ((tt * 16 + lr) * 16 + j) * 256 + ((chunk ^ j) << 4) + (lg & 1) * 8) = hv;
                }
            }
        }
    }
    __syncthreads();
    const int tok = t0 + (tid >> 4), j = tid & 15;
    const int qbase = u * 64 + w * 8;
    f32x4 qv[4][4];
#pragma unroll
    for (int i = 0; i < 4; ++i) qrow_issue(p, layer, qbase + i, lane, qv[i]);
    unsigned tk[16];
    {
        const char* sp = lds + tid * 256;
#pragma unroll 1
        for (int bt = 0; bt < 8; ++bt) {
            unsigned X[16];
#pragma unroll
            for (int cc = 0; cc < 2; ++cc) {
                const int c = 2 * bt + cc;
                const f16x8 v = *(const f16x8*)(sp + ((c ^ j) << 4));
#pragma unroll
                for (int q = 0; q < 8; ++q) X[8 * cc + q] = (ford((float)v[q]) & ~127u) | (unsigned)(127 - (8 * c + q));
            }
            SORT16_DESC(X);
            if (bt == 0) {
#pragma unroll
                for (int k = 0; k < 16; ++k) tk[k] = X[k];
            } else MERGE16(tk, X);
        }
    }
#pragma unroll
    for (int i = 0; i < 4; ++i) qrow_finish(p, layer, qbase + i, lane, qv[i]);
#pragma unroll
    for (int i = 0; i < 4; ++i) qrow_issue(p, layer, qbase + 4 + i, lane, qv[i]);
    __syncthreads();
    float* lv = (float*)lds;
    int* li = (int*)(lds + 512 * 17 * 4);
#pragma unroll
    for (int k = 0; k < 16; ++k) { lv[tid * 17 + k] = funord(tk[k] & ~127u); li[tid * 17 + k] = 127 - (int)(tk[k] & 127u); }
    __syncthreads();
    if ((j & 1) == 0) {
        float v1[16], v2[16];
#pragma unroll
        for (int k = 0; k < 16; ++k) { v1[k] = lv[tid * 17 + k]; v2[k] = lv[(tid + 1) * 17 + k]; }
        unsigned sk[16];
#define CKEY(a, b) ((ford(v1[a] + v2[b]) & ~255u) | (unsigned)(255 - ((a) * 16 + (b))))
        {
            unsigned X[16];
            CAND_BATCH0(sk);
            CAND_BATCH1(X); SORT16_DESC(X); MERGE16(sk, X);
            CAND_BATCH2(X); SORT16_DESC(X); MERGE16(sk, X);
            CAND_BATCH3(X); SORT16_DESC(X); MERGE16(sk, X);
        }
#undef CKEY
        float sc[16]; int ee[16];
#pragma unroll
        for (int k = 0; k < 16; ++k) {
            const int c = 255 - (int)(sk[k] & 255u), a = c >> 4, bq = c & 15;
            sc[k] = lv[tid * 17 + a] + lv[(tid + 1) * 17 + bq];
            ee[k] = li[tid * 17 + a] * 128 + li[(tid + 1) * 17 + bq];
        }
        float sm = 0.f; float e[16];
#pragma unroll
        for (int k = 0; k < 16; ++k) { e[k] = __expf(sc[k] - sc[0]); sm += e[k]; }
        const float inv = 1.f / sm; const int h = j >> 1;
#pragma unroll
        for (int k = 0; k < 16; ++k) { p.E[(size_t)tok * 128 + h * 16 + k] = ee[k]; p.G[(size_t)tok * 128 + h * 16 + k] = e[k] * inv; }
    }
#pragma unroll
    for (int i = 0; i < 4; ++i) qrow_finish(p, layer, qbase + 4 + i, lane, qv[i]);
}

constexpr int EHS = 129;
constexpr int PEER_EH = 65536, PEER_TOK = 65536 + 64 * EHS * 8, PEER_END = PEER_TOK + 1024;
DI float gelu_exact(float z) { return 0.5f * z * (1.f + erff(z * 0.70710678118654752f)); }
#define FMA4U(ACC, O, H, W) { ACC[O] += H * (float)((W) & 0xffu); ACC[O + 1] += H * (float)(((W) >> 8) & 0xffu); ACC[O + 2] += H * (float)(((W) >> 16) & 0xffu); ACC[O + 3] += H * (float)((W) >> 24); }

DI void peer_tile(const Params& p, int layer, int tile, char* lds, bool final_out) {
    const int lane = TIDX & 63, w = TIDX >> 6, lr = lane & 15, lg = lane >> 4;
    unsigned char* X8 = (unsigned char*)lds; int2* EH = (int2*)(lds + PEER_EH); float* TOK = (float*)(lds + PEER_TOK);
    const unsigned char* U8 = p.U8 + (size_t)layer * 16384 * DM; const unsigned char* V8 = p.V8 + (size_t)layer * 16384 * DM;
    const float* SUi = p.SU + layer * 16384; const float* SVi = p.SV + layer * 16384;
    const float* lng = p.ln_g + (layer * 2 + 1) * DM; const float* lnb = p.ln_b + (layer * 2 + 1) * DM;
    const int t0 = tile * 64 + w * 8;
#pragma unroll 4
    for (int i = 0; i < 8; ++i) {
        const int t = t0 + i, tk = w * 8 + i;
        f32x4 v[4]; float am = 0.f;
#pragma unroll
        for (int k = 0; k < 4; ++k) { v[k] = ld_bf4(p.XB + (size_t)t * DM + 4 * lane + 256 * k); am = fmaxf(am, fmaxf(fmaxf(fabsf(v[k][0]), fabsf(v[k][1])), fmaxf(fabsf(v[k][2]), fabsf(v[k][3])))); }
        am = wave_max(am);
        const float sc = am > 0.f ? 127.f / am : 0.f;
#pragma unroll
        for (int k = 0; k < 4; ++k) {
            unsigned pk = 0;
#pragma unroll
            for (int q = 0; q < 4; ++q) { const int qi = (int)rintf(v[k][q] * sc); pk |= ((unsigned)qi & 0xffu) << (8 * q); }
            *(unsigned*)(X8 + tk * 1024 + 4 * lane + 256 * k) = pk;
        }
        if (lane == 0) TOK[tk * 2] = am * (1.f / 127.f);
        EH[tk * EHS + lane] = make_int2(p.E[(size_t)t * 128 + lane], 0);
        EH[tk * EHS + 64 + lane] = make_int2(p.E[(size_t)t * 128 + 64 + lane], 0);
    }
    {
        const int gq = lane >> 3, li = lane & 7, tk = w * 8 + gq;
        auto uld = [&](int c, int p0, u32x4 (&uu)[4]) {
            const unsigned char* Uc = U8 + (size_t)c * (16384 * 128);
#pragma unroll
            for (int j = 0; j < 4; ++j) { const unsigned e = (unsigned)EH[tk * EHS + p0 + j].x; uu[j] = *(const u32x4*)(Uc + (e * 128u + 16u * li)); }
        };
        auto ucp = [&](int p0, u32x4 (&uu)[4], const i32x4& xq) {
#pragma unroll
            for (int j = 0; j < 4; ++j) {
                int d = __builtin_amdgcn_sdot4((int)uu[j][0], xq[0], 0, false);
                d = __builtin_amdgcn_sdot4((int)uu[j][1], xq[1], d, false);
                d = __builtin_amdgcn_sdot4((int)uu[j][2], xq[2], d, false);
                d = __builtin_amdgcn_sdot4((int)uu[j][3], xq[3], d, false);
                d += __builtin_amdgcn_update_dpp(0, d, 0x114, 0xf, 0xf, true);
                d += __builtin_amdgcn_update_dpp(0, d, 0x112, 0xf, 0xf, true);
                d += __builtin_amdgcn_update_dpp(0, d, 0x111, 0xf, 0xf, true);
                if (li == 7) __hip_atomic_fetch_add(&EH[tk * EHS + p0 + j].y, d, __ATOMIC_RELAXED, __HIP_MEMORY_SCOPE_WORKGROUP);
            }
        };
        u32x4 uA[4], uB[4];
        uld(0, 0, uA);
#pragma unroll 1
        for (int c = 0; c < 8; ++c) {
            const i32x4 xq = *(const i32x4*)(X8 + tk * 1024 + c * 128 + 16 * li);
#pragma unroll 1
            for (int p0 = 0; p0 < 128; p0 += 8) {
                uld(c, p0 + 4, uB);
                ucp(p0, uA, xq);
                if (p0 + 8 < 128) uld(c, p0 + 8, uA); else if (c < 7) uld(c + 1, 0, uA);
                ucp(p0 + 4, uB, xq);
            }
        }
    }
#pragma unroll 4
    for (int i = 0; i < 8; ++i) {
        const int t = t0 + i, tk = w * 8 + i;
        const float sxi = TOK[tk * 2];
#pragma unroll
        for (int hf = 0; hf < 2; ++hf) {
            const int pi = hf * 64 + lane;
            const int2 eh = EH[tk * EHS + pi];
            const float z = (float)eh.y * SUi[eh.x] * sxi;
            const float hp = p.G[(size_t)t * 128 + pi] * gelu_exact(z) * SVi[eh.x];
            EH[tk * EHS + pi].y = __float_as_int(hp);
        }
    }
    const int gq = lane >> 3, li = lane & 7, tk = w * 8 + gq, t = t0 + gq;
    float s1 = 0.f, s2 = 0.f;
    auto vload = [&](int c, int p0, float (&hh)[4], u32x4 (&vv)[4]) {
        const unsigned char* Vc = V8 + (size_t)c * (16384 * 128);
#pragma unroll
        for (int j = 0; j < 4; ++j) { const int2 eh = EH[tk * EHS + p0 + j]; hh[j] = __int_as_float(eh.y); vv[j] = *(const u32x4*)(Vc + ((unsigned)eh.x * 128u + 16u * li)); }
    };
    auto vcomp = [&](float (&hh)[4], u32x4 (&vv)[4], f32x2 (&acc)[8]) {
#pragma unroll
        for (int j = 0; j < 4; ++j) {
            const f32x2 h2 = {hh[j], hh[j]};
#pragma unroll
            for (int q = 0; q < 4; ++q) {
                const f32x2 a = __builtin_amdgcn_cvt_pk_f32_fp8((int)vv[j][q], false), b = __builtin_amdgcn_cvt_pk_f32_fp8((int)vv[j][q], true);
                acc[2 * q] = h2 * a + acc[2 * q]; acc[2 * q + 1] = h2 * b + acc[2 * q + 1];
            }
        }
    };
    float ehA[4], ehB[4]; u32x4 vvA[4], vvB[4];
    vload(0, 0, ehA, vvA);
#pragma unroll 1
    for (int c = 0; c < 8; ++c) {
        f32x2 acc[8];
#pragma unroll
        for (int k = 0; k < 8; ++k) acc[k] = (f32x2){0.f, 0.f};
        f32x4 xs[4];
#pragma unroll
        for (int k4 = 0; k4 < 4; ++k4) xs[k4] = ld_bf4(p.XB + (size_t)t * DM + c * 128 + li * 16 + 4 * k4);
#pragma unroll 1
        for (int p0 = 0; p0 < 128; p0 += 8) {
            vload(c, p0 + 4, ehB, vvB);
            vcomp(ehA, vvA, acc);
            if (p0 + 8 < 128) vload(c, p0 + 8, ehA, vvA); else if (c < 7) vload(c + 1, 0, ehA, vvA);
            vcomp(ehB, vvB, acc);
        }
        const int col = c * 128 + li * 16;
#pragma unroll
        for (int k4 = 0; k4 < 4; ++k4) {
            const f32x4 x = xs[k4];
            f32x4 y;
#pragma unroll
            for (int k = 0; k < 4; ++k) { y[k] = DN_ALPHA * x[k] + acc[2 * k4 + (k >> 1)][k & 1]; s1 += y[k]; s2 += y[k] * y[k]; }
            store_bf4(p.T + (size_t)t * DM + col + 4 * k4, y);
        }
    }
#pragma unroll
    for (int o = 1; o <= 4; o <<= 1) { s1 += __shfl_xor(s1, o, 64); s2 += __shfl_xor(s2, o, 64); }
    const float mu = s1 * (1.f / 1024.f);
    const float rs = rsqrtf(fmaxf(s2 * (1.f / 1024.f) - mu * mu, 0.f) + LN_EPS);
#pragma unroll 4
    for (int c = 0; c < 8; ++c) {
        const int col = c * 128 + li * 16;
#pragma unroll
        for (int k4 = 0; k4 < 4; ++k4) {
            const f32x4 y = ld_bf4(p.T + (size_t)t * DM + col + 4 * k4);
            const f32x4 gg = *(const f32x4*)(lng + col + 4 * k4), be = *(const f32x4*)(lnb + col + 4 * k4);
            f32x4 o;
#pragma unroll
            for (int k = 0; k < 4; ++k) o[k] = (y[k] - mu) * rs * gg[k] + be[k];
            if (final_out) *(f32x4*)(p.y_prompt + (size_t)t * DM + col + 4 * k4) = o;
            else store_bf4(p.XB + (size_t)t * DM + col + 4 * k4, o);
        }
    }
}


DI unsigned wave_top16(unsigned x0, unsigned x1, int lane) {
    unsigned res = 0u;
#pragma unroll 1
    for (int r = 0; r < 16; ++r) {
        unsigned m = x0 > x1 ? x0 : x1;
#pragma unroll
        for (int o = 32; o >= 1; o >>= 1) { const unsigned y = (unsigned)__shfl_xor((int)m, o, 64); m = y > m ? y : m; }
        if (x0 == m) x0 = 0u; else if (x1 == m) x1 = 0u;
        if (lane == r) res = m;
    }
    return res;
}
DI void peer_sample(const Params& p, int layer, int sidx, char* lds, bool final_out) {
    const int tid = TIDX, lane = tid & 63, w = tid >> 6, lr = lane & 15, lg = lane >> 4;
    unsigned char* X8 = (unsigned char*)lds; int2* EH = (int2*)(lds + 1024); float* Z = (float*)(lds + 1024 + 1024); float* Y = Z + 128; float* PART = Y + 1024;
    int* Es = (int*)(PART + 32); float* Gs = (float*)(Es + 128);
    const unsigned char* U8 = p.U8 + (size_t)layer * 16384 * DM; const unsigned char* V8 = p.V8 + (size_t)layer * 16384 * DM;
    const float* SUi = p.SU + layer * 16384; const float* SVi = p.SV + layer * 16384;
    const float* lng = p.ln_g + (layer * 2 + 1) * DM; const float* lnb = p.ln_b + (layer * 2 + 1) * DM;
    const int t = TP + sidx;
    __syncthreads();
    if (w == 0) {
        f32x4 v[4]; float am = 0.f;
#pragma unroll
        for (int k = 0; k < 4; ++k) { v[k] = ld_bf4(p.XB + (size_t)t * DM + 4 * lane + 256 * k); am = fmaxf(am, fmaxf(fmaxf(fabsf(v[k][0]), fabsf(v[k][1])), fmaxf(fabsf(v[k][2]), fabsf(v[k][3])))); }
        am = wave_max(am);
        const float sc = am > 0.f ? 127.f / am : 0.f;
#pragma unroll
        for (int k = 0; k < 4; ++k) {
            unsigned pk = 0;
#pragma unroll
            for (int q = 0; q < 4; ++q) { const int qi = (int)rintf(v[k][q] * sc); pk |= ((unsigned)qi & 0xffu) << (8 * q); }
            *(unsigned*)(X8 + 4 * lane + 256 * k) = pk;
        }
        if (lane == 0) PART[24] = am * (1.f / 127.f);
    }
    {
        const float* sp = p.S + (size_t)t * 2048 + w * 256;
        const unsigned k1 = wave_top16((ford(sp[lane]) & ~127u) | (unsigned)(127 - lane), (ford(sp[64 + lane]) & ~127u) | (unsigned)(63 - lane), lane);
        const unsigned k2 = wave_top16((ford(sp[128 + lane]) & ~127u) | (unsigned)(127 - lane), (ford(sp[192 + lane]) & ~127u) | (unsigned)(63 - lane), lane);
        const float v1 = funord(k1 & ~127u), v2 = funord(k2 & ~127u); const int i1 = 127 - (int)(k1 & 127u), i2 = 127 - (int)(k2 & 127u);
        int a = 0, b = 0;
        { int base = 0;
#pragma unroll
          for (int aa = 0; aa < 16; ++aa) { const int cnt = 16 / (aa + 1); if (lane >= base && lane < base + cnt) { a = aa; b = lane - base; } base += cnt; } }
        const float sv = __shfl(v1, a, 64) + __shfl(v2, b, 64);
        const unsigned ck = lane < 50 ? ((ford(sv) & ~255u) | (unsigned)(255 - (a * 16 + b))) : 0u;
        const unsigned rk = wave_top16(ck, 0u, lane);
        const int c2 = 255 - (int)(rk & 255u), a2 = (c2 >> 4) & 15, b2 = c2 & 15;
        const float sc = __shfl(v1, a2, 64) + __shfl(v2, b2, 64);
        const int ex = __shfl(i1, a2, 64) * 128 + __shfl(i2, b2, 64);
        const float mx = __shfl(sc, 0, 64);
        const float ee = lane < 16 ? __expf(sc - mx) : 0.f;
        const float sm = wave_sum(ee);
        if (lane < 16) { Es[w * 16 + lane] = ex; Gs[w * 16 + lane] = ee / sm; }
    }
    __syncthreads();
    {
        const int e = Es[w * 16 + lr];
        i32x4 acc = {0, 0, 0, 0};
#pragma unroll
        for (int ch = 0; ch < 16; ++ch) {
            const i32x4 a = *(const i32x4*)(U8 + (size_t)(ch >> 1) * (16384 * 128) + (size_t)e * 128 + (ch & 1) * 64 + 16 * lg);
            const i32x4 xb = *(const i32x4*)(X8 + ch * 64 + 16 * lg);
            acc = __builtin_amdgcn_mfma_i32_16x16x64_i8(a, xb, acc, 0, 0, 0);
        }
        if (lr == 0) {
#pragma unroll
            for (int r = 0; r < 4; ++r) Z[w * 16 + 4 * lg + r] = (float)acc[r];
        }
        __builtin_amdgcn_s_waitcnt(0);
        __builtin_amdgcn_wave_barrier();
        float hp = 0.f;
        if (lane < 16) {
            const int pi = w * 16 + lane;
            const float z = Z[pi] * SUi[e] * PART[24];
            hp = Gs[pi] * gelu_exact(z) * SVi[e];
            EH[pi] = make_int2(e, __float_as_int(hp));
        }
        hp = wave_sum(hp);
        if (lane == 0) PART[w] = hp;
    }
    __syncthreads();
    float sumh = 0.f;
#pragma unroll
    for (int i = 0; i < 8; ++i) sumh += PART[i];
    {
        const int c = w, pg = lane >> 3, li = lane & 7;
        float acc[16];
#pragma unroll
        for (int k = 0; k < 16; ++k) acc[k] = 0.f;
        const unsigned char* vb = V8 + (size_t)c * (16384 * 128) + li * 16;
        for (int p0 = 0; p0 < 16; p0 += 8) {
            int2 eh[8]; u32x4 vv[8];
#pragma unroll
            for (int j = 0; j < 8; ++j) eh[j] = EH[pg * 16 + p0 + j];
#pragma unroll
            for (int j = 0; j < 8; ++j) vv[j] = *(const u32x4*)(vb + (size_t)eh[j].x * 128);
#pragma unroll
            for (int j = 0; j < 8; ++j) { const float h = __int_as_float(eh[j].y);
#pragma unroll
                for (int q = 0; q < 4; ++q) { const f32x2 a = __builtin_amdgcn_cvt_pk_f32_fp8((int)vv[j][q], false), bq = __builtin_amdgcn_cvt_pk_f32_fp8((int)vv[j][q], true);
                    acc[4 * q] += h * a[0]; acc[4 * q + 1] += h * a[1]; acc[4 * q + 2] += h * bq[0]; acc[4 * q + 3] += h * bq[1]; } }
        }
#pragma unroll
        for (int k = 0; k < 16; ++k) { float a = acc[k]; a += __shfl_xor(a, 8, 64); a += __shfl_xor(a, 16, 64); a += __shfl_xor(a, 32, 64); acc[k] = a; }
        float s1 = 0.f, s2 = 0.f;
        if (pg == 0) {
            const int col = c * 128 + li * 16;
#pragma unroll
            for (int k = 0; k < 16; ++k) { const float y = DN_ALPHA * bf2f(p.XB[(size_t)t * DM + col + k]) + acc[k]; Y[col + k] = y; s1 += y; s2 += y * y; }
        }
        s1 = wave_sum(s1); s2 = wave_sum(s2);
        if (lane == 0) { PART[8 + w] = s1; PART[16 + w] = s2; }
    }
    __syncthreads();
    float s1 = 0.f, s2 = 0.f;
#pragma unroll
    for (int i = 0; i < 8; ++i) { s1 += PART[8 + i]; s2 += PART[16 + i]; }
    const float mu = s1 * (1.f / 1024.f);
    const float rs = rsqrtf(fmaxf(s2 * (1.f / 1024.f) - mu * mu, 0.f) + LN_EPS);
#pragma unroll
    for (int k = 0; k < 2; ++k) {
        const int col = tid + NT * k;
        const float o = (Y[col] - mu) * rs * lng[col] + lnb[col];
        if (final_out) p.y_sample[(size_t)sidx * DM + col] = o;
        else p.XB[(size_t)t * DM + col] = f2bf(o);
    }
    __syncthreads();
}

DI void peer_expert_phase(const Params& p, int layer, char* lds, int bid, int nb, bool final_out) {
    for (int tile = bid; tile < 256; tile += nb) peer_tile(p, layer, tile, lds, final_out);
    for (int sidx = bid; sidx < TS; sidx += nb) peer_sample(p, layer, sidx, lds, final_out);
}

DI void hgrn_cumsum(const Params& p, size_t row0, int h, float* bs, float* tot) {
    const int tid = TIDX;
#pragma unroll
    for (int i = 0; i < 4; ++i) { int id = tid + NT * i; int s = id >> 5, c4 = id & 31; typedef _Float16 h4 __attribute__((ext_vector_type(4))); const h4 hv = *(const h4*)(p.LF + (row0 + s) * DM + h * 128 + 4 * c4); *(f32x4*)(bs + s * 128 + 4 * c4) = (f32x4){(float)hv[0], (float)hv[1], (float)hv[2], (float)hv[3]}; }
    __syncthreads();
    const int k = tid & 127, seg = tid >> 7;
    float run = 0.f;
#pragma unroll
    for (int i = 0; i < 16; ++i) { run += bs[(seg * 16 + i) * 128 + k]; bs[(seg * 16 + i) * 128 + k] = run; }
    tot[seg * 128 + k] = run;
    __syncthreads();
    float off = 0.f;
#pragma unroll
    for (int s2 = 0; s2 < 3; ++s2) if (s2 < seg) off += tot[s2 * 128 + k];
    if (seg > 0) {
#pragma unroll
        for (int i = 0; i < 16; ++i) bs[(seg * 16 + i) * 128 + k] += off;
    }
    __syncthreads();
}
constexpr int HG_TS = 72;
constexpr int HG_FS = 136;
DI void hgrn_b1_unit(const Params& p, int u, char* lds) {
    float* bs = (float*)lds;
    float* tot = (float*)(lds + 32768);
    bf16_t* KT = (bf16_t*)(lds + 36864);
    bf16_t* IT = (bf16_t*)(lds + 36864 + 18432);
    const int tid = TIDX, lane = tid & 63, w = tid >> 6, lr = lane & 15, lg = lane >> 4;
    const int bh = u >> 7, c = u & 127, b = bh >> 3, h = bh & 7;
    const size_t row0 = (size_t)b * SEQ + c * 64;
    hgrn_cumsum(p, row0, h, bs, tot);
    const bf16_t* KK = p.H + (size_t)MP * DM; const bf16_t* I1 = p.H + (size_t)2 * MP * DM;
    {
        const int s = tid >> 3, kc = (tid & 7) * 16;
        const bf16_t* kr = KK + (row0 + s) * DM + h * 128 + kc; const bf16_t* ir = I1 + (row0 + s) * DM + h * 128 + kc;
        u32x4 ka = *(const u32x4*)kr, kb = *(const u32x4*)(kr + 8), ia = *(const u32x4*)ir, ib = *(const u32x4*)(ir + 8);
#pragma unroll
        for (int i = 0; i < 16; ++i) {
            const unsigned kw = (i < 8) ? ka[(i & 7) >> 1] : kb[(i & 7) >> 1]; const unsigned iw = (i < 8) ? ia[(i & 7) >> 1] : ib[(i & 7) >> 1];
            const float kv = (i & 1) ? bfhi(kw) : bflo(kw);
            const float e = __expf(fminf(-bs[s * 128 + kc + i], 80.f));
            KT[(kc + i) * HG_TS + s] = f2bf(kv * e);
            IT[(kc + i) * HG_TS + s] = (bf16_t)((i & 1) ? (iw >> 16) : (iw & 0xffffu));
        }
    }
    __syncthreads();
    f32x4 acc[8];
#pragma unroll
    for (int j = 0; j < 8; ++j) acc[j] = (f32x4){0.f, 0.f, 0.f, 0.f};
#pragma unroll
    for (int ks = 0; ks < 2; ++ks) {
        const bf16x8 af = *(const bf16x8*)(KT + (w * 16 + lr) * HG_TS + ks * 32 + lg * 8);
#pragma unroll
        for (int j = 0; j < 8; ++j) { const bf16x8 bfr = *(const bf16x8*)(IT + (j * 16 + lr) * HG_TS + ks * 32 + lg * 8); acc[j] = MFMA16(af, bfr, acc[j]); }
    }
    f32x4 dl;
#pragma unroll
    for (int r = 0; r < 4; ++r) dl[r] = __expf(bs[63 * 128 + w * 16 + 4 * lg + r]);
#pragma unroll
    for (int j = 0; j < 8; ++j) store_bf4(p.UT + ((size_t)u * 128 + j * 16 + lr) * 128 + w * 16 + 4 * lg, acc[j] * dl);
    if (tid < 128) p.DEC[(size_t)u * 128 + tid] = __expf(bs[63 * 128 + tid]);
    __syncthreads();
}
DI void hgrn_b2(const Params& p, int bid, int nb) {
    for (int e = bid * NT + TIDX; e < 16 * 8192; e += nb * NT) {
        const int bh = e >> 13, vk = (e & 8191) * 2, k = vk & 127, v = vk >> 7;
        float S0 = 0.f, S1 = 0.f;
        for (int c0 = 0; c0 < 128; c0 += 8) {
            unsigned uu[8]; float d0[8], d1[8];
#pragma unroll
            for (int i = 0; i < 8; ++i) { const size_t un = (size_t)bh * 128 + c0 + i; uu[i] = *(const unsigned*)(p.UT + un * 16384 + vk); d0[i] = p.DEC[un * 128 + k]; d1[i] = p.DEC[un * 128 + k + 1]; }
#pragma unroll
            for (int i = 0; i < 8; ++i) { const size_t un = (size_t)bh * 128 + c0 + i; *(unsigned*)(p.ST + un * 16384 + vk) = pack_bf2(S0, S1); S0 = d0[i] * S0 + bflo(uu[i]); S1 = d1[i] * S1 + bfhi(uu[i]); }
        }
        p.hgrn_prompt[((size_t)bh * 128 + k) * 128 + v] = S0;
        p.hgrn_prompt[((size_t)bh * 128 + k + 1) * 128 + v] = S1;
    }
}
DI void hgrn_b3_unit(const Params& p, int u, char* lds) {
    float* bs = (float*)lds;
    float* tot = (float*)(lds + 32768);
    bf16_t* QH = (bf16_t*)(lds + 36864);
    bf16_t* KH = (bf16_t*)(lds + 36864 + 17408);
    bf16_t* IT = (bf16_t*)(lds + 36864 + 34816);
    bf16_t* AT = (bf16_t*)(lds + 36864 + 34816 + 18432);
    const int tid = TIDX, lane = tid & 63, w = tid >> 6, lr = lane & 15, lg = lane >> 4;
    const int bh = u >> 7, c = u & 127, b = bh >> 3, h = bh & 7;
    const size_t row0 = (size_t)b * SEQ + c * 64;
    hgrn_cumsum(p, row0, h, bs, tot);
    const bf16_t* Q1 = p.H; const bf16_t* KK = p.H + (size_t)MP * DM; const bf16_t* I1 = p.H + (size_t)2 * MP * DM; const bf16_t* G1 = p.H + (size_t)3 * MP * DM;
    {
        const int s = tid >> 3, kc = (tid & 7) * 16;
        const bf16_t* qr = Q1 + (row0 + s) * DM + h * 128 + kc; const bf16_t* kr = KK + (row0 + s) * DM + h * 128 + kc; const bf16_t* ir = I1 + (row0 + s) * DM + h * 128 + kc;
        u32x4 qa = *(const u32x4*)qr, qb = *(const u32x4*)(qr + 8), ka = *(const u32x4*)kr, kb = *(const u32x4*)(kr + 8), ia = *(const u32x4*)ir, ib = *(const u32x4*)(ir + 8);
#pragma unroll
        for (int i = 0; i < 16; ++i) {
            const unsigned qw = (i < 8) ? qa[(i & 7) >> 1] : qb[(i & 7) >> 1]; const unsigned kw = (i < 8) ? ka[(i & 7) >> 1] : kb[(i & 7) >> 1]; const unsigned iw = (i < 8) ? ia[(i & 7) >> 1] : ib[(i & 7) >> 1];
            const float qv = (i & 1) ? bfhi(qw) : bflo(qw); const float kv = (i & 1) ? bfhi(kw) : bflo(kw);
            const float bb = bs[s * 128 + kc + i];
            QH[s * HG_FS + kc + i] = f2bf(qv * __expf(bb));
            KH[s * HG_FS + kc + i] = f2bf(kv * __expf(fminf(-bb, 80.f)));
            IT[(kc + i) * HG_TS + s] = (bf16_t)((i & 1) ? (iw >> 16) : (iw & 0xffffu));
        }
    }
    __syncthreads();
    {
        const int tt = w & 3;
#pragma unroll
        for (int si = 0; si < 2; ++si) {
            const int stile = (w >> 2) * 2 + si;
            f32x4 a = {0.f, 0.f, 0.f, 0.f};
            if (stile <= tt) {
#pragma unroll
                for (int ks = 0; ks < 4; ++ks) {
                    const bf16x8 af = *(const bf16x8*)(KH + (stile * 16 + lr) * HG_FS + ks * 32 + lg * 8);
                    const bf16x8 bfr = *(const bf16x8*)(QH + (tt * 16 + lr) * HG_FS + ks * 32 + lg * 8);
                    a = MFMA16(af, bfr, a);
                }
            }
            const int t = tt * 16 + lr;
#pragma unroll
            for (int r = 0; r < 4; ++r) { const int s = stile * 16 + 4 * lg + r; if (s > t) a[r] = 0.f; }
            store_bf4(AT + t * HG_TS + stile * 16 + 4 * lg, a);
        }
    }
    __syncthreads();
    const int tt = w & 3;
    f32x4 acc[4];
#pragma unroll
    for (int j = 0; j < 4; ++j) acc[j] = (f32x4){0.f, 0.f, 0.f, 0.f};
#pragma unroll
    for (int ks = 0; ks < 2; ++ks) {
        const bf16x8 bfr = *(const bf16x8*)(AT + (tt * 16 + lr) * HG_TS + ks * 32 + lg * 8);
#pragma unroll
        for (int j = 0; j < 4; ++j) { const int vt = (w >> 2) * 4 + j; const bf16x8 af = *(const bf16x8*)(IT + (vt * 16 + lr) * HG_TS + ks * 32 + lg * 8); acc[j] = MFMA16(af, bfr, acc[j]); }
    }
    const bf16_t* STu = p.ST + (size_t)u * 16384;
#pragma unroll
    for (int ks = 0; ks < 4; ++ks) {
        const bf16x8 bfr = *(const bf16x8*)(QH + (tt * 16 + lr) * HG_FS + ks * 32 + lg * 8);
#pragma unroll
        for (int j = 0; j < 4; ++j) { const int vt = (w >> 2) * 4 + j; const bf16x8 af = *(const bf16x8*)(STu + (vt * 16 + lr) * 128 + ks * 32 + lg * 8); acc[j] = MFMA16(af, bfr, acc[j]); }
    }
    float ss = 0.f;
#pragma unroll
    for (int j = 0; j < 4; ++j)
#pragma unroll
        for (int r = 0; r < 4; ++r) ss += acc[j][r] * acc[j][r];
    ss += __shfl_xor(ss, 16, 64); ss += __shfl_xor(ss, 32, 64);
    float* red = tot;
    if (lg == 0) red[(w >> 2) * 64 + tt * 16 + lr] = ss;
    __syncthreads();
    const float rs = rsqrtf((red[tt * 16 + lr] + red[64 + tt * 16 + lr]) * (1.f / 128.f) + RMS_EPS);
    const size_t row = row0 + tt * 16 + lr;
#pragma unroll
    for (int j = 0; j < 4; ++j) {
        const int col = h * 128 + ((w >> 2) * 4 + j) * 16 + 4 * lg;
        const u32x2 gw = *(const u32x2*)(G1 + row * DM + col);
        const f32x4 ng = *(const f32x4*)(p.hgrn_norm_g + col);
        f32x4 o;
        const float gg[4] = {bflo(gw[0]), bfhi(gw[0]), bflo(gw[1]), bfhi(gw[1])};
#pragma unroll
        for (int r = 0; r < 4; ++r) o[r] = acc[j][r] * rs * ng[r] * (gg[r] * sigmoidf_(gg[r]));
        store_bf4(p.MIX + row * DM + col, o);
    }
    __syncthreads();
}
DI void hgrn_sample_unit(const Params& p, int u, char* lds) {
    float* part = (float*)lds;
    float* red = part + 512;
    const int tid = TIDX, lane = tid & 63, w = tid >> 6;
    const int b = u >> 3, h = u & 7; const size_t row = (size_t)TP + b;
    const bf16_t* Q1 = p.H; const bf16_t* KK = p.H + (size_t)MP * DM; const bf16_t* I1 = p.H + (size_t)2 * MP * DM; const bf16_t* G1 = p.H + (size_t)3 * MP * DM;
    const int v = tid & 127, kq = tid >> 7;
    const float iv = bf2f(I1[row * DM + h * 128 + v]);
    float acc = 0.f;
    const float* S0 = p.state_hgrn + (size_t)u * 16384; float* S1 = p.hgrn_sample + (size_t)u * 16384;
#pragma unroll 8
    for (int kk = 0; kk < 32; ++kk) {
        const int k = kq * 32 + kk;
        const float f = __expf((float)p.LF[row * DM + h * 128 + k]);
        const float kv = bf2f(KK[row * DM + h * 128 + k]);
        const float q = bf2f(Q1[row * DM + h * 128 + k]);
        const float st = f * S0[k * 128 + v] + kv * iv;
        S1[k * 128 + v] = st; acc += q * st;
    }
    part[kq * 128 + v] = acc;
    __syncthreads();
    float o = 0.f, sq = 0.f;
    if (tid < 128) { o = part[tid] + part[128 + tid] + part[256 + tid] + part[384 + tid]; sq = o * o; }
    sq = wave_sum(sq); if (lane == 0) red[w] = sq;
    __syncthreads();
    if (tid < 128) {
        const float rs = rsqrtf((red[0] + red[1]) * (1.f / 128.f) + RMS_EPS);
        const float g = bf2f(G1[row * DM + h * 128 + tid]);
        p.MIX[row * DM + h * 128 + tid] = f2bf(o * rs * p.hgrn_norm_g[h * 128 + tid] * (g * sigmoidf_(g)));
    }
    __syncthreads();
}

constexpr int LDS_BAR = 157824;
constexpr int LDS_BYTES = LDS_BAR + 256;

template <int LAYER> DI void peer_phases(const Params& p, char* lds, int bid, int nb, const XcdBarrier& bar) {
    REPEAT(REP_GEMM) {
        EpiBf16 epi{p.QH, 2048};
        gemm_big(p.XB, p.WT_WQ + (size_t)LAYER * 2048 * 1024, 2048, epi, lds, bid, nb);
    }
    xcd_barrier(bar);
    REPEAT(REP_TOPK) {
        { EpiF32 epi{p.S, 2048};
          for (int u = nb - 1 - bid; u < 16; u += nb) gemm_small32_unit(p.QH + u * 128, 2048, p.KB + (size_t)LAYER * 2048 * 128, 128, 128, TP, u * 128, epi); }
        for (int u = bid; u < TP / 32; u += nb) peer_topk_unit(p, LAYER, u, lds);
    }
    xcd_barrier(bar);
    REPEAT(LAYER == 1 ? REP_PEER1 : 1) peer_expert_phase(p, LAYER, lds, bid, nb, LAYER == 1);
}

__global__ void __launch_bounds__(NT, 2) mega(Params p) {
    extern __shared__ __attribute__((aligned(16))) char lds[];
    const int bid = blockIdx.x, nb = gridDim.x;
    if (TIDX == 0) *(uint4*)(lds + LDS_BAR) = make_uint4(0u, 0u, 0u, 0u);
    __syncthreads();
    XcdBarrier bar = xcd_barrier_post(p.bar, (volatile LAS unsigned*)(lds + LDS_BAR));
    REPEAT(REP_PRO) {
    for (int u = bid; u < 16 * 40; u += nb) transpose_unit(p.w_in_even, 1024, 2560, p.WT_IN_EVEN, u, lds);
    for (int u = bid; u < 16 * 16; u += nb) transpose_unit(p.w_out_even, 1024, 1024, p.WT_OUT_EVEN, u, lds);
    for (int u = bid; u < 16 * 64; u += nb) transpose_unit(p.w_in_odd, 1024, 4096, p.WT_IN_ODD, u, lds);
    for (int u = bid; u < 16 * 16; u += nb) transpose_unit(p.w_out_odd, 1024, 1024, p.WT_OUT_ODD, u, lds);
    for (int u = bid; u < 16 * 32; u += nb) transpose_unit(p.peer_wq, 1024, 2048, p.WT_WQ, u, lds);
    for (int u = bid; u < 16 * 32; u += nb) transpose_unit(p.peer_wq + (size_t)1024 * 2048, 1024, 2048, p.WT_WQ + (size_t)2048 * 1024, u, lds);
    convert_x(p, bid, nb);
    convert_keys(p, bid, nb);
    }
    xcd_barrier(bar);
    REPEAT(REP_GEMM) {
        EpiInEven epi{p.H, p.y_prompt, p.VT};
        gemm_big(p.XB, p.WT_IN_EVEN, 2560, epi, lds, bid, nb);
    }
    xcd_barrier(bar);
    REPEAT(REP_CONV) {
    for (int u = bid; u < 512; u += nb) kmean_prompt_unit(p, u);
    for (int u = bid; u < 544; u += nb) conv_unit(p, u, lds);
    }
    xcd_barrier(bar);
    {
        int bgk = 0;
        if (nb == 256) {
            { const int bh = bid >> 4, i = bid & 15; moba_prompt_unit(p, bh, i, lds, bid, bgk); moba_prompt_unit(p, bh, 31 - i, lds, bid, bgk); }
            while (bgk < 32) { bg_kmean_fore(p, bid, bgk, lds); ++bgk; }
            moba_sample_unit(p, bid, lds);
        } else {
            for (int u = bid; u < 512; u += nb) { const int bh = (u & 255) >> 4, i = u & 15; const int blk = (u < 256) ? i : 31 - i; int none = 32; moba_prompt_unit(p, bh, blk, lds, 0, none); }
            for (int u = bid; u < 256; u += nb) { __syncthreads(); for (int k = 0; k < 32; ++k) bg_kmean_fore(p, u, k, lds); moba_sample_unit(p, u, lds); }
        }
    }
    xcd_barrier(bar);
    REPEAT(REP_GEMM) {
        EpiResid epi{p.T, p.XB};
        gemm_big(p.MIX, p.WT_OUT_EVEN, 1024, epi, lds, bid, nb);
    }
    xcd_barrier(bar);
    ln_rows(p, p.ln_g, p.ln_b, bid, nb, false);
    xcd_barrier(bar);
    peer_phases<0>(p, lds, bid, nb, bar);
    xcd_barrier(bar);
    REPEAT(REP_GEMM) {
        EpiInOdd epi{p.H, p.LF, p.LB};
        gemm_big(p.XB, p.WT_IN_ODD, 4096, epi, lds, bid, nb);
    }
    xcd_barrier(bar);
    REPEAT(REP_HGRN) for (int u = bid; u < 2048 + 256; u += nb) { if (u < 2048) hgrn_b1_unit(p, u, lds); else hgrn_sample_unit(p, u - 2048, lds); }
    xcd_barrier(bar);
    REPEAT(REP_HGRN) hgrn_b2(p, bid, nb);
    xcd_barrier(bar);
    REPEAT(REP_HGRN) for (int u = bid; u < 2048; u += nb) hgrn_b3_unit(p, u, lds);
    xcd_barrier(bar);
    REPEAT(REP_GEMM) {
        EpiResid epi{p.T, p.XB};
        gemm_big(p.MIX, p.WT_OUT_ODD, 1024, epi, lds, bid, nb);
    }
    xcd_barrier(bar);
    ln_rows(p, p.ln_g + 2 * DM, p.ln_b + 2 * DM, bid, nb, false);
    xcd_barrier(bar);
    peer_phases<1>(p, lds, bid, nb, bar);
}

extern "C" void kernel_launch(void* const* d_in, const int* in_sizes, int n_in, void* d_out, int out_size, void* d_ws, size_t ws_size, hipStream_t stream) {
    Params p{};
    p.x_prompt = (const float*)d_in[0]; p.x_sample = (const float*)d_in[1]; p.cache_k = (const float*)d_in[2]; p.cache_v = (const float*)d_in[3];
    p.state_conv = (const float*)d_in[4]; p.state_hgrn = (const float*)d_in[5]; p.page_table = (const int*)d_in[6];
    p.w_in_even = (const float*)d_in[7]; p.conv_w = (const float*)d_in[8]; p.conv_b = (const float*)d_in[9]; p.conv_ln_g = (const float*)d_in[10]; p.conv_ln_b = (const float*)d_in[11];
    p.w_out_even = (const float*)d_in[12]; p.w_in_odd = (const float*)d_in[13]; p.lb_logits = (const float*)d_in[14]; p.hgrn_norm_g = (const float*)d_in[15]; p.w_out_odd = (const float*)d_in[16];
    p.ln_g = (const float*)d_in[17]; p.ln_b = (const float*)d_in[18]; p.peer_wq = (const float*)d_in[19]; p.peer_keys = (const float*)d_in[20]; p.peer_u = (const float*)d_in[21]; p.peer_v = (const float*)d_in[22];
    float* o = (float*)d_out;
    p.y_prompt = o; o += (size_t)TP * DM; p.y_sample = o; o += (size_t)TS * DM;
    p.k_prompt = o; o += (size_t)TP * 512; p.v_prompt = o; o += (size_t)TP * 512; p.k_sample = o; o += (size_t)TS * 512; p.v_sample = o; o += (size_t)TS * 512;
    p.conv_prompt = o; o += 2 * 30 * 512; p.conv_sample = o; o += 32 * 30 * 512; p.hgrn_prompt = o; o += 2 * 8 * 128 * 128; p.hgrn_sample = o;
    char* ws = (char*)d_ws; size_t off = 0;
    auto take = [&](size_t bytes) { char* r = ws + off; off += (bytes + 255) & ~(size_t)255; return r; };
    p.bar = (unsigned*)take(16384); p.LB = (float*)take(4096);
    p.WT_IN_EVEN = (bf16_t*)take((size_t)2560 * 1024 * 2); p.WT_OUT_EVEN = (bf16_t*)take((size_t)1024 * 1024 * 2);
    p.WT_IN_ODD = (bf16_t*)take((size_t)4096 * 1024 * 2); p.WT_OUT_ODD = (bf16_t*)take((size_t)1024 * 1024 * 2);
    p.WT_WQ = (bf16_t*)take((size_t)2 * 2048 * 1024 * 2); p.KB = (bf16_t*)take((size_t)2 * 2048 * 128 * 2);
    p.U8 = (unsigned char*)take((size_t)2 * 16384 * DM); p.V8 = (unsigned char*)take((size_t)2 * 16384 * DM); p.SU = (float*)take(2 * 16384 * 4); p.SV = (float*)take(2 * 16384 * 4);
    p.XB = (bf16_t*)take((size_t)MP * DM * 2);
    p.H = (bf16_t*)take((size_t)MP * 4096 * 2); p.LF = (_Float16*)take((size_t)MP * DM * 2);
    p.VT = (bf16_t*)take((size_t)16 * 64 * 8192 * 2); p.KMPP = (float*)take((size_t)512 * 512 * 4); p.KMS = (bf16_t*)take((size_t)1024 * 512 * 2);
    p.MIX = (bf16_t*)take((size_t)MP * DM * 2); p.T = (bf16_t*)take((size_t)MP * DM * 2);
    p.QH = (bf16_t*)take((size_t)MP * 2048 * 2); p.S = (float*)take((size_t)MP * 2048 * 4);
    p.E = (int*)take((size_t)MP * 128 * 4); p.G = (float*)take((size_t)MP * 128 * 4);
    p.UT = (bf16_t*)take((size_t)2048 * 16384 * 2); p.DEC = (float*)take((size_t)2048 * 128 * 4); p.ST = (bf16_t*)take((size_t)2048 * 16384 * 2);
    if (off > ws_size) { fprintf(stderr, "workspace too small: need %zu have %zu\n", off, ws_size); return; }

    static int grid = 0;
    if (!grid) {
        int dev = 0, cus = 0, per_cu = 0;
        (void)hipGetDevice(&dev);
        (void)hipDeviceGetAttribute(&cus, hipDeviceAttributeMultiprocessorCount, dev);
        (void)hipFuncSetAttribute((const void*)mega, hipFuncAttributeMaxDynamicSharedMemorySize, LDS_BYTES);
        (void)hipOccupancyMaxActiveBlocksPerMultiprocessor(&per_cu, (const void*)mega, NT, LDS_BYTES);
        grid = cus * (per_cu < 1 ? per_cu : 1);
        if (grid <= 0) { fprintf(stderr, "mega kernel not resident: cus %d per_cu %d\n", cus, per_cu); grid = 0; return; }
    }
    (void)hipMemsetAsync(p.bar, 0, XCD_BAR_WORDS * sizeof(unsigned), stream);
    hipLaunchKernelGGL(mega, dim3(grid), dim3(NT), LDS_BYTES, stream, p);
}
```
